# Optimizing an MI355X kernel written in HIP

```python
import jax, jax.numpy as jnp
from jax import lax
import numpy as np

D_MODEL = 2048
BATCH = 8
SEQ = 2048
DEPTH = 1

MEM_LEN = 256
MIX_WIDTH = D_MODEL
A_WIDTH = MIX_WIDTH // 2
A_HEAD_DIM = 128
A_HEADS = A_WIDTH // A_HEAD_DIM
CONV_K = 5
CHUNK = 64
B_WIDTH = MIX_WIDTH // 4
B_HEAD_DIM = 64
B_Q_HEADS = B_WIDTH // B_HEAD_DIM
B_KV_HEADS = B_Q_HEADS // 4
WINDOW = 128
C_WIDTH = MIX_WIDTH // 4
C_HEADS = 4
C_HEAD_DIM = C_WIDTH // C_HEADS

ROPE_THETA = 10000.0
EPS = 1e-6
IN_SIZES = (A_WIDTH, A_WIDTH, A_WIDTH, A_WIDTH, A_HEADS, A_HEADS, A_HEADS, A_HEADS,
            B_WIDTH, B_KV_HEADS * B_HEAD_DIM, B_KV_HEADS * B_HEAD_DIM, B_WIDTH,
            C_WIDTH, C_WIDTH)
IN_WIDTH = sum(IN_SIZES)

kernel_name = "hybrid_deltanet_swa_sink_memxattn_layer"

F32 = jnp.float32


def rms_norm(t, w):
    tf = t.astype(F32)
    y = tf * lax.rsqrt(jnp.mean(tf * tf, axis=-1, keepdims=True) + EPS)
    return (y * w.astype(F32)).astype(t.dtype)


def l2_norm(t):
    tf = t.astype(F32)
    return tf * lax.rsqrt(jnp.sum(tf * tf, axis=-1, keepdims=True) + EPS)


def rope(t):
    seq, d = t.shape[1], t.shape[-1]
    inv = ROPE_THETA ** (-jnp.arange(0, d, 2, dtype=F32) / d)
    ang = jnp.arange(seq, dtype=F32)[:, None] * inv[None, :]
    cos = jnp.cos(ang)[None, :, None, :]
    sin = jnp.sin(ang)[None, :, None, :]
    tf = t.astype(F32)
    t1, t2 = tf[..., : d // 2], tf[..., d // 2:]
    return jnp.concatenate([t1 * cos - t2 * sin, t2 * cos + t1 * sin], axis=-1).astype(t.dtype)


def centred_depthwise_conv(t, w):
    c = t.shape[-1]
    pad = CONV_K // 2
    return lax.conv_general_dilated(
        t, w.astype(t.dtype)[:, None, :], window_strides=(1,), padding=[(pad, pad)],
        dimension_numbers=("NWC", "WIO", "NWC"), feature_group_count=c)


def gated_delta_rule_chunked(q, k, v, g, beta):
    bsz, seq, nh, dk = q.shape
    dv = v.shape[-1]
    n = seq // CHUNK

    def to_chunks(t):
        t = t.astype(F32).reshape((bsz, n, CHUNK, nh) + t.shape[3:])
        return jnp.moveaxis(t, 3, 1)

    q = to_chunks(q) * (dk ** -0.5)
    k, v, g, beta = to_chunks(k), to_chunks(v), to_chunks(g), to_chunks(beta)
    gc = jnp.cumsum(g, axis=-1)
    idx = jnp.arange(CHUNK)
    incl = idx[:, None] >= idx[None, :]
    strict = idx[:, None] > idx[None, :]
    diff = gc[..., :, None] - gc[..., None, :]
    decay = jnp.where(incl, jnp.exp(jnp.where(incl, diff, 0.0)), 0.0)
    kb = k * beta[..., None]
    vb = v * beta[..., None]
    a = -jnp.where(strict, jnp.einsum('bhncd,bhnkd->bhnck', kb, k) * decay, 0.0)

    def fwd_sub(i, tm):
        row = tm[..., i, :]
        return tm.at[..., i, :].set(row + jnp.einsum('...j,...jk->...k', row, tm))

    tinv = lax.fori_loop(1, CHUNK, fwd_sub, a) + jnp.eye(CHUNK, dtype=F32)
    u = jnp.einsum('bhnck,bhnkd->bhncd', tinv, vb)
    w = jnp.einsum('bhnck,bhnkd->bhncd', tinv, kb * jnp.exp(gc)[..., None])
    qk = jnp.einsum('bhncd,bhnkd->bhnck', q, k) * decay
    q_dec = q * jnp.exp(gc)[..., None]
    k_dec = k * jnp.exp(gc[..., -1:] - gc)[..., None]
    chunk_decay = jnp.exp(gc[..., -1])
    xs = tuple(jnp.moveaxis(t_, 2, 0) for t_ in (u, w, qk, q_dec, k_dec, chunk_decay))

    def step(state, xs_i):
        u_i, w_i, qk_i, qd_i, kd_i, cd_i = xs_i
        v_new = u_i - jnp.einsum('bhcd,bhde->bhce', w_i, state)
        o = (jnp.einsum('bhcd,bhde->bhce', qd_i, state)
             + jnp.einsum('bhck,bhke->bhce', qk_i, v_new))
        state = state * cd_i[..., None, None] + jnp.einsum('bhcd,bhce->bhde', kd_i, v_new)
        return state, o

    s0 = jnp.zeros((bsz, nh, dk, dv), F32)
    _, o = lax.scan(step, s0, xs)
    return jnp.transpose(o, (1, 0, 3, 2, 4)).reshape(bsz, seq, nh, dv)


def windowed_gqa_with_sink(q, k, v, sink):
    bsz, seq, hq, d = q.shape
    hkv = k.shape[2]
    grp = hq // hkv
    nb = seq // WINDOW
    qb = q.reshape(bsz, nb, WINDOW, hkv, grp, d)

    def band(t):
        tp = jnp.pad(t, ((0, 0), (WINDOW, WINDOW), (0, 0), (0, 0)))
        tp = tp.reshape(bsz, nb + 2, WINDOW, hkv, d)
        return jnp.concatenate([tp[:, :-2], tp[:, 1:-1], tp[:, 2:]], axis=2)

    kw, vw = band(k), band(v)
    s = jnp.einsum('bnqhgd,bnkhd->bnhgqk', qb, kw).astype(F32) * (d ** -0.5)
    i = jnp.arange(WINDOW)
    j = jnp.arange(3 * WINDOW)
    blk = jnp.arange(nb)
    rel = j[None, :] - WINDOW - i[:, None]
    kpos = blk[:, None] * WINDOW - WINDOW + j[None, :]
    mask = (jnp.abs(rel) <= WINDOW)[None] & ((kpos >= 0) & (kpos < seq))[:, None, :]
    mask = mask[None, :, None, None]
    s = jnp.where(mask, s, -jnp.inf)
    sink_l = sink.astype(F32).reshape(1, 1, hkv, grp, 1, 1)
    m = jnp.maximum(jnp.max(s, axis=-1, keepdims=True), sink_l)
    p = jnp.exp(s - m)
    p = p / (jnp.sum(p, axis=-1, keepdims=True) + jnp.exp(sink_l - m))
    o = jnp.einsum('bnhgqk,bnkhd->bnqhgd', p.astype(v.dtype), vw)
    return o.reshape(bsz, seq, hq, d)


def memory_cross_attention(q, k, v):
    d = q.shape[-1]
    s = jnp.einsum('bshd,bmhd->bhsm', q, k).astype(F32) * (d ** -0.5)
    p = jax.nn.softmax(s, axis=-1)
    return jnp.einsum('bhsm,bmhd->bshd', p.astype(v.dtype), v)


def hybrid_layer(h, mem, norm_w, w_in, conv_w_a, a_log_fwd, a_log_bwd, dt_bias_fwd,
                 dt_bias_bwd, o_norm_a, q_norm_b, k_norm_b, sink_b, mem_norm_w, w_mem_kv,
                 q_norm_c, k_norm_c, w_out):
    bsz, seq, _ = h.shape
    hn = rms_norm(h, norm_w)
    proj = hn @ w_in.astype(hn.dtype)
    (qa, ka, va, za, alpha_f, alpha_b, beta_f, beta_b,
     qb, kb, vb, zb, qc, zc) = jnp.split(proj, np.cumsum(IN_SIZES)[:-1].tolist(), axis=-1)

    qkv = jax.nn.silu(centred_depthwise_conv(jnp.concatenate([qa, ka, va], axis=-1), conv_w_a))
    qa, ka, va = jnp.split(qkv, 3, axis=-1)
    qa = l2_norm(qa.reshape(bsz, seq, A_HEADS, A_HEAD_DIM))
    ka = l2_norm(ka.reshape(bsz, seq, A_HEADS, A_HEAD_DIM))
    va = va.reshape(bsz, seq, A_HEADS, A_HEAD_DIM).astype(F32)
    g_f = -jnp.exp(a_log_fwd.astype(F32)) * jax.nn.softplus(alpha_f.astype(F32) + dt_bias_fwd.astype(F32))
    g_b = -jnp.exp(a_log_bwd.astype(F32)) * jax.nn.softplus(alpha_b.astype(F32) + dt_bias_bwd.astype(F32))
    bt_f = jax.nn.sigmoid(beta_f.astype(F32))
    bt_b = jax.nn.sigmoid(beta_b.astype(F32))
    flip = lambda t: jnp.flip(t, axis=1)
    o_fwd = gated_delta_rule_chunked(qa, ka, va, g_f, bt_f)
    o_bwd = flip(gated_delta_rule_chunked(flip(qa), flip(ka), flip(va), flip(g_b), flip(bt_b)))
    o_a = rms_norm((o_fwd + o_bwd).astype(h.dtype), o_norm_a).reshape(bsz, seq, A_WIDTH)
    o_a = o_a * jax.nn.silu(za)

    qb = rope(rms_norm(qb.reshape(bsz, seq, B_Q_HEADS, B_HEAD_DIM), q_norm_b))
    kb = rope(rms_norm(kb.reshape(bsz, seq, B_KV_HEADS, B_HEAD_DIM), k_norm_b))
    vb = vb.reshape(bsz, seq, B_KV_HEADS, B_HEAD_DIM)
    o_b = windowed_gqa_with_sink(qb, kb, vb, sink_b).reshape(bsz, seq, B_WIDTH)
    o_b = o_b * jax.nn.silu(zb)

    mn = rms_norm(mem, mem_norm_w)
    kv_m = mn @ w_mem_kv.astype(mn.dtype)
    km, vm = jnp.split(kv_m, 2, axis=-1)
    mlen = mem.shape[1]
    km = rms_norm(km.reshape(bsz, mlen, C_HEADS, C_HEAD_DIM), k_norm_c)
    vm = vm.reshape(bsz, mlen, C_HEADS, C_HEAD_DIM)
    qc = rms_norm(qc.reshape(bsz, seq, C_HEADS, C_HEAD_DIM), q_norm_c)
    o_c = memory_cross_attention(qc, km, vm).reshape(bsz, seq, C_WIDTH)
    o_c = o_c * jax.nn.silu(zc)

    mixed = jnp.concatenate([o_a.astype(h.dtype), o_b.astype(h.dtype), o_c.astype(h.dtype)], axis=-1)
    return h + mixed @ w_out.astype(h.dtype)


def setup_inputs(seed: int = 0) -> dict:
    key = jax.random.key(seed)
    ks = jax.random.split(key, 20)
    nrm = lambda k_, shape: jax.random.normal(k_, shape, F32)
    x = nrm(ks[0], (BATCH, SEQ, D_MODEL))
    mem = nrm(ks[1], (BATCH, MEM_LEN, D_MODEL))
    norm_w = 1.0 + 0.02 * nrm(ks[2], (DEPTH, D_MODEL))
    w_in = nrm(ks[3], (DEPTH, D_MODEL, IN_WIDTH)) * D_MODEL ** -0.5
    conv_w_a = nrm(ks[4], (DEPTH, CONV_K, 3 * A_WIDTH)) * CONV_K ** -0.5
    a_log_fwd = jnp.log(jax.random.uniform(ks[5], (DEPTH, A_HEADS), F32, 1.0, 16.0))
    a_log_bwd = jnp.log(jax.random.uniform(ks[6], (DEPTH, A_HEADS), F32, 1.0, 16.0))
    dt_f = jnp.exp(jax.random.uniform(ks[7], (DEPTH, A_HEADS), F32, jnp.log(1e-3), jnp.log(1e-1)))
    dt_b = jnp.exp(jax.random.uniform(ks[8], (DEPTH, A_HEADS), F32, jnp.log(1e-3), jnp.log(1e-1)))
    dt_bias_fwd = dt_f + jnp.log(-jnp.expm1(-dt_f))
    dt_bias_bwd = dt_b + jnp.log(-jnp.expm1(-dt_b))
    o_norm_a = 1.0 + 0.02 * nrm(ks[9], (DEPTH, A_HEAD_DIM))
    q_norm_b = 1.0 + 0.02 * nrm(ks[10], (DEPTH, B_HEAD_DIM))
    k_norm_b = 1.0 + 0.02 * nrm(ks[11], (DEPTH, B_HEAD_DIM))
    sink_b = 0.5 * nrm(ks[12], (DEPTH, B_Q_HEADS))
    mem_norm_w = 1.0 + 0.02 * nrm(ks[13], (DEPTH, D_MODEL))
    w_mem_kv = nrm(ks[14], (DEPTH, D_MODEL, 2 * C_WIDTH)) * D_MODEL ** -0.5
    q_norm_c = 1.0 + 0.02 * nrm(ks[15], (DEPTH, C_HEAD_DIM))
    k_norm_c = 1.0 + 0.02 * nrm(ks[16], (DEPTH, C_HEAD_DIM))
    w_out = nrm(ks[17], (DEPTH, MIX_WIDTH, D_MODEL)) * MIX_WIDTH ** -0.5
    return {"x": x, "mem": mem, "norm_w": norm_w, "w_in": w_in, "conv_w_a": conv_w_a,
            "a_log_fwd": a_log_fwd, "a_log_bwd": a_log_bwd, "dt_bias_fwd": dt_bias_fwd,
            "dt_bias_bwd": dt_bias_bwd, "o_norm_a": o_norm_a, "q_norm_b": q_norm_b,
            "k_norm_b": k_norm_b, "sink_b": sink_b, "mem_norm_w": mem_norm_w,
            "w_mem_kv": w_mem_kv, "q_norm_c": q_norm_c, "k_norm_c": k_norm_c, "w_out": w_out}


def reference(x, mem, norm_w, w_in, conv_w_a, a_log_fwd, a_log_bwd, dt_bias_fwd, dt_bias_bwd,
              o_norm_a, q_norm_b, k_norm_b, sink_b, mem_norm_w, w_mem_kv, q_norm_c, k_norm_c,
              w_out):
    h = x
    for l in range(DEPTH):
        h = hybrid_layer(h, mem, norm_w[l], w_in[l], conv_w_a[l], a_log_fwd[l], a_log_bwd[l],
                         dt_bias_fwd[l], dt_bias_bwd[l], o_norm_a[l], q_norm_b[l], k_norm_b[l],
                         sink_b[l], mem_norm_w[l], w_mem_kv[l], q_norm_c[l], k_norm_c[l], w_out[l])
    return h
```

```cpp
#include <hip/hip_runtime.h>
#include <cstdio>
#include <cstdint>
namespace pg8 {
#define PG8_LAS __attribute__((address_space(3)))
typedef unsigned short bf16_t;
typedef short bf16x8 __attribute__((ext_vector_type(8)));
typedef float f32x4 __attribute__((ext_vector_type(4)));
typedef unsigned u32x4 __attribute__((ext_vector_type(4)));
constexpr int BM = 256, BK = 64, HALF = 128, HTB = HALF * BK * 2  , STAGE_BYTES = 8 * HTB, NXCD = 8, WGM = 8;

__host__ __device__ __forceinline__ int lds_byte(int r, int c) { const int st = (r >> 4) * 2 + (c >> 5), rr = r & 15, cc = c & 31, ob = rr * 64 + cc * 2; return st * 1024 + (ob ^ (((ob >> 9) & 1) << 5)); }
__host__ __device__ __forceinline__ void stage_rc(int b, int& R, int& C) { const int st = b / 1024, sb = b % 1024, swz = sb ^ (((sb >> 9) & 1) << 5); R = (st >> 1) * 16 + swz / 64; C = (st & 1) * 32 + (swz % 64) / 2; }
__host__ __device__ __forceinline__ int perm32(int rho) { const int n = rho >> 4, i = rho & 15; return 8 * (i >> 2) + 4 * n + (i & 3); }

struct Unit { int pm, pn; };
struct Gemm { const bf16_t* A; const bf16_t* Bt; int M, N, K; };

struct StaticOrder {
    int nM, nN, nwg, G, c;
    __host__ __device__ void init(int M, int N, int G_, int c_) { nM = M / BM; nN = N / BM; nwg = nM * nN; G = G_; c = c_; }
    __host__ __device__ bool next(int i, Unit& u) const {
        const long L = (long)i * G + c; if (L >= nwg) return false;
        int wgid = (int)L; { const int q = nwg / NXCD, r = nwg % NXCD, xcd = wgid % NXCD, off = wgid / NXCD; wgid = (xcd < r ? xcd * (q + 1) : r * (q + 1) + (xcd - r) * q) + off; }
        const int nig = WGM * nN, gid = wgid / nig, fm = gid * WGM, gsz = (nM - fm) < WGM ? (nM - fm) : WGM;
        u.pm = fm + ((wgid % nig) % gsz); u.pn = (wgid % nig) / gsz; return true;
    }
    __device__ __forceinline__ void a_ready(const Unit&) const {}
    __device__ __forceinline__ void done(const Unit&) const {}
};

typedef float f32x2 __attribute__((ext_vector_type(2)));
typedef __bf16 bf16x2_t __attribute__((ext_vector_type(2)));
__device__ __forceinline__ unsigned cvt_pk_bf16(float lo, float hi) { f32x2 v = {lo, hi}; bf16x2_t b = __builtin_convertvector(v, bf16x2_t); return __builtin_bit_cast(unsigned, b); }
__device__ __forceinline__ float silu_f(float v) { return v * __builtin_amdgcn_rcpf(1.0f + __expf(-v)); }

struct EpiIn {
    static constexpr bool PERM = true, AFTER_DRAIN = false;
    bf16_t *PA, *PB, *PC, *MIX, *KVM; float* GATES;
    __device__ __forceinline__ void operator()(const f32x4 (&acc)[2][2][4][2], const Unit& u, int wr, int wc, int fr, int fq) const {
        const int row0 = u.pm * BM + wr * 64 + fr, cl = wc * 32 + 8 * fq, pn = u.pn;
        if (u.pm < 64 && pn == 25) {
            if (wc == 0) {
#pragma unroll
                for (int ai = 0; ai < 2; ++ai)
#pragma unroll
                    for (int m = 0; m < 4; ++m) { float* g = GATES + (size_t)(row0 + ai * HALF + m * 16) * 32 + 8 * fq;
                        *(f32x4*)g = acc[ai][0][m][0]; *(f32x4*)(g + 4) = acc[ai][0][m][1]; }
            }
            return;
        }
        bf16_t* base; int ldc; bool act = false;
        if (u.pm >= 64) { base = KVM + (size_t)(row0 - 16384) * 1024 + (pn - 26) * 256; ldc = 1024; }
        else if (pn < 12) { base = PA + (size_t)row0 * 3072 + pn * 256; ldc = 3072; }
        else if (pn < 16) { base = MIX + (size_t)row0 * 2048 + (pn - 12) * 256; ldc = 2048; act = true; }
        else if (pn < 19) { base = PB + (size_t)row0 * 768 + (pn - 16) * 256; ldc = 768; }
        else if (pn < 21) { base = MIX + (size_t)row0 * 2048 + 1024 + (pn - 19) * 256; ldc = 2048; act = true; }
        else if (pn < 23) { base = PC + (size_t)row0 * 512 + (pn - 21) * 256; ldc = 512; }
        else { base = MIX + (size_t)row0 * 2048 + 1536 + (pn - 23) * 256; ldc = 2048; act = true; }
        base += cl;
#pragma unroll
        for (int ai = 0; ai < 2; ++ai)
#pragma unroll
            for (int m = 0; m < 4; ++m) { bf16_t* rowp = base + (size_t)(ai * HALF + m * 16) * ldc;
#pragma unroll
                for (int bj = 0; bj < 2; ++bj) { f32x4 v0 = acc[ai][bj][m][0], v1 = acc[ai][bj][m][1];
                    if (act) { v0 = (f32x4){silu_f(v0[0]), silu_f(v0[1]), silu_f(v0[2]), silu_f(v0[3])}; v1 = (f32x4){silu_f(v1[0]), silu_f(v1[1]), silu_f(v1[2]), silu_f(v1[3])}; }
                    u32x4 w; w.x = cvt_pk_bf16(v0[0], v0[1]); w.y = cvt_pk_bf16(v0[2], v0[3]); w.z = cvt_pk_bf16(v1[0], v1[1]); w.w = cvt_pk_bf16(v1[2], v1[3]);
                    *(u32x4*)(rowp + bj * HALF) = w; } }
    }
};
struct EpiOut {
    static constexpr bool PERM = false, AFTER_DRAIN = false;
    const float* X; float* O;
    __device__ __forceinline__ void operator()(const f32x4 (&acc)[2][2][4][2], const Unit& u, int wr, int wc, int fr, int fq) const {
        const int row0 = u.pm * BM + wr * 64 + fr, col0 = u.pn * BM + wc * 32 + 4 * fq;
#pragma unroll
        for (int ai = 0; ai < 2; ++ai)
#pragma unroll
            for (int m = 0; m < 4; ++m) { const size_t off = (size_t)(row0 + ai * HALF + m * 16) * 2048 + col0;
#pragma unroll
                for (int bj = 0; bj < 2; ++bj)
#pragma unroll
                    for (int n = 0; n < 2; ++n) { const f32x4 xv = *(const f32x4*)(X + off + bj * HALF + n * 16); *(f32x4*)(O + off + bj * HALF + n * 16) = xv + acc[ai][bj][m][n]; } }
    }
};
struct InOrder {
    StaticOrder base; int G, c;
    __host__ __device__ void init(int G_, int c_) { G = G_; c = c_; base.init(16384, 6656, G_, c_); }
    __host__ __device__ bool next(int i, Unit& u) const {
        const long L = (long)i * G + c;
        if (L < base.nwg) return base.next(i, u);
        const int j = (int)(L - base.nwg); if (j >= 32) return false;
        u.pm = 64 + (j >> 2); u.pn = 26 + (j & 3); return true;
    }
    __device__ __forceinline__ void a_ready(const Unit&) const {}
    __device__ __forceinline__ void done(const Unit&) const {}
};

template <class Epi, class Sched, bool ALIGN_EPI = false, bool SP2 = false>
__device__ __forceinline__ void gemm_phase(PG8_LAS unsigned char* lds, const Gemm g, const Sched& S, const Epi& E) {
    const int tid = threadIdx.x, wid = __builtin_amdgcn_readfirstlane(tid >> 6), lane = tid & 63, wr = wid >> 2, wc = wid & 3, fr = lane & 15, fq = lane >> 4;
    const int K = g.K, nt = K / BK;
    unsigned voffA[2], voffB[2];
#pragma unroll
    for (int i = 0; i < 2; ++i) { int R, C; stage_rc(tid * 16 + i * 8192, R, C); const int Rb = Epi::PERM ? ((R & ~31) + perm32(R & 31)) : R;
        voffA[i] = (unsigned)(R * K + C) * 2u; voffB[i] = (unsigned)(Rb * K + C) * 2u; }
    const size_t kstep = (size_t)(BK * 2);
    const size_t hstep = (size_t)HALF * K * 2;
    const size_t tstep = 2 * hstep;
    const unsigned ldsw = (unsigned)wid * 1024u;
    const int aoff = lds_byte(wr * 64 + fr, fq * 8), boff = lds_byte(wc * 32 + fr, fq * 8);
#define PG8_SA(b, h) (((b) * 2 + (h)) * HTB)
#define PG8_SB(b, h) ((4 + (b) * 2 + (h)) * HTB)
#define PG8_STAGE(bufoff, gbase, voff) do { _Pragma("unroll") for (int _i = 0; _i < 2; ++_i) \
        __builtin_amdgcn_global_load_lds((const unsigned*)((const char*)(gbase) + (voff)[_i]), (PG8_LAS unsigned*)(lds + (bufoff) + ldsw + _i * 8192), 16, 0, 0); } while (0)
#define PG8_LDA(dst, b, h) do { _Pragma("unroll") for (int m = 0; m < 4; ++m) _Pragma("unroll") for (int k = 0; k < 2; ++k) dst[m][k] = *(const PG8_LAS bf16x8*)(lds + PG8_SA(b, h) + aoff + m * 2048 + k * 1024); } while (0)
#define PG8_LDB(dst, b, h) do { _Pragma("unroll") for (int n = 0; n < 2; ++n) _Pragma("unroll") for (int k = 0; k < 2; ++k) dst[n][k] = *(const PG8_LAS bf16x8*)(lds + PG8_SB(b, h) + boff + n * 2048 + k * 1024); } while (0)
#define PG8_MMA(ai, bj, At, Bt) do { __builtin_amdgcn_s_setprio(1); _Pragma("unroll") for (int m = 0; m < 4; ++m) _Pragma("unroll") for (int n = 0; n < 2; ++n) _Pragma("unroll") for (int k = 0; k < 2; ++k) \
        acc[ai][bj][m][n] = __builtin_amdgcn_mfma_f32_16x16x32_bf16(Bt[n][k], At[m][k], acc[ai][bj][m][n], 0, 0, 0); __builtin_amdgcn_s_setprio(0); } while (0)
#define PG8_WAIT_V(n) asm volatile("s_waitcnt vmcnt(" #n ")" ::: "memory")
#define PG8_WAIT_L(n) asm volatile("s_waitcnt lgkmcnt(" #n ")" ::: "memory")
#define PG8_BAR __builtin_amdgcn_s_barrier()
#define PG8_SCHED __builtin_amdgcn_sched_barrier(0)
    Unit cur, nxt; int ui = 0;
    if (!S.next(0, cur)) return;
    f32x4 acc[2][2][4][2];
#pragma unroll
    for (int a = 0; a < 2; ++a)
#pragma unroll
        for (int b = 0; b < 2; ++b)
#pragma unroll
            for (int m = 0; m < 4; ++m)
#pragma unroll
                for (int n = 0; n < 2; ++n) acc[a][b][m][n] = (f32x4){0.f, 0.f, 0.f, 0.f};
    bf16x8 At[4][2], B0[2][2], B1[2][2];
    const char* cA = (const char*)g.A + (size_t)cur.pm * tstep; const char* cB = (const char*)g.Bt + (size_t)cur.pn * tstep;
    S.a_ready(cur);
    if constexpr (SP2) {
        PG8_STAGE(PG8_SB(0, 0), cB, voffB); PG8_STAGE(PG8_SB(0, 1), cB + hstep, voffB); PG8_STAGE(PG8_SA(0, 0), cA, voffA); PG8_STAGE(PG8_SA(0, 1), cA + hstep, voffA);
        if (wr == 1) PG8_BAR;
        PG8_WAIT_V(2); PG8_BAR;
        PG8_STAGE(PG8_SB(1, 0), cB + kstep, voffB); PG8_STAGE(PG8_SA(1, 0), cA + kstep, voffA); PG8_STAGE(PG8_SB(1, 1), cB + hstep + kstep, voffB);
        PG8_WAIT_V(6); PG8_BAR;
    } else {
        PG8_STAGE(PG8_SB(0, 0), cB, voffB); PG8_STAGE(PG8_SA(0, 0), cA, voffA); PG8_STAGE(PG8_SB(0, 1), cB + hstep, voffB); PG8_STAGE(PG8_SA(0, 1), cA + hstep, voffA);
        if (wr == 1) PG8_BAR;
        PG8_WAIT_V(4); PG8_BAR;
        PG8_STAGE(PG8_SB(1, 0), cB + kstep, voffB); PG8_STAGE(PG8_SA(1, 0), cA + kstep, voffA); PG8_STAGE(PG8_SB(1, 1), cB + hstep + kstep, voffB);
        PG8_WAIT_V(6); PG8_BAR;
    }
    for (;;) {
        const bool has_next = S.next(ui + 1, nxt);
        const char* nA = has_next ? (const char*)g.A + (size_t)nxt.pm * tstep : cA; const char* nB = has_next ? (const char*)g.Bt + (size_t)nxt.pn * tstep : cB;
        for (int t = 0; t < nt; t += 2) {
            const bool last = (t == nt - 2);
            const char* a1 = cA + (size_t)(t + 1) * kstep;
            const char* a2 = last ? nA : cA + (size_t)(t + 2) * kstep; const char* b2 = last ? nB : cB + (size_t)(t + 2) * kstep;
            const char* a3 = a2 + kstep; const char* b3 = b2 + kstep;
            if (last && has_next) S.a_ready(nxt);
            if constexpr (SP2) {
            PG8_LDB(B0, 0, 0); PG8_LDB(B1, 0, 1); PG8_SCHED; PG8_LDA(At, 0, 0); PG8_STAGE(PG8_SA(1, 1), a1 + hstep, voffA);
            PG8_WAIT_V(8); PG8_WAIT_L(0); PG8_BAR; PG8_MMA(0, 0, At, B0); PG8_MMA(0, 1, At, B1); PG8_BAR; PG8_SCHED;
            PG8_LDA(At, 0, 1); PG8_STAGE(PG8_SB(0, 0), b2, voffB); PG8_STAGE(PG8_SB(0, 1), b2 + hstep, voffB); PG8_STAGE(PG8_SA(0, 0), a2, voffA);
            PG8_WAIT_V(8); PG8_WAIT_L(0); PG8_BAR; PG8_MMA(1, 0, At, B0); PG8_MMA(1, 1, At, B1); PG8_BAR; PG8_SCHED;
            PG8_LDB(B0, 1, 0); PG8_LDB(B1, 1, 1); PG8_SCHED; PG8_LDA(At, 1, 0); PG8_STAGE(PG8_SA(0, 1), a2 + hstep, voffA);
            PG8_WAIT_V(8); PG8_WAIT_L(0); PG8_BAR; PG8_MMA(0, 0, At, B0); PG8_MMA(0, 1, At, B1); PG8_BAR; PG8_SCHED;
            PG8_LDA(At, 1, 1); PG8_STAGE(PG8_SB(1, 0), b3, voffB); PG8_STAGE(PG8_SB(1, 1), b3 + hstep, voffB); PG8_STAGE(PG8_SA(1, 0), a3, voffA);
            PG8_WAIT_V(8); PG8_WAIT_L(0); PG8_BAR; PG8_MMA(1, 0, At, B0); PG8_MMA(1, 1, At, B1); PG8_BAR; PG8_SCHED;
            } else {
            PG8_LDB(B0, 0, 0); PG8_SCHED; PG8_LDA(At, 0, 0); PG8_STAGE(PG8_SA(1, 1), a1 + hstep, voffA);
            PG8_WAIT_L(8); PG8_BAR; PG8_WAIT_L(0); PG8_MMA(0, 0, At, B0); PG8_BAR; PG8_SCHED;
            PG8_LDB(B1, 0, 1); PG8_STAGE(PG8_SB(0, 0), b2, voffB);
            PG8_BAR; PG8_WAIT_L(0); PG8_MMA(0, 1, At, B1); PG8_BAR;
            PG8_LDA(At, 0, 1); PG8_STAGE(PG8_SA(0, 0), a2, voffA);
            PG8_BAR; PG8_WAIT_L(0); PG8_MMA(1, 0, At, B0); PG8_BAR; PG8_SCHED;
            PG8_STAGE(PG8_SB(0, 1), b2 + hstep, voffB);
            PG8_WAIT_V(6); PG8_BAR; PG8_MMA(1, 1, At, B1); PG8_BAR;
            PG8_LDB(B0, 1, 0); PG8_SCHED; PG8_LDA(At, 1, 0); PG8_STAGE(PG8_SA(0, 1), a2 + hstep, voffA);
            PG8_WAIT_L(8); PG8_BAR; PG8_WAIT_L(0); PG8_MMA(0, 0, At, B0); PG8_BAR; PG8_SCHED;
            PG8_LDB(B1, 1, 1); PG8_STAGE(PG8_SB(1, 0), b3, voffB);
            PG8_BAR; PG8_WAIT_L(0); PG8_MMA(0, 1, At, B1); PG8_BAR;
            PG8_LDA(At, 1, 1); PG8_STAGE(PG8_SA(1, 0), a3, voffA);
            PG8_BAR; PG8_WAIT_L(0); PG8_MMA(1, 0, At, B0); PG8_BAR; PG8_SCHED;
            PG8_STAGE(PG8_SB(1, 1), b3 + hstep, voffB);
            PG8_WAIT_V(6); PG8_BAR; PG8_MMA(1, 1, At, B1); PG8_BAR;
            }
        }
        if constexpr (ALIGN_EPI) { if (wr == 0) PG8_BAR; }
        if constexpr (!Epi::AFTER_DRAIN) { E(acc, cur, wr, wc, fr, fq); S.done(cur); }
        if (!has_next) break;
#pragma unroll
        for (int a = 0; a < 2; ++a)
#pragma unroll
            for (int b = 0; b < 2; ++b)
#pragma unroll
                for (int m = 0; m < 4; ++m)
#pragma unroll
                    for (int n = 0; n < 2; ++n) acc[a][b][m][n] = (f32x4){0.f, 0.f, 0.f, 0.f};
        cur = nxt; cA = nA; cB = nB; ++ui;
        if constexpr (ALIGN_EPI) { if (wr == 1) PG8_BAR; }
    }
    PG8_WAIT_V(0);
    if constexpr (!ALIGN_EPI) { if (wr == 0) PG8_BAR; }
    PG8_BAR;
    if constexpr (Epi::AFTER_DRAIN) { E.fused(acc, cur, wr, wc, fr, fq, lds, wid, lane); S.done(cur); }
#undef PG8_SA
#undef PG8_SB
#undef PG8_STAGE
#undef PG8_LDA
#undef PG8_LDB
#undef PG8_MMA
#undef PG8_WAIT_V
#undef PG8_WAIT_L
#undef PG8_BAR
#undef PG8_SCHED
}
}
#define GAS __attribute__((address_space(1)))
#define LAS __attribute__((address_space(3)))
typedef unsigned short bf16;
typedef unsigned v4u __attribute__((ext_vector_type(4)));
typedef float f32x4 __attribute__((ext_vector_type(4)));
typedef short bf16x8 __attribute__((ext_vector_type(8)));
typedef GAS unsigned gu32;
typedef GAS unsigned long long gu64;
#define RLX_AGENT __ATOMIC_RELAXED, __HIP_MEMORY_SCOPE_AGENT
#define LDS_WAIT() asm volatile("s_waitcnt lgkmcnt(0)" ::: "memory")
#define VM_WAIT() asm volatile("s_waitcnt vmcnt(0)" ::: "memory")
__device__ __forceinline__ unsigned long long rt() { return __builtin_amdgcn_s_memrealtime(); }
__device__ __forceinline__ unsigned f2bf(float f) { unsigned u = __builtin_bit_cast(unsigned, f); return (u + 0x7fffu + ((u >> 16) & 1u)) >> 16; }
__device__ __forceinline__ unsigned pk2(float lo, float hi) { return f2bf(lo) | (f2bf(hi) << 16); }

#define XB_TMO      128
#define XB_XCNT(j)  (256  + 64 * (j))
#define XB_XSUB(j)  (1280 + 64 * (j))
#define XB_XGEN(j)  (2304 + 64 * (j))
#define XB_TOP      3328
#define XB_TOPGEN   3392
#define XCD_BAR_WORDS 3456
#define XB_SPIN_CAP (1u << 18)

__device__ __forceinline__ unsigned xb_ld(unsigned* p)              { return __hip_atomic_load(p, __ATOMIC_RELAXED, __HIP_MEMORY_SCOPE_AGENT); }
__device__ __forceinline__ unsigned xb_add(unsigned* p, unsigned v) { return __hip_atomic_fetch_add(p, v, __ATOMIC_RELAXED, __HIP_MEMORY_SCOPE_AGENT); }
__device__ __forceinline__ unsigned xb_xcc_id() { return (unsigned)__builtin_amdgcn_s_getreg((3 << 11) | 20) & 0xFu; }
#define XB_SPIN(cond, bar) do { unsigned _sp = 0; while (cond) { __builtin_amdgcn_s_sleep(1); \
    if ((++_sp & 255u) == 0u) { if (xb_ld(&(bar)[XB_TMO])) break; if (_sp > XB_SPIN_CAP) { atomicAdd(&(bar)[XB_TMO], 1u); break; } } } } while (0)

struct XcdBarrier {
    unsigned* bar; unsigned x;
    volatile LAS unsigned* st;
};

__device__ __forceinline__ XcdBarrier xcd_barrier_post(unsigned* bar, volatile LAS unsigned* st) {
    XcdBarrier b; b.bar = bar; b.x = xb_xcc_id(); b.st = st;
    if (threadIdx.x == 0) (void)xb_add(&bar[XB_XCNT(b.x)], 1u);
    return b;
}
__device__ __forceinline__ void xcd_barrier_complete(unsigned* bar, unsigned x, unsigned& nloc, unsigned& nx) {
    const unsigned G = gridDim.x * gridDim.y * gridDim.z;
    unsigned sum, cnt, mine, sp = 0u;
    for (;;) {
        sum = 0u; cnt = 0u; mine = 0u;
#pragma unroll
        for (unsigned j = 0; j < 16; ++j) { const unsigned c = xb_ld(&bar[XB_XCNT(j)]); sum += c; cnt += (c > 0u) ? 1u : 0u; mine = (j == x) ? c : mine; }
        if (sum == G) break;
        __builtin_amdgcn_s_sleep(1);
        if ((++sp & 255u) == 0u) { if (xb_ld(&bar[XB_TMO])) break; if (sp > XB_SPIN_CAP) { atomicAdd(&bar[XB_TMO], 1u); break; } }
    }
    nloc = mine > 0u ? mine : 1u; nx = cnt > 0u ? cnt : 1u;
}

__device__ __forceinline__ void xcd_barrier(const XcdBarrier& b) {
    asm volatile("s_waitcnt vmcnt(0)" ::: "memory");
    __syncthreads();
    if (threadIdx.x == 0) {
        unsigned* bar = b.bar;
        __builtin_amdgcn_s_waitcnt(0);
        unsigned nloc = b.st[0], nx = b.st[1];
        if (nloc == 0u) { xcd_barrier_complete(bar, b.x, nloc, nx); b.st[0] = nloc; b.st[1] = nx; }
        const unsigned old = xb_add(&bar[XB_XSUB(b.x)], 1u);
        const unsigned gen = old / nloc;
        if (old + 1u == (gen + 1u) * nloc) {
            __builtin_amdgcn_fence(__ATOMIC_RELEASE, "agent");
            asm volatile("s_waitcnt vmcnt(0)" ::: "memory");
            const unsigned og = xb_add(&bar[XB_TOP], 1u);
            const unsigned tg = og / nx;
            if (og + 1u == (tg + 1u) * nx) xb_add(&bar[XB_TOPGEN], 1u);
            else XB_SPIN(xb_ld(&bar[XB_TOPGEN]) == tg, bar);
            __builtin_amdgcn_fence(__ATOMIC_ACQUIRE, "agent");
            xb_add(&bar[XB_XGEN(b.x)], 1u);
            asm volatile("s_waitcnt vmcnt(0)" ::: "memory");
        } else {
            XB_SPIN(xb_ld(&bar[XB_XGEN(b.x)]) == gen, bar);
            __builtin_amdgcn_fence(__ATOMIC_ACQUIRE, "agent");
            asm volatile("s_waitcnt vmcnt(0)" ::: "memory");
        }
    }
    __syncthreads();
}
constexpr int NWAVES = 8;
#ifndef MK_N_LAUNCHES
#define MK_N_LAUNCHES 1
#endif
constexpr int N_LAUNCHES = MK_N_LAUNCHES;
constexpr int PER_PHASE = 6;

constexpr int NBATCH = 8, SEQ = 2048, DMODEL = 2048, M = NBATCH * SEQ;
constexpr int MEMLEN = 256;
constexpr int NIN = 6432;
constexpr float EPS = 1e-6f;
constexpr float LOG2E = 1.4426950408889634f;

constexpr size_t MiB = 1u << 20;
constexpr size_t WS_CTL = 0, CTL_ZERO_BYTES = 1 * MiB;
constexpr size_t WS_WOUT = 1 * MiB;
constexpr size_t WS_WIN = 9 * MiB, WS_WMEM = 35 * MiB;
constexpr size_t WS_XN = 39 * MiB, WS_MEMN = 103 * MiB;
constexpr size_t WS_PA = 111 * MiB;
constexpr size_t WS_PB = 207 * MiB;
constexpr size_t WS_PC = 231 * MiB;
constexpr size_t WS_MIX = 247 * MiB;
constexpr size_t WS_GATES = 311 * MiB;
constexpr size_t WS_KVM = 313 * MiB;
constexpr size_t WS_ROPE = 317 * MiB;
constexpr size_t WS_CD = 317 * MiB + 512 * 1024;
constexpr size_t WS_UT = 318 * MiB, WS_WNEG = 382 * MiB, WS_QDEC = 446 * MiB;
constexpr size_t WS_KDECT = 9 * MiB, WS_QKM = 73 * MiB;
constexpr size_t WS_OF = 111 * MiB, WS_OB = 143 * MiB;
constexpr size_t WS_END = 510 * MiB;
constexpr int CW_TMO = 0, CW_CODE = 1, CW_BAR = 4096;

constexpr int RING_OFF = 0, RING_BYTES = 147456;
constexpr int LDSCTL_OFF = RING_BYTES, MISC_OFF = LDSCTL_OFF + 320;
constexpr int LDS_BYTES = 148480;
static_assert(MISC_OFF + 128 <= LDS_BYTES, "LDS map");

#define DI __device__ __forceinline__
typedef short s16x4 __attribute__((ext_vector_type(4)));
typedef unsigned u32x2 __attribute__((ext_vector_type(2)));
typedef float f32x2v __attribute__((ext_vector_type(2)));
#define MFMA16(a, b, c) __builtin_amdgcn_mfma_f32_16x16x32_bf16((a), (b), (c), 0, 0, 0)
DI unsigned cvtpk(float lo, float hi) { return pg8::cvt_pk_bf16(lo, hi); }
DI float bflo(unsigned v) { return __uint_as_float(v << 16); }
DI float bfhi(unsigned v) { return __uint_as_float(v & 0xffff0000u); }
DI float wave_sum(float v) {
#pragma unroll
    for (int o = 1; o < 64; o <<= 1) v += __shfl_xor(v, o);
    return v;
}
DI float silu_f(float v) { return pg8::silu_f(v); }
DI float softplus_f(float x) { return x > 20.f ? x : log1pf(expf(x)); }
DI float sigmoid_f(float x) { return 1.0f / (1.0f + expf(-x)); }
DI int perm32k(int k) { return (k & ~31) | (((k >> 2) & 3) << 3) | (((k >> 4) & 1) << 2) | (k & 3); }
typedef short v4i16_t __attribute__((ext_vector_type(4)));
DI s16x4 vtr(const LAS unsigned char* p) { return __builtin_bit_cast(s16x4, __builtin_amdgcn_ds_read_tr16_b64_v4i16((LAS v4i16_t*)p)); }
DI bf16x8 tr_frag(const LAS unsigned char* lo, int hi_off) { const s16x4 a = vtr(lo), b = vtr(lo + hi_off); return (bf16x8){a[0], a[1], a[2], a[3], b[0], b[1], b[2], b[3]}; }
DI bf16x8 ld_frag(const LAS unsigned char* p) { return *(const LAS bf16x8*)p; }
DI bf16x8 pack8(const f32x4& a, const f32x4& b) { v4u w; w.x = cvtpk(a[0], a[1]); w.y = cvtpk(a[2], a[3]); w.z = cvtpk(b[0], b[1]); w.w = cvtpk(b[2], b[3]); return __builtin_bit_cast(bf16x8, w); }

struct Frame {
    LAS unsigned char* lds;
    volatile LAS unsigned* MISC;
    gu32* ctl;
    int tid, lane, wave;
    int vcu, G;
    const float *x, *mem, *norm_w, *w_in, *conv_w, *a_log_f, *a_log_b, *dt_f, *dt_b, *o_norm_a, *q_norm_b, *k_norm_b, *sink_b, *mem_norm_w, *w_mem_kv, *q_norm_c, *k_norm_c, *w_out;
    float* out;
    bf16 *WinT, *WmemT, *WoutT, *XN, *MEMN, *PA, *PB, *PC, *MIX, *KVM, *UT, *WNEG, *QDEC, *KDECT, *QKM, *OF, *OB;
    float *GATES, *ROPE, *CD;
};

DI void p0_transpose_item(const float* W, int K, int N, bf16* WT, int k0, int n0, int drow0, LAS float* scr, int lane) {
#pragma unroll 8
    for (int i = 0; i < 32; ++i) { const int kk = 2 * i + (lane >> 5); scr[kk * 33 + (lane & 31)] = W[(size_t)(k0 + kk) * N + n0 + (lane & 31)]; }
    LDS_WAIT(); asm volatile("" ::: "memory");
    const int c = lane & 7;
#pragma unroll
    for (int j = 0; j < 4; ++j) { const int n = (lane >> 3) + 8 * j; const LAS float* s = scr + (8 * c) * 33 + n;
        v4u o; o.x = pk2(s[0 * 33], s[1 * 33]); o.y = pk2(s[2 * 33], s[3 * 33]); o.z = pk2(s[4 * 33], s[5 * 33]); o.w = pk2(s[6 * 33], s[7 * 33]);
        *(GAS v4u*)(WT + (size_t)(drow0 + n) * K + k0 + 8 * c) = o; }
    LDS_WAIT(); asm volatile("" ::: "memory");
}
DI void rms_row_to_bf16(const float* xrow, const float* w, bf16* orow, int lane) {
    const GAS f32x4* xr = (const GAS f32x4*)xrow + lane; const GAS f32x4* wr = (const GAS f32x4*)w + lane;
    f32x4 v[8]; float s = 0.f;
#pragma unroll
    for (int j = 0; j < 8; ++j) { v[j] = xr[64 * j]; s += (v[j].x * v[j].x + v[j].y * v[j].y) + (v[j].z * v[j].z + v[j].w * v[j].w); }
    const float rstd = 1.0f / sqrtf(wave_sum(s) * (1.0f / 2048.0f) + EPS);
    GAS unsigned long long* o8 = (GAS unsigned long long*)orow + lane;
#pragma unroll
    for (int j = 0; j < 8; ++j) { const f32x4 wv = wr[64 * j]; const f32x4 y = v[j] * rstd * wv;
        o8[64 * j] = (unsigned long long)cvtpk(y.x, y.y) | ((unsigned long long)cvtpk(y.z, y.w) << 32); }
}
DI void p0_prologue(Frame& F) {
    LAS float* scr = (LAS float*)(F.lds + RING_OFF + F.wave * 16384);
    const int gw = F.vcu * NWAVES + F.wave, NGW = F.G * NWAVES;
    constexpr int I_IN = 32 * 201, I_MEM = 32 * 32, I_OUT = 32 * 64, NITEMS = I_IN + I_MEM + I_OUT;
    for (int it = gw; it < NITEMS; it += NGW) {
        int r = it;
        if (r < I_IN) { const int kb = r / 201, sb = r % 201, n0 = 32 * sb; const int drow = n0 < 4096 ? n0 : (n0 < 4128 ? 6400 + (n0 - 4096) : n0 - 32);
            p0_transpose_item(F.w_in, 2048, NIN, F.WinT, 64 * kb, n0, drow, scr, F.lane); continue; }
        r -= I_IN;
        if (r < I_MEM) { p0_transpose_item(F.w_mem_kv, 2048, 1024, F.WmemT, 64 * (r / 32), 32 * (r % 32), 32 * (r % 32), scr, F.lane); continue; }
        r -= I_MEM;
        p0_transpose_item(F.w_out, 2048, 2048, F.WoutT, 64 * (r / 64), 32 * (r % 64), 32 * (r % 64), scr, F.lane);
    }
    { GAS v4u* z = (GAS v4u*)(F.WinT + (size_t)NIN * 2048); const int gt = F.vcu * 512 + F.tid, NT = F.G * 512;
      for (int i = gt; i < 224 * 256; i += NT) z[i] = (v4u){0u, 0u, 0u, 0u}; }
    for (int m = gw; m < M; m += NGW) rms_row_to_bf16(F.x + (size_t)m * DMODEL, F.norm_w, F.XN + (size_t)m * DMODEL, F.lane);
    for (int m = gw; m < NBATCH * MEMLEN; m += NGW) rms_row_to_bf16(F.mem + (size_t)m * DMODEL, F.mem_norm_w, F.MEMN + (size_t)m * DMODEL, F.lane);
    { const int gt = F.vcu * 512 + F.tid, NT = F.G * 512;
      for (int i = gt; i < SEQ * 32; i += NT) { const int pos = i >> 5, fi = i & 31; const float inv = powf(10000.0f, -(float)(2 * fi) / 64.0f); const float ang = (float)pos * inv;
          F.ROPE[2 * i] = cosf(ang); F.ROPE[2 * i + 1] = sinf(ang); } }
}

constexpr int A_QH = 0, A_KH = 18432, A_VV = 36864, A_LF = 55296, A_LB = 72704, A_T1F = 90112, A_T2F = 99328, A_T1B = 108544, A_T2B = 117760, A_GV = 126976;
static_assert(A_GV + 2048 <= RING_BYTES, "A-prep LDS");
DI void a_prep_item(Frame& F, int b, int h, int c) {
    const int tid = F.tid, lane = F.lane, wave = F.wave; (void)tid;
    LAS unsigned char* L = F.lds + RING_OFF;
    LAS float* GV = (LAS float*)(L + A_GV);
    const int item_f = ((b * 8 + h) * 2) * 32 + c, item_b = item_f + 32;
    const size_t m0 = (size_t)b * SEQ + (size_t)c * 64;
    if (wave == 0) {
        const float* gr = F.GATES + (m0 + lane) * 32;
        const float af = gr[h], ab = gr[8 + h], bf_ = gr[16 + h], bb = gr[24 + h];
        const float gf = -expf(F.a_log_f[h]) * softplus_f(af + F.dt_f[h]);
        const float gb = -expf(F.a_log_b[h]) * softplus_f(ab + F.dt_b[h]);
        float pf = gf, pb = gb;
#pragma unroll
        for (int o = 1; o < 64; o <<= 1) { const float tf = __shfl_up(pf, o), tb = __shfl_up(pb, o); if (lane >= o) { pf += tf; pb += tb; } }
        const float totf = __shfl(pf, 63), totb = __shfl(pb, 63);
        const float gcf = pf, gcb = totb - pb + gb;
        GV[lane] = gcf; GV[64 + lane] = gcb; GV[128 + lane] = sigmoid_f(bf_); GV[192 + lane] = sigmoid_f(bb);
        GV[256 + lane] = expf(gcf); GV[320 + lane] = expf(gcb); GV[384 + lane] = expf(totf - gcf); GV[448 + lane] = expf(totb - gcb);
        if (lane == 0) { F.CD[item_f] = expf(totf); F.CD[item_b] = expf(totb); }
    }
    __syncthreads();
#ifndef ASUB
#define ASUB 15
#endif
    if (ASUB & 1) {
        const int i0 = 8 * wave;
        float w[5][3][2];
#pragma unroll
        for (int k = 0; k < 5; ++k)
#pragma unroll
            for (int p = 0; p < 3; ++p) { const f32x2v wv = *(const f32x2v*)(F.conv_w + k * 3072 + p * 1024 + h * 128 + 2 * lane); w[k][p][0] = wv.x; w[k][p][1] = wv.y; }
        float x[12][3][2];
#pragma unroll
        for (int r = 0; r < 12; ++r) { const int t = c * 64 + i0 - 2 + r; const bool valid = (t >= 0) && (t < SEQ);
#pragma unroll
            for (int p = 0; p < 3; ++p) { unsigned v = 0u; if (valid) v = *(const unsigned*)(F.PA + ((size_t)b * SEQ + t) * 3072 + p * 1024 + h * 128 + 2 * lane); x[r][p][0] = bflo(v); x[r][p][1] = bfhi(v); } }
        float kdf_[8][2], kdb_[8][2];
#pragma unroll
        for (int ii = 0; ii < 8; ++ii) { const int pos = i0 + ii; float o[3][2];
#pragma unroll
            for (int p = 0; p < 3; ++p)
#pragma unroll
                for (int e = 0; e < 2; ++e) { float a = 0.f;
#pragma unroll
                    for (int k = 0; k < 5; ++k) a += x[ii + k][p][e] * w[k][p][e];
                    o[p][e] = silu_f(a); }
            const float ssq = wave_sum(o[0][0] * o[0][0] + o[0][1] * o[0][1]), ssk = wave_sum(o[1][0] * o[1][0] + o[1][1] * o[1][1]);
            const float rq = (1.0f / sqrtf(ssq + EPS)) * 0.08838834764831845f, rk = 1.0f / sqrtf(ssk + EPS);
            const float q0 = o[0][0] * rq, q1 = o[0][1] * rq, k0 = o[1][0] * rk, k1 = o[1][1] * rk;
            *(LAS unsigned*)(L + A_QH + pos * 288 + 4 * lane) = cvtpk(q0, q1);
            *(LAS unsigned*)(L + A_KH + pos * 288 + 4 * lane) = cvtpk(k0, k1);
            *(LAS unsigned*)(L + A_VV + pos * 288 + 4 * lane) = cvtpk(o[2][0], o[2][1]);
            const float egf = GV[256 + pos], egb = GV[320 + pos], kf = GV[384 + pos], kb = GV[448 + pos];
            const int pd = perm32k(2 * lane);
            *(unsigned*)(F.QDEC + ((size_t)item_f * 64 + pos) * 128 + pd) = cvtpk(q0 * egf, q1 * egf);
            *(unsigned*)(F.QDEC + ((size_t)item_b * 64 + pos) * 128 + pd) = cvtpk(q0 * egb, q1 * egb);
            kdf_[ii][0] = k0 * kf; kdf_[ii][1] = k1 * kf; kdb_[ii][0] = k0 * kb; kdb_[ii][1] = k1 * kb; }
#pragma unroll
        for (int e = 0; e < 2; ++e)
#pragma unroll
            for (int hh = 0; hh < 2; ++hh) { const int pp = perm32k(i0 + 4 * hh); const size_t d = 2 * lane + e;
                u32x2 vf, vb; vf.x = cvtpk(kdf_[4 * hh][e], kdf_[4 * hh + 1][e]); vf.y = cvtpk(kdf_[4 * hh + 2][e], kdf_[4 * hh + 3][e]);
                vb.x = cvtpk(kdb_[4 * hh][e], kdb_[4 * hh + 1][e]); vb.y = cvtpk(kdb_[4 * hh + 2][e], kdb_[4 * hh + 3][e]);
                *(u32x2*)(F.KDECT + ((size_t)item_f * 128 + d) * 64 + pp) = vf; *(u32x2*)(F.KDECT + ((size_t)item_b * 128 + d) * 64 + pp) = vb; }
    }
    __syncthreads();
    if (ASUB & 2) {
        const int mat = wave >> 2, tm = wave & 3, r16 = lane & 15, g = lane >> 4;
        f32x4 acc[4];
#pragma unroll
        for (int tn = 0; tn < 4; ++tn) acc[tn] = (f32x4){0.f, 0.f, 0.f, 0.f};
        const LAS unsigned char* Ab = L + A_KH + (16 * tm + r16) * 288 + g * 16;
        const LAS unsigned char* Bb = L + (mat ? A_QH : A_KH) + r16 * 288 + g * 16;
#pragma unroll
        for (int ks = 0; ks < 4; ++ks) { const bf16x8 a = ld_frag(Ab + ks * 64);
#pragma unroll
            for (int tn = 0; tn < 4; ++tn) acc[tn] = MFMA16(a, ld_frag(Bb + tn * 16 * 288 + ks * 64), acc[tn]); }
        if (mat == 0) {
            LAS float* LF = (LAS float*)(L + A_LF); LAS float* LB = (LAS float*)(L + A_LB);
#pragma unroll
            for (int tn = 0; tn < 4; ++tn) { const int j = 16 * tn + r16; const float gcfj = GV[j], gcbj = GV[64 + j];
#pragma unroll
                for (int reg = 0; reg < 4; ++reg) { const int i = 16 * tm + 4 * g + reg; const float G = acc[tn][reg];
                    const float lf = (j < i) ? GV[128 + i] * G * __expf(fminf(GV[i] - gcfj, 0.f)) : 0.f;
                    const float lb = (j > i) ? GV[192 + i] * G * __expf(fminf(GV[64 + i] - gcbj, 0.f)) : 0.f;
                    LF[i * 68 + j] = lf; LB[(63 - i) * 68 + (63 - j)] = lb; } }
        } else {
#pragma unroll
            for (int tn = 0; tn < 4; ++tn) { const int i = 16 * tn + r16; const float gcfi = GV[i], gcbi = GV[64 + i]; float qf[4], qb[4];
#pragma unroll
                for (int reg = 0; reg < 4; ++reg) { const int j = 16 * tm + 4 * g + reg; const float v = acc[tn][reg];
                    qf[reg] = (j <= i) ? v * __expf(fminf(gcfi - GV[j], 0.f)) : 0.f;
                    qb[reg] = (j >= i) ? v * __expf(fminf(gcbi - GV[64 + j], 0.f)) : 0.f; }
                const int idx = 32 * (tm >> 1) + 8 * g + 4 * (tm & 1);
                u32x2 vf, vb; vf.x = cvtpk(qf[0], qf[1]); vf.y = cvtpk(qf[2], qf[3]); vb.x = cvtpk(qb[0], qb[1]); vb.y = cvtpk(qb[2], qb[3]);
                *(u32x2*)(F.QKM + ((size_t)item_f * 64 + i) * 64 + idx) = vf; *(u32x2*)(F.QKM + ((size_t)item_b * 64 + i) * 64 + idx) = vb; }
        }
    }
    __syncthreads();
    if ((ASUB & 4) && wave < 2) {
        int lane_o = lane; asm volatile("" : "+v"(lane_o));
        const LAS float* Lm = (const LAS float*)(L + (wave ? A_LB : A_LF)) + lane_o; const LAS float* Lb = (const LAS float*)(L + (wave ? A_LB : A_LF));
        float t[64];
#pragma unroll
        for (int i = 0; i < 64; ++i) {
            float s = (lane_o == i) ? 1.f : 0.f;
#pragma unroll
            for (int k4 = 0; k4 < i; k4 += 4) { const f32x4 lv = *(const LAS f32x4*)(Lb + i * 68 + k4);
#pragma unroll
                for (int e = 0; e < 4; ++e) if (k4 + e < i) s -= lv[e] * t[k4 + e]; }
            t[i] = s; __builtin_amdgcn_sched_barrier(0);
        }
        if (wave == 0) { const float bj = GV[128 + lane_o], ej = GV[256 + lane_o]; LAS bf16* T1 = (LAS bf16*)(L + A_T1F) + lane_o; LAS bf16* T2 = (LAS bf16*)(L + A_T2F) + lane_o;
#pragma unroll
            for (int i = 0; i < 64; ++i) { const float v = t[i] * bj; const unsigned pk = cvtpk(v, v * ej); T1[i * 72] = (bf16)(pk & 0xffffu); T2[i * 72] = (bf16)(pk >> 16); __builtin_amdgcn_sched_barrier(0); }
        } else { const int j = 63 - lane_o; const float bj = GV[192 + j], ej = GV[320 + j]; LAS bf16* T1 = (LAS bf16*)(L + A_T1B) + j; LAS bf16* T2 = (LAS bf16*)(L + A_T2B) + j;
#pragma unroll
            for (int ip = 0; ip < 64; ++ip) { const float v = t[ip] * bj; const unsigned pk = cvtpk(v, v * ej); T1[(63 - ip) * 72] = (bf16)(pk & 0xffffu); T2[(63 - ip) * 72] = (bf16)(pk >> 16); __builtin_amdgcn_sched_barrier(0); }
        }
    }
    __syncthreads();
    if (ASUB & 8) {
        const int dir = wave >> 2, ti = wave & 3, r16 = lane & 15, g = lane >> 4, q4 = r16 >> 2, p4 = r16 & 3;
        const LAS unsigned char* T1 = L + (dir ? A_T1B : A_T1F); const LAS unsigned char* T2 = L + (dir ? A_T2B : A_T2F);
        const int item = dir ? item_b : item_f;
        bf16x8 a1[2], a2[2];
#pragma unroll
        for (int ks = 0; ks < 2; ++ks) { a1[ks] = ld_frag(T1 + (16 * ti + r16) * 144 + ks * 64 + g * 16); a2[ks] = ld_frag(T2 + (16 * ti + r16) * 144 + ks * 64 + g * 16); }
#pragma unroll
        for (int te = 0; te < 8; ++te) { f32x4 acc = (f32x4){0.f, 0.f, 0.f, 0.f};
#pragma unroll
            for (int ks = 0; ks < 2; ++ks) acc = MFMA16(a1[ks], tr_frag(L + A_VV + ((32 * ks + 8 * g + q4) * 144 + 16 * te + 4 * p4) * 2, 4 * 288), acc);
            u32x2 o; o.x = cvtpk(acc[0], acc[1]); o.y = cvtpk(acc[2], acc[3]);
            *(u32x2*)(F.UT + ((size_t)item * 128 + 16 * te + r16) * 64 + 16 * ti + 4 * g) = o; __builtin_amdgcn_sched_barrier(0); }
#pragma unroll
        for (int td = 0; td < 8; ++td) { f32x4 acc = (f32x4){0.f, 0.f, 0.f, 0.f};
#pragma unroll
            for (int ks = 0; ks < 2; ++ks) acc = MFMA16(tr_frag(L + A_KH + ((32 * ks + 8 * g + q4) * 144 + 16 * td + 4 * p4) * 2, 4 * 288), a2[ks], acc);
            u32x2 o; o.x = cvtpk(-acc[0], -acc[1]); o.y = cvtpk(-acc[2], -acc[3]);
            *(u32x2*)(F.WNEG + ((size_t)item * 64 + 16 * ti + r16) * 128 + 32 * (td >> 1) + 8 * g + 4 * (td & 1)) = o; __builtin_amdgcn_sched_barrier(0); }
    }
    __syncthreads();
}

constexpr int B_KB = 0, B_VB = 55296;
DI void b_attn_unit(Frame& F, int b, int nb, int kvh) {
    const int tid = F.tid, lane = F.lane, wave = F.wave;
    LAS unsigned char* L = F.lds + RING_OFF;
#pragma unroll
    for (int it = 0; it < 6; ++it) { const int q = tid + 512 * it, row = q >> 3, cc = q & 7; const int t = (nb - 1) * 128 + row; const bool valid = (t >= 0) && (t < SEQ);
        v4u kv = (v4u){0u, 0u, 0u, 0u}, vv = (v4u){0u, 0u, 0u, 0u};
        if (valid) { const bf16* rp = F.PB + ((size_t)b * SEQ + t) * 768 + 512 + kvh * 64 + 8 * cc; kv = *(const v4u*)rp; vv = *(const v4u*)(rp + 128); }
        float xk[8]; xk[0] = bflo(kv.x); xk[1] = bfhi(kv.x); xk[2] = bflo(kv.y); xk[3] = bfhi(kv.y); xk[4] = bflo(kv.z); xk[5] = bfhi(kv.z); xk[6] = bflo(kv.w); xk[7] = bfhi(kv.w);
        float ss = 0.f;
#pragma unroll
        for (int e = 0; e < 8; ++e) ss += xk[e] * xk[e];
        ss += __shfl_xor(ss, 1); ss += __shfl_xor(ss, 2); ss += __shfl_xor(ss, 4);
        const float rstd = 1.0f / sqrtf(ss * (1.0f / 64.0f) + EPS);
        const int tt = valid ? t : 0; float o[8];
#pragma unroll
        for (int e = 0; e < 8; ++e) { const float y = xk[e] * rstd * F.k_norm_b[8 * cc + e]; const float pr = __shfl_xor(y, 4);
            const f32x2v cs = *(const f32x2v*)(F.ROPE + ((size_t)tt * 32 + ((8 * cc + e) & 31)) * 2);
            o[e] = (cc < 4) ? (y * cs.x - pr * cs.y) : (y * cs.x + pr * cs.y); }
        v4u ok; ok.x = cvtpk(o[0], o[1]); ok.y = cvtpk(o[2], o[3]); ok.z = cvtpk(o[4], o[5]); ok.w = cvtpk(o[6], o[7]);
        if (!valid) ok = (v4u){0u, 0u, 0u, 0u};
        *(LAS v4u*)(L + B_KB + row * 144 + cc * 16) = ok; *(LAS v4u*)(L + B_VB + row * 144 + cc * 16) = vv; }
    if (tid < 128) *(LAS v4u*)(L + B_VB + (384 + (tid >> 3)) * 144 + (tid & 7) * 16) = (v4u){0u, 0u, 0u, 0u};
    __syncthreads();
    const int hq = kvh * 4 + (wave >> 1), r16 = lane & 15, g = lane >> 4, q4 = r16 >> 2, p4 = r16 & 3;
    const float sk = F.sink_b[hq] * LOG2E;
#pragma unroll 1
    for (int qt = 0; qt < 4; ++qt) {
        const int i0 = (wave & 1) * 64 + 16 * qt, iq = i0 + r16, pos = nb * 128 + iq; const size_t m = (size_t)b * SEQ + pos;
        bf16x8 qf[2];
        { const bf16* qp = F.PB + m * 768 + hq * 64 + 8 * g; const v4u a = *(const v4u*)qp, c2 = *(const v4u*)(qp + 32);
          float x0[8], x1[8]; x0[0] = bflo(a.x); x0[1] = bfhi(a.x); x0[2] = bflo(a.y); x0[3] = bfhi(a.y); x0[4] = bflo(a.z); x0[5] = bfhi(a.z); x0[6] = bflo(a.w); x0[7] = bfhi(a.w);
          x1[0] = bflo(c2.x); x1[1] = bfhi(c2.x); x1[2] = bflo(c2.y); x1[3] = bfhi(c2.y); x1[4] = bflo(c2.z); x1[5] = bfhi(c2.z); x1[6] = bflo(c2.w); x1[7] = bfhi(c2.w);
          float ss = 0.f;
#pragma unroll
          for (int e = 0; e < 8; ++e) ss += x0[e] * x0[e] + x1[e] * x1[e];
          ss += __shfl_xor(ss, 16); ss += __shfl_xor(ss, 32);
          const float rstd = (1.0f / sqrtf(ss * (1.0f / 64.0f) + EPS));
          float o0[8], o1[8];
#pragma unroll
          for (int e = 0; e < 8; ++e) { const float y0 = x0[e] * rstd * F.q_norm_b[8 * g + e], y1 = x1[e] * rstd * F.q_norm_b[32 + 8 * g + e];
              const f32x2v cs = *(const f32x2v*)(F.ROPE + ((size_t)pos * 32 + 8 * g + e) * 2);
              o0[e] = (y0 * cs.x - y1 * cs.y) * (0.125f * LOG2E); o1[e] = (y1 * cs.x + y0 * cs.y) * (0.125f * LOG2E); }
          v4u w0, w1; w0.x = cvtpk(o0[0], o0[1]); w0.y = cvtpk(o0[2], o0[3]); w0.z = cvtpk(o0[4], o0[5]); w0.w = cvtpk(o0[6], o0[7]);
          w1.x = cvtpk(o1[0], o1[1]); w1.y = cvtpk(o1[2], o1[3]); w1.z = cvtpk(o1[4], o1[5]); w1.w = cvtpk(o1[6], o1[7]);
          qf[0] = __builtin_bit_cast(bf16x8, w0); qf[1] = __builtin_bit_cast(bf16x8, w1); }
        f32x4 st[18];
#pragma unroll
        for (int c = 0; c < 17; ++c) { f32x4 acc = (f32x4){0.f, 0.f, 0.f, 0.f};
#pragma unroll
            for (int s = 0; s < 2; ++s) acc = MFMA16(ld_frag(L + B_KB + (i0 + 16 * c + r16) * 144 + s * 64 + g * 16), qf[s], acc);
            st[c] = acc; __builtin_amdgcn_sched_barrier(0); }
        st[17] = (f32x4){0.f, 0.f, 0.f, 0.f};
        float mx = sk;
#pragma unroll
        for (int c = 0; c < 17; ++c)
#pragma unroll
            for (int reg = 0; reg < 4; ++reg) { const int j = i0 + 16 * c + 4 * g + reg; const int kpos = (nb - 1) * 128 + j;
                const bool ok = (j >= iq) && (j <= iq + 256) && (kpos >= 0) && (kpos < SEQ);
                const float v = ok ? st[c][reg] : -INFINITY; st[c][reg] = v; mx = fmaxf(mx, v); }
        mx = fmaxf(mx, __shfl_xor(mx, 16)); mx = fmaxf(mx, __shfl_xor(mx, 32));
        float sum = 0.f;
#pragma unroll
        for (int c = 0; c < 17; ++c)
#pragma unroll
            for (int reg = 0; reg < 4; ++reg) { const float p = __builtin_amdgcn_exp2f(st[c][reg] - mx); st[c][reg] = p; sum += p; }
        sum += __shfl_xor(sum, 16); sum += __shfl_xor(sum, 32);
        const float inv = 1.0f / (sum + __builtin_amdgcn_exp2f(sk - mx));
        bf16x8 pb[9];
#pragma unroll
        for (int kp = 0; kp < 9; ++kp) pb[kp] = pack8(st[2 * kp], st[2 * kp + 1]);
#pragma unroll
        for (int td = 0; td < 4; ++td) { f32x4 acc = (f32x4){0.f, 0.f, 0.f, 0.f};
#pragma unroll
            for (int kp = 0; kp < 9; ++kp) acc = MFMA16(tr_frag(L + B_VB + ((i0 + 32 * kp + 4 * g + q4) * 72 + 16 * td + 4 * p4) * 2, 16 * 144), pb[kp], acc);
            bf16* mp = F.MIX + m * 2048 + 1024 + hq * 64 + 16 * td + 4 * g; const u32x2 z = *(const u32x2*)mp;
            u32x2 o; o.x = cvtpk(acc[0] * inv * bflo(z.x), acc[1] * inv * bfhi(z.x)); o.y = cvtpk(acc[2] * inv * bflo(z.y), acc[3] * inv * bfhi(z.y));
            *(u32x2*)mp = o; __builtin_amdgcn_sched_barrier(0); }
    }
    __syncthreads();
}

constexpr int C_KC = 0, C_VC = 69632;
DI void c_attn_unit(Frame& F, int b, int hc, int qblk) {
    const int tid = F.tid, lane = F.lane, wave = F.wave;
    LAS unsigned char* L = F.lds + RING_OFF;
#pragma unroll
    for (int it = 0; it < 8; ++it) { const int q = tid + 512 * it, row = q >> 4, cc = q & 15;
        const bf16* rp = F.KVM + ((size_t)b * MEMLEN + row) * 1024 + hc * 128 + 8 * cc; const v4u kv = *(const v4u*)rp, vv = *(const v4u*)(rp + 512);
        float xk[8]; xk[0] = bflo(kv.x); xk[1] = bfhi(kv.x); xk[2] = bflo(kv.y); xk[3] = bfhi(kv.y); xk[4] = bflo(kv.z); xk[5] = bfhi(kv.z); xk[6] = bflo(kv.w); xk[7] = bfhi(kv.w);
        float ss = 0.f;
#pragma unroll
        for (int e = 0; e < 8; ++e) ss += xk[e] * xk[e];
        ss += __shfl_xor(ss, 1); ss += __shfl_xor(ss, 2); ss += __shfl_xor(ss, 4); ss += __shfl_xor(ss, 8);
        const float rstd = 1.0f / sqrtf(ss * (1.0f / 128.0f) + EPS);
        float o[8];
#pragma unroll
        for (int e = 0; e < 8; ++e) o[e] = xk[e] * rstd * F.k_norm_c[8 * cc + e];
        v4u ok; ok.x = cvtpk(o[0], o[1]); ok.y = cvtpk(o[2], o[3]); ok.z = cvtpk(o[4], o[5]); ok.w = cvtpk(o[6], o[7]);
        *(LAS v4u*)(L + C_KC + row * 272 + cc * 16) = ok; *(LAS v4u*)(L + C_VC + row * 272 + cc * 16) = vv; }
    __syncthreads();
    const int r16 = lane & 15, g = lane >> 4, q4 = r16 >> 2, p4 = r16 & 3;
#pragma unroll 1
    for (int qt = 0; qt < 2; ++qt) {
        const size_t m = (size_t)b * SEQ + qblk * 256 + wave * 32 + qt * 16 + r16;
        bf16x8 qf[4];
        { float xs[4][8]; float ss = 0.f;
#pragma unroll
          for (int s = 0; s < 4; ++s) { const v4u a = *(const v4u*)(F.PC + m * 512 + hc * 128 + 32 * s + 8 * g);
              xs[s][0] = bflo(a.x); xs[s][1] = bfhi(a.x); xs[s][2] = bflo(a.y); xs[s][3] = bfhi(a.y); xs[s][4] = bflo(a.z); xs[s][5] = bfhi(a.z); xs[s][6] = bflo(a.w); xs[s][7] = bfhi(a.w);
#pragma unroll
              for (int e = 0; e < 8; ++e) ss += xs[s][e] * xs[s][e]; }
          ss += __shfl_xor(ss, 16); ss += __shfl_xor(ss, 32);
          const float rstd = (1.0f / sqrtf(ss * (1.0f / 128.0f) + EPS)) * (0.08838834764831845f * LOG2E);
#pragma unroll
          for (int s = 0; s < 4; ++s) { float o[8];
#pragma unroll
              for (int e = 0; e < 8; ++e) o[e] = xs[s][e] * rstd * F.q_norm_c[32 * s + 8 * g + e];
              v4u w0; w0.x = cvtpk(o[0], o[1]); w0.y = cvtpk(o[2], o[3]); w0.z = cvtpk(o[4], o[5]); w0.w = cvtpk(o[6], o[7]); qf[s] = __builtin_bit_cast(bf16x8, w0); } }
        f32x4 st[16];
#pragma unroll
        for (int c = 0; c < 16; ++c) { f32x4 acc = (f32x4){0.f, 0.f, 0.f, 0.f};
#pragma unroll
            for (int s = 0; s < 4; ++s) acc = MFMA16(ld_frag(L + C_KC + (16 * c + r16) * 272 + s * 64 + g * 16), qf[s], acc);
            st[c] = acc; __builtin_amdgcn_sched_barrier(0); }
        float mx = -INFINITY;
#pragma unroll
        for (int c = 0; c < 16; ++c)
#pragma unroll
            for (int reg = 0; reg < 4; ++reg) mx = fmaxf(mx, st[c][reg]);
        mx = fmaxf(mx, __shfl_xor(mx, 16)); mx = fmaxf(mx, __shfl_xor(mx, 32));
        float sum = 0.f;
#pragma unroll
        for (int c = 0; c < 16; ++c)
#pragma unroll
            for (int reg = 0; reg < 4; ++reg) { const float p = __builtin_amdgcn_exp2f(st[c][reg] - mx); st[c][reg] = p; sum += p; }
        sum += __shfl_xor(sum, 16); sum += __shfl_xor(sum, 32);
        const float inv = 1.0f / sum;
        bf16x8 pb[8];
#pragma unroll
        for (int kp = 0; kp < 8; ++kp) pb[kp] = pack8(st[2 * kp], st[2 * kp + 1]);
#pragma unroll
        for (int td = 0; td < 8; ++td) { f32x4 acc = (f32x4){0.f, 0.f, 0.f, 0.f};
#pragma unroll
            for (int kp = 0; kp < 8; ++kp) acc = MFMA16(tr_frag(L + C_VC + ((32 * kp + 4 * g + q4) * 136 + 16 * td + 4 * p4) * 2, 16 * 272), pb[kp], acc);
            bf16* mp = F.MIX + m * 2048 + 1536 + hc * 128 + 16 * td + 4 * g; const u32x2 z = *(const u32x2*)mp;
            u32x2 o; o.x = cvtpk(acc[0] * inv * bflo(z.x), acc[1] * inv * bfhi(z.x)); o.y = cvtpk(acc[2] * inv * bflo(z.y), acc[3] * inv * bfhi(z.y));
            *(u32x2*)mp = o; __builtin_amdgcn_sched_barrier(0); }
    }
    __syncthreads();
}

constexpr int S_WN = 0, S_QD = 18432, S_KT = 36864, S_QK = 55296, S_BUF = 64512;
static_assert(2 * S_BUF <= RING_BYTES, "scan LDS");
DI void scan_unit(Frame& F, int bh, int dir, int half) {
    const int tid = F.tid, lane = F.lane, wave = F.wave;
    LAS unsigned char* L = F.lds + RING_OFF;
    const int b = bh >> 3, h = bh & 7;
    const int item0 = (bh * 2 + dir) * 32;
    const int r16 = lane & 15, g = lane >> 4;
    const int lt = tid - 256;
    f32x4 S[8];
#pragma unroll
    for (int td = 0; td < 8; ++td) S[td] = (f32x4){0.f, 0.f, 0.f, 0.f};
    v4u ld[14];
#define SC_LOAD(n_) do { const size_t it_ = (size_t)(item0 + (n_)); \
        _Pragma("unroll") for (int i_ = 0; i_ < 4; ++i_) { const int q_ = lt + 256 * i_; ld[i_] = *(const v4u*)(F.WNEG + it_ * 8192 + (size_t)q_ * 8); ld[4 + i_] = *(const v4u*)(F.QDEC + it_ * 8192 + (size_t)q_ * 8); ld[8 + i_] = *(const v4u*)(F.KDECT + it_ * 8192 + (size_t)q_ * 8); } \
        _Pragma("unroll") for (int i_ = 0; i_ < 2; ++i_) { const int q_ = lt + 256 * i_; ld[12 + i_] = *(const v4u*)(F.QKM + it_ * 4096 + (size_t)q_ * 8); } } while (0)
#define SC_WRITE(bufo_) do { LAS unsigned char* B_ = L + (bufo_); \
        _Pragma("unroll") for (int i_ = 0; i_ < 4; ++i_) { const int q_ = lt + 256 * i_; *(LAS v4u*)(B_ + S_WN + (q_ >> 4) * 288 + (q_ & 15) * 16) = ld[i_]; *(LAS v4u*)(B_ + S_QD + (q_ >> 4) * 288 + (q_ & 15) * 16) = ld[4 + i_]; *(LAS v4u*)(B_ + S_KT + (q_ >> 3) * 144 + (q_ & 7) * 16) = ld[8 + i_]; } \
        _Pragma("unroll") for (int i_ = 0; i_ < 2; ++i_) { const int q_ = lt + 256 * i_; *(LAS v4u*)(B_ + S_QK + (q_ >> 3) * 144 + (q_ & 7) * 16) = ld[12 + i_]; } } while (0)
    if (wave >= 4) { const int n0 = dir ? 31 : 0; SC_LOAD(n0); SC_WRITE(0); }
    __syncthreads();
#pragma unroll 1
    for (int s = 0; s < 32; ++s) {
        const int n = dir ? 31 - s : s;
        if (wave >= 4) {
            if (s + 1 < 32) { const int nn = dir ? 30 - s : s + 1; SC_LOAD(nn); SC_WRITE(((s + 1) & 1) * S_BUF); }
        } else {
            const LAS unsigned char* Bf = L + (s & 1) * S_BUF;
            const int e = half * 64 + wave * 16 + r16;
            const float cd = F.CD[item0 + n];
            f32x4 vacc[4], oacc[4];
            { const bf16* up = F.UT + ((size_t)(item0 + n) * 128 + e) * 64 + 4 * g;
#pragma unroll
              for (int t = 0; t < 4; ++t) { const u32x2 uu = *(const u32x2*)(up + 16 * t); vacc[t] = (f32x4){bflo(uu.x), bfhi(uu.x), bflo(uu.y), bfhi(uu.y)}; oacc[t] = (f32x4){0.f, 0.f, 0.f, 0.f}; } }
            bf16x8 Sb[4];
#pragma unroll
            for (int ks = 0; ks < 4; ++ks) Sb[ks] = pack8(S[2 * ks], S[2 * ks + 1]);
#pragma unroll
            for (int t = 0; t < 4; ++t)
#pragma unroll
                for (int ks = 0; ks < 4; ++ks) { vacc[t] = MFMA16(ld_frag(Bf + S_WN + (16 * t + r16) * 288 + ks * 64 + g * 16), Sb[ks], vacc[t]);
                    oacc[t] = MFMA16(ld_frag(Bf + S_QD + (16 * t + r16) * 288 + ks * 64 + g * 16), Sb[ks], oacc[t]); }
            bf16x8 Vb[2];
#pragma unroll
            for (int kp = 0; kp < 2; ++kp) Vb[kp] = pack8(vacc[2 * kp], vacc[2 * kp + 1]);
#pragma unroll
            for (int t = 0; t < 4; ++t)
#pragma unroll
                for (int kp = 0; kp < 2; ++kp) oacc[t] = MFMA16(ld_frag(Bf + S_QK + (16 * t + r16) * 144 + kp * 64 + g * 16), Vb[kp], oacc[t]);
            { bf16* op = (dir ? F.OB : F.OF) + ((size_t)b * SEQ + (size_t)n * 64 + 4 * g) * 1024 + h * 128 + e;
#pragma unroll
              for (int t = 0; t < 4; ++t)
#pragma unroll
                  for (int reg = 0; reg < 4; ++reg) op[(size_t)(16 * t + reg) * 1024] = (bf16)f2bf(oacc[t][reg]); }
#pragma unroll
            for (int td = 0; td < 8; ++td) { f32x4 a = S[td] * cd;
#pragma unroll
                for (int kp = 0; kp < 2; ++kp) a = MFMA16(ld_frag(Bf + S_KT + (16 * td + r16) * 144 + kp * 64 + g * 16), Vb[kp], a);
                S[td] = a; }
        }
        __syncthreads();
    }
#undef SC_LOAD
#undef SC_WRITE
}

DI void combine_row(Frame& F, size_t m) {
    const int lane = F.lane; const size_t off = m * 1024 + 16 * lane;
    const v4u f0 = *(const v4u*)(F.OF + off), f1 = *(const v4u*)(F.OF + off + 8), b0 = *(const v4u*)(F.OB + off), b1 = *(const v4u*)(F.OB + off + 8);
    bf16* mp = F.MIX + m * 2048 + 16 * lane; const v4u z0 = *(const v4u*)mp, z1 = *(const v4u*)(mp + 8);
    float o[16];
    o[0] = bflo(f0.x) + bflo(b0.x); o[1] = bfhi(f0.x) + bfhi(b0.x); o[2] = bflo(f0.y) + bflo(b0.y); o[3] = bfhi(f0.y) + bfhi(b0.y);
    o[4] = bflo(f0.z) + bflo(b0.z); o[5] = bfhi(f0.z) + bfhi(b0.z); o[6] = bflo(f0.w) + bflo(b0.w); o[7] = bfhi(f0.w) + bfhi(b0.w);
    o[8] = bflo(f1.x) + bflo(b1.x); o[9] = bfhi(f1.x) + bfhi(b1.x); o[10] = bflo(f1.y) + bflo(b1.y); o[11] = bfhi(f1.y) + bfhi(b1.y);
    o[12] = bflo(f1.z) + bflo(b1.z); o[13] = bfhi(f1.z) + bfhi(b1.z); o[14] = bflo(f1.w) + bflo(b1.w); o[15] = bfhi(f1.w) + bfhi(b1.w);
    float ss = 0.f;
#pragma unroll
    for (int e = 0; e < 16; ++e) ss += o[e] * o[e];
    ss += __shfl_xor(ss, 1); ss += __shfl_xor(ss, 2); ss += __shfl_xor(ss, 4);
    const float rstd = 1.0f / sqrtf(ss * (1.0f / 128.0f) + EPS);
    float z[16];
    z[0] = bflo(z0.x); z[1] = bfhi(z0.x); z[2] = bflo(z0.y); z[3] = bfhi(z0.y); z[4] = bflo(z0.z); z[5] = bfhi(z0.z); z[6] = bflo(z0.w); z[7] = bfhi(z0.w);
    z[8] = bflo(z1.x); z[9] = bfhi(z1.x); z[10] = bflo(z1.y); z[11] = bfhi(z1.y); z[12] = bflo(z1.z); z[13] = bfhi(z1.z); z[14] = bflo(z1.w); z[15] = bfhi(z1.w);
    const int c0 = (16 * lane) & 127; float y[16];
#pragma unroll
    for (int e = 0; e < 16; ++e) y[e] = o[e] * rstd * F.o_norm_a[c0 + e] * z[e];
    v4u w0, w1; w0.x = cvtpk(y[0], y[1]); w0.y = cvtpk(y[2], y[3]); w0.z = cvtpk(y[4], y[5]); w0.w = cvtpk(y[6], y[7]);
    w1.x = cvtpk(y[8], y[9]); w1.y = cvtpk(y[10], y[11]); w1.z = cvtpk(y[12], y[13]); w1.w = cvtpk(y[14], y[15]);
    *(v4u*)mp = w0; *(v4u*)(mp + 8) = w1;
}

struct Args { const float* in[18]; float* out; unsigned char* ws; int ph_lo, ph_hi, li, pad; };
__global__ void __launch_bounds__(NWAVES * 64, 2) hybrid_fwd(Args args) {
    extern __shared__ __attribute__((aligned(16))) unsigned char lds[];
    Frame F;
    F.lds = (LAS unsigned char*)lds;
    F.MISC = (volatile LAS unsigned*)(F.lds + MISC_OFF);
    F.tid = threadIdx.x; F.lane = F.tid & 63; F.wave = __builtin_amdgcn_readfirstlane(F.tid >> 6);
    F.G = gridDim.x; { const int bx = blockIdx.x; F.vcu = (F.G % 8 == 0) ? (bx % 8) * (F.G / 8) + bx / 8 : bx; }
    unsigned char* ws = args.ws;
    F.ctl = (gu32*)(ws + WS_CTL);
    F.x = args.in[0]; F.mem = args.in[1]; F.norm_w = args.in[2]; F.w_in = args.in[3]; F.conv_w = args.in[4]; F.a_log_f = args.in[5]; F.a_log_b = args.in[6];
    F.dt_f = args.in[7]; F.dt_b = args.in[8]; F.o_norm_a = args.in[9]; F.q_norm_b = args.in[10]; F.k_norm_b = args.in[11]; F.sink_b = args.in[12];
    F.mem_norm_w = args.in[13]; F.w_mem_kv = args.in[14]; F.q_norm_c = args.in[15]; F.k_norm_c = args.in[16]; F.w_out = args.in[17]; F.out = args.out;
    F.WinT = (bf16*)(ws + WS_WIN); F.WmemT = (bf16*)(ws + WS_WMEM); F.WoutT = (bf16*)(ws + WS_WOUT); F.XN = (bf16*)(ws + WS_XN); F.MEMN = (bf16*)(ws + WS_MEMN);
    F.PA = (bf16*)(ws + WS_PA); F.PB = (bf16*)(ws + WS_PB); F.PC = (bf16*)(ws + WS_PC); F.MIX = (bf16*)(ws + WS_MIX); F.KVM = (bf16*)(ws + WS_KVM);
    F.UT = (bf16*)(ws + WS_UT); F.WNEG = (bf16*)(ws + WS_WNEG); F.QDEC = (bf16*)(ws + WS_QDEC); F.KDECT = (bf16*)(ws + WS_KDECT); F.QKM = (bf16*)(ws + WS_QKM);
    F.OF = (bf16*)(ws + WS_OF); F.OB = (bf16*)(ws + WS_OB);
    F.GATES = (float*)(ws + WS_GATES); F.ROPE = (float*)(ws + WS_ROPE); F.CD = (float*)(ws + WS_CD);
    for (int u = F.tid; u < (LDS_BYTES - LDSCTL_OFF) / 4; u += NWAVES * 64) ((LAS unsigned*)(F.lds + LDSCTL_OFF))[u] = 0u;
    __syncthreads();
    XcdBarrier bar; bar.bar = (unsigned*)(F.ctl + CW_BAR); bar.x = 0; bar.st = nullptr;
    if (N_LAUNCHES != PER_PHASE) bar = xcd_barrier_post((unsigned*)(F.ctl + CW_BAR), F.MISC + 8);
#define GRID_BAR() do { if (N_LAUNCHES == PER_PHASE) { if (F.tid == 0) __hip_atomic_store(F.ctl + CW_TMO, 0xBADBA0u, RLX_AGENT); } else { xcd_barrier(bar); } } while (0)
    const int lo = args.ph_lo, hi = args.ph_hi;
#define IN(k) (lo <= (k) && (k) < hi)
#define BOTH(k) (IN(k) && IN((k) + 1))

#ifndef PHASES
#define PHASES 63
#endif
    if ((PHASES & 1) && IN(0)) { p0_prologue(F); if (BOTH(0)) GRID_BAR(); }

    if ((PHASES & 2) && IN(1)) {
        pg8::Gemm g{F.XN, F.WinT, M + NBATCH * MEMLEN, 6656 + 1024, DMODEL}; pg8::InOrder S; S.init(F.G, (int)blockIdx.x);
        pg8::EpiIn E{F.PA, F.PB, F.PC, F.MIX, F.KVM, F.GATES};
        pg8::gemm_phase<pg8::EpiIn, pg8::InOrder, true, true>(F.lds + RING_OFF, g, S, E);
        if (BOTH(1)) GRID_BAR();
    }

    if ((PHASES & 4) && IN(2)) {
#ifndef P2SUB
#define P2SUB 7
#endif
        if (P2SUB & 1) for (int it = F.vcu; it < 2048; it += F.G) a_prep_item(F, it >> 8, it & 7, (it >> 3) & 31);
        if (P2SUB & 2) for (int it = F.vcu; it < 256; it += F.G) b_attn_unit(F, it >> 5, (it >> 1) & 15, it & 1);
        if (P2SUB & 4) for (int it = F.vcu; it < 256; it += F.G) c_attn_unit(F, it >> 5, (it >> 3) & 3, it & 7);
        if (BOTH(2)) GRID_BAR();
    }

    if ((PHASES & 8) && IN(3)) {
        for (int it = F.vcu; it < 256; it += F.G) scan_unit(F, it >> 2, (it >> 1) & 1, it & 1);
        if (BOTH(3)) GRID_BAR();
    }

    if ((PHASES & 16) && IN(4)) {
        const int gw = F.vcu * NWAVES + F.wave, NGW = F.G * NWAVES;
        for (int m = gw; m < M; m += NGW) combine_row(F, (size_t)m);
        if (BOTH(4)) GRID_BAR();
    }

    if ((PHASES & 32) && IN(5)) {
        pg8::Gemm g{F.MIX, F.WoutT, M, DMODEL, DMODEL}; pg8::StaticOrder S; S.init(M, DMODEL, F.G, (int)blockIdx.x);
        pg8::EpiOut E{F.x, F.out};
        pg8::gemm_phase<pg8::EpiOut, pg8::StaticOrder, true, true>(F.lds + RING_OFF, g, S, E);
    }
#undef IN
#undef BOTH
}

extern "C" void kernel_launch(void* const* d_in, const int* in_sizes, int n_in, void* d_out, int out_size, void* d_ws, size_t ws_size, hipStream_t stream) {
    static int grid = 0;
    if (grid == 0) {
        if (n_in != 18 || in_sizes[0] != M * DMODEL || out_size != M * DMODEL || ws_size < WS_END) { fprintf(stderr, "kernel_launch: unexpected problem shape (n_in %d, in0 %d, out %d, ws %zu); nothing launched\n", n_in, n_in > 0 ? in_sizes[0] : -1, out_size, ws_size); grid = -1; return; }
        int dev = 0, cus = 0, per_cu = 0;
        if (hipGetDevice(&dev) != hipSuccess || hipDeviceGetAttribute(&cus, hipDeviceAttributeMultiprocessorCount, dev) != hipSuccess) { fprintf(stderr, "kernel_launch: device query failed\n"); grid = -1; return; }
        if (hipFuncSetAttribute((const void*)hybrid_fwd, hipFuncAttributeMaxDynamicSharedMemorySize, LDS_BYTES) != hipSuccess) { fprintf(stderr, "kernel_launch: hipFuncSetAttribute failed\n"); grid = -1; return; }
        if (hipOccupancyMaxActiveBlocksPerMultiprocessor(&per_cu, (const void*)hybrid_fwd, NWAVES * 64, LDS_BYTES) != hipSuccess || per_cu < 1)
            fprintf(stderr, "kernel_launch: note: occupancy query reports %d workgroups per CU\n", per_cu);
        (void)hipGetLastError();
        grid = cus;
    }
    if (grid < 0) return;
    if (hipMemsetAsync((char*)d_ws + WS_CTL, 0, CTL_ZERO_BYTES, stream) != hipSuccess) { fprintf(stderr, "kernel_launch: hipMemsetAsync failed\n"); return; }
    Args a{};
    for (int i = 0; i < 18; ++i) a.in[i] = (const float*)d_in[i];
    a.out = (float*)d_out; a.ws = (unsigned char*)d_ws;
    for (int li = 0; li < N_LAUNCHES; ++li) {
        a.ph_lo = (N_LAUNCHES == PER_PHASE) ? li : 0; a.ph_hi = (N_LAUNCHES == PER_PHASE) ? li + 1 : PER_PHASE; a.li = li;
        hipLaunchKernelGGL(hybrid_fwd, dim3(grid), dim3(NWAVES * 64), LDS_BYTES, stream, a);
        const hipError_t le = hipPeekAtLastError();
        if (le != hipSuccess) { fprintf(stderr, "kernel_launch: launch %d failed: %s\n", li, hipGetErrorName(le)); break; }
    }
}
```

```cpp
#include <hip/hip_runtime.h>
#include <cstdio>
#include <cstdint>
namespace pg8 {
#define PG8_LAS __attribute__((address_space(3)))
typedef unsigned short bf16_t;
typedef short bf16x8 __attribute__((ext_vector_type(8)));
typedef float f32x4 __attribute__((ext_vector_type(4)));
typedef unsigned u32x4 __attribute__((ext_vector_type(4)));
constexpr int BM = 256, BK = 64, HALF = 128, HTB = HALF * BK * 2  , STAGE_BYTES = 8 * HTB, NXCD = 8, WGM = 8;

__host__ __device__ __forceinline__ int lds_byte(int r, int c) { const int st = (r >> 4) * 2 + (c >> 5), rr = r & 15, cc = c & 31, ob = rr * 64 + cc * 2; return st * 1024 + (ob ^ (((ob >> 9) & 1) << 5)); }
__host__ __device__ __forceinline__ void stage_rc(int b, int& R, int& C) { const int st = b / 1024, sb = b % 1024, swz = sb ^ (((sb >> 9) & 1) << 5); R = (st >> 1) * 16 + swz / 64; C = (st & 1) * 32 + (swz % 64) / 2; }
__host__ __device__ __forceinline__ int perm32(int rho) { const int n = rho >> 4, i = rho & 15; return 8 * (i >> 2) + 4 * n + (i & 3); }

struct Unit { int pm, pn; };
struct Gemm { const bf16_t* A; const bf16_t* Bt; int M, N, K; };

struct StaticOrder {
    int nM, nN, nwg, G, c;
    __host__ __device__ void init(int M, int N, int G_, int c_) { nM = M / BM; nN = N / BM; nwg = nM * nN; G = G_; c = c_; }
    __host__ __device__ bool next(int i, Unit& u) const {
        const long L = (long)i * G + c; if (L >= nwg) return false;
        int wgid = (int)L; { const int q = nwg / NXCD, r = nwg % NXCD, xcd = wgid % NXCD, off = wgid / NXCD; wgid = (xcd < r ? xcd * (q + 1) : r * (q + 1) + (xcd - r) * q) + off; }
        const int nig = WGM * nN, gid = wgid / nig, fm = gid * WGM, gsz = (nM - fm) < WGM ? (nM - fm) : WGM;
        u.pm = fm + ((wgid % nig) % gsz); u.pn = (wgid % nig) / gsz; return true;
    }
    __device__ __forceinline__ void a_ready(const Unit&) const {}
    __device__ __forceinline__ void done(const Unit&) const {}
};

typedef float f32x2 __attribute__((ext_vector_type(2)));
typedef __bf16 bf16x2_t __attribute__((ext_vector_type(2)));
__device__ __forceinline__ unsigned cvt_pk_bf16(float lo, float hi) { f32x2 v = {lo, hi}; bf16x2_t b = __builtin_convertvector(v, bf16x2_t); return __builtin_bit_cast(unsigned, b); }
__device__ __forceinline__ float silu_f(float v) { return v * __builtin_amdgcn_rcpf(1.0f + __expf(-v)); }

struct EpiIn {
    static constexpr bool PERM = true, AFTER_DRAIN = false;
    bf16_t *PA, *PB, *PC, *MIX, *KVM; float* GATES;
    __device__ __forceinline__ void operator()(const f32x4 (&acc)[2][2][4][2], const Unit& u, int wr, int wc, int fr, int fq) const {
        const int row0 = u.pm * BM + wr * 64 + fr, cl = wc * 32 + 8 * fq, pn = u.pn;
        if (u.pm < 64 && pn == 25) {
            if (wc == 0) {
#pragma unroll
                for (int ai = 0; ai < 2; ++ai)
#pragma unroll
                    for (int m = 0; m < 4; ++m) { float* g = GATES + (size_t)(row0 + ai * HALF + m * 16) * 32 + 8 * fq;
                        *(f32x4*)g = acc[ai][0][m][0]; *(f32x4*)(g + 4) = acc[ai][0][m][1]; }
            }
            return;
        }
        bf16_t* base; int ldc; bool act = false;
        if (u.pm >= 64) { base = KVM + (size_t)(row0 - 16384) * 1024 + (pn - 26) * 256; ldc = 1024; }
        else if (pn < 12) { base = PA + (size_t)row0 * 3072 + pn * 256; ldc = 3072; }
        else if (pn < 16) { base = MIX + (size_t)row0 * 2048 + (pn - 12) * 256; ldc = 2048; act = true; }
        else if (pn < 19) { base = PB + (size_t)row0 * 768 + (pn - 16) * 256; ldc = 768; }
        else if (pn < 21) { base = MIX + (size_t)row0 * 2048 + 1024 + (pn - 19) * 256; ldc = 2048; act = true; }
        else if (pn < 23) { base = PC + (size_t)row0 * 512 + (pn - 21) * 256; ldc = 512; }
        else { base = MIX + (size_t)row0 * 2048 + 1536 + (pn - 23) * 256; ldc = 2048; act = true; }
        base += cl;
#pragma unroll
        for (int ai = 0; ai < 2; ++ai)
#pragma unroll
            for (int m = 0; m < 4; ++m) { bf16_t* rowp = base + (size_t)(ai * HALF + m * 16) * ldc;
#pragma unroll
                for (int bj = 0; bj < 2; ++bj) { f32x4 v0 = acc[ai][bj][m][0], v1 = acc[ai][bj][m][1];
                    if (act) { v0 = (f32x4){silu_f(v0[0]), silu_f(v0[1]), silu_f(v0[2]), silu_f(v0[3])}; v1 = (f32x4){silu_f(v1[0]), silu_f(v1[1]), silu_f(v1[2]), silu_f(v1[3])}; }
                    u32x4 w; w.x = cvt_pk_bf16(v0[0], v0[1]); w.y = cvt_pk_bf16(v0[2], v0[3]); w.z = cvt_pk_bf16(v1[0], v1[1]); w.w = cvt_pk_bf16(v1[2], v1[3]);
                    *(u32x4*)(rowp + bj * HALF) = w; } }
    }
};
struct EpiOut {
    static constexpr bool PERM = false, AFTER_DRAIN = false;
    const float* X; float* O;
    __device__ __forceinline__ void operator()(const f32x4 (&acc)[2][2][4][2], const Unit& u, int wr, int wc, int fr, int fq) const {
        const int row0 = u.pm * BM + wr * 64 + fr, col0 = u.pn * BM + wc * 32 + 4 * fq;
#pragma unroll
        for (int ai = 0; ai < 2; ++ai)
#pragma unroll
            for (int m = 0; m < 4; ++m) { const size_t off = (size_t)(row0 + ai * HALF + m * 16) * 2048 + col0;
#pragma unroll
                for (int bj = 0; bj < 2; ++bj)
#pragma unroll
                    for (int n = 0; n < 2; ++n) { const f32x4 xv = *(const f32x4*)(X + off + bj * HALF + n * 16); *(f32x4*)(O + off + bj * HALF + n * 16) = xv + acc[ai][bj][m][n]; } }
    }
};
struct InOrder {
    StaticOrder base; int G, c, rep;
    __host__ __device__ void init(int G_, int c_, int rep_ = 1) { G = G_; c = c_; rep = rep_; base.init(16384, 6656, G_, 0); }
    __host__ __device__ bool next(int i, Unit& u) const {
        long L = (long)i * G + c; const long tot = base.nwg + 32;
        if (L >= tot * rep) return false;
        L %= tot;
        if (L < base.nwg) { StaticOrder b2 = base; b2.c = (int)(L % G); return b2.next((int)(L / G), u); }
        const int j = (int)(L - base.nwg);
        u.pm = 64 + (j >> 2); u.pn = 26 + (j & 3); return true;
    }
    __device__ __forceinline__ void a_ready(const Unit&) const {}
    __device__ __forceinline__ void done(const Unit&) const {}
};
struct RepOrder {
    StaticOrder base; int G, c, rep;
    __host__ __device__ void init(int M_, int N_, int G_, int c_, int rep_ = 1) { G = G_; c = c_; rep = rep_; base.init(M_, N_, G_, 0); }
    __host__ __device__ bool next(int i, Unit& u) const {
        long L = (long)i * G + c; if (L >= (long)base.nwg * rep) return false;
        L %= base.nwg; StaticOrder b2 = base; b2.c = (int)(L % G); return b2.next((int)(L / G), u);
    }
    __device__ __forceinline__ void a_ready(const Unit&) const {}
    __device__ __forceinline__ void done(const Unit&) const {}
};

template <class Epi, class Sched, bool ALIGN_EPI = false, bool SP2 = false>
__device__ __forceinline__ void gemm_phase(PG8_LAS unsigned char* lds, const Gemm g, const Sched& S, const Epi& E) {
    const int tid = threadIdx.x, wid = __builtin_amdgcn_readfirstlane(tid >> 6), lane = tid & 63, wr = wid >> 2, wc = wid & 3, fr = lane & 15, fq = lane >> 4;
    const int K = g.K, nt = K / BK;
    unsigned voffA[2], voffB[2];
#pragma unroll
    for (int i = 0; i < 2; ++i) { int R, C; stage_rc(tid * 16 + i * 8192, R, C); const int Rb = Epi::PERM ? ((R & ~31) + perm32(R & 31)) : R;
        voffA[i] = (unsigned)(R * K + C) * 2u; voffB[i] = (unsigned)(Rb * K + C) * 2u; }
    const size_t kstep = (size_t)(BK * 2);
    const size_t hstep = (size_t)HALF * K * 2;
    const size_t tstep = 2 * hstep;
    const unsigned ldsw = (unsigned)wid * 1024u;
    const int aoff = lds_byte(wr * 64 + fr, fq * 8), boff = lds_byte(wc * 32 + fr, fq * 8);
#define PG8_SA(b, h) (((b) * 2 + (h)) * HTB)
#define PG8_SB(b, h) ((4 + (b) * 2 + (h)) * HTB)
#define PG8_STAGE(bufoff, gbase, voff) do { _Pragma("unroll") for (int _i = 0; _i < 2; ++_i) \
        __builtin_amdgcn_global_load_lds((const unsigned*)((const char*)(gbase) + (voff)[_i]), (PG8_LAS unsigned*)(lds + (bufoff) + ldsw + _i * 8192), 16, 0, 0); } while (0)
#define PG8_LDA(dst, b, h) do { _Pragma("unroll") for (int m = 0; m < 4; ++m) _Pragma("unroll") for (int k = 0; k < 2; ++k) dst[m][k] = *(const PG8_LAS bf16x8*)(lds + PG8_SA(b, h) + aoff + m * 2048 + k * 1024); } while (0)
#define PG8_LDB(dst, b, h) do { _Pragma("unroll") for (int n = 0; n < 2; ++n) _Pragma("unroll") for (int k = 0; k < 2; ++k) dst[n][k] = *(const PG8_LAS bf16x8*)(lds + PG8_SB(b, h) + boff + n * 2048 + k * 1024); } while (0)
#define PG8_MMA(ai, bj, At, Bt) do { __builtin_amdgcn_s_setprio(1); _Pragma("unroll") for (int m = 0; m < 4; ++m) _Pragma("unroll") for (int n = 0; n < 2; ++n) _Pragma("unroll") for (int k = 0; k < 2; ++k) \
        acc[ai][bj][m][n] = __builtin_amdgcn_mfma_f32_16x16x32_bf16(Bt[n][k], At[m][k], acc[ai][bj][m][n], 0, 0, 0); __builtin_amdgcn_s_setprio(0); } while (0)
#define PG8_WAIT_V(n) asm volatile("s_waitcnt vmcnt(" #n ")" ::: "memory")
#define PG8_WAIT_L(n) asm volatile("s_waitcnt lgkmcnt(" #n ")" ::: "memory")
#define PG8_BAR __builtin_amdgcn_s_barrier()
#define PG8_SCHED __builtin_amdgcn_sched_barrier(0)
    Unit cur, nxt; int ui = 0;
    if (!S.next(0, cur)) return;
    f32x4 acc[2][2][4][2];
#pragma unroll
    for (int a = 0; a < 2; ++a)
#pragma unroll
        for (int b = 0; b < 2; ++b)
#pragma unroll
            for (int m = 0; m < 4; ++m)
#pragma unroll
                for (int n = 0; n < 2; ++n) acc[a][b][m][n] = (f32x4){0.f, 0.f, 0.f, 0.f};
    bf16x8 At[4][2], B0[2][2], B1[2][2];
    const char* cA = (const char*)g.A + (size_t)cur.pm * tstep; const char* cB = (const char*)g.Bt + (size_t)cur.pn * tstep;
    S.a_ready(cur);
    if constexpr (SP2) {
        PG8_STAGE(PG8_SB(0, 0), cB, voffB); PG8_STAGE(PG8_SB(0, 1), cB + hstep, voffB); PG8_STAGE(PG8_SA(0, 0), cA, voffA); PG8_STAGE(PG8_SA(0, 1), cA + hstep, voffA);
        if (wr == 1) PG8_BAR;
        PG8_WAIT_V(2); PG8_BAR;
        PG8_STAGE(PG8_SB(1, 0), cB + kstep, voffB); PG8_STAGE(PG8_SA(1, 0), cA + kstep, voffA); PG8_STAGE(PG8_SB(1, 1), cB + hstep + kstep, voffB);
        PG8_WAIT_V(6); PG8_BAR;
    } else {
        PG8_STAGE(PG8_SB(0, 0), cB, voffB); PG8_STAGE(PG8_SA(0, 0), cA, voffA); PG8_STAGE(PG8_SB(0, 1), cB + hstep, voffB); PG8_STAGE(PG8_SA(0, 1), cA + hstep, voffA);
        if (wr == 1) PG8_BAR;
        PG8_WAIT_V(4); PG8_BAR;
        PG8_STAGE(PG8_SB(1, 0), cB + kstep, voffB); PG8_STAGE(PG8_SA(1, 0), cA + kstep, voffA); PG8_STAGE(PG8_SB(1, 1), cB + hstep + kstep, voffB);
        PG8_WAIT_V(6); PG8_BAR;
    }
    for (;;) {
        const bool has_next = S.next(ui + 1, nxt);
        const char* nA = has_next ? (const char*)g.A + (size_t)nxt.pm * tstep : cA; const char* nB = has_next ? (const char*)g.Bt + (size_t)nxt.pn * tstep : cB;
        for (int t = 0; t < nt; t += 2) {
            const bool last = (t == nt - 2);
            const char* a1 = cA + (size_t)(t + 1) * kstep;
            const char* a2 = last ? nA : cA + (size_t)(t + 2) * kstep; const char* b2 = last ? nB : cB + (size_t)(t + 2) * kstep;
            const char* a3 = a2 + kstep; const char* b3 = b2 + kstep;
            if (last && has_next) S.a_ready(nxt);
            if constexpr (SP2) {
            PG8_LDB(B0, 0, 0); PG8_LDB(B1, 0, 1); PG8_SCHED; PG8_LDA(At, 0, 0); PG8_STAGE(PG8_SA(1, 1), a1 + hstep, voffA);
            PG8_WAIT_V(8); PG8_WAIT_L(0); PG8_BAR; PG8_MMA(0, 0, At, B0); PG8_MMA(0, 1, At, B1); PG8_BAR; PG8_SCHED;
            PG8_LDA(At, 0, 1); PG8_STAGE(PG8_SB(0, 0), b2, voffB); PG8_STAGE(PG8_SB(0, 1), b2 + hstep, voffB); PG8_STAGE(PG8_SA(0, 0), a2, voffA);
            PG8_WAIT_V(8); PG8_WAIT_L(0); PG8_BAR; PG8_MMA(1, 0, At, B0); PG8_MMA(1, 1, At, B1); PG8_BAR; PG8_SCHED;
            PG8_LDB(B0, 1, 0); PG8_LDB(B1, 1, 1); PG8_SCHED; PG8_LDA(At, 1, 0); PG8_STAGE(PG8_SA(0, 1), a2 + hstep, voffA);
            PG8_WAIT_V(8); PG8_WAIT_L(0); PG8_BAR; PG8_MMA(0, 0, At, B0); PG8_MMA(0, 1, At, B1); PG8_BAR; PG8_SCHED;
            PG8_LDA(At, 1, 1); PG8_STAGE(PG8_SB(1, 0), b3, voffB); PG8_STAGE(PG8_SB(1, 1), b3 + hstep, voffB); PG8_STAGE(PG8_SA(1, 0), a3, voffA);
            PG8_WAIT_V(8); PG8_WAIT_L(0); PG8_BAR; PG8_MMA(1, 0, At, B0); PG8_MMA(1, 1, At, B1); PG8_BAR; PG8_SCHED;
            } else {
            PG8_LDB(B0, 0, 0); PG8_SCHED; PG8_LDA(At, 0, 0); PG8_STAGE(PG8_SA(1, 1), a1 + hstep, voffA);
            PG8_WAIT_L(8); PG8_BAR; PG8_WAIT_L(0); PG8_MMA(0, 0, At, B0); PG8_BAR; PG8_SCHED;
            PG8_LDB(B1, 0, 1); PG8_STAGE(PG8_SB(0, 0), b2, voffB);
            PG8_BAR; PG8_WAIT_L(0); PG8_MMA(0, 1, At, B1); PG8_BAR;
            PG8_LDA(At, 0, 1); PG8_STAGE(PG8_SA(0, 0), a2, voffA);
            PG8_BAR; PG8_WAIT_L(0); PG8_MMA(1, 0, At, B0); PG8_BAR; PG8_SCHED;
            PG8_STAGE(PG8_SB(0, 1), b2 + hstep, voffB);
            PG8_WAIT_V(6); PG8_BAR; PG8_MMA(1, 1, At, B1); PG8_BAR;
            PG8_LDB(B0, 1, 0); PG8_SCHED; PG8_LDA(At, 1, 0); PG8_STAGE(PG8_SA(0, 1), a2 + hstep, voffA);
            PG8_WAIT_L(8); PG8_BAR; PG8_WAIT_L(0); PG8_MMA(0, 0, At, B0); PG8_BAR; PG8_SCHED;
            PG8_LDB(B1, 1, 1); PG8_STAGE(PG8_SB(1, 0), b3, voffB);
            PG8_BAR; PG8_WAIT_L(0); PG8_MMA(0, 1, At, B1); PG8_BAR;
            PG8_LDA(At, 1, 1); PG8_STAGE(PG8_SA(1, 0), a3, voffA);
            PG8_BAR; PG8_WAIT_L(0); PG8_MMA(1, 0, At, B0); PG8_BAR; PG8_SCHED;
            PG8_STAGE(PG8_SB(1, 1), b3 + hstep, voffB);
            PG8_WAIT_V(6); PG8_BAR; PG8_MMA(1, 1, At, B1); PG8_BAR;
            }
        }
        if constexpr (ALIGN_EPI) { if (wr == 0) PG8_BAR; }
        if constexpr (!Epi::AFTER_DRAIN) { E(acc, cur, wr, wc, fr, fq); S.done(cur); }
        if (!has_next) break;
#pragma unroll
        for (int a = 0; a < 2; ++a)
#pragma unroll
            for (int b = 0; b < 2; ++b)
#pragma unroll
                for (int m = 0; m < 4; ++m)
#pragma unroll
                    for (int n = 0; n < 2; ++n) acc[a][b][m][n] = (f32x4){0.f, 0.f, 0.f, 0.f};
        cur = nxt; cA = nA; cB = nB; ++ui;
        if constexpr (ALIGN_EPI) { if (wr == 1) PG8_BAR; }
    }
    PG8_WAIT_V(0);
    if constexpr (!ALIGN_EPI) { if (wr == 0) PG8_BAR; }
    PG8_BAR;
    if constexpr (Epi::AFTER_DRAIN) { E.fused(acc, cur, wr, wc, fr, fq, lds, wid, lane); S.done(cur); }
#undef PG8_SA
#undef PG8_SB
#undef PG8_STAGE
#undef PG8_LDA
#undef PG8_LDB
#undef PG8_MMA
#undef PG8_WAIT_V
#undef PG8_WAIT_L
#undef PG8_BAR
#undef PG8_SCHED
}
}
#define GAS __attribute__((address_space(1)))
#define LAS __attribute__((address_space(3)))
typedef unsigned short bf16;
typedef unsigned v4u __attribute__((ext_vector_type(4)));
typedef float f32x4 __attribute__((ext_vector_type(4)));
typedef short bf16x8 __attribute__((ext_vector_type(8)));
typedef GAS unsigned gu32;
typedef GAS unsigned long long gu64;
#define RLX_AGENT __ATOMIC_RELAXED, __HIP_MEMORY_SCOPE_AGENT
#define LDS_WAIT() asm volatile("s_waitcnt lgkmcnt(0)" ::: "memory")
#define VM_WAIT() asm volatile("s_waitcnt vmcnt(0)" ::: "memory")
__device__ __forceinline__ unsigned long long rt() { return __builtin_amdgcn_s_memrealtime(); }
__device__ __forceinline__ unsigned f2bf(float f) { unsigned u = __builtin_bit_cast(unsigned, f); return (u + 0x7fffu + ((u >> 16) & 1u)) >> 16; }
__device__ __forceinline__ unsigned pk2(float lo, float hi) { return f2bf(lo) | (f2bf(hi) << 16); }

#define XB_TMO      128
#define XB_XCNT(j)  (256  + 64 * (j))
#define XB_XSUB(j)  (1280 + 64 * (j))
#define XB_XGEN(j)  (2304 + 64 * (j))
#define XB_TOP      3328
#define XB_TOPGEN   3392
#define XCD_BAR_WORDS 3456
#define XB_SPIN_CAP (1u << 18)

__device__ __forceinline__ unsigned xb_ld(unsigned* p)              { return __hip_atomic_load(p, __ATOMIC_RELAXED, __HIP_MEMORY_SCOPE_AGENT); }
__device__ __forceinline__ unsigned xb_add(unsigned* p, unsigned v) { return __hip_atomic_fetch_add(p, v, __ATOMIC_RELAXED, __HIP_MEMORY_SCOPE_AGENT); }
__device__ __forceinline__ unsigned xb_xcc_id() { return (unsigned)__builtin_amdgcn_s_getreg((3 << 11) | 20) & 0xFu; }
#define XB_SPIN(cond, bar) do { unsigned _sp = 0; while (cond) { __builtin_amdgcn_s_sleep(1); \
    if ((++_sp & 255u) == 0u) { if (xb_ld(&(bar)[XB_TMO])) break; if (_sp > XB_SPIN_CAP) { atomicAdd(&(bar)[XB_TMO], 1u); break; } } } } while (0)

struct XcdBarrier {
    unsigned* bar; unsigned x;
    volatile LAS unsigned* st;
};

__device__ __forceinline__ XcdBarrier xcd_barrier_post(unsigned* bar, volatile LAS unsigned* st) {
    XcdBarrier b; b.bar = bar; b.x = xb_xcc_id(); b.st = st;
    if (threadIdx.x == 0) (void)xb_add(&bar[XB_XCNT(b.x)], 1u);
    return b;
}
__device__ __forceinline__ void xcd_barrier_complete(unsigned* bar, unsigned x, unsigned& nloc, unsigned& nx) {
    const unsigned G = gridDim.x * gridDim.y * gridDim.z;
    unsigned sum, cnt, mine, sp = 0u;
    for (;;) {
        sum = 0u; cnt = 0u; mine = 0u;
#pragma unroll
        for (unsigned j = 0; j < 16; ++j) { const unsigned c = xb_ld(&bar[XB_XCNT(j)]); sum += c; cnt += (c > 0u) ? 1u : 0u; mine = (j == x) ? c : mine; }
        if (sum == G) break;
        __builtin_amdgcn_s_sleep(1);
        if ((++sp & 255u) == 0u) { if (xb_ld(&bar[XB_TMO])) break; if (sp > XB_SPIN_CAP) { atomicAdd(&bar[XB_TMO], 1u); break; } }
    }
    nloc = mine > 0u ? mine : 1u; nx = cnt > 0u ? cnt : 1u;
}

__device__ __forceinline__ void xcd_barrier(const XcdBarrier& b) {
    asm volatile("s_waitcnt vmcnt(0)" ::: "memory");
    __syncthreads();
    if (threadIdx.x == 0) {
        unsigned* bar = b.bar;
        __builtin_amdgcn_s_waitcnt(0);
        unsigned nloc = b.st[0], nx = b.st[1];
        if (nloc == 0u) { xcd_barrier_complete(bar, b.x, nloc, nx); b.st[0] = nloc; b.st[1] = nx; }
        const unsigned old = xb_add(&bar[XB_XSUB(b.x)], 1u);
        const unsigned gen = old / nloc;
        if (old + 1u == (gen + 1u) * nloc) {
            __builtin_amdgcn_fence(__ATOMIC_RELEASE, "agent");
            asm volatile("s_waitcnt vmcnt(0)" ::: "memory");
            const unsigned og = xb_add(&bar[XB_TOP], 1u);
            const unsigned tg = og / nx;
            if (og + 1u == (tg + 1u) * nx) xb_add(&bar[XB_TOPGEN], 1u);
            else XB_SPIN(xb_ld(&bar[XB_TOPGEN]) == tg, bar);
            __builtin_amdgcn_fence(__ATOMIC_ACQUIRE, "agent");
            xb_add(&bar[XB_XGEN(b.x)], 1u);
            asm volatile("s_waitcnt vmcnt(0)" ::: "memory");
        } else {
            XB_SPIN(xb_ld(&bar[XB_XGEN(b.x)]) == gen, bar);
            __builtin_amdgcn_fence(__ATOMIC_ACQUIRE, "agent");
            asm volatile("s_waitcnt vmcnt(0)" ::: "memory");
        }
    }
    __syncthreads();
}
constexpr int NWAVES = 8;
#ifndef MK_N_LAUNCHES
#define MK_N_LAUNCHES 1
#endif
constexpr int N_LAUNCHES = MK_N_LAUNCHES;
constexpr int PER_PHASE = 6;

constexpr int NBATCH = 8, SEQ = 2048, DMODEL = 2048, M = NBATCH * SEQ;
constexpr int MEMLEN = 256;
constexpr int NIN = 6432;
constexpr float EPS = 1e-6f;
constexpr float LOG2E = 1.4426950408889634f;

constexpr size_t MiB = 1u << 20;
constexpr size_t WS_CTL = 0, CTL_ZERO_BYTES = 1 * MiB;
constexpr size_t WS_WOUT = 1 * MiB;
constexpr size_t WS_WIN = 9 * MiB, WS_WMEM = 35 * MiB;
constexpr size_t WS_XN = 39 * MiB, WS_MEMN = 103 * MiB;
constexpr size_t WS_PA = 111 * MiB;
constexpr size_t WS_PB = 207 * MiB;
constexpr size_t WS_PC = 231 * MiB;
constexpr size_t WS_MIX = 247 * MiB;
constexpr size_t WS_GATES = 311 * MiB;
constexpr size_t WS_KVM = 313 * MiB;
constexpr size_t WS_ROPE = 317 * MiB;
constexpr size_t WS_CD = 317 * MiB + 512 * 1024;
constexpr size_t WS_UT = 318 * MiB, WS_WNEG = 382 * MiB, WS_QDEC = 446 * MiB;
constexpr size_t WS_KDECT = 9 * MiB, WS_QKM = 73 * MiB;
constexpr size_t WS_OF = 111 * MiB, WS_OB = 143 * MiB;
constexpr size_t WS_END = 510 * MiB;
constexpr int CW_TMO = 0, CW_CODE = 1, CW_BAR = 4096;

constexpr int RING_OFF = 0, RING_BYTES = 149504;
constexpr int LDSCTL_OFF = RING_BYTES, MISC_OFF = LDSCTL_OFF + 320;
constexpr int LDS_BYTES = 150528;
static_assert(MISC_OFF + 128 <= LDS_BYTES, "LDS map");

#define DI __device__ __forceinline__
typedef short s16x4 __attribute__((ext_vector_type(4)));
typedef unsigned u32x2 __attribute__((ext_vector_type(2)));
typedef float f32x2v __attribute__((ext_vector_type(2)));
#define MFMA16(a, b, c) __builtin_amdgcn_mfma_f32_16x16x32_bf16((a), (b), (c), 0, 0, 0)
DI unsigned cvtpk(float lo, float hi) { return pg8::cvt_pk_bf16(lo, hi); }
DI float bflo(unsigned v) { return __uint_as_float(v << 16); }
DI float bfhi(unsigned v) { return __uint_as_float(v & 0xffff0000u); }
DI float wave_sum(float v) {
#pragma unroll
    for (int o = 1; o < 64; o <<= 1) v += __shfl_xor(v, o);
    return v;
}
DI float silu_f(float v) { return pg8::silu_f(v); }
DI float softplus_f(float x) { return x > 20.f ? x : log1pf(expf(x)); }
DI float sigmoid_f(float x) { return 1.0f / (1.0f + expf(-x)); }
DI int perm32k(int k) { return (k & ~31) | (((k >> 2) & 3) << 3) | (((k >> 4) & 1) << 2) | (k & 3); }
typedef short v4i16_t __attribute__((ext_vector_type(4)));
DI s16x4 vtr(const LAS unsigned char* p) { return __builtin_bit_cast(s16x4, __builtin_amdgcn_ds_read_tr16_b64_v4i16((LAS v4i16_t*)p)); }
DI bf16x8 tr_frag(const LAS unsigned char* lo, int hi_off) { const s16x4 a = vtr(lo), b = vtr(lo + hi_off); return (bf16x8){a[0], a[1], a[2], a[3], b[0], b[1], b[2], b[3]}; }
DI bf16x8 ld_frag(const LAS unsigned char* p) { return *(const LAS bf16x8*)p; }
DI bf16x8 pack8(const f32x4& a, const f32x4& b) { v4u w; w.x = cvtpk(a[0], a[1]); w.y = cvtpk(a[2], a[3]); w.z = cvtpk(b[0], b[1]); w.w = cvtpk(b[2], b[3]); return __builtin_bit_cast(bf16x8, w); }

struct Frame {
    LAS unsigned char* lds;
    volatile LAS unsigned* MISC;
    gu32* ctl;
    int tid, lane, wave;
    int vcu, G;
    const float *x, *mem, *norm_w, *w_in, *conv_w, *a_log_f, *a_log_b, *dt_f, *dt_b, *o_norm_a, *q_norm_b, *k_norm_b, *sink_b, *mem_norm_w, *w_mem_kv, *q_norm_c, *k_norm_c, *w_out;
    float* out;
    bf16 *WinT, *WmemT, *WoutT, *XN, *MEMN, *PA, *PB, *PC, *MIX, *KVM, *UT, *WNEG, *QDEC, *KDECT, *QKM, *OF, *OB;
    float *GATES, *ROPE, *CD;
};

DI void p0_transpose_item(const float* W, int K, int N, bf16* WT, int k0, int n0, int drow0, LAS float* scr, int lane) {
#pragma unroll 8
    for (int i = 0; i < 32; ++i) { const int kk = 2 * i + (lane >> 5); scr[kk * 33 + (lane & 31)] = W[(size_t)(k0 + kk) * N + n0 + (lane & 31)]; }
    LDS_WAIT(); asm volatile("" ::: "memory");
    const int c = lane & 7;
#pragma unroll
    for (int j = 0; j < 4; ++j) { const int n = (lane >> 3) + 8 * j; const LAS float* s = scr + (8 * c) * 33 + n;
        v4u o; o.x = pk2(s[0 * 33], s[1 * 33]); o.y = pk2(s[2 * 33], s[3 * 33]); o.z = pk2(s[4 * 33], s[5 * 33]); o.w = pk2(s[6 * 33], s[7 * 33]);
        *(GAS v4u*)(WT + (size_t)(drow0 + n) * K + k0 + 8 * c) = o; }
    LDS_WAIT(); asm volatile("" ::: "memory");
}
DI void rms_row_to_bf16(const float* xrow, const float* w, bf16* orow, int lane) {
    const GAS f32x4* xr = (const GAS f32x4*)xrow + lane; const GAS f32x4* wr = (const GAS f32x4*)w + lane;
    f32x4 v[8]; float s = 0.f;
#pragma unroll
    for (int j = 0; j < 8; ++j) { v[j] = xr[64 * j]; s += (v[j].x * v[j].x + v[j].y * v[j].y) + (v[j].z * v[j].z + v[j].w * v[j].w); }
    const float rstd = 1.0f / sqrtf(wave_sum(s) * (1.0f / 2048.0f) + EPS);
    GAS unsigned long long* o8 = (GAS unsigned long long*)orow + lane;
#pragma unroll
    for (int j = 0; j < 8; ++j) { const f32x4 wv = wr[64 * j]; const f32x4 y = v[j] * rstd * wv;
        o8[64 * j] = (unsigned long long)cvtpk(y.x, y.y) | ((unsigned long long)cvtpk(y.z, y.w) << 32); }
}
DI void p0_prologue(Frame& F) {
    LAS float* scr = (LAS float*)(F.lds + RING_OFF + F.wave * 16384);
    const int gw = F.vcu * NWAVES + F.wave, NGW = F.G * NWAVES;
    constexpr int I_IN = 32 * 201, I_MEM = 32 * 32, I_OUT = 32 * 64, NITEMS = I_IN + I_MEM + I_OUT;
    for (int it = gw; it < NITEMS; it += NGW) {
        int r = it;
        if (r < I_IN) { const int kb = r / 201, sb = r % 201, n0 = 32 * sb; const int drow = n0 < 4096 ? n0 : (n0 < 4128 ? 6400 + (n0 - 4096) : n0 - 32);
            p0_transpose_item(F.w_in, 2048, NIN, F.WinT, 64 * kb, n0, drow, scr, F.lane); continue; }
        r -= I_IN;
        if (r < I_MEM) { p0_transpose_item(F.w_mem_kv, 2048, 1024, F.WmemT, 64 * (r / 32), 32 * (r % 32), 32 * (r % 32), scr, F.lane); continue; }
        r -= I_MEM;
        p0_transpose_item(F.w_out, 2048, 2048, F.WoutT, 64 * (r / 64), 32 * (r % 64), 32 * (r % 64), scr, F.lane);
    }
    { GAS v4u* z = (GAS v4u*)(F.WinT + (size_t)NIN * 2048); const int gt = F.vcu * 512 + F.tid, NT = F.G * 512;
      for (int i = gt; i < 224 * 256; i += NT) z[i] = (v4u){0u, 0u, 0u, 0u}; }
    for (int m = gw; m < M; m += NGW) rms_row_to_bf16(F.x + (size_t)m * DMODEL, F.norm_w, F.XN + (size_t)m * DMODEL, F.lane);
    for (int m = gw; m < NBATCH * MEMLEN; m += NGW) rms_row_to_bf16(F.mem + (size_t)m * DMODEL, F.mem_norm_w, F.MEMN + (size_t)m * DMODEL, F.lane);
    { const int gt = F.vcu * 512 + F.tid, NT = F.G * 512;
      for (int i = gt; i < SEQ * 32; i += NT) { const int pos = i >> 5, fi = i & 31; const float inv = powf(10000.0f, -(float)(2 * fi) / 64.0f); const float ang = (float)pos * inv;
          F.ROPE[2 * i] = cosf(ang); F.ROPE[2 * i + 1] = sinf(ang); } }
}

constexpr int AB_QH = 0, AB_KH = 17408, AB_VV = 34816, AB_BUF = 52224, AB_LD = 272;
constexpr int AD_F = 104448, AD_B = 122880, AD_T2 = 9216, AD_LDL = 72, AD_LDT = 144;
constexpr int AG_0 = 141312, AG_SZ = 2560, AG_RAW = 146432;
constexpr int ASCR_F = 0, ASCR_B = 5120;
static_assert(AG_RAW == AG_0 + 2 * AG_SZ && AG_RAW + 1024 <= RING_BYTES && AD_F == 2 * AB_BUF && AD_B == AD_F + 64 * 72 * 4 && AG_0 == AD_B + 64 * 72 * 4, "A-prep LDS map");
#define LBAR() asm volatile("s_waitcnt lgkmcnt(0)\n\ts_barrier" ::: "memory")

#define DPP_ADD(s, ctrl) (s) += __builtin_bit_cast(float, __builtin_amdgcn_update_dpp(0, __builtin_bit_cast(int, (s)), (ctrl), 0xf, 0xf, true))
DI float row16_sum(float s) { DPP_ADD(s, 0xB1); DPP_ADD(s, 0x4E); DPP_ADD(s, 0x141); DPP_ADD(s, 0x140); return s; }

template <bool BWD> DI void s3_solve(LAS unsigned char* L, LAS unsigned char* scr, const LAS float* GV, int lane) {
    int lane_o = lane; asm volatile("" : "+v"(lane_o));
    const int hb = lane_o >> 5, cc = lane_o & 31, r16 = lane_o & 15, g = lane_o >> 4;
    LAS unsigned char* D = L + (BWD ? AD_B : AD_F);
    const LAS float* LS = (const LAS float*)D;
    const LAS float* Lb = LS + hb * (32 * AD_LDL + 32);
    LAS unsigned char* SA = scr + (BWD ? ASCR_B : ASCR_F); LAS unsigned char* SB = SA + 2560;
    LAS unsigned char* T1 = D; LAS unsigned char* T2 = D + AD_T2;
    const LAS float* S1 = GV + (BWD ? 192 : 128); const LAS float* S2 = GV + (BWD ? 576 : 512);
    bf16x8 la[2];
#pragma unroll
    for (int ti = 0; ti < 2; ++ti) { const LAS float* lp = LS + (32 + 16 * ti + r16) * AD_LDL + 8 * g; const f32x4 x0 = *(const LAS f32x4*)lp, x1 = *(const LAS f32x4*)(lp + 4); la[ti] = pack8(x0, x1); }
    float t[32];
    t[0] = (cc == 0) ? 1.f : 0.f;
    f32x4 rwA[8], rwB[8];
    rwB[0] = *(const LAS f32x4*)(Lb + AD_LDL);
#pragma unroll
    for (int i = 1; i < 32; ++i) {
        if (i + 1 < 32) {
#pragma unroll
            for (int q = 0; q < 8; ++q) if (4 * q < i + 1) { if ((i + 1) & 1) rwB[q] = *(const LAS f32x4*)(Lb + (i + 1) * AD_LDL + 4 * q); else rwA[q] = *(const LAS f32x4*)(Lb + (i + 1) * AD_LDL + 4 * q); } }
        __builtin_amdgcn_sched_barrier(0);
        float sa = (cc == i) ? 1.f : 0.f, sb = 0.f;
#pragma unroll
        for (int q = 0; q < 8; ++q)
#pragma unroll
            for (int e = 0; e < 4; ++e) if (4 * q + e < i) { const float lv = (i & 1) ? rwB[q][e] : rwA[q][e];
                if (e & 1) asm("v_fma_f32 %0, -%1, %2, %0" : "+v"(sb) : "v"(lv), "v"(t[4 * q + e])); else asm("v_fma_f32 %0, -%1, %2, %0" : "+v"(sa) : "v"(lv), "v"(t[4 * q + e])); }
        t[i] = sa + sb;
        __builtin_amdgcn_sched_barrier(0);
    }
    {
        const int R = BWD ? 32 * hb + cc : 63 - 32 * hb - cc, colb = BWD ? 32 * hb : 32 * (1 - hb);
#pragma unroll
        for (int q = 0; q < 4; ++q) { const f32x4 a0 = *(const LAS f32x4*)(S1 + colb + 8 * q), a1 = *(const LAS f32x4*)(S1 + colb + 8 * q + 4), b0 = *(const LAS f32x4*)(S2 + colb + 8 * q), b1 = *(const LAS f32x4*)(S2 + colb + 8 * q + 4);
            const f32x4 v0 = BWD ? (f32x4){t[8 * q], t[8 * q + 1], t[8 * q + 2], t[8 * q + 3]} : (f32x4){t[31 - 8 * q], t[30 - 8 * q], t[29 - 8 * q], t[28 - 8 * q]};
            const f32x4 v1 = BWD ? (f32x4){t[8 * q + 4], t[8 * q + 5], t[8 * q + 6], t[8 * q + 7]} : (f32x4){t[27 - 8 * q], t[26 - 8 * q], t[25 - 8 * q], t[24 - 8 * q]};
            *(LAS bf16x8*)(T1 + R * AD_LDT + (colb + 8 * q) * 2) = pack8(v0 * a0, v1 * a1); *(LAS bf16x8*)(T2 + R * AD_LDT + (colb + 8 * q) * 2) = pack8(v0 * b0, v1 * b1); }
    }
    __builtin_amdgcn_sched_barrier(0);
    if (hb == 0) {
#pragma unroll
        for (int q = 0; q < 4; ++q) *(LAS bf16x8*)(SA + cc * 80 + 16 * q) = pack8((f32x4){t[8 * q], t[8 * q + 1], t[8 * q + 2], t[8 * q + 3]}, (f32x4){t[8 * q + 4], t[8 * q + 5], t[8 * q + 6], t[8 * q + 7]});
    } else {
#pragma unroll
        for (int i = 0; i < 32; i += 2) { const unsigned pk = cvtpk(t[i], t[i + 1]); *(LAS bf16*)(SB + i * 80 + 2 * cc) = (bf16)(pk & 0xffffu); *(LAS bf16*)(SB + (i + 1) * 80 + 2 * cc) = (bf16)(pk >> 16); }
    }
    asm volatile("s_waitcnt lgkmcnt(0)" ::: "memory");
    __builtin_amdgcn_sched_barrier(0);
    bf16x8 tbf[2];
#pragma unroll
    for (int ti = 0; ti < 2; ++ti) tbf[ti] = ld_frag(SA + (16 * ti + r16) * 80 + 16 * g);
    f32x4 P[2][2];
#pragma unroll
    for (int ti = 0; ti < 2; ++ti)
#pragma unroll
        for (int tj = 0; tj < 2; ++tj) P[ti][tj] = MFMA16(la[ti], tbf[tj], ((f32x4){0.f, 0.f, 0.f, 0.f}));
    bf16x8 pbb[2];
#pragma unroll
    for (int tj = 0; tj < 2; ++tj) pbb[tj] = pack8(P[0][tj], P[1][tj]);
#pragma unroll
    for (int tip = 0; tip < 2; ++tip) {
        const u32x2 lo = *(const LAS u32x2*)(SB + (16 * tip + r16) * 80 + 8 * g), hi = *(const LAS u32x2*)(SB + (16 * tip + r16) * 80 + 32 + 8 * g);
        const v4u aw = (v4u){lo.x, lo.y, hi.x, hi.y}; const bf16x8 af = __builtin_bit_cast(bf16x8, aw);
#pragma unroll
        for (int tj = 0; tj < 2; ++tj) { const f32x4 X = MFMA16(af, pbb[tj], ((f32x4){0.f, 0.f, 0.f, 0.f})); const int b = 16 * tj + r16;
            const int Rn = BWD ? b : 63 - b, col0 = BWD ? 32 + 16 * tip + 4 * g : 28 - 16 * tip - 4 * g;
            const f32x4 a0 = *(const LAS f32x4*)(S1 + col0), b0 = *(const LAS f32x4*)(S2 + col0);
            const f32x4 xv = BWD ? (f32x4){-X[0], -X[1], -X[2], -X[3]} : (f32x4){-X[3], -X[2], -X[1], -X[0]};
            u32x2 o1, o2; o1.x = cvtpk(xv[0] * a0[0], xv[1] * a0[1]); o1.y = cvtpk(xv[2] * a0[2], xv[3] * a0[3]); o2.x = cvtpk(xv[0] * b0[0], xv[1] * b0[1]); o2.y = cvtpk(xv[2] * b0[2], xv[3] * b0[3]);
            *(LAS u32x2*)(T1 + Rn * AD_LDT + col0 * 2) = o1; *(LAS u32x2*)(T2 + Rn * AD_LDT + col0 * 2) = o2; }
    }
}

DI void acons_s2(Frame& F, LAS unsigned char* L, LAS unsigned char* B, const LAS float* GV, int item_f, int wv, int lane) {
    int lane_o = lane; asm volatile("" : "+v"(lane_o));
    const int r16 = lane_o & 15, g = lane_o >> 4, item_b = item_f + 32;
    f32x4 accG[4], accQ[4];
#pragma unroll
    for (int tn = 0; tn < 4; ++tn) { accG[tn] = (f32x4){0.f, 0.f, 0.f, 0.f}; accQ[tn] = (f32x4){0.f, 0.f, 0.f, 0.f}; }
    const LAS unsigned char* Ab = B + AB_KH + (16 * wv + r16) * AB_LD + g * 16;
    const LAS unsigned char* Kb = B + AB_KH + r16 * AB_LD + g * 16;
    const LAS unsigned char* Qb = B + AB_QH + r16 * AB_LD + g * 16;
#pragma unroll
    for (int ks = 0; ks < 4; ++ks) { const bf16x8 a = ld_frag(Ab + ks * 64);
#pragma unroll
        for (int tn = 0; tn < 4; ++tn) { accG[tn] = MFMA16(a, ld_frag(Kb + tn * 16 * AB_LD + ks * 64), accG[tn]); accQ[tn] = MFMA16(a, ld_frag(Qb + tn * 16 * AB_LD + ks * 64), accQ[tn]); }
        __builtin_amdgcn_sched_barrier(0); }
    LAS float* LF = (LAS float*)(L + AD_F); LAS float* LB = (LAS float*)(L + AD_B);
#pragma unroll
    for (int tn = 0; tn < 4; ++tn) {
        const int j = 16 * tn + r16; const float gcfj = GV[j], gcbj = GV[64 + j];
#pragma unroll
        for (int reg = 0; reg < 4; ++reg) { const int i = 16 * wv + 4 * g + reg; const float G = accG[tn][reg];
            if (j < i) LF[(63 - j) * AD_LDL + (63 - i)] = GV[128 + i] * G * __expf(fminf(GV[i] - gcfj, 0.f));
            else if (j > i) LB[j * AD_LDL + i] = GV[192 + i] * G * __expf(fminf(GV[64 + i] - gcbj, 0.f)); } }
#pragma unroll
    for (int tn = 0; tn < 4; ++tn) {
        const int i = 16 * tn + r16; const float gcfi = GV[i], gcbi = GV[64 + i]; float qf[4], qb[4];
#pragma unroll
        for (int reg = 0; reg < 4; ++reg) { const int j = 16 * wv + 4 * g + reg; const float v = accQ[tn][reg];
            qf[reg] = (j <= i) ? v * __expf(fminf(gcfi - GV[j], 0.f)) : 0.f;
            qb[reg] = (j >= i) ? v * __expf(fminf(gcbi - GV[64 + j], 0.f)) : 0.f; }
        const int idx = 32 * (wv >> 1) + 8 * g + 4 * (wv & 1);
        u32x2 vf, vb; vf.x = cvtpk(qf[0], qf[1]); vf.y = cvtpk(qf[2], qf[3]); vb.x = cvtpk(qb[0], qb[1]); vb.y = cvtpk(qb[2], qb[3]);
        *(u32x2*)(F.QKM + ((size_t)item_f * 64 + i) * 64 + idx) = vf; *(u32x2*)(F.QKM + ((size_t)item_b * 64 + i) * 64 + idx) = vb; }
}
DI void acons_kdect(Frame& F, LAS unsigned char* B, const LAS float* GV, int item, int dirb, int lane) {
    int lane_o = lane; asm volatile("" : "+v"(lane_o));
    const int i16 = lane_o & 15, gg = lane_o >> 4, q4 = i16 >> 2, p4 = i16 & 3;
    const LAS float* KD = GV + (dirb ? 448 : 384);
#pragma unroll
    for (int s = 0; s < 2; ++s) { const f32x4 k0 = *(const LAS f32x4*)(KD + 32 * s + 4 * gg), k1 = *(const LAS f32x4*)(KD + 32 * s + 16 + 4 * gg);
#pragma unroll
        for (int dt = 0; dt < 8; ++dt) { const LAS unsigned char* ap = B + AB_KH + (32 * s + 4 * gg + q4) * AB_LD + (16 * dt + 4 * p4) * 2;
            const s16x4 lo = vtr(ap), hi = vtr(ap + 16 * AB_LD);
            const f32x4 a = (f32x4){bflo((unsigned)(unsigned short)lo[0]), bflo((unsigned)(unsigned short)lo[1]), bflo((unsigned)(unsigned short)lo[2]), bflo((unsigned)(unsigned short)lo[3])} * k0;
            const f32x4 c = (f32x4){bflo((unsigned)(unsigned short)hi[0]), bflo((unsigned)(unsigned short)hi[1]), bflo((unsigned)(unsigned short)hi[2]), bflo((unsigned)(unsigned short)hi[3])} * k1;
            v4u o; o.x = cvtpk(a[0], a[1]); o.y = cvtpk(a[2], a[3]); o.z = cvtpk(c[0], c[1]); o.w = cvtpk(c[2], c[3]);
            *(v4u*)(F.KDECT + ((size_t)item * 128 + 16 * dt + i16) * 64 + 32 * s + 8 * gg) = o; __builtin_amdgcn_sched_barrier(0); } }
}
DI void acons_s4(Frame& F, LAS unsigned char* L, LAS unsigned char* B, int item_f, int wv, int lane) {
    int lane_o = lane; asm volatile("" : "+v"(lane_o));
    const int dir = wv >> 1, tip = wv & 1, r16 = lane_o & 15, g = lane_o >> 4, q4 = r16 >> 2, p4 = r16 & 3;
    const int tiA = tip ? 1 : 0, tiB = tip ? 2 : 3;
    const LAS unsigned char* T1 = L + (dir ? AD_B : AD_F); const LAS unsigned char* T2 = T1 + AD_T2;
    const int item = item_f + 32 * dir;
    bf16x8 a1A[2], a1B[2], a2A[2], a2B[2];
#pragma unroll
    for (int ks = 0; ks < 2; ++ks) { a1A[ks] = ld_frag(T1 + (16 * tiA + r16) * AD_LDT + ks * 64 + g * 16); a1B[ks] = ld_frag(T1 + (16 * tiB + r16) * AD_LDT + ks * 64 + g * 16);
        a2A[ks] = ld_frag(T2 + (16 * tiA + r16) * AD_LDT + ks * 64 + g * 16); a2B[ks] = ld_frag(T2 + (16 * tiB + r16) * AD_LDT + ks * 64 + g * 16); }
    const bool A0 = true, A1 = (dir == 1), B0 = (dir == 0), B1 = true;
#pragma unroll
    for (int te = 0; te < 8; ++te) { f32x4 accA = (f32x4){0.f, 0.f, 0.f, 0.f}, accB = (f32x4){0.f, 0.f, 0.f, 0.f};
        const bf16x8 v0 = tr_frag(B + AB_VV + ((8 * g + q4) * 136 + 16 * te + 4 * p4) * 2, 4 * AB_LD), v1 = tr_frag(B + AB_VV + ((32 + 8 * g + q4) * 136 + 16 * te + 4 * p4) * 2, 4 * AB_LD);
        if (A0) accA = MFMA16(a1A[0], v0, accA); if (A1) accA = MFMA16(a1A[1], v1, accA);
        if (B0) accB = MFMA16(a1B[0], v0, accB); if (B1) accB = MFMA16(a1B[1], v1, accB);
        u32x2 o; o.x = cvtpk(accA[0], accA[1]); o.y = cvtpk(accA[2], accA[3]);
        *(u32x2*)(F.UT + ((size_t)item * 128 + 16 * te + r16) * 64 + 16 * tiA + 4 * g) = o;
        o.x = cvtpk(accB[0], accB[1]); o.y = cvtpk(accB[2], accB[3]);
        *(u32x2*)(F.UT + ((size_t)item * 128 + 16 * te + r16) * 64 + 16 * tiB + 4 * g) = o; __builtin_amdgcn_sched_barrier(0); }
#pragma unroll
    for (int td = 0; td < 8; ++td) { f32x4 accA = (f32x4){0.f, 0.f, 0.f, 0.f}, accB = (f32x4){0.f, 0.f, 0.f, 0.f};
        const bf16x8 k0 = tr_frag(B + AB_KH + ((8 * g + q4) * 136 + 16 * td + 4 * p4) * 2, 4 * AB_LD), k1 = tr_frag(B + AB_KH + ((32 + 8 * g + q4) * 136 + 16 * td + 4 * p4) * 2, 4 * AB_LD);
        if (A0) accA = MFMA16(k0, a2A[0], accA); if (A1) accA = MFMA16(k1, a2A[1], accA);
        if (B0) accB = MFMA16(k0, a2B[0], accB); if (B1) accB = MFMA16(k1, a2B[1], accB);
        const int idx = 32 * (td >> 1) + 8 * g + 4 * (td & 1);
        u32x2 o; o.x = cvtpk(-accA[0], -accA[1]); o.y = cvtpk(-accA[2], -accA[3]);
        *(u32x2*)(F.WNEG + ((size_t)item * 64 + 16 * tiA + r16) * 128 + idx) = o;
        o.x = cvtpk(-accB[0], -accB[1]); o.y = cvtpk(-accB[2], -accB[3]);
        *(u32x2*)(F.WNEG + ((size_t)item * 64 + 16 * tiB + r16) * 128 + idx) = o; __builtin_amdgcn_sched_barrier(0); }
}
DI void aprod_s0(Frame& F, LAS float* GV, const LAS float* RAW, int item_f, int h, int lane) {
    const float ga[4] = {RAW[lane], RAW[64 + lane], RAW[128 + lane], RAW[192 + lane]};
    const float xf_ = ga[0] + F.dt_f[h], xb_ = ga[1] + F.dt_b[h];
    const float gf = -__expf(F.a_log_f[h]) * (xf_ > 15.f ? xf_ : __logf(1.0f + __expf(xf_)));
    const float gb = -__expf(F.a_log_b[h]) * (xb_ > 15.f ? xb_ : __logf(1.0f + __expf(xb_)));
    float pf = gf, pb = gb;
#pragma unroll
    for (int o = 1; o < 64; o <<= 1) { const float tf = __shfl_up(pf, o), tb = __shfl_up(pb, o); if (lane >= o) { pf += tf; pb += tb; } }
    const float totf = __shfl(pf, 63), totb = __shfl(pb, 63);
    const float gcf = pf, gcb = totb - pb + gb;
    const float btf_ = __builtin_amdgcn_rcpf(1.0f + __expf(-ga[2])), btb_ = __builtin_amdgcn_rcpf(1.0f + __expf(-ga[3])), egf_ = __expf(gcf), egb_ = __expf(gcb);
    GV[lane] = gcf; GV[64 + lane] = gcb; GV[128 + lane] = btf_; GV[192 + lane] = btb_;
    GV[256 + lane] = egf_; GV[320 + lane] = egb_; GV[384 + lane] = __expf(totf - gcf); GV[448 + lane] = __expf(totb - gcb); GV[512 + lane] = btf_ * egf_; GV[576 + lane] = btb_ * egb_;
    if (lane == 0) { F.CD[item_f] = __expf(totf); F.CD[item_f + 32] = __expf(totb); }
}
DI void aprod_load(Frame& F, v4u (&x)[8], int b, int c, int h, int part, int p0, int c16) {
#pragma unroll
    for (int r = 0; r < 8; ++r) { const int t = c * 64 + p0 - 2 + r; v4u v = (v4u){0u, 0u, 0u, 0u};
        if (t >= 0 && t < SEQ) v = *(const v4u*)(F.PA + ((size_t)b * SEQ + t) * 3072 + part * 1024 + h * 128 + 8 * c16);
        x[r] = v; }
}
DI void aprod_conv(Frame& F, const v4u (&x)[8], float (&o)[4][8], int h, int part, int c16) {
#pragma unroll
    for (int j = 0; j < 4; ++j)
#pragma unroll
        for (int e = 0; e < 8; ++e) o[j][e] = 0.f;
#pragma unroll
    for (int k = 0; k < 5; ++k) { const float* wp = F.conv_w + k * 3072 + part * 1024 + h * 128 + 8 * c16; const f32x4 w0 = *(const f32x4*)wp, w1 = *(const f32x4*)(wp + 4);
#pragma unroll
        for (int j = 0; j < 4; ++j) { const v4u xr = x[j + k];
            o[j][0] += bflo(xr.x) * w0[0]; o[j][1] += bfhi(xr.x) * w0[1]; o[j][2] += bflo(xr.y) * w0[2]; o[j][3] += bfhi(xr.y) * w0[3];
            o[j][4] += bflo(xr.z) * w1[0]; o[j][5] += bfhi(xr.z) * w1[1]; o[j][6] += bflo(xr.w) * w1[2]; o[j][7] += bfhi(xr.w) * w1[3]; } }
#pragma unroll
    for (int j = 0; j < 4; ++j)
#pragma unroll
        for (int e = 0; e < 8; ++e) o[j][e] = silu_f(o[j][e]);
}
DI void aprod_store_rows(LAS unsigned char* img, const float (&o)[4][8], const float (&sc)[4], int p0, int c16) {
#pragma unroll
    for (int j = 0; j < 4; ++j) { v4u w; w.x = cvtpk(o[j][0] * sc[j], o[j][1] * sc[j]); w.y = cvtpk(o[j][2] * sc[j], o[j][3] * sc[j]); w.z = cvtpk(o[j][4] * sc[j], o[j][5] * sc[j]); w.w = cvtpk(o[j][6] * sc[j], o[j][7] * sc[j]);
        *(LAS v4u*)(img + (p0 + j) * AB_LD + c16 * 16) = w; }
}

DI void a_prep_phase(Frame& F) {
    const int lane = F.lane, wave = F.wave;
    LAS unsigned char* L = F.lds + RING_OFF;
    const int nit = (F.vcu < 2048) ? (2048 - F.vcu + F.G - 1) / F.G : 0;
    const int pw = wave - 4;
    int gI = lane >> 4, c16 = lane & 15, p0 = 16 * (pw & 3) + 4 * gI;
    LAS float* RAW = (LAS float*)(L + AG_RAW);
    v4u xq[8], xk[8], xv[8];
    if (wave >= 4 && nit > 0) { const int it = F.vcu; aprod_load(F, xk, it >> 8, (it >> 3) & 31, it & 7, 1, p0, c16); }
    if (wave == 4 && nit > 0) { const int it = F.vcu; const int b = it >> 8, c = (it >> 3) & 31, h = it & 7; const float* gr = F.GATES + ((size_t)b * SEQ + c * 64 + lane) * 32; RAW[lane] = gr[h]; RAW[64 + lane] = gr[8 + h]; RAW[128 + lane] = gr[16 + h]; RAW[192 + lane] = gr[24 + h]; }
#pragma unroll 1
    for (int k = -1; k < nit; ++k) {
        LAS unsigned char* Bc = L + (k & 1) * AB_BUF;
        LAS unsigned char* Bn = L + ((k + 1) & 1) * AB_BUF;
        const LAS float* GVc = (const LAS float*)(L + AG_0 + (k & 1) * AG_SZ);
        LAS float* GVn = (LAS float*)(L + AG_0 + ((k + 1) & 1) * AG_SZ);
        const int itc = F.vcu + k * F.G, itn = itc + F.G;
        const int item_c = (((itc >> 8) * 8 + (itc & 7)) * 2) * 32 + ((itc >> 3) & 31);
        const int bn = itn >> 8, cn = (itn >> 3) & 31, hn = itn & 7; const int item_n = ((bn * 8 + hn) * 2) * 32 + cn;
        const bool cons = (k >= 0), prod = (k + 1 < nit);
        { int lo_ = lane; asm volatile("" : "+v"(lo_)); gI = lo_ >> 4; c16 = lo_ & 15; p0 = 16 * (pw & 3) + 4 * gI; }
        if (wave < 4) { if (cons) acons_s2(F, L, Bc, GVc, item_c, wave, lane); }
        else if (prod) {
            if (wave == 4) aprod_s0(F, GVn, RAW, item_n, hn, lane);
            aprod_load(F, xq, bn, cn, hn, 0, p0, c16);
            float o[4][8]; aprod_conv(F, xk, o, hn, 1, c16);
            float sc[4];
#pragma unroll
            for (int j = 0; j < 4; ++j) { float ss = 0.f;
#pragma unroll
                for (int e = 0; e < 8; ++e) ss += o[j][e] * o[j][e];
                sc[j] = 1.0f / sqrtf(row16_sum(ss) + EPS); }
            aprod_store_rows(Bn + AB_KH, o, sc, p0, c16);
        }
        LBAR();
        if (wave < 4) { if (cons) { if (wave == 0) s3_solve<false>(L, Bc + AB_QH, GVc, lane); else if (wave == 1) s3_solve<true>(L, Bc + AB_QH, GVc, lane); else acons_kdect(F, Bc, GVc, item_c + 32 * (wave - 2), wave - 2, lane); } }
        else if (prod) {
            aprod_load(F, xv, bn, cn, hn, 2, p0, c16);
            float o[4][8]; aprod_conv(F, xq, o, hn, 0, c16);
            float sc[4];
#pragma unroll
            for (int j = 0; j < 4; ++j) { float ss = 0.f;
#pragma unroll
                for (int e = 0; e < 8; ++e) ss += o[j][e] * o[j][e];
                sc[j] = (1.0f / sqrtf(row16_sum(ss) + EPS)) * 0.08838834764831845f; }
            aprod_store_rows(Bn + AB_QH, o, sc, p0, c16);
            const int idA = 32 * (c16 >> 2) + 8 * ((2 * c16) & 3) + 4 * ((c16 >> 1) & 1);
#pragma unroll
            for (int j = 0; j < 4; ++j) { const int pos = p0 + j; const float ef = GVn[256 + pos] * sc[j], eb = GVn[320 + pos] * sc[j];
                u32x2 a, c2; a.x = cvtpk(o[j][0] * ef, o[j][1] * ef); a.y = cvtpk(o[j][2] * ef, o[j][3] * ef); c2.x = cvtpk(o[j][4] * ef, o[j][5] * ef); c2.y = cvtpk(o[j][6] * ef, o[j][7] * ef);
                bf16* qp = F.QDEC + ((size_t)item_n * 64 + pos) * 128 + idA; *(u32x2*)qp = a; *(u32x2*)(qp + 8) = c2;
                a.x = cvtpk(o[j][0] * eb, o[j][1] * eb); a.y = cvtpk(o[j][2] * eb, o[j][3] * eb); c2.x = cvtpk(o[j][4] * eb, o[j][5] * eb); c2.y = cvtpk(o[j][6] * eb, o[j][7] * eb);
                qp += (size_t)32 * 64 * 128; *(u32x2*)qp = a; *(u32x2*)(qp + 8) = c2; }
        }
        LBAR();
        if (wave < 4) { if (cons) acons_s4(F, L, Bc, item_c, wave, lane); }
        else {
            float g4[4] = {0.f, 0.f, 0.f, 0.f}; const bool more = (k + 2 < nit);
            if (more) { const int it2 = itn + F.G; const int b2 = it2 >> 8, c2 = (it2 >> 3) & 31, h2 = it2 & 7; aprod_load(F, xk, b2, c2, h2, 1, p0, c16);
                if (wave == 4) { const float* gr = F.GATES + ((size_t)b2 * SEQ + c2 * 64 + lane) * 32; g4[0] = gr[h2]; g4[1] = gr[8 + h2]; g4[2] = gr[16 + h2]; g4[3] = gr[24 + h2]; } }
            if (prod) { float o[4][8]; aprod_conv(F, xv, o, hn, 2, c16);
                const float sc[4] = {1.f, 1.f, 1.f, 1.f};
                aprod_store_rows(Bn + AB_VV, o, sc, p0, c16); }
            if (more && wave == 4) { RAW[lane] = g4[0]; RAW[64 + lane] = g4[1]; RAW[128 + lane] = g4[2]; RAW[192 + lane] = g4[3]; }
        }
        LBAR();
    }
}

constexpr int B_KB = 0, B_VB = 55296;
DI void b_attn_unit(Frame& F, int b, int nb, int kvh, bf16* MO) {
    const int tid = F.tid, lane = F.lane, wave = F.wave;
    LAS unsigned char* L = F.lds + RING_OFF;
#pragma unroll
    for (int it = 0; it < 6; ++it) { const int q = tid + 512 * it, row = q >> 3, cc = q & 7; const int t = (nb - 1) * 128 + row; const bool valid = (t >= 0) && (t < SEQ);
        v4u kv = (v4u){0u, 0u, 0u, 0u}, vv = (v4u){0u, 0u, 0u, 0u};
        if (valid) { const bf16* rp = F.PB + ((size_t)b * SEQ + t) * 768 + 512 + kvh * 64 + 8 * cc; kv = *(const v4u*)rp; vv = *(const v4u*)(rp + 128); }
        float xk[8]; xk[0] = bflo(kv.x); xk[1] = bfhi(kv.x); xk[2] = bflo(kv.y); xk[3] = bfhi(kv.y); xk[4] = bflo(kv.z); xk[5] = bfhi(kv.z); xk[6] = bflo(kv.w); xk[7] = bfhi(kv.w);
        float ss = 0.f;
#pragma unroll
        for (int e = 0; e < 8; ++e) ss += xk[e] * xk[e];
        ss += __shfl_xor(ss, 1); ss += __shfl_xor(ss, 2); ss += __shfl_xor(ss, 4);
        const float rstd = 1.0f / sqrtf(ss * (1.0f / 64.0f) + EPS);
        const int tt = valid ? t : 0; float o[8];
#pragma unroll
        for (int e = 0; e < 8; ++e) { const float y = xk[e] * rstd * F.k_norm_b[8 * cc + e]; const float pr = __shfl_xor(y, 4);
            const f32x2v cs = *(const f32x2v*)(F.ROPE + ((size_t)tt * 32 + ((8 * cc + e) & 31)) * 2);
            o[e] = (cc < 4) ? (y * cs.x - pr * cs.y) : (y * cs.x + pr * cs.y); }
        v4u ok; ok.x = cvtpk(o[0], o[1]); ok.y = cvtpk(o[2], o[3]); ok.z = cvtpk(o[4], o[5]); ok.w = cvtpk(o[6], o[7]);
        if (!valid) ok = (v4u){0u, 0u, 0u, 0u};
        *(LAS v4u*)(L + B_KB + row * 144 + cc * 16) = ok; *(LAS v4u*)(L + B_VB + row * 144 + cc * 16) = vv; }
    if (tid < 128) *(LAS v4u*)(L + B_VB + (384 + (tid >> 3)) * 144 + (tid & 7) * 16) = (v4u){0u, 0u, 0u, 0u};
    __syncthreads();
    const int hq = kvh * 4 + (wave >> 1), r16 = lane & 15, g = lane >> 4, q4 = r16 >> 2, p4 = r16 & 3;
    const float sk = F.sink_b[hq] * LOG2E;
#pragma unroll 1
    for (int qt = 0; qt < 4; ++qt) {
        const int i0 = (wave & 1) * 64 + 16 * qt, iq = i0 + r16, pos = nb * 128 + iq; const size_t m = (size_t)b * SEQ + pos;
        bf16x8 qf[2];
        { const bf16* qp = F.PB + m * 768 + hq * 64 + 8 * g; const v4u a = *(const v4u*)qp, c2 = *(const v4u*)(qp + 32);
          float x0[8], x1[8]; x0[0] = bflo(a.x); x0[1] = bfhi(a.x); x0[2] = bflo(a.y); x0[3] = bfhi(a.y); x0[4] = bflo(a.z); x0[5] = bfhi(a.z); x0[6] = bflo(a.w); x0[7] = bfhi(a.w);
          x1[0] = bflo(c2.x); x1[1] = bfhi(c2.x); x1[2] = bflo(c2.y); x1[3] = bfhi(c2.y); x1[4] = bflo(c2.z); x1[5] = bfhi(c2.z); x1[6] = bflo(c2.w); x1[7] = bfhi(c2.w);
          float ss = 0.f;
#pragma unroll
          for (int e = 0; e < 8; ++e) ss += x0[e] * x0[e] + x1[e] * x1[e];
          ss += __shfl_xor(ss, 16); ss += __shfl_xor(ss, 32);
          const float rstd = (1.0f / sqrtf(ss * (1.0f / 64.0f) + EPS));
          float o0[8], o1[8];
#pragma unroll
          for (int e = 0; e < 8; ++e) { const float y0 = x0[e] * rstd * F.q_norm_b[8 * g + e], y1 = x1[e] * rstd * F.q_norm_b[32 + 8 * g + e];
              const f32x2v cs = *(const f32x2v*)(F.ROPE + ((size_t)pos * 32 + 8 * g + e) * 2);
              o0[e] = (y0 * cs.x - y1 * cs.y) * (0.125f * LOG2E); o1[e] = (y1 * cs.x + y0 * cs.y) * (0.125f * LOG2E); }
          v4u w0, w1; w0.x = cvtpk(o0[0], o0[1]); w0.y = cvtpk(o0[2], o0[3]); w0.z = cvtpk(o0[4], o0[5]); w0.w = cvtpk(o0[6], o0[7]);
          w1.x = cvtpk(o1[0], o1[1]); w1.y = cvtpk(o1[2], o1[3]); w1.z = cvtpk(o1[4], o1[5]); w1.w = cvtpk(o1[6], o1[7]);
          qf[0] = __builtin_bit_cast(bf16x8, w0); qf[1] = __builtin_bit_cast(bf16x8, w1); }
        f32x4 st[18];
#pragma unroll
        for (int c = 0; c < 17; ++c) { f32x4 acc = (f32x4){0.f, 0.f, 0.f, 0.f};
#pragma unroll
            for (int s = 0; s < 2; ++s) acc = MFMA16(ld_frag(L + B_KB + (i0 + 16 * c + r16) * 144 + s * 64 + g * 16), qf[s], acc);
            st[c] = acc; __builtin_amdgcn_sched_barrier(0); }
        st[17] = (f32x4){0.f, 0.f, 0.f, 0.f};
        float mx = sk;
#pragma unroll
        for (int c = 0; c < 17; ++c)
#pragma unroll
            for (int reg = 0; reg < 4; ++reg) { const int j = i0 + 16 * c + 4 * g + reg; const int kpos = (nb - 1) * 128 + j;
                const bool ok = (j >= iq) && (j <= iq + 256) && (kpos >= 0) && (kpos < SEQ);
                const float v = ok ? st[c][reg] : -INFINITY; st[c][reg] = v; mx = fmaxf(mx, v); }
        mx = fmaxf(mx, __shfl_xor(mx, 16)); mx = fmaxf(mx, __shfl_xor(mx, 32));
        float sum = 0.f;
#pragma unroll
        for (int c = 0; c < 17; ++c)
#pragma unroll
            for (int reg = 0; reg < 4; ++reg) { const float p = __builtin_amdgcn_exp2f(st[c][reg] - mx); st[c][reg] = p; sum += p; }
        sum += __shfl_xor(sum, 16); sum += __shfl_xor(sum, 32);
        const float inv = 1.0f / (sum + __builtin_amdgcn_exp2f(sk - mx));
        bf16x8 pb[9];
#pragma unroll
        for (int kp = 0; kp < 9; ++kp) pb[kp] = pack8(st[2 * kp], st[2 * kp + 1]);
#pragma unroll
        for (int td = 0; td < 4; ++td) { f32x4 acc = (f32x4){0.f, 0.f, 0.f, 0.f};
#pragma unroll
            for (int kp = 0; kp < 9; ++kp) acc = MFMA16(tr_frag(L + B_VB + ((i0 + 32 * kp + 4 * g + q4) * 72 + 16 * td + 4 * p4) * 2, 16 * 144), pb[kp], acc);
            const size_t mo = m * 2048 + 1024 + hq * 64 + 16 * td + 4 * g; const u32x2 z = *(const u32x2*)(F.MIX + mo); bf16* mp = MO + mo;
            u32x2 o; o.x = cvtpk(acc[0] * inv * bflo(z.x), acc[1] * inv * bfhi(z.x)); o.y = cvtpk(acc[2] * inv * bflo(z.y), acc[3] * inv * bfhi(z.y));
            *(u32x2*)mp = o; __builtin_amdgcn_sched_barrier(0); }
    }
    __syncthreads();
}

constexpr int C_KC = 0, C_VC = 69632;
DI void c_attn_unit(Frame& F, int b, int hc, int qblk, bf16* MO) {
    const int tid = F.tid, lane = F.lane, wave = F.wave;
    LAS unsigned char* L = F.lds + RING_OFF;
#pragma unroll
    for (int it = 0; it < 8; ++it) { const int q = tid + 512 * it, row = q >> 4, cc = q & 15;
        const bf16* rp = F.KVM + ((size_t)b * MEMLEN + row) * 1024 + hc * 128 + 8 * cc; const v4u kv = *(const v4u*)rp, vv = *(const v4u*)(rp + 512);
        float xk[8]; xk[0] = bflo(kv.x); xk[1] = bfhi(kv.x); xk[2] = bflo(kv.y); xk[3] = bfhi(kv.y); xk[4] = bflo(kv.z); xk[5] = bfhi(kv.z); xk[6] = bflo(kv.w); xk[7] = bfhi(kv.w);
        float ss = 0.f;
#pragma unroll
        for (int e = 0; e < 8; ++e) ss += xk[e] * xk[e];
        ss += __shfl_xor(ss, 1); ss += __shfl_xor(ss, 2); ss += __shfl_xor(ss, 4); ss += __shfl_xor(ss, 8);
        const float rstd = 1.0f / sqrtf(ss * (1.0f / 128.0f) + EPS);
        float o[8];
#pragma unroll
        for (int e = 0; e < 8; ++e) o[e] = xk[e] * rstd * F.k_norm_c[8 * cc + e];
        v4u ok; ok.x = cvtpk(o[0], o[1]); ok.y = cvtpk(o[2], o[3]); ok.z = cvtpk(o[4], o[5]); ok.w = cvtpk(o[6], o[7]);
        *(LAS v4u*)(L + C_KC + row * 272 + cc * 16) = ok; *(LAS v4u*)(L + C_VC + row * 272 + cc * 16) = vv; }
    __syncthreads();
    const int r16 = lane & 15, g = lane >> 4, q4 = r16 >> 2, p4 = r16 & 3;
#pragma unroll 1
    for (int qt = 0; qt < 2; ++qt) {
        const size_t m = (size_t)b * SEQ + qblk * 256 + wave * 32 + qt * 16 + r16;
        bf16x8 qf[4];
        { float xs[4][8]; float ss = 0.f;
#pragma unroll
          for (int s = 0; s < 4; ++s) { const v4u a = *(const v4u*)(F.PC + m * 512 + hc * 128 + 32 * s + 8 * g);
              xs[s][0] = bflo(a.x); xs[s][1] = bfhi(a.x); xs[s][2] = bflo(a.y); xs[s][3] = bfhi(a.y); xs[s][4] = bflo(a.z); xs[s][5] = bfhi(a.z); xs[s][6] = bflo(a.w); xs[s][7] = bfhi(a.w);
#pragma unroll
              for (int e = 0; e < 8; ++e) ss += xs[s][e] * xs[s][e]; }
          ss += __shfl_xor(ss, 16); ss += __shfl_xor(ss, 32);
          const float rstd = (1.0f / sqrtf(ss * (1.0f / 128.0f) + EPS)) * (0.08838834764831845f * LOG2E);
#pragma unroll
          for (int s = 0; s < 4; ++s) { float o[8];
#pragma unroll
              for (int e = 0; e < 8; ++e) o[e] = xs[s][e] * rstd * F.q_norm_c[32 * s + 8 * g + e];
              v4u w0; w0.x = cvtpk(o[0], o[1]); w0.y = cvtpk(o[2], o[3]); w0.z = cvtpk(o[4], o[5]); w0.w = cvtpk(o[6], o[7]); qf[s] = __builtin_bit_cast(bf16x8, w0); } }
        f32x4 st[16];
#pragma unroll
        for (int c = 0; c < 16; ++c) { f32x4 acc = (f32x4){0.f, 0.f, 0.f, 0.f};
#pragma unroll
            for (int s = 0; s < 4; ++s) acc = MFMA16(ld_frag(L + C_KC + (16 * c + r16) * 272 + s * 64 + g * 16), qf[s], acc);
            st[c] = acc; __builtin_amdgcn_sched_barrier(0); }
        float mx = -INFINITY;
#pragma unroll
        for (int c = 0; c < 16; ++c)
#pragma unroll
            for (int reg = 0; reg < 4; ++reg) mx = fmaxf(mx, st[c][reg]);
        mx = fmaxf(mx, __shfl_xor(mx, 16)); mx = fmaxf(mx, __shfl_xor(mx, 32));
        float sum = 0.f;
#pragma unroll
        for (int c = 0; c < 16; ++c)
#pragma unroll
            for (int reg = 0; reg < 4; ++reg) { const float p = __builtin_amdgcn_exp2f(st[c][reg] - mx); st[c][reg] = p; sum += p; }
        sum += __shfl_xor(sum, 16); sum += __shfl_xor(sum, 32);
        const float inv = 1.0f / sum;
        bf16x8 pb[8];
#pragma unroll
        for (int kp = 0; kp < 8; ++kp) pb[kp] = pack8(st[2 * kp], st[2 * kp + 1]);
#pragma unroll
        for (int td = 0; td < 8; ++td) { f32x4 acc = (f32x4){0.f, 0.f, 0.f, 0.f};
#pragma unroll
            for (int kp = 0; kp < 8; ++kp) acc = MFMA16(tr_frag(L + C_VC + ((32 * kp + 4 * g + q4) * 136 + 16 * td + 4 * p4) * 2, 16 * 272), pb[kp], acc);
            const size_t mo = m * 2048 + 1536 + hc * 128 + 16 * td + 4 * g; const u32x2 z = *(const u32x2*)(F.MIX + mo); bf16* mp = MO + mo;
            u32x2 o; o.x = cvtpk(acc[0] * inv * bflo(z.x), acc[1] * inv * bfhi(z.x)); o.y = cvtpk(acc[2] * inv * bflo(z.y), acc[3] * inv * bfhi(z.y));
            *(u32x2*)mp = o; __builtin_amdgcn_sched_barrier(0); }
    }
    __syncthreads();
}

constexpr int S_WN = 0, S_QD = 18432, S_KT = 36864, S_QK = 55296, S_BUF = 64512;
static_assert(2 * S_BUF <= RING_BYTES, "scan LDS");
DI void scan_unit(Frame& F, int bh, int dir, int half) {
    const int tid = F.tid, lane = F.lane, wave = F.wave;
    LAS unsigned char* L = F.lds + RING_OFF;
    const int b = bh >> 3, h = bh & 7;
    const int item0 = (bh * 2 + dir) * 32;
    const int r16 = lane & 15, g = lane >> 4;
    const int lt = tid - 256;
    f32x4 S[8];
#pragma unroll
    for (int td = 0; td < 8; ++td) S[td] = (f32x4){0.f, 0.f, 0.f, 0.f};
    v4u ld[14];
#define SC_LOAD(n_) do { const size_t it_ = (size_t)(item0 + (n_)); \
        _Pragma("unroll") for (int i_ = 0; i_ < 4; ++i_) { const int q_ = lt + 256 * i_; ld[i_] = *(const v4u*)(F.WNEG + it_ * 8192 + (size_t)q_ * 8); ld[4 + i_] = *(const v4u*)(F.QDEC + it_ * 8192 + (size_t)q_ * 8); ld[8 + i_] = *(const v4u*)(F.KDECT + it_ * 8192 + (size_t)q_ * 8); } \
        _Pragma("unroll") for (int i_ = 0; i_ < 2; ++i_) { const int q_ = lt + 256 * i_; ld[12 + i_] = *(const v4u*)(F.QKM + it_ * 4096 + (size_t)q_ * 8); } } while (0)
#define SC_WRITE(bufo_) do { LAS unsigned char* B_ = L + (bufo_); \
        _Pragma("unroll") for (int i_ = 0; i_ < 4; ++i_) { const int q_ = lt + 256 * i_; *(LAS v4u*)(B_ + S_WN + (q_ >> 4) * 288 + (q_ & 15) * 16) = ld[i_]; *(LAS v4u*)(B_ + S_QD + (q_ >> 4) * 288 + (q_ & 15) * 16) = ld[4 + i_]; *(LAS v4u*)(B_ + S_KT + (q_ >> 3) * 144 + (q_ & 7) * 16) = ld[8 + i_]; } \
        _Pragma("unroll") for (int i_ = 0; i_ < 2; ++i_) { const int q_ = lt + 256 * i_; *(LAS v4u*)(B_ + S_QK + (q_ >> 3) * 144 + (q_ & 7) * 16) = ld[12 + i_]; } } while (0)
    if (wave >= 4) { const int n0 = dir ? 31 : 0; SC_LOAD(n0); SC_WRITE(0); }
    __syncthreads();
#pragma unroll 1
    for (int s = 0; s < 32; ++s) {
        const int n = dir ? 31 - s : s;
        if (wave >= 4) {
            if (s + 1 < 32) { const int nn = dir ? 30 - s : s + 1; SC_LOAD(nn); SC_WRITE(((s + 1) & 1) * S_BUF); }
        } else {
            const LAS unsigned char* Bf = L + (s & 1) * S_BUF;
            const int e = half * 64 + wave * 16 + r16;
            const float cd = F.CD[item0 + n];
            f32x4 vacc[4], oacc[4];
            { const bf16* up = F.UT + ((size_t)(item0 + n) * 128 + e) * 64 + 4 * g;
#pragma unroll
              for (int t = 0; t < 4; ++t) { const u32x2 uu = *(const u32x2*)(up + 16 * t); vacc[t] = (f32x4){bflo(uu.x), bfhi(uu.x), bflo(uu.y), bfhi(uu.y)}; oacc[t] = (f32x4){0.f, 0.f, 0.f, 0.f}; } }
            bf16x8 Sb[4];
#pragma unroll
            for (int ks = 0; ks < 4; ++ks) Sb[ks] = pack8(S[2 * ks], S[2 * ks + 1]);
#pragma unroll
            for (int t = 0; t < 4; ++t)
#pragma unroll
                for (int ks = 0; ks < 4; ++ks) { vacc[t] = MFMA16(ld_frag(Bf + S_WN + (16 * t + r16) * 288 + ks * 64 + g * 16), Sb[ks], vacc[t]);
                    oacc[t] = MFMA16(ld_frag(Bf + S_QD + (16 * t + r16) * 288 + ks * 64 + g * 16), Sb[ks], oacc[t]); }
            bf16x8 Vb[2];
#pragma unroll
            for (int kp = 0; kp < 2; ++kp) Vb[kp] = pack8(vacc[2 * kp], vacc[2 * kp + 1]);
#pragma unroll
            for (int t = 0; t < 4; ++t)
#pragma unroll
                for (int kp = 0; kp < 2; ++kp) oacc[t] = MFMA16(ld_frag(Bf + S_QK + (16 * t + r16) * 144 + kp * 64 + g * 16), Vb[kp], oacc[t]);
            { bf16* op = (dir ? F.OB : F.OF) + ((size_t)b * SEQ + (size_t)n * 64 + 4 * g) * 1024 + h * 128 + e;
#pragma unroll
              for (int t = 0; t < 4; ++t)
#pragma unroll
                  for (int reg = 0; reg < 4; ++reg) op[(size_t)(16 * t + reg) * 1024] = (bf16)f2bf(oacc[t][reg]); }
#pragma unroll
            for (int td = 0; td < 8; ++td) { f32x4 a = S[td] * cd;
#pragma unroll
                for (int kp = 0; kp < 2; ++kp) a = MFMA16(ld_frag(Bf + S_KT + (16 * td + r16) * 144 + kp * 64 + g * 16), Vb[kp], a);
                S[td] = a; }
        }
        __syncthreads();
    }
#undef SC_LOAD
#undef SC_WRITE
}

DI void combine_row(Frame& F, size_t m, bf16* MO) {
    const int lane = F.lane; const size_t off = m * 1024 + 16 * lane;
    const v4u f0 = *(const v4u*)(F.OF + off), f1 = *(const v4u*)(F.OF + off + 8), b0 = *(const v4u*)(F.OB + off), b1 = *(const v4u*)(F.OB + off + 8);
    const bf16* zp = F.MIX + m * 2048 + 16 * lane; const v4u z0 = *(const v4u*)zp, z1 = *(const v4u*)(zp + 8); bf16* mp = MO + m * 2048 + 16 * lane;
    float o[16];
    o[0] = bflo(f0.x) + bflo(b0.x); o[1] = bfhi(f0.x) + bfhi(b0.x); o[2] = bflo(f0.y) + bflo(b0.y); o[3] = bfhi(f0.y) + bfhi(b0.y);
    o[4] = bflo(f0.z) + bflo(b0.z); o[5] = bfhi(f0.z) + bfhi(b0.z); o[6] = bflo(f0.w) + bflo(b0.w); o[7] = bfhi(f0.w) + bfhi(b0.w);
    o[8] = bflo(f1.x) + bflo(b1.x); o[9] = bfhi(f1.x) + bfhi(b1.x); o[10] = bflo(f1.y) + bflo(b1.y); o[11] = bfhi(f1.y) + bfhi(b1.y);
    o[12] = bflo(f1.z) + bflo(b1.z); o[13] = bfhi(f1.z) + bfhi(b1.z); o[14] = bflo(f1.w) + bflo(b1.w); o[15] = bfhi(f1.w) + bfhi(b1.w);
    float ss = 0.f;
#pragma unroll
    for (int e = 0; e < 16; ++e) ss += o[e] * o[e];
    ss += __shfl_xor(ss, 1); ss += __shfl_xor(ss, 2); ss += __shfl_xor(ss, 4);
    const float rstd = 1.0f / sqrtf(ss * (1.0f / 128.0f) + EPS);
    float z[16];
    z[0] = bflo(z0.x); z[1] = bfhi(z0.x); z[2] = bflo(z0.y); z[3] = bfhi(z0.y); z[4] = bflo(z0.z); z[5] = bfhi(z0.z); z[6] = bflo(z0.w); z[7] = bfhi(z0.w);
    z[8] = bflo(z1.x); z[9] = bfhi(z1.x); z[10] = bflo(z1.y); z[11] = bfhi(z1.y); z[12] = bflo(z1.z); z[13] = bfhi(z1.z); z[14] = bflo(z1.w); z[15] = bfhi(z1.w);
    const int c0 = (16 * lane) & 127; float y[16];
#pragma unroll
    for (int e = 0; e < 16; ++e) y[e] = o[e] * rstd * F.o_norm_a[c0 + e] * z[e];
    v4u w0, w1; w0.x = cvtpk(y[0], y[1]); w0.y = cvtpk(y[2], y[3]); w0.z = cvtpk(y[4], y[5]); w0.w = cvtpk(y[6], y[7]);
    w1.x = cvtpk(y[8], y[9]); w1.y = cvtpk(y[10], y[11]); w1.z = cvtpk(y[12], y[13]); w1.w = cvtpk(y[14], y[15]);
    *(v4u*)mp = w0; *(v4u*)(mp + 8) = w1;
}

struct Args { const float* in[18]; float* out; unsigned char* ws; int ph_lo, ph_hi, li, pad; };
__global__ void __launch_bounds__(NWAVES * 64, 2) hybrid_fwd(Args args) {
    extern __shared__ __attribute__((aligned(16))) unsigned char lds[];
    Frame F;
    F.lds = (LAS unsigned char*)lds;
    F.MISC = (volatile LAS unsigned*)(F.lds + MISC_OFF);
    F.tid = threadIdx.x; F.lane = F.tid & 63; F.wave = __builtin_amdgcn_readfirstlane(F.tid >> 6);
    F.G = gridDim.x; { const int bx = blockIdx.x; F.vcu = (F.G % 8 == 0) ? (bx % 8) * (F.G / 8) + bx / 8 : bx; }
    unsigned char* ws = args.ws;
    F.ctl = (gu32*)(ws + WS_CTL);
    F.x = args.in[0]; F.mem = args.in[1]; F.norm_w = args.in[2]; F.w_in = args.in[3]; F.conv_w = args.in[4]; F.a_log_f = args.in[5]; F.a_log_b = args.in[6];
    F.dt_f = args.in[7]; F.dt_b = args.in[8]; F.o_norm_a = args.in[9]; F.q_norm_b = args.in[10]; F.k_norm_b = args.in[11]; F.sink_b = args.in[12];
    F.mem_norm_w = args.in[13]; F.w_mem_kv = args.in[14]; F.q_norm_c = args.in[15]; F.k_norm_c = args.in[16]; F.w_out = args.in[17]; F.out = args.out;
    F.WinT = (bf16*)(ws + WS_WIN); F.WmemT = (bf16*)(ws + WS_WMEM); F.WoutT = (bf16*)(ws + WS_WOUT); F.XN = (bf16*)(ws + WS_XN); F.MEMN = (bf16*)(ws + WS_MEMN);
    F.PA = (bf16*)(ws + WS_PA); F.PB = (bf16*)(ws + WS_PB); F.PC = (bf16*)(ws + WS_PC); F.MIX = (bf16*)(ws + WS_MIX); F.KVM = (bf16*)(ws + WS_KVM);
    F.UT = (bf16*)(ws + WS_UT); F.WNEG = (bf16*)(ws + WS_WNEG); F.QDEC = (bf16*)(ws + WS_QDEC); F.KDECT = (bf16*)(ws + WS_KDECT); F.QKM = (bf16*)(ws + WS_QKM);
    F.OF = (bf16*)(ws + WS_OF); F.OB = (bf16*)(ws + WS_OB);
    F.GATES = (float*)(ws + WS_GATES); F.ROPE = (float*)(ws + WS_ROPE); F.CD = (float*)(ws + WS_CD);
    for (int u = F.tid; u < (LDS_BYTES - LDSCTL_OFF) / 4; u += NWAVES * 64) ((LAS unsigned*)(F.lds + LDSCTL_OFF))[u] = 0u;
    __syncthreads();
    XcdBarrier bar; bar.bar = (unsigned*)(F.ctl + CW_BAR); bar.x = 0; bar.st = nullptr;
    if (N_LAUNCHES != PER_PHASE) bar = xcd_barrier_post((unsigned*)(F.ctl + CW_BAR), F.MISC + 8);
#define GRID_BAR() do { if (N_LAUNCHES == PER_PHASE) { if (F.tid == 0) __hip_atomic_store(F.ctl + CW_TMO, 0xBADBA0u, RLX_AGENT); } else { xcd_barrier(bar); } } while (0)
    const int lo = args.ph_lo, hi = args.ph_hi;
#define IN(k) (lo <= (k) && (k) < hi)
#define BOTH(k) (IN(k) && IN((k) + 1))

#ifndef REP0
#define REP0 1
#endif
#ifndef REP1
#define REP1 1
#endif
#ifndef REP2A
#define REP2A 1
#endif
#ifndef REP2B
#define REP2B 1
#endif
#ifndef REP2C
#define REP2C 1
#endif
#ifndef REP3
#define REP3 1
#endif
#ifndef REP4
#define REP4 1
#endif
#ifndef REP5
#define REP5 1
#endif
#ifndef REPBAR
#define REPBAR 1
#endif
    bf16* const DRY = (bf16*)F.out;
    if (IN(0)) { for (int rep = 0; rep < REP0; ++rep) p0_prologue(F); if (BOTH(0)) for (int rep = 0; rep < REPBAR; ++rep) GRID_BAR(); }

    if (IN(1)) {
        pg8::Gemm g{F.XN, F.WinT, M + NBATCH * MEMLEN, 6656 + 1024, DMODEL}; pg8::InOrder S; S.init(F.G, (int)blockIdx.x, REP1);
        pg8::EpiIn E{F.PA, F.PB, F.PC, F.MIX, F.KVM, F.GATES};
        pg8::gemm_phase<pg8::EpiIn, pg8::InOrder, true, true>(F.lds + RING_OFF, g, S, E);
        if (BOTH(1)) GRID_BAR();
    }

    if (IN(2)) {
        for (int rep = 0; rep < REP2A; ++rep) a_prep_phase(F);
        for (int rep = 0; rep < REP2B; ++rep) for (int it = F.vcu; it < 256; it += F.G) b_attn_unit(F, it >> 5, (it >> 1) & 15, it & 1, rep == REP2B - 1 ? F.MIX : DRY);
        for (int rep = 0; rep < REP2C; ++rep) for (int it = F.vcu; it < 256; it += F.G) c_attn_unit(F, it >> 5, (it >> 3) & 3, it & 7, rep == REP2C - 1 ? F.MIX : DRY);
        if (BOTH(2)) GRID_BAR();
    }

    if (IN(3)) {
        for (int rep = 0; rep < REP3; ++rep) for (int it = F.vcu; it < 256; it += F.G) scan_unit(F, it >> 2, (it >> 1) & 1, it & 1);
        if (BOTH(3)) GRID_BAR();
    }

    if (IN(4)) {
        const int gw = F.vcu * NWAVES + F.wave, NGW = F.G * NWAVES;
        for (int rep = 0; rep < REP4; ++rep) for (int m = gw; m < M; m += NGW) combine_row(F, (size_t)m, rep == REP4 - 1 ? F.MIX : DRY);
        if (BOTH(4)) GRID_BAR();
    }

    if (IN(5)) {
        pg8::Gemm g{F.MIX, F.WoutT, M, DMODEL, DMODEL}; pg8::RepOrder S; S.init(M, DMODEL, F.G, (int)blockIdx.x, REP5);
        pg8::EpiOut E{F.x, F.out};
        pg8::gemm_phase<pg8::EpiOut, pg8::RepOrder, true, true>(F.lds + RING_OFF, g, S, E);
    }
#undef IN
#undef BOTH
}

extern "C" void kernel_launch(void* const* d_in, const int* in_sizes, int n_in, void* d_out, int out_size, void* d_ws, size_t ws_size, hipStream_t stream) {
    static int grid = 0;
    if (grid == 0) {
        if (n_in != 18 || in_sizes[0] != M * DMODEL || out_size != M * DMODEL || ws_size < WS_END) { fprintf(stderr, "kernel_launch: unexpected problem shape (n_in %d, in0 %d, out %d, ws %zu); nothing launched\n", n_in, n_in > 0 ? in_sizes[0] : -1, out_size, ws_size); grid = -1; return; }
        int dev = 0, cus = 0, per_cu = 0;
        if (hipGetDevice(&dev) != hipSuccess || hipDeviceGetAttribute(&cus, hipDeviceAttributeMultiprocessorCount, dev) != hipSuccess) { fprintf(stderr, "kernel_launch: device query failed\n"); grid = -1; return; }
        if (hipFuncSetAttribute((const void*)hybrid_fwd, hipFuncAttributeMaxDynamicSharedMemorySize, LDS_BYTES) != hipSuccess) { fprintf(stderr, "kernel_launch: hipFuncSetAttribute failed\n"); grid = -1; return; }
        if (hipOccupancyMaxActiveBlocksPerMultiprocessor(&per_cu, (const void*)hybrid_fwd, NWAVES * 64, LDS_BYTES) != hipSuccess || per_cu < 1)
            fprintf(stderr, "kernel_launch: note: occupancy query reports %d workgroups per CU\n", per_cu);
        (void)hipGetLastError();
        grid = cus;
    }
    if (grid < 0) return;
    if (hipMemsetAsync((char*)d_ws + WS_CTL, 0, CTL_ZERO_BYTES, stream) != hipSuccess) { fprintf(stderr, "kernel_launch: hipMemsetAsync failed\n"); return; }
    Args a{};
    for (int i = 0; i < 18; ++i) a.in[i] = (const float*)d_in[i];
    a.out = (float*)d_out; a.ws = (unsigned char*)d_ws;
    for (int li = 0; li < N_LAUNCHES; ++li) {
        a.ph_lo = (N_LAUNCHES == PER_PHASE) ? li : 0; a.ph_hi = (N_LAUNCHES == PER_PHASE) ? li + 1 : PER_PHASE; a.li = li;
        hipLaunchKernelGGL(hybrid_fwd, dim3(grid), dim3(NWAVES * 64), LDS_BYTES, stream, a);
        const hipError_t le = hipPeekAtLastError();
        if (le != hipSuccess) { fprintf(stderr, "kernel_launch: launch %d failed: %s\n", li, hipGetErrorName(le)); break; }
    }
}
```

```cpp
#include <hip/hip_runtime.h>
#include <cstdio>
#include <cstdint>
namespace pg8 {
#define PG8_LAS __attribute__((address_space(3)))
typedef unsigned short bf16_t;
typedef short bf16x8 __attribute__((ext_vector_type(8)));
typedef float f32x4 __attribute__((ext_vector_type(4)));
typedef unsigned u32x4 __attribute__((ext_vector_type(4)));
constexpr int BM = 256, BK = 64, HALF = 128, HTB = HALF * BK * 2  , STAGE_BYTES = 8 * HTB, NXCD = 8, WGM = 8;

__host__ __device__ __forceinline__ int lds_byte(int r, int c) { const int st = (r >> 4) * 2 + (c >> 5), rr = r & 15, cc = c & 31, ob = rr * 64 + cc * 2; return st * 1024 + (ob ^ (((ob >> 9) & 1) << 5)); }
__host__ __device__ __forceinline__ void stage_rc(int b, int& R, int& C) { const int st = b / 1024, sb = b % 1024, swz = sb ^ (((sb >> 9) & 1) << 5); R = (st >> 1) * 16 + swz / 64; C = (st & 1) * 32 + (swz % 64) / 2; }
__host__ __device__ __forceinline__ int perm32(int rho) { const int n = rho >> 4, i = rho & 15; return 8 * (i >> 2) + 4 * n + (i & 3); }

struct Unit { int pm, pn; };
struct Gemm { const bf16_t* A; const bf16_t* Bt; int M, N, K; };

struct StaticOrder {
    int nM, nN, nwg, G, c;
    __host__ __device__ void init(int M, int N, int G_, int c_) { nM = M / BM; nN = N / BM; nwg = nM * nN; G = G_; c = c_; }
    __host__ __device__ bool next(int i, Unit& u) const {
        const long L = (long)i * G + c; if (L >= nwg) return false;
        int wgid = (int)L; { const int q = nwg / NXCD, r = nwg % NXCD, xcd = wgid % NXCD, off = wgid / NXCD; wgid = (xcd < r ? xcd * (q + 1) : r * (q + 1) + (xcd - r) * q) + off; }
        const int nig = WGM * nN, gid = wgid / nig, fm = gid * WGM, gsz = (nM - fm) < WGM ? (nM - fm) : WGM;
        u.pm = fm + ((wgid % nig) % gsz); u.pn = (wgid % nig) / gsz; return true;
    }
    __device__ __forceinline__ void a_ready(const Unit&) const {}
    __device__ __forceinline__ void done(const Unit&) const {}
};

typedef float f32x2 __attribute__((ext_vector_type(2)));
typedef __bf16 bf16x2_t __attribute__((ext_vector_type(2)));
__device__ __forceinline__ unsigned cvt_pk_bf16(float lo, float hi) { f32x2 v = {lo, hi}; bf16x2_t b = __builtin_convertvector(v, bf16x2_t); return __builtin_bit_cast(unsigned, b); }
__device__ __forceinline__ float silu_f(float v) { return v * __builtin_amdgcn_rcpf(1.0f + __expf(-v)); }

struct EpiIn {
    static constexpr bool PERM = true, AFTER_DRAIN = false;
    bf16_t *PA, *PB, *PC, *MIX, *KVM; float* GATES;
    __device__ __forceinline__ void init(f32x4 (&acc)[2][2][4][2], const Unit&, int, int, int, int) const {
#pragma unroll
        for (int a = 0; a < 2; ++a)
#pragma unroll
            for (int b = 0; b < 2; ++b)
#pragma unroll
                for (int m = 0; m < 4; ++m)
#pragma unroll
                    for (int n = 0; n < 2; ++n) acc[a][b][m][n] = (f32x4){0.f, 0.f, 0.f, 0.f};
    }
    __device__ __forceinline__ void operator()(const f32x4 (&acc)[2][2][4][2], const Unit& u, int wr, int wc, int fr, int fq) const {
        const int row0 = u.pm * BM + wr * 64 + fr, cl = wc * 32 + 8 * fq, pn = u.pn;
        if (u.pm < 64 && pn == 25) {
            if (wc == 0) {
#pragma unroll
                for (int ai = 0; ai < 2; ++ai)
#pragma unroll
                    for (int m = 0; m < 4; ++m) { float* g = GATES + (size_t)(row0 + ai * HALF + m * 16) * 32 + 8 * fq;
                        *(f32x4*)g = acc[ai][0][m][0]; *(f32x4*)(g + 4) = acc[ai][0][m][1]; }
            }
            return;
        }
        bf16_t* base; int ldc; bool act = false;
        if (u.pm >= 64) { base = KVM + (size_t)(row0 - 16384) * 1024 + (pn - 26) * 256; ldc = 1024; }
        else if (pn < 12) { base = PA + (size_t)row0 * 3072 + pn * 256; ldc = 3072; }
        else if (pn < 16) { base = MIX + (size_t)row0 * 2048 + (pn - 12) * 256; ldc = 2048; act = true; }
        else if (pn < 19) { base = PB + (size_t)row0 * 768 + (pn - 16) * 256; ldc = 768; }
        else if (pn < 21) { base = MIX + (size_t)row0 * 2048 + 1024 + (pn - 19) * 256; ldc = 2048; act = true; }
        else if (pn < 23) { base = PC + (size_t)row0 * 512 + (pn - 21) * 256; ldc = 512; }
        else { base = MIX + (size_t)row0 * 2048 + 1536 + (pn - 23) * 256; ldc = 2048; act = true; }
        base += cl;
#pragma unroll
        for (int ai = 0; ai < 2; ++ai)
#pragma unroll
            for (int m = 0; m < 4; ++m) { bf16_t* rowp = base + (size_t)(ai * HALF + m * 16) * ldc;
#pragma unroll
                for (int bj = 0; bj < 2; ++bj) { f32x4 v0 = acc[ai][bj][m][0], v1 = acc[ai][bj][m][1];
                    if (act) { v0 = (f32x4){silu_f(v0[0]), silu_f(v0[1]), silu_f(v0[2]), silu_f(v0[3])}; v1 = (f32x4){silu_f(v1[0]), silu_f(v1[1]), silu_f(v1[2]), silu_f(v1[3])}; }
                    u32x4 w; w.x = cvt_pk_bf16(v0[0], v0[1]); w.y = cvt_pk_bf16(v0[2], v0[3]); w.z = cvt_pk_bf16(v1[0], v1[1]); w.w = cvt_pk_bf16(v1[2], v1[3]);
                    *(u32x4*)(rowp + bj * HALF) = w; } }
    }
};
struct EpiOut {
    static constexpr bool PERM = false, AFTER_DRAIN = false;
    const float* X; float* O;
    __device__ __forceinline__ void init(f32x4 (&acc)[2][2][4][2], const Unit& u, int wr, int wc, int fr, int fq) const {
        const int row0 = u.pm * BM + wr * 64 + fr, col0 = u.pn * BM + wc * 32 + 4 * fq;
#pragma unroll
        for (int ai = 0; ai < 2; ++ai)
#pragma unroll
            for (int m = 0; m < 4; ++m) { const size_t off = (size_t)(row0 + ai * HALF + m * 16) * 2048 + col0;
#pragma unroll
                for (int bj = 0; bj < 2; ++bj)
#pragma unroll
                    for (int n = 0; n < 2; ++n) acc[ai][bj][m][n] = *(const f32x4*)(X + off + bj * HALF + n * 16); }
    }
    __device__ __forceinline__ void operator()(const f32x4 (&acc)[2][2][4][2], const Unit& u, int wr, int wc, int fr, int fq) const {
        const int row0 = u.pm * BM + wr * 64 + fr, col0 = u.pn * BM + wc * 32 + 4 * fq;
#pragma unroll
        for (int ai = 0; ai < 2; ++ai)
#pragma unroll
            for (int m = 0; m < 4; ++m) { const size_t off = (size_t)(row0 + ai * HALF + m * 16) * 2048 + col0;
#pragma unroll
                for (int bj = 0; bj < 2; ++bj)
#pragma unroll
                    for (int n = 0; n < 2; ++n) *(f32x4*)(O + off + bj * HALF + n * 16) = acc[ai][bj][m][n]; }
    }
};
struct InOrder {
    StaticOrder base; int G, c, rep;
    __host__ __device__ void init(int G_, int c_, int rep_ = 1) { G = G_; c = c_; rep = rep_; base.init(16384, 6656, G_, 0); }
    __host__ __device__ bool next(int i, Unit& u) const {
        long L = (long)i * G + c; const long tot = base.nwg + 32;
        if (L >= tot * rep) return false;
        L %= tot;
        if (L < base.nwg) { StaticOrder b2 = base; b2.c = (int)(L % G); return b2.next((int)(L / G), u); }
        const int j = (int)(L - base.nwg);
        u.pm = 64 + (j >> 2); u.pn = 26 + (j & 3); return true;
    }
    __device__ __forceinline__ void a_ready(const Unit&) const {}
    __device__ __forceinline__ void done(const Unit&) const {}
};
struct RepOrder {
    StaticOrder base; int G, c, rep;
    __host__ __device__ void init(int M_, int N_, int G_, int c_, int rep_ = 1) { G = G_; c = c_; rep = rep_; base.init(M_, N_, G_, 0); }
    __host__ __device__ bool next(int i, Unit& u) const {
        long L = (long)i * G + c; if (L >= (long)base.nwg * rep) return false;
        L %= base.nwg; StaticOrder b2 = base; b2.c = (int)(L % G); return b2.next((int)(L / G), u);
    }
    __device__ __forceinline__ void a_ready(const Unit&) const {}
    __device__ __forceinline__ void done(const Unit&) const {}
};

template <class Epi, class Sched, bool ALIGN_EPI = false, bool SP2 = false>
__device__ __forceinline__ void gemm_phase(PG8_LAS unsigned char* lds, const Gemm g, const Sched& S, const Epi& E) {
    const int tid = threadIdx.x, wid = __builtin_amdgcn_readfirstlane(tid >> 6), lane = tid & 63, wr = wid >> 2, wc = wid & 3, fr = lane & 15, fq = lane >> 4;
    const int K = g.K, nt = K / BK;
    unsigned voffA[2], voffB[2];
#pragma unroll
    for (int i = 0; i < 2; ++i) { int R, C; stage_rc(tid * 16 + i * 8192, R, C); const int Rb = Epi::PERM ? ((R & ~31) + perm32(R & 31)) : R;
        voffA[i] = (unsigned)(R * K + C) * 2u; voffB[i] = (unsigned)(Rb * K + C) * 2u; }
    const size_t kstep = (size_t)(BK * 2);
    const size_t hstep = (size_t)HALF * K * 2;
    const size_t tstep = 2 * hstep;
    const unsigned ldsw = (unsigned)wid * 1024u;
    const int aoff = lds_byte(wr * 64 + fr, fq * 8), boff = lds_byte(wc * 32 + fr, fq * 8);
#define PG8_SA(b, h) (((b) * 2 + (h)) * HTB)
#define PG8_SB(b, h) ((4 + (b) * 2 + (h)) * HTB)
#define PG8_STAGE(bufoff, gbase, voff) do { _Pragma("unroll") for (int _i = 0; _i < 2; ++_i) \
        __builtin_amdgcn_global_load_lds((const unsigned*)((const char*)(gbase) + (voff)[_i]), (PG8_LAS unsigned*)(lds + (bufoff) + ldsw + _i * 8192), 16, 0, 0); } while (0)
#define PG8_LDA(dst, b, h) do { _Pragma("unroll") for (int m = 0; m < 4; ++m) _Pragma("unroll") for (int k = 0; k < 2; ++k) dst[m][k] = *(const PG8_LAS bf16x8*)(lds + PG8_SA(b, h) + aoff + m * 2048 + k * 1024); } while (0)
#define PG8_LDB(dst, b, h) do { _Pragma("unroll") for (int n = 0; n < 2; ++n) _Pragma("unroll") for (int k = 0; k < 2; ++k) dst[n][k] = *(const PG8_LAS bf16x8*)(lds + PG8_SB(b, h) + boff + n * 2048 + k * 1024); } while (0)
#define PG8_MMA(ai, bj, At, Bt) do { __builtin_amdgcn_s_setprio(1); _Pragma("unroll") for (int m = 0; m < 4; ++m) _Pragma("unroll") for (int n = 0; n < 2; ++n) _Pragma("unroll") for (int k = 0; k < 2; ++k) \
        acc[ai][bj][m][n] = __builtin_amdgcn_mfma_f32_16x16x32_bf16(Bt[n][k], At[m][k], acc[ai][bj][m][n], 0, 0, 0); __builtin_amdgcn_s_setprio(0); } while (0)
#define PG8_WAIT_V(n) asm volatile("s_waitcnt vmcnt(" #n ")" ::: "memory")
#define PG8_WAIT_L(n) asm volatile("s_waitcnt lgkmcnt(" #n ")" ::: "memory")
#define PG8_BAR __builtin_amdgcn_s_barrier()
#define PG8_SCHED __builtin_amdgcn_sched_barrier(0)
    Unit cur, nxt; int ui = 0;
    if (!S.next(0, cur)) return;
    f32x4 acc[2][2][4][2];
    E.init(acc, cur, wr, wc, fr, fq);
    bf16x8 At[4][2], B0[2][2], B1[2][2];
    const char* cA = (const char*)g.A + (size_t)cur.pm * tstep; const char* cB = (const char*)g.Bt + (size_t)cur.pn * tstep;
    S.a_ready(cur);
    if constexpr (SP2) {
        PG8_STAGE(PG8_SB(0, 0), cB, voffB); PG8_STAGE(PG8_SB(0, 1), cB + hstep, voffB); PG8_STAGE(PG8_SA(0, 0), cA, voffA); PG8_STAGE(PG8_SA(0, 1), cA + hstep, voffA);
        if (wr == 1) PG8_BAR;
        PG8_WAIT_V(2); PG8_BAR;
        PG8_STAGE(PG8_SB(1, 0), cB + kstep, voffB); PG8_STAGE(PG8_SA(1, 0), cA + kstep, voffA); PG8_STAGE(PG8_SB(1, 1), cB + hstep + kstep, voffB);
        PG8_WAIT_V(6); PG8_BAR;
    } else {
        PG8_STAGE(PG8_SB(0, 0), cB, voffB); PG8_STAGE(PG8_SA(0, 0), cA, voffA); PG8_STAGE(PG8_SB(0, 1), cB + hstep, voffB); PG8_STAGE(PG8_SA(0, 1), cA + hstep, voffA);
        if (wr == 1) PG8_BAR;
        PG8_WAIT_V(4); PG8_BAR;
        PG8_STAGE(PG8_SB(1, 0), cB + kstep, voffB); PG8_STAGE(PG8_SA(1, 0), cA + kstep, voffA); PG8_STAGE(PG8_SB(1, 1), cB + hstep + kstep, voffB);
        PG8_WAIT_V(6); PG8_BAR;
    }
    for (;;) {
        const bool has_next = S.next(ui + 1, nxt);
        const char* nA = has_next ? (const char*)g.A + (size_t)nxt.pm * tstep : cA; const char* nB = has_next ? (const char*)g.Bt + (size_t)nxt.pn * tstep : cB;
        for (int t = 0; t < nt; t += 2) {
            const bool last = (t == nt - 2);
            const char* a1 = cA + (size_t)(t + 1) * kstep;
            const char* a2 = last ? nA : cA + (size_t)(t + 2) * kstep; const char* b2 = last ? nB : cB + (size_t)(t + 2) * kstep;
            const char* a3 = a2 + kstep; const char* b3 = b2 + kstep;
            if (last && has_next) S.a_ready(nxt);
            if constexpr (SP2) {
            PG8_LDB(B0, 0, 0); PG8_LDB(B1, 0, 1); PG8_SCHED; PG8_LDA(At, 0, 0); PG8_STAGE(PG8_SA(1, 1), a1 + hstep, voffA);
            PG8_WAIT_V(8); PG8_WAIT_L(0); PG8_BAR; PG8_MMA(0, 0, At, B0); PG8_MMA(0, 1, At, B1); PG8_BAR; PG8_SCHED;
            PG8_LDA(At, 0, 1); PG8_STAGE(PG8_SB(0, 0), b2, voffB); PG8_STAGE(PG8_SB(0, 1), b2 + hstep, voffB); PG8_STAGE(PG8_SA(0, 0), a2, voffA);
            PG8_WAIT_V(8); PG8_WAIT_L(0); PG8_BAR; PG8_MMA(1, 0, At, B0); PG8_MMA(1, 1, At, B1); PG8_BAR; PG8_SCHED;
            PG8_LDB(B0, 1, 0); PG8_LDB(B1, 1, 1); PG8_SCHED; PG8_LDA(At, 1, 0); PG8_STAGE(PG8_SA(0, 1), a2 + hstep, voffA);
            PG8_WAIT_V(8); PG8_WAIT_L(0); PG8_BAR; PG8_MMA(0, 0, At, B0); PG8_MMA(0, 1, At, B1); PG8_BAR; PG8_SCHED;
            PG8_LDA(At, 1, 1); PG8_STAGE(PG8_SB(1, 0), b3, voffB); PG8_STAGE(PG8_SB(1, 1), b3 + hstep, voffB); PG8_STAGE(PG8_SA(1, 0), a3, voffA);
            PG8_WAIT_V(8); PG8_WAIT_L(0); PG8_BAR; PG8_MMA(1, 0, At, B0); PG8_MMA(1, 1, At, B1); PG8_BAR; PG8_SCHED;
            } else {
            PG8_LDB(B0, 0, 0); PG8_SCHED; PG8_LDA(At, 0, 0); PG8_STAGE(PG8_SA(1, 1), a1 + hstep, voffA);
            PG8_WAIT_L(8); PG8_BAR; PG8_WAIT_L(0); PG8_MMA(0, 0, At, B0); PG8_BAR; PG8_SCHED;
            PG8_LDB(B1, 0, 1); PG8_STAGE(PG8_SB(0, 0), b2, voffB);
            PG8_BAR; PG8_WAIT_L(0); PG8_MMA(0, 1, At, B1); PG8_BAR;
            PG8_LDA(At, 0, 1); PG8_STAGE(PG8_SA(0, 0), a2, voffA);
            PG8_BAR; PG8_WAIT_L(0); PG8_MMA(1, 0, At, B0); PG8_BAR; PG8_SCHED;
            PG8_STAGE(PG8_SB(0, 1), b2 + hstep, voffB);
            PG8_WAIT_V(6); PG8_BAR; PG8_MMA(1, 1, At, B1); PG8_BAR;
            PG8_LDB(B0, 1, 0); PG8_SCHED; PG8_LDA(At, 1, 0); PG8_STAGE(PG8_SA(0, 1), a2 + hstep, voffA);
            PG8_WAIT_L(8); PG8_BAR; PG8_WAIT_L(0); PG8_MMA(0, 0, At, B0); PG8_BAR; PG8_SCHED;
            PG8_LDB(B1, 1, 1); PG8_STAGE(PG8_SB(1, 0), b3, voffB);
            PG8_BAR; PG8_WAIT_L(0); PG8_MMA(0, 1, At, B1); PG8_BAR;
            PG8_LDA(At, 1, 1); PG8_STAGE(PG8_SA(1, 0), a3, voffA);
            PG8_BAR; PG8_WAIT_L(0); PG8_MMA(1, 0, At, B0); PG8_BAR; PG8_SCHED;
            PG8_STAGE(PG8_SB(1, 1), b3 + hstep, voffB);
            PG8_WAIT_V(6); PG8_BAR; PG8_MMA(1, 1, At, B1); PG8_BAR;
            }
        }
        if constexpr (ALIGN_EPI) { if (wr == 0) PG8_BAR; }
        if constexpr (!Epi::AFTER_DRAIN) { E(acc, cur, wr, wc, fr, fq); S.done(cur); }
        if (!has_next) break;
        cur = nxt; cA = nA; cB = nB; ++ui;
        E.init(acc, cur, wr, wc, fr, fq);
        if constexpr (ALIGN_EPI) { if (wr == 1) PG8_BAR; }
    }
    PG8_WAIT_V(0);
    if constexpr (!ALIGN_EPI) { if (wr == 0) PG8_BAR; }
    PG8_BAR;
    if constexpr (Epi::AFTER_DRAIN) { E.fused(acc, cur, wr, wc, fr, fq, lds, wid, lane); S.done(cur); }
#undef PG8_SA
#undef PG8_SB
#undef PG8_STAGE
#undef PG8_LDA
#undef PG8_LDB
#undef PG8_MMA
#undef PG8_WAIT_V
#undef PG8_WAIT_L
#undef PG8_BAR
#undef PG8_SCHED
}
}
#define GAS __attribute__((address_space(1)))
#define LAS __attribute__((address_space(3)))
typedef unsigned short bf16;
typedef unsigned v4u __attribute__((ext_vector_type(4)));
typedef float f32x4 __attribute__((ext_vector_type(4)));
typedef short bf16x8 __attribute__((ext_vector_type(8)));
typedef GAS unsigned gu32;
typedef GAS unsigned long long gu64;
#define RLX_AGENT __ATOMIC_RELAXED, __HIP_MEMORY_SCOPE_AGENT
#define LDS_WAIT() asm volatile("s_waitcnt lgkmcnt(0)" ::: "memory")
#define VM_WAIT() asm volatile("s_waitcnt vmcnt(0)" ::: "memory")
__device__ __forceinline__ unsigned long long rt() { return __builtin_amdgcn_s_memrealtime(); }
__device__ __forceinline__ unsigned f2bf(float f) { unsigned u = __builtin_bit_cast(unsigned, f); return (u + 0x7fffu + ((u >> 16) & 1u)) >> 16; }
__device__ __forceinline__ unsigned pk2(float lo, float hi) { return f2bf(lo) | (f2bf(hi) << 16); }

#define XB_TMO      128
#define XB_XCNT(j)  (256  + 64 * (j))
#define XB_XSUB(j)  (1280 + 64 * (j))
#define XB_XGEN(j)  (2304 + 64 * (j))
#define XB_TOP      3328
#define XB_TOPGEN   3392
#define XCD_BAR_WORDS 3456
#define XB_SPIN_CAP (1u << 18)

__device__ __forceinline__ unsigned xb_ld(unsigned* p)              { return __hip_atomic_load(p, __ATOMIC_RELAXED, __HIP_MEMORY_SCOPE_AGENT); }
__device__ __forceinline__ unsigned xb_add(unsigned* p, unsigned v) { return __hip_atomic_fetch_add(p, v, __ATOMIC_RELAXED, __HIP_MEMORY_SCOPE_AGENT); }
__device__ __forceinline__ unsigned xb_xcc_id() { return (unsigned)__builtin_amdgcn_s_getreg((3 << 11) | 20) & 0xFu; }
#define XB_SPIN(cond, bar) do { unsigned _sp = 0; while (cond) { __builtin_amdgcn_s_sleep(1); \
    if ((++_sp & 255u) == 0u) { if (xb_ld(&(bar)[XB_TMO])) break; if (_sp > XB_SPIN_CAP) { atomicAdd(&(bar)[XB_TMO], 1u); break; } } } } while (0)

struct XcdBarrier {
    unsigned* bar; unsigned x;
    volatile LAS unsigned* st;
};

__device__ __forceinline__ XcdBarrier xcd_barrier_post(unsigned* bar, volatile LAS unsigned* st) {
    XcdBarrier b; b.bar = bar; b.x = xb_xcc_id(); b.st = st;
    if (threadIdx.x == 0) (void)xb_add(&bar[XB_XCNT(b.x)], 1u);
    return b;
}
__device__ __forceinline__ void xcd_barrier_complete(unsigned* bar, unsigned x, unsigned& nloc, unsigned& nx) {
    const unsigned G = gridDim.x * gridDim.y * gridDim.z;
    unsigned sum, cnt, mine, sp = 0u;
    for (;;) {
        sum = 0u; cnt = 0u; mine = 0u;
#pragma unroll
        for (unsigned j = 0; j < 16; ++j) { const unsigned c = xb_ld(&bar[XB_XCNT(j)]); sum += c; cnt += (c > 0u) ? 1u : 0u; mine = (j == x) ? c : mine; }
        if (sum == G) break;
        __builtin_amdgcn_s_sleep(1);
        if ((++sp & 255u) == 0u) { if (xb_ld(&bar[XB_TMO])) break; if (sp > XB_SPIN_CAP) { atomicAdd(&bar[XB_TMO], 1u); break; } }
    }
    nloc = mine > 0u ? mine : 1u; nx = cnt > 0u ? cnt : 1u;
}

__device__ __forceinline__ void xcd_barrier(const XcdBarrier& b) {
    asm volatile("s_waitcnt vmcnt(0)" ::: "memory");
    __syncthreads();
    if (threadIdx.x == 0) {
        unsigned* bar = b.bar;
        __builtin_amdgcn_s_waitcnt(0);
        unsigned nloc = b.st[0], nx = b.st[1];
        if (nloc == 0u) { xcd_barrier_complete(bar, b.x, nloc, nx); b.st[0] = nloc; b.st[1] = nx; }
        const unsigned old = xb_add(&bar[XB_XSUB(b.x)], 1u);
        const unsigned gen = old / nloc;
        if (old + 1u == (gen + 1u) * nloc) {
            __builtin_amdgcn_fence(__ATOMIC_RELEASE, "agent");
            asm volatile("s_waitcnt vmcnt(0)" ::: "memory");
            const unsigned og = xb_add(&bar[XB_TOP], 1u);
            const unsigned tg = og / nx;
            if (og + 1u == (tg + 1u) * nx) xb_add(&bar[XB_TOPGEN], 1u);
            else XB_SPIN(xb_ld(&bar[XB_TOPGEN]) == tg, bar);
            __builtin_amdgcn_fence(__ATOMIC_ACQUIRE, "agent");
            xb_add(&bar[XB_XGEN(b.x)], 1u);
            asm volatile("s_waitcnt vmcnt(0)" ::: "memory");
        } else {
            XB_SPIN(xb_ld(&bar[XB_XGEN(b.x)]) == gen, bar);
            __builtin_amdgcn_fence(__ATOMIC_ACQUIRE, "agent");
            asm volatile("s_waitcnt vmcnt(0)" ::: "memory");
        }
    }
    __syncthreads();
}
constexpr int NWAVES = 8;
#ifndef MK_N_LAUNCHES
#define MK_N_LAUNCHES 1
#endif
constexpr int N_LAUNCHES = MK_N_LAUNCHES;
constexpr int PER_PHASE = 6;

constexpr int NBATCH = 8, SEQ = 2048, DMODEL = 2048, M = NBATCH * SEQ;
constexpr int MEMLEN = 256;
constexpr int NIN = 6432;
constexpr float EPS = 1e-6f;
constexpr float LOG2E = 1.4426950408889634f;

constexpr size_t MiB = 1u << 20;
constexpr size_t WS_CTL = 0, CTL_ZERO_BYTES = 1 * MiB;
constexpr size_t WS_WOUT = 1 * MiB;
constexpr size_t WS_WIN = 9 * MiB, WS_WMEM = 35 * MiB;
constexpr size_t WS_XN = 39 * MiB, WS_MEMN = 103 * MiB;
constexpr size_t WS_PA = 111 * MiB;
constexpr size_t WS_PB = 207 * MiB;
constexpr size_t WS_PC = 231 * MiB;
constexpr size_t WS_MIX = 247 * MiB;
constexpr size_t WS_GATES = 311 * MiB;
constexpr size_t WS_KVM = 313 * MiB;
constexpr size_t WS_ROPE = 317 * MiB;
constexpr size_t WS_CD = 317 * MiB + 512 * 1024;
constexpr size_t WS_UT = 318 * MiB, WS_WNEG = 382 * MiB, WS_QDEC = 446 * MiB;
constexpr size_t WS_KDECT = 9 * MiB, WS_QKM = 73 * MiB;
constexpr size_t WS_OF = 111 * MiB, WS_OB = 143 * MiB;
constexpr size_t WS_END = 510 * MiB;
constexpr int CW_TMO = 0, CW_CODE = 1, CW_WQ = 64, CW_BAR = 4096;

constexpr int RING_OFF = 0, RING_BYTES = 149504;
constexpr int LDSCTL_OFF = RING_BYTES, MISC_OFF = LDSCTL_OFF + 320;
constexpr int LDS_BYTES = 150528;
static_assert(MISC_OFF + 128 <= LDS_BYTES, "LDS map");

#define DI __device__ __forceinline__
typedef short s16x4 __attribute__((ext_vector_type(4)));
typedef unsigned u32x2 __attribute__((ext_vector_type(2)));
typedef float f32x2v __attribute__((ext_vector_type(2)));
#define MFMA16(a, b, c) __builtin_amdgcn_mfma_f32_16x16x32_bf16((a), (b), (c), 0, 0, 0)
DI unsigned cvtpk(float lo, float hi) { return pg8::cvt_pk_bf16(lo, hi); }
DI float bflo(unsigned v) { return __uint_as_float(v << 16); }
DI float bfhi(unsigned v) { return __uint_as_float(v & 0xffff0000u); }
DI float wave_sum(float v) {
#pragma unroll
    for (int o = 1; o < 64; o <<= 1) v += __shfl_xor(v, o);
    return v;
}
DI float silu_f(float v) { return pg8::silu_f(v); }
DI float softplus_f(float x) { return x > 20.f ? x : log1pf(expf(x)); }
DI float sigmoid_f(float x) { return 1.0f / (1.0f + expf(-x)); }
DI int perm32k(int k) { return (k & ~31) | (((k >> 2) & 3) << 3) | (((k >> 4) & 1) << 2) | (k & 3); }
typedef short v4i16_t __attribute__((ext_vector_type(4)));
DI s16x4 vtr(const LAS unsigned char* p) { return __builtin_bit_cast(s16x4, __builtin_amdgcn_ds_read_tr16_b64_v4i16((LAS v4i16_t*)p)); }
DI bf16x8 tr_frag(const LAS unsigned char* lo, int hi_off) { const s16x4 a = vtr(lo), b = vtr(lo + hi_off); return (bf16x8){a[0], a[1], a[2], a[3], b[0], b[1], b[2], b[3]}; }
DI bf16x8 ld_frag(const LAS unsigned char* p) { return *(const LAS bf16x8*)p; }
DI bf16x8 pack8(const f32x4& a, const f32x4& b) { v4u w; w.x = cvtpk(a[0], a[1]); w.y = cvtpk(a[2], a[3]); w.z = cvtpk(b[0], b[1]); w.w = cvtpk(b[2], b[3]); return __builtin_bit_cast(bf16x8, w); }

struct Frame {
    LAS unsigned char* lds;
    volatile LAS unsigned* MISC;
    gu32* ctl;
    int tid, lane, wave;
    int vcu, G;
    const float *x, *mem, *norm_w, *w_in, *conv_w, *a_log_f, *a_log_b, *dt_f, *dt_b, *o_norm_a, *q_norm_b, *k_norm_b, *sink_b, *mem_norm_w, *w_mem_kv, *q_norm_c, *k_norm_c, *w_out;
    float* out;
    bf16 *WinT, *WmemT, *WoutT, *XN, *MEMN, *PA, *PB, *PC, *MIX, *KVM, *UT, *WNEG, *QDEC, *KDECT, *QKM, *OF, *OB;
    float *GATES, *ROPE, *CD;
};

DI void p0_transpose_item(const float* W, int K, int N, bf16* WT, int k0, int n0, int drow0, LAS float* scr, int lane) {
#pragma unroll 8
    for (int i = 0; i < 32; ++i) { const int kk = 2 * i + (lane >> 5); scr[kk * 33 + (lane & 31)] = W[(size_t)(k0 + kk) * N + n0 + (lane & 31)]; }
    LDS_WAIT(); asm volatile("" ::: "memory");
    const int c = lane & 7;
#pragma unroll
    for (int j = 0; j < 4; ++j) { const int n = (lane >> 3) + 8 * j; const LAS float* s = scr + (8 * c) * 33 + n;
        v4u o; o.x = pk2(s[0 * 33], s[1 * 33]); o.y = pk2(s[2 * 33], s[3 * 33]); o.z = pk2(s[4 * 33], s[5 * 33]); o.w = pk2(s[6 * 33], s[7 * 33]);
        *(GAS v4u*)(WT + (size_t)(drow0 + n) * K + k0 + 8 * c) = o; }
    LDS_WAIT(); asm volatile("" ::: "memory");
}
DI void rms_row_to_bf16(const float* xrow, const float* w, bf16* orow, int lane) {
    const GAS f32x4* xr = (const GAS f32x4*)xrow + lane; const GAS f32x4* wr = (const GAS f32x4*)w + lane;
    f32x4 v[8]; float s = 0.f;
#pragma unroll
    for (int j = 0; j < 8; ++j) { v[j] = xr[64 * j]; s += (v[j].x * v[j].x + v[j].y * v[j].y) + (v[j].z * v[j].z + v[j].w * v[j].w); }
    const float rstd = 1.0f / sqrtf(wave_sum(s) * (1.0f / 2048.0f) + EPS);
    GAS unsigned long long* o8 = (GAS unsigned long long*)orow + lane;
#pragma unroll
    for (int j = 0; j < 8; ++j) { const f32x4 wv = wr[64 * j]; const f32x4 y = v[j] * rstd * wv;
        o8[64 * j] = (unsigned long long)cvtpk(y.x, y.y) | ((unsigned long long)cvtpk(y.z, y.w) << 32); }
}
DI void p0_prologue(Frame& F) {
    LAS float* scr = (LAS float*)(F.lds + RING_OFF + F.wave * 16384);
    const int gw = F.vcu * NWAVES + F.wave, NGW = F.G * NWAVES;
    constexpr int I_IN = 32 * 201, I_MEM = 32 * 32, I_OUT = 32 * 64, NITEMS = I_IN + I_MEM + I_OUT;
    for (int it = gw; it < NITEMS; it += NGW) {
        int r = it;
        if (r < I_IN) { const int kb = r / 201, sb = r % 201, n0 = 32 * sb; const int drow = n0 < 4096 ? n0 : (n0 < 4128 ? 6400 + (n0 - 4096) : n0 - 32);
            p0_transpose_item(F.w_in, 2048, NIN, F.WinT, 64 * kb, n0, drow, scr, F.lane); continue; }
        r -= I_IN;
        if (r < I_MEM) { p0_transpose_item(F.w_mem_kv, 2048, 1024, F.WmemT, 64 * (r / 32), 32 * (r % 32), 32 * (r % 32), scr, F.lane); continue; }
        r -= I_MEM;
        p0_transpose_item(F.w_out, 2048, 2048, F.WoutT, 64 * (r / 64), 32 * (r % 64), 32 * (r % 64), scr, F.lane);
    }
    { GAS v4u* z = (GAS v4u*)(F.WinT + (size_t)NIN * 2048); const int gt = F.vcu * 512 + F.tid, NT = F.G * 512;
      for (int i = gt; i < 224 * 256; i += NT) z[i] = (v4u){0u, 0u, 0u, 0u}; }
    for (int m = gw; m < M; m += NGW) rms_row_to_bf16(F.x + (size_t)m * DMODEL, F.norm_w, F.XN + (size_t)m * DMODEL, F.lane);
    for (int m = gw; m < NBATCH * MEMLEN; m += NGW) rms_row_to_bf16(F.mem + (size_t)m * DMODEL, F.mem_norm_w, F.MEMN + (size_t)m * DMODEL, F.lane);
    { const int gt = F.vcu * 512 + F.tid, NT = F.G * 512;
      for (int i = gt; i < SEQ * 32; i += NT) { const int pos = i >> 5, fi = i & 31; const float inv = powf(10000.0f, -(float)(2 * fi) / 64.0f); const float ang = (float)pos * inv;
          F.ROPE[2 * i] = cosf(ang); F.ROPE[2 * i + 1] = sinf(ang); } }
}

constexpr int AB_QH = 0, AB_KH = 17408, AB_VV = 34816, AB_BUF = 52224, AB_LD = 272;
constexpr int AD_F = 104448, AD_B = 122880, AD_T2 = 9216, AD_LDL = 72, AD_LDT = 144;
constexpr int AG_0 = 141312, AG_SZ = 2560, AG_RAW = 146432;
constexpr int ASCR_F = 0, ASCR_B = 5120;
static_assert(AG_RAW == AG_0 + 2 * AG_SZ && AG_RAW + 1024 <= RING_BYTES && AD_F == 2 * AB_BUF && AD_B == AD_F + 64 * 72 * 4 && AG_0 == AD_B + 64 * 72 * 4, "A-prep LDS map");
#define LBAR() asm volatile("s_waitcnt lgkmcnt(0)\n\ts_barrier" ::: "memory")

#define DPP_ADD(s, ctrl) (s) += __builtin_bit_cast(float, __builtin_amdgcn_update_dpp(0, __builtin_bit_cast(int, (s)), (ctrl), 0xf, 0xf, true))
DI float row16_sum(float s) { DPP_ADD(s, 0xB1); DPP_ADD(s, 0x4E); DPP_ADD(s, 0x141); DPP_ADD(s, 0x140); return s; }

template <bool BWD> DI void s3_solve(LAS unsigned char* L, LAS unsigned char* scr, const LAS float* GV, int lane) {
    int lane_o = lane; asm volatile("" : "+v"(lane_o));
    const int hb = lane_o >> 5, cc = lane_o & 31, r16 = lane_o & 15, g = lane_o >> 4;
    LAS unsigned char* D = L + (BWD ? AD_B : AD_F);
    const LAS float* LS = (const LAS float*)D;
    const LAS float* Lb = LS + hb * (32 * AD_LDL + 32);
    LAS unsigned char* SA = scr + (BWD ? ASCR_B : ASCR_F); LAS unsigned char* SB = SA + 2560;
    LAS unsigned char* T1 = D; LAS unsigned char* T2 = D + AD_T2;
    const LAS float* S1 = GV + (BWD ? 192 : 128); const LAS float* S2 = GV + (BWD ? 576 : 512);
    bf16x8 la[2];
#pragma unroll
    for (int ti = 0; ti < 2; ++ti) { const LAS float* lp = LS + (32 + 16 * ti + r16) * AD_LDL + 8 * g; const f32x4 x0 = *(const LAS f32x4*)lp, x1 = *(const LAS f32x4*)(lp + 4); la[ti] = pack8(x0, x1); }
#ifndef RS3L
#define RS3L 1
#endif
    float t[32];
    for (int r3_ = 0; r3_ < RS3L; ++r3_) {
    t[0] = (cc == 0) ? 1.f : 0.f;
    f32x4 rwA[8], rwB[8];
    rwB[0] = *(const LAS f32x4*)(Lb + AD_LDL);
#pragma unroll
    for (int i = 1; i < 32; ++i) {
        if (i + 1 < 32) {
#pragma unroll
            for (int q = 0; q < 8; ++q) if (4 * q < i + 1) { if ((i + 1) & 1) rwB[q] = *(const LAS f32x4*)(Lb + (i + 1) * AD_LDL + 4 * q); else rwA[q] = *(const LAS f32x4*)(Lb + (i + 1) * AD_LDL + 4 * q); } }
        __builtin_amdgcn_sched_barrier(0);
        float sa = (cc == i) ? 1.f : 0.f, sb = 0.f;
#pragma unroll
        for (int q = 0; q < 8; ++q)
#pragma unroll
            for (int e = 0; e < 4; ++e) if (4 * q + e < i) { const float lv = (i & 1) ? rwB[q][e] : rwA[q][e];
                if (e & 1) asm("v_fma_f32 %0, -%1, %2, %0" : "+v"(sb) : "v"(lv), "v"(t[4 * q + e])); else asm("v_fma_f32 %0, -%1, %2, %0" : "+v"(sa) : "v"(lv), "v"(t[4 * q + e])); }
        t[i] = sa + sb;
        __builtin_amdgcn_sched_barrier(0);
    }
    }
#ifndef RS3T
#define RS3T 1
#endif
    for (int r4_ = 0; r4_ < RS3T; ++r4_) {
    {
        const int R = BWD ? 32 * hb + cc : 63 - 32 * hb - cc, colb = BWD ? 32 * hb : 32 * (1 - hb);
#pragma unroll
        for (int q = 0; q < 4; ++q) { const f32x4 a0 = *(const LAS f32x4*)(S1 + colb + 8 * q), a1 = *(const LAS f32x4*)(S1 + colb + 8 * q + 4), b0 = *(const LAS f32x4*)(S2 + colb + 8 * q), b1 = *(const LAS f32x4*)(S2 + colb + 8 * q + 4);
            const f32x4 v0 = BWD ? (f32x4){t[8 * q], t[8 * q + 1], t[8 * q + 2], t[8 * q + 3]} : (f32x4){t[31 - 8 * q], t[30 - 8 * q], t[29 - 8 * q], t[28 - 8 * q]};
            const f32x4 v1 = BWD ? (f32x4){t[8 * q + 4], t[8 * q + 5], t[8 * q + 6], t[8 * q + 7]} : (f32x4){t[27 - 8 * q], t[26 - 8 * q], t[25 - 8 * q], t[24 - 8 * q]};
            *(LAS bf16x8*)(T1 + R * AD_LDT + (colb + 8 * q) * 2) = pack8(v0 * a0, v1 * a1); *(LAS bf16x8*)(T2 + R * AD_LDT + (colb + 8 * q) * 2) = pack8(v0 * b0, v1 * b1); }
    }
    __builtin_amdgcn_sched_barrier(0);
    if (hb == 0) {
#pragma unroll
        for (int q = 0; q < 4; ++q) *(LAS bf16x8*)(SA + cc * 80 + 16 * q) = pack8((f32x4){t[8 * q], t[8 * q + 1], t[8 * q + 2], t[8 * q + 3]}, (f32x4){t[8 * q + 4], t[8 * q + 5], t[8 * q + 6], t[8 * q + 7]});
    } else {
#pragma unroll
        for (int i = 0; i < 32; i += 2) { const unsigned pk = cvtpk(t[i], t[i + 1]); *(LAS bf16*)(SB + i * 80 + 2 * cc) = (bf16)(pk & 0xffffu); *(LAS bf16*)(SB + (i + 1) * 80 + 2 * cc) = (bf16)(pk >> 16); }
    }
    asm volatile("s_waitcnt lgkmcnt(0)" ::: "memory");
    __builtin_amdgcn_sched_barrier(0);
    bf16x8 tbf[2];
#pragma unroll
    for (int ti = 0; ti < 2; ++ti) tbf[ti] = ld_frag(SA + (16 * ti + r16) * 80 + 16 * g);
    f32x4 P[2][2];
#pragma unroll
    for (int ti = 0; ti < 2; ++ti)
#pragma unroll
        for (int tj = 0; tj < 2; ++tj) P[ti][tj] = MFMA16(la[ti], tbf[tj], ((f32x4){0.f, 0.f, 0.f, 0.f}));
    bf16x8 pbb[2];
#pragma unroll
    for (int tj = 0; tj < 2; ++tj) pbb[tj] = pack8(P[0][tj], P[1][tj]);
#pragma unroll
    for (int tip = 0; tip < 2; ++tip) {
        const u32x2 lo = *(const LAS u32x2*)(SB + (16 * tip + r16) * 80 + 8 * g), hi = *(const LAS u32x2*)(SB + (16 * tip + r16) * 80 + 32 + 8 * g);
        const v4u aw = (v4u){lo.x, lo.y, hi.x, hi.y}; const bf16x8 af = __builtin_bit_cast(bf16x8, aw);
#pragma unroll
        for (int tj = 0; tj < 2; ++tj) { const f32x4 X = MFMA16(af, pbb[tj], ((f32x4){0.f, 0.f, 0.f, 0.f})); const int b = 16 * tj + r16;
            const int Rn = BWD ? b : 63 - b, col0 = BWD ? 32 + 16 * tip + 4 * g : 28 - 16 * tip - 4 * g;
            const f32x4 a0 = *(const LAS f32x4*)(S1 + col0), b0 = *(const LAS f32x4*)(S2 + col0);
            const f32x4 xv = BWD ? (f32x4){-X[0], -X[1], -X[2], -X[3]} : (f32x4){-X[3], -X[2], -X[1], -X[0]};
            u32x2 o1, o2; o1.x = cvtpk(xv[0] * a0[0], xv[1] * a0[1]); o1.y = cvtpk(xv[2] * a0[2], xv[3] * a0[3]); o2.x = cvtpk(xv[0] * b0[0], xv[1] * b0[1]); o2.y = cvtpk(xv[2] * b0[2], xv[3] * b0[3]);
            *(LAS u32x2*)(T1 + Rn * AD_LDT + col0 * 2) = o1; *(LAS u32x2*)(T2 + Rn * AD_LDT + col0 * 2) = o2; }
    }
    }
}

DI void acons_s2(Frame& F, LAS unsigned char* L, LAS unsigned char* B, const LAS float* GV, int item_f, int wv, int lane) {
    int lane_o = lane; asm volatile("" : "+v"(lane_o));
    const int r16 = lane_o & 15, g = lane_o >> 4, item_b = item_f + 32;
    f32x4 accG[4], accQ[4];
#pragma unroll
    for (int tn = 0; tn < 4; ++tn) { accG[tn] = (f32x4){0.f, 0.f, 0.f, 0.f}; accQ[tn] = (f32x4){0.f, 0.f, 0.f, 0.f}; }
    const LAS unsigned char* Ab = B + AB_KH + (16 * wv + r16) * AB_LD + g * 16;
    const LAS unsigned char* Kb = B + AB_KH + r16 * AB_LD + g * 16;
    const LAS unsigned char* Qb = B + AB_QH + r16 * AB_LD + g * 16;
#pragma unroll
    for (int ks = 0; ks < 4; ++ks) { const bf16x8 a = ld_frag(Ab + ks * 64);
#pragma unroll
        for (int tn = 0; tn < 4; ++tn) { accG[tn] = MFMA16(a, ld_frag(Kb + tn * 16 * AB_LD + ks * 64), accG[tn]); accQ[tn] = MFMA16(a, ld_frag(Qb + tn * 16 * AB_LD + ks * 64), accQ[tn]); }
        __builtin_amdgcn_sched_barrier(0); }
    LAS float* LF = (LAS float*)(L + AD_F); LAS float* LB = (LAS float*)(L + AD_B);
#pragma unroll
    for (int tn = 0; tn < 4; ++tn) {
        const int j = 16 * tn + r16; const float gcfj = GV[j], gcbj = GV[64 + j];
#pragma unroll
        for (int reg = 0; reg < 4; ++reg) { const int i = 16 * wv + 4 * g + reg; const float G = accG[tn][reg];
            if (j < i) LF[(63 - j) * AD_LDL + (63 - i)] = GV[128 + i] * G * __expf(fminf(GV[i] - gcfj, 0.f));
            else if (j > i) LB[j * AD_LDL + i] = GV[192 + i] * G * __expf(fminf(GV[64 + i] - gcbj, 0.f)); } }
#pragma unroll
    for (int tn = 0; tn < 4; ++tn) {
        const int i = 16 * tn + r16; const float gcfi = GV[i], gcbi = GV[64 + i]; float qf[4], qb[4];
#pragma unroll
        for (int reg = 0; reg < 4; ++reg) { const int j = 16 * wv + 4 * g + reg; const float v = accQ[tn][reg];
            qf[reg] = (j <= i) ? v * __expf(fminf(gcfi - GV[j], 0.f)) : 0.f;
            qb[reg] = (j >= i) ? v * __expf(fminf(gcbi - GV[64 + j], 0.f)) : 0.f; }
        const int idx = 32 * (wv >> 1) + 8 * g + 4 * (wv & 1);
        u32x2 vf, vb; vf.x = cvtpk(qf[0], qf[1]); vf.y = cvtpk(qf[2], qf[3]); vb.x = cvtpk(qb[0], qb[1]); vb.y = cvtpk(qb[2], qb[3]);
        *(u32x2*)(F.QKM + ((size_t)item_f * 64 + i) * 64 + idx) = vf; *(u32x2*)(F.QKM + ((size_t)item_b * 64 + i) * 64 + idx) = vb; }
}
DI void acons_kdect(Frame& F, LAS unsigned char* B, const LAS float* GV, int item, int dirb, int lane) {
    int lane_o = lane; asm volatile("" : "+v"(lane_o));
    const int i16 = lane_o & 15, gg = lane_o >> 4, q4 = i16 >> 2, p4 = i16 & 3;
    const LAS float* KD = GV + (dirb ? 448 : 384);
#pragma unroll
    for (int s = 0; s < 2; ++s) { const f32x4 k0 = *(const LAS f32x4*)(KD + 32 * s + 4 * gg), k1 = *(const LAS f32x4*)(KD + 32 * s + 16 + 4 * gg);
#pragma unroll
        for (int dt = 0; dt < 8; ++dt) { const LAS unsigned char* ap = B + AB_KH + (32 * s + 4 * gg + q4) * AB_LD + (16 * dt + 4 * p4) * 2;
            const s16x4 lo = vtr(ap), hi = vtr(ap + 16 * AB_LD);
            const f32x4 a = (f32x4){bflo((unsigned)(unsigned short)lo[0]), bflo((unsigned)(unsigned short)lo[1]), bflo((unsigned)(unsigned short)lo[2]), bflo((unsigned)(unsigned short)lo[3])} * k0;
            const f32x4 c = (f32x4){bflo((unsigned)(unsigned short)hi[0]), bflo((unsigned)(unsigned short)hi[1]), bflo((unsigned)(unsigned short)hi[2]), bflo((unsigned)(unsigned short)hi[3])} * k1;
            v4u o; o.x = cvtpk(a[0], a[1]); o.y = cvtpk(a[2], a[3]); o.z = cvtpk(c[0], c[1]); o.w = cvtpk(c[2], c[3]);
            *(v4u*)(F.KDECT + ((size_t)item * 128 + 16 * dt + i16) * 64 + 32 * s + 8 * gg) = o; __builtin_amdgcn_sched_barrier(0); } }
}
DI void acons_s4(Frame& F, LAS unsigned char* L, LAS unsigned char* B, int item_f, int wv, int lane) {
    int lane_o = lane; asm volatile("" : "+v"(lane_o));
    const int dir = wv >> 1, tip = wv & 1, r16 = lane_o & 15, g = lane_o >> 4, q4 = r16 >> 2, p4 = r16 & 3;
    const int tiA = tip ? 1 : 0, tiB = tip ? 2 : 3;
    const LAS unsigned char* T1 = L + (dir ? AD_B : AD_F); const LAS unsigned char* T2 = T1 + AD_T2;
    const int item = item_f + 32 * dir;
    bf16x8 a1A[2], a1B[2], a2A[2], a2B[2];
#pragma unroll
    for (int ks = 0; ks < 2; ++ks) { a1A[ks] = ld_frag(T1 + (16 * tiA + r16) * AD_LDT + ks * 64 + g * 16); a1B[ks] = ld_frag(T1 + (16 * tiB + r16) * AD_LDT + ks * 64 + g * 16);
        a2A[ks] = ld_frag(T2 + (16 * tiA + r16) * AD_LDT + ks * 64 + g * 16); a2B[ks] = ld_frag(T2 + (16 * tiB + r16) * AD_LDT + ks * 64 + g * 16); }
    const bool A0 = true, A1 = (dir == 1), B0 = (dir == 0), B1 = true;
#pragma unroll
    for (int te = 0; te < 8; ++te) { f32x4 accA = (f32x4){0.f, 0.f, 0.f, 0.f}, accB = (f32x4){0.f, 0.f, 0.f, 0.f};
        const bf16x8 v0 = tr_frag(B + AB_VV + ((8 * g + q4) * 136 + 16 * te + 4 * p4) * 2, 4 * AB_LD), v1 = tr_frag(B + AB_VV + ((32 + 8 * g + q4) * 136 + 16 * te + 4 * p4) * 2, 4 * AB_LD);
        if (A0) accA = MFMA16(a1A[0], v0, accA); if (A1) accA = MFMA16(a1A[1], v1, accA);
        if (B0) accB = MFMA16(a1B[0], v0, accB); if (B1) accB = MFMA16(a1B[1], v1, accB);
        u32x2 o; o.x = cvtpk(accA[0], accA[1]); o.y = cvtpk(accA[2], accA[3]);
        *(u32x2*)(F.UT + ((size_t)item * 128 + 16 * te + r16) * 64 + 16 * tiA + 4 * g) = o;
        o.x = cvtpk(accB[0], accB[1]); o.y = cvtpk(accB[2], accB[3]);
        *(u32x2*)(F.UT + ((size_t)item * 128 + 16 * te + r16) * 64 + 16 * tiB + 4 * g) = o; __builtin_amdgcn_sched_barrier(0); }
#pragma unroll
    for (int td = 0; td < 8; ++td) { f32x4 accA = (f32x4){0.f, 0.f, 0.f, 0.f}, accB = (f32x4){0.f, 0.f, 0.f, 0.f};
        const bf16x8 k0 = tr_frag(B + AB_KH + ((8 * g + q4) * 136 + 16 * td + 4 * p4) * 2, 4 * AB_LD), k1 = tr_frag(B + AB_KH + ((32 + 8 * g + q4) * 136 + 16 * td + 4 * p4) * 2, 4 * AB_LD);
        if (A0) accA = MFMA16(k0, a2A[0], accA); if (A1) accA = MFMA16(k1, a2A[1], accA);
        if (B0) accB = MFMA16(k0, a2B[0], accB); if (B1) accB = MFMA16(k1, a2B[1], accB);
        const int idx = 32 * (td >> 1) + 8 * g + 4 * (td & 1);
        u32x2 o; o.x = cvtpk(-accA[0], -accA[1]); o.y = cvtpk(-accA[2], -accA[3]);
        *(u32x2*)(F.WNEG + ((size_t)item * 64 + 16 * tiA + r16) * 128 + idx) = o;
        o.x = cvtpk(-accB[0], -accB[1]); o.y = cvtpk(-accB[2], -accB[3]);
        *(u32x2*)(F.WNEG + ((size_t)item * 64 + 16 * tiB + r16) * 128 + idx) = o; __builtin_amdgcn_sched_barrier(0); }
}
DI void aprod_s0(Frame& F, LAS float* GV, const LAS float* RAW, int item_f, int h, int lane) {
    const float ga[4] = {RAW[lane], RAW[64 + lane], RAW[128 + lane], RAW[192 + lane]};
    const float xf_ = ga[0] + F.dt_f[h], xb_ = ga[1] + F.dt_b[h];
    const float gf = -__expf(F.a_log_f[h]) * (xf_ > 15.f ? xf_ : __logf(1.0f + __expf(xf_)));
    const float gb = -__expf(F.a_log_b[h]) * (xb_ > 15.f ? xb_ : __logf(1.0f + __expf(xb_)));
    float pf = gf, pb = gb;
#pragma unroll
    for (int o = 1; o < 64; o <<= 1) { const float tf = __shfl_up(pf, o), tb = __shfl_up(pb, o); if (lane >= o) { pf += tf; pb += tb; } }
    const float totf = __shfl(pf, 63), totb = __shfl(pb, 63);
    const float gcf = pf, gcb = totb - pb + gb;
    const float btf_ = __builtin_amdgcn_rcpf(1.0f + __expf(-ga[2])), btb_ = __builtin_amdgcn_rcpf(1.0f + __expf(-ga[3])), egf_ = __expf(gcf), egb_ = __expf(gcb);
    GV[lane] = gcf; GV[64 + lane] = gcb; GV[128 + lane] = btf_; GV[192 + lane] = btb_;
    GV[256 + lane] = egf_; GV[320 + lane] = egb_; GV[384 + lane] = __expf(totf - gcf); GV[448 + lane] = __expf(totb - gcb); GV[512 + lane] = btf_ * egf_; GV[576 + lane] = btb_ * egb_;
    if (lane == 0) { F.CD[item_f] = __expf(totf); F.CD[item_f + 32] = __expf(totb); }
}
DI void aprod_load(Frame& F, v4u (&x)[8], int b, int c, int h, int part, int p0, int c16) {
#pragma unroll
    for (int r = 0; r < 8; ++r) { const int t = c * 64 + p0 - 2 + r; v4u v = (v4u){0u, 0u, 0u, 0u};
        if (t >= 0 && t < SEQ) v = *(const v4u*)(F.PA + ((size_t)b * SEQ + t) * 3072 + part * 1024 + h * 128 + 8 * c16);
        x[r] = v; }
}
DI void aprod_conv(Frame& F, const v4u (&x)[8], float (&o)[4][8], int h, int part, int c16) {
#pragma unroll
    for (int j = 0; j < 4; ++j)
#pragma unroll
        for (int e = 0; e < 8; ++e) o[j][e] = 0.f;
#pragma unroll
    for (int k = 0; k < 5; ++k) { const float* wp = F.conv_w + k * 3072 + part * 1024 + h * 128 + 8 * c16; const f32x4 w0 = *(const f32x4*)wp, w1 = *(const f32x4*)(wp + 4);
#pragma unroll
        for (int j = 0; j < 4; ++j) { const v4u xr = x[j + k];
            o[j][0] += bflo(xr.x) * w0[0]; o[j][1] += bfhi(xr.x) * w0[1]; o[j][2] += bflo(xr.y) * w0[2]; o[j][3] += bfhi(xr.y) * w0[3];
            o[j][4] += bflo(xr.z) * w1[0]; o[j][5] += bfhi(xr.z) * w1[1]; o[j][6] += bflo(xr.w) * w1[2]; o[j][7] += bfhi(xr.w) * w1[3]; } }
#pragma unroll
    for (int j = 0; j < 4; ++j)
#pragma unroll
        for (int e = 0; e < 8; ++e) o[j][e] = silu_f(o[j][e]);
}
DI void aprod_store_rows(LAS unsigned char* img, const float (&o)[4][8], const float (&sc)[4], int p0, int c16) {
#pragma unroll
    for (int j = 0; j < 4; ++j) { v4u w; w.x = cvtpk(o[j][0] * sc[j], o[j][1] * sc[j]); w.y = cvtpk(o[j][2] * sc[j], o[j][3] * sc[j]); w.z = cvtpk(o[j][4] * sc[j], o[j][5] * sc[j]); w.w = cvtpk(o[j][6] * sc[j], o[j][7] * sc[j]);
        *(LAS v4u*)(img + (p0 + j) * AB_LD + c16 * 16) = w; }
}

#ifndef RCK
#define RCK 1
#endif
#ifndef RC2
#define RC2 1
#endif
#ifndef RC3
#define RC3 1
#endif
#ifndef RC4
#define RC4 1
#endif
#ifndef RP1
#define RP1 1
#endif
#ifndef RP2
#define RP2 1
#endif
#ifndef RP3
#define RP3 1
#endif
DI void a_prep_phase(Frame& F) {
    const int lane = F.lane, wave = F.wave;
    LAS unsigned char* L = F.lds + RING_OFF;
    const int nit = (F.vcu < 2048) ? (2048 - F.vcu + F.G - 1) / F.G : 0;
    if (wave < 4) {
#pragma unroll 1
        for (int k = -1; k < nit; ++k) {
            LAS unsigned char* Bc = L + (k & 1) * AB_BUF;
            const LAS float* GVc = (const LAS float*)(L + AG_0 + (k & 1) * AG_SZ);
            const int itc = F.vcu + k * F.G;
            const int item_c = (((itc >> 8) * 8 + (itc & 7)) * 2) * 32 + ((itc >> 3) & 31);
            const bool cons = (k >= 0);
            if (cons) for (int r_ = 0; r_ < RC2; ++r_) acons_s2(F, L, Bc, GVc, item_c, wave, lane);
            LBAR();
            if (cons) for (int r_ = 0; r_ < RC3; ++r_) { if (wave == 0) s3_solve<false>(L, Bc + AB_QH, GVc, lane); else if (wave == 1) s3_solve<true>(L, Bc + AB_QH, GVc, lane); else for (int r2_ = 0; r2_ < RCK; ++r2_) acons_kdect(F, Bc, GVc, item_c + 32 * (wave - 2), wave - 2, lane); }
            LBAR();
            if (cons) for (int r_ = 0; r_ < RC4; ++r_) acons_s4(F, L, Bc, item_c, wave, lane);
            LBAR();
        }
    } else {
        const int pw = wave - 4;
        LAS float* RAW = (LAS float*)(L + AG_RAW);
        v4u xq[8], xk[8], xv[8];
        { const int c16 = lane & 15, p0 = 16 * pw + 4 * (lane >> 4);
          if (nit > 0) { const int it = F.vcu; aprod_load(F, xk, it >> 8, (it >> 3) & 31, it & 7, 1, p0, c16); }
          if (wave == 4 && nit > 0) { const int it = F.vcu; const int b = it >> 8, c = (it >> 3) & 31, h = it & 7; const float* gr = F.GATES + ((size_t)b * SEQ + c * 64 + lane) * 32; RAW[lane] = gr[h]; RAW[64 + lane] = gr[8 + h]; RAW[128 + lane] = gr[16 + h]; RAW[192 + lane] = gr[24 + h]; } }
#pragma unroll 1
        for (int k = -1; k < nit; ++k) {
            LAS unsigned char* Bn = L + ((k + 1) & 1) * AB_BUF;
            LAS float* GVn = (LAS float*)(L + AG_0 + ((k + 1) & 1) * AG_SZ);
            const int itn = F.vcu + (k + 1) * F.G;
            const int bn = itn >> 8, cn = (itn >> 3) & 31, hn = itn & 7; const int item_n = ((bn * 8 + hn) * 2) * 32 + cn;
            const bool prod = (k + 1 < nit);
            int lo_ = lane; asm volatile("" : "+v"(lo_));
            const int gI = lo_ >> 4, c16 = lo_ & 15, p0 = 16 * pw + 4 * gI;
            if (prod) {
                if (wave == 4) aprod_s0(F, GVn, RAW, item_n, hn, lane);
                aprod_load(F, xq, bn, cn, hn, 0, p0, c16);
                for (int r_ = 0; r_ < RP1; ++r_) {
                float o[4][8]; aprod_conv(F, xk, o, hn, 1, c16);
                float sc[4];
#pragma unroll
                for (int j = 0; j < 4; ++j) { float ss = 0.f;
#pragma unroll
                    for (int e = 0; e < 8; ++e) ss += o[j][e] * o[j][e];
                    sc[j] = 1.0f / sqrtf(row16_sum(ss) + EPS); }
                aprod_store_rows(Bn + AB_KH, o, sc, p0, c16); }
            }
            LBAR();
            if (prod) {
                aprod_load(F, xv, bn, cn, hn, 2, p0, c16);
                float o[4][8]; float sc[4];
                for (int r_ = 0; r_ < RP2; ++r_) {
                aprod_conv(F, xq, o, hn, 0, c16);
#pragma unroll
                for (int j = 0; j < 4; ++j) { float ss = 0.f;
#pragma unroll
                    for (int e = 0; e < 8; ++e) ss += o[j][e] * o[j][e];
                    sc[j] = (1.0f / sqrtf(row16_sum(ss) + EPS)) * 0.08838834764831845f; }
                aprod_store_rows(Bn + AB_QH, o, sc, p0, c16); }
#ifndef RPQ
#define RPQ 1
#endif
                for (int r_ = 0; r_ < RPQ; ++r_) {
                const int idA = 32 * (c16 >> 2) + 8 * ((2 * c16) & 3) + 4 * ((c16 >> 1) & 1);
#pragma unroll
                for (int j = 0; j < 4; ++j) { const int pos = p0 + j; const float ef = GVn[256 + pos] * sc[j], eb = GVn[320 + pos] * sc[j];
                    u32x2 a, c2; a.x = cvtpk(o[j][0] * ef, o[j][1] * ef); a.y = cvtpk(o[j][2] * ef, o[j][3] * ef); c2.x = cvtpk(o[j][4] * ef, o[j][5] * ef); c2.y = cvtpk(o[j][6] * ef, o[j][7] * ef);
                    bf16* qp = F.QDEC + ((size_t)item_n * 64 + pos) * 128 + idA; *(u32x2*)qp = a; *(u32x2*)(qp + 8) = c2;
                    a.x = cvtpk(o[j][0] * eb, o[j][1] * eb); a.y = cvtpk(o[j][2] * eb, o[j][3] * eb); c2.x = cvtpk(o[j][4] * eb, o[j][5] * eb); c2.y = cvtpk(o[j][6] * eb, o[j][7] * eb);
                    qp += (size_t)32 * 64 * 128; *(u32x2*)qp = a; *(u32x2*)(qp + 8) = c2; } }
            }
            LBAR();
            {
                float g4[4] = {0.f, 0.f, 0.f, 0.f}; const bool more = (k + 2 < nit);
                if (more) { const int it2 = itn + F.G; const int b2 = it2 >> 8, c2 = (it2 >> 3) & 31, h2 = it2 & 7; aprod_load(F, xk, b2, c2, h2, 1, p0, c16);
                    if (wave == 4) { const float* gr = F.GATES + ((size_t)b2 * SEQ + c2 * 64 + lane) * 32; g4[0] = gr[h2]; g4[1] = gr[8 + h2]; g4[2] = gr[16 + h2]; g4[3] = gr[24 + h2]; } }
                if (prod) for (int r_ = 0; r_ < RP3; ++r_) { float o[4][8]; aprod_conv(F, xv, o, hn, 2, c16);
                    const float sc[4] = {1.f, 1.f, 1.f, 1.f};
                    aprod_store_rows(Bn + AB_VV, o, sc, p0, c16); }
                if (more && wave == 4) { RAW[lane] = g4[0]; RAW[64 + lane] = g4[1]; RAW[128 + lane] = g4[2]; RAW[192 + lane] = g4[3]; }
            }
            LBAR();
        }
    }
}

constexpr int B_KB = 0, B_VB = 55296;
DI void b_attn_unit(Frame& F, int b, int nb, int kvh, bf16* MO) {
    const int tid = F.tid, lane = F.lane, wave = F.wave;
    LAS unsigned char* L = F.lds + RING_OFF;
#pragma unroll
    for (int it = 0; it < 6; ++it) { const int q = tid + 512 * it, row = q >> 3, cc = q & 7; const int t = (nb - 1) * 128 + row; const bool valid = (t >= 0) && (t < SEQ);
        v4u kv = (v4u){0u, 0u, 0u, 0u}, vv = (v4u){0u, 0u, 0u, 0u};
        if (valid) { const bf16* rp = F.PB + ((size_t)b * SEQ + t) * 768 + 512 + kvh * 64 + 8 * cc; kv = *(const v4u*)rp; vv = *(const v4u*)(rp + 128); }
        float xk[8]; xk[0] = bflo(kv.x); xk[1] = bfhi(kv.x); xk[2] = bflo(kv.y); xk[3] = bfhi(kv.y); xk[4] = bflo(kv.z); xk[5] = bfhi(kv.z); xk[6] = bflo(kv.w); xk[7] = bfhi(kv.w);
        float ss = 0.f;
#pragma unroll
        for (int e = 0; e < 8; ++e) ss += xk[e] * xk[e];
        ss += __shfl_xor(ss, 1); ss += __shfl_xor(ss, 2); ss += __shfl_xor(ss, 4);
        const float rstd = 1.0f / sqrtf(ss * (1.0f / 64.0f) + EPS);
        const int tt = valid ? t : 0; float o[8];
#pragma unroll
        for (int e = 0; e < 8; ++e) { const float y = xk[e] * rstd * F.k_norm_b[8 * cc + e]; const float pr = __shfl_xor(y, 4);
            const f32x2v cs = *(const f32x2v*)(F.ROPE + ((size_t)tt * 32 + ((8 * cc + e) & 31)) * 2);
            o[e] = (cc < 4) ? (y * cs.x - pr * cs.y) : (y * cs.x + pr * cs.y); }
        v4u ok; ok.x = cvtpk(o[0], o[1]); ok.y = cvtpk(o[2], o[3]); ok.z = cvtpk(o[4], o[5]); ok.w = cvtpk(o[6], o[7]);
        if (!valid) ok = (v4u){0u, 0u, 0u, 0u};
        *(LAS v4u*)(L + B_KB + row * 144 + cc * 16) = ok; *(LAS v4u*)(L + B_VB + row * 144 + cc * 16) = vv; }
    if (tid < 128) *(LAS v4u*)(L + B_VB + (384 + (tid >> 3)) * 144 + (tid & 7) * 16) = (v4u){0u, 0u, 0u, 0u};
    __syncthreads();
    const int hq = kvh * 4 + (wave >> 1), r16 = lane & 15, g = lane >> 4, q4 = r16 >> 2, p4 = r16 & 3;
    const float sk = F.sink_b[hq] * LOG2E;
#pragma unroll 1
    for (int qt = 0; qt < 4; ++qt) {
        const int i0 = (wave & 1) * 64 + 16 * qt, iq = i0 + r16, pos = nb * 128 + iq; const size_t m = (size_t)b * SEQ + pos;
        bf16x8 qf[2];
        { const bf16* qp = F.PB + m * 768 + hq * 64 + 8 * g; const v4u a = *(const v4u*)qp, c2 = *(const v4u*)(qp + 32);
          float x0[8], x1[8]; x0[0] = bflo(a.x); x0[1] = bfhi(a.x); x0[2] = bflo(a.y); x0[3] = bfhi(a.y); x0[4] = bflo(a.z); x0[5] = bfhi(a.z); x0[6] = bflo(a.w); x0[7] = bfhi(a.w);
          x1[0] = bflo(c2.x); x1[1] = bfhi(c2.x); x1[2] = bflo(c2.y); x1[3] = bfhi(c2.y); x1[4] = bflo(c2.z); x1[5] = bfhi(c2.z); x1[6] = bflo(c2.w); x1[7] = bfhi(c2.w);
          float ss = 0.f;
#pragma unroll
          for (int e = 0; e < 8; ++e) ss += x0[e] * x0[e] + x1[e] * x1[e];
          ss += __shfl_xor(ss, 16); ss += __shfl_xor(ss, 32);
          const float rstd = (1.0f / sqrtf(ss * (1.0f / 64.0f) + EPS));
          float o0[8], o1[8];
#pragma unroll
          for (int e = 0; e < 8; ++e) { const float y0 = x0[e] * rstd * F.q_norm_b[8 * g + e], y1 = x1[e] * rstd * F.q_norm_b[32 + 8 * g + e];
              const f32x2v cs = *(const f32x2v*)(F.ROPE + ((size_t)pos * 32 + 8 * g + e) * 2);
              o0[e] = (y0 * cs.x - y1 * cs.y) * (0.125f * LOG2E); o1[e] = (y1 * cs.x + y0 * cs.y) * (0.125f * LOG2E); }
          v4u w0, w1; w0.x = cvtpk(o0[0], o0[1]); w0.y = cvtpk(o0[2], o0[3]); w0.z = cvtpk(o0[4], o0[5]); w0.w = cvtpk(o0[6], o0[7]);
          w1.x = cvtpk(o1[0], o1[1]); w1.y = cvtpk(o1[2], o1[3]); w1.z = cvtpk(o1[4], o1[5]); w1.w = cvtpk(o1[6], o1[7]);
          qf[0] = __builtin_bit_cast(bf16x8, w0); qf[1] = __builtin_bit_cast(bf16x8, w1); }
        f32x4 st[18];
#pragma unroll
        for (int c = 0; c < 17; ++c) { f32x4 acc = (f32x4){0.f, 0.f, 0.f, 0.f};
#pragma unroll
            for (int s = 0; s < 2; ++s) acc = MFMA16(ld_frag(L + B_KB + (i0 + 16 * c + r16) * 144 + s * 64 + g * 16), qf[s], acc);
            st[c] = acc; __builtin_amdgcn_sched_barrier(0); }
        st[17] = (f32x4){0.f, 0.f, 0.f, 0.f};
        float mx = sk;
#pragma unroll
        for (int c = 0; c < 17; ++c)
#pragma unroll
            for (int reg = 0; reg < 4; ++reg) { const int j = i0 + 16 * c + 4 * g + reg; const int kpos = (nb - 1) * 128 + j;
                const bool ok = (j >= iq) && (j <= iq + 256) && (kpos >= 0) && (kpos < SEQ);
                const float v = ok ? st[c][reg] : -INFINITY; st[c][reg] = v; mx = fmaxf(mx, v); }
        mx = fmaxf(mx, __shfl_xor(mx, 16)); mx = fmaxf(mx, __shfl_xor(mx, 32));
        float sum = 0.f;
#pragma unroll
        for (int c = 0; c < 17; ++c)
#pragma unroll
            for (int reg = 0; reg < 4; ++reg) { const float p = __builtin_amdgcn_exp2f(st[c][reg] - mx); st[c][reg] = p; sum += p; }
        sum += __shfl_xor(sum, 16); sum += __shfl_xor(sum, 32);
        const float inv = 1.0f / (sum + __builtin_amdgcn_exp2f(sk - mx));
        bf16x8 pb[9];
#pragma unroll
        for (int kp = 0; kp < 9; ++kp) pb[kp] = pack8(st[2 * kp], st[2 * kp + 1]);
#pragma unroll
        for (int td = 0; td < 4; ++td) { f32x4 acc = (f32x4){0.f, 0.f, 0.f, 0.f};
#pragma unroll
            for (int kp = 0; kp < 9; ++kp) acc = MFMA16(tr_frag(L + B_VB + ((i0 + 32 * kp + 4 * g + q4) * 72 + 16 * td + 4 * p4) * 2, 16 * 144), pb[kp], acc);
            const size_t mo = m * 2048 + 1024 + hq * 64 + 16 * td + 4 * g; const u32x2 z = *(const u32x2*)(F.MIX + mo); bf16* mp = MO + mo;
            u32x2 o; o.x = cvtpk(acc[0] * inv * bflo(z.x), acc[1] * inv * bfhi(z.x)); o.y = cvtpk(acc[2] * inv * bflo(z.y), acc[3] * inv * bfhi(z.y));
            *(u32x2*)mp = o; __builtin_amdgcn_sched_barrier(0); }
    }
    __syncthreads();
}

constexpr int C_KC = 0, C_VC = 69632;
DI void c_attn_unit(Frame& F, int b, int hc, int qblk, bf16* MO) {
    const int tid = F.tid, lane = F.lane, wave = F.wave;
    LAS unsigned char* L = F.lds + RING_OFF;
#pragma unroll
    for (int it = 0; it < 8; ++it) { const int q = tid + 512 * it, row = q >> 4, cc = q & 15;
        const bf16* rp = F.KVM + ((size_t)b * MEMLEN + row) * 1024 + hc * 128 + 8 * cc; const v4u kv = *(const v4u*)rp, vv = *(const v4u*)(rp + 512);
        float xk[8]; xk[0] = bflo(kv.x); xk[1] = bfhi(kv.x); xk[2] = bflo(kv.y); xk[3] = bfhi(kv.y); xk[4] = bflo(kv.z); xk[5] = bfhi(kv.z); xk[6] = bflo(kv.w); xk[7] = bfhi(kv.w);
        float ss = 0.f;
#pragma unroll
        for (int e = 0; e < 8; ++e) ss += xk[e] * xk[e];
        ss += __shfl_xor(ss, 1); ss += __shfl_xor(ss, 2); ss += __shfl_xor(ss, 4); ss += __shfl_xor(ss, 8);
        const float rstd = 1.0f / sqrtf(ss * (1.0f / 128.0f) + EPS);
        float o[8];
#pragma unroll
        for (int e = 0; e < 8; ++e) o[e] = xk[e] * rstd * F.k_norm_c[8 * cc + e];
        v4u ok; ok.x = cvtpk(o[0], o[1]); ok.y = cvtpk(o[2], o[3]); ok.z = cvtpk(o[4], o[5]); ok.w = cvtpk(o[6], o[7]);
        *(LAS v4u*)(L + C_KC + row * 272 + cc * 16) = ok; *(LAS v4u*)(L + C_VC + row * 272 + cc * 16) = vv; }
    __syncthreads();
    const int r16 = lane & 15, g = lane >> 4, q4 = r16 >> 2, p4 = r16 & 3;
#pragma unroll 1
    for (int qt = 0; qt < 2; ++qt) {
        const size_t m = (size_t)b * SEQ + qblk * 256 + wave * 32 + qt * 16 + r16;
        bf16x8 qf[4];
        { float xs[4][8]; float ss = 0.f;
#pragma unroll
          for (int s = 0; s < 4; ++s) { const v4u a = *(const v4u*)(F.PC + m * 512 + hc * 128 + 32 * s + 8 * g);
              xs[s][0] = bflo(a.x); xs[s][1] = bfhi(a.x); xs[s][2] = bflo(a.y); xs[s][3] = bfhi(a.y); xs[s][4] = bflo(a.z); xs[s][5] = bfhi(a.z); xs[s][6] = bflo(a.w); xs[s][7] = bfhi(a.w);
#pragma unroll
              for (int e = 0; e < 8; ++e) ss += xs[s][e] * xs[s][e]; }
          ss += __shfl_xor(ss, 16); ss += __shfl_xor(ss, 32);
          const float rstd = (1.0f / sqrtf(ss * (1.0f / 128.0f) + EPS)) * (0.08838834764831845f * LOG2E);
#pragma unroll
          for (int s = 0; s < 4; ++s) { float o[8];
#pragma unroll
              for (int e = 0; e < 8; ++e) o[e] = xs[s][e] * rstd * F.q_norm_c[32 * s + 8 * g + e];
              v4u w0; w0.x = cvtpk(o[0], o[1]); w0.y = cvtpk(o[2], o[3]); w0.z = cvtpk(o[4], o[5]); w0.w = cvtpk(o[6], o[7]); qf[s] = __builtin_bit_cast(bf16x8, w0); } }
        f32x4 st[16];
#pragma unroll
        for (int c = 0; c < 16; ++c) { f32x4 acc = (f32x4){0.f, 0.f, 0.f, 0.f};
#pragma unroll
            for (int s = 0; s < 4; ++s) acc = MFMA16(ld_frag(L + C_KC + (16 * c + r16) * 272 + s * 64 + g * 16), qf[s], acc);
            st[c] = acc; __builtin_amdgcn_sched_barrier(0); }
        float mx = -INFINITY;
#pragma unroll
        for (int c = 0; c < 16; ++c)
#pragma unroll
            for (int reg = 0; reg < 4; ++reg) mx = fmaxf(mx, st[c][reg]);
        mx = fmaxf(mx, __shfl_xor(mx, 16)); mx = fmaxf(mx, __shfl_xor(mx, 32));
        float sum = 0.f;
#pragma unroll
        for (int c = 0; c < 16; ++c)
#pragma unroll
            for (int reg = 0; reg < 4; ++reg) { const float p = __builtin_amdgcn_exp2f(st[c][reg] - mx); st[c][reg] = p; sum += p; }
        sum += __shfl_xor(sum, 16); sum += __shfl_xor(sum, 32);
        const float inv = 1.0f / sum;
        bf16x8 pb[8];
#pragma unroll
        for (int kp = 0; kp < 8; ++kp) pb[kp] = pack8(st[2 * kp], st[2 * kp + 1]);
#pragma unroll
        for (int td = 0; td < 8; ++td) { f32x4 acc = (f32x4){0.f, 0.f, 0.f, 0.f};
#pragma unroll
            for (int kp = 0; kp < 8; ++kp) acc = MFMA16(tr_frag(L + C_VC + ((32 * kp + 4 * g + q4) * 136 + 16 * td + 4 * p4) * 2, 16 * 272), pb[kp], acc);
            const size_t mo = m * 2048 + 1536 + hc * 128 + 16 * td + 4 * g; const u32x2 z = *(const u32x2*)(F.MIX + mo); bf16* mp = MO + mo;
            u32x2 o; o.x = cvtpk(acc[0] * inv * bflo(z.x), acc[1] * inv * bfhi(z.x)); o.y = cvtpk(acc[2] * inv * bflo(z.y), acc[3] * inv * bfhi(z.y));
            *(u32x2*)mp = o; __builtin_amdgcn_sched_barrier(0); }
    }
    __syncthreads();
}

constexpr int S_WN = 0, S_QD = 18432, S_KT = 36864, S_QK = 55296, S_BUF = 64512;
constexpr int S_OST = 2 * S_BUF, S_OLD = 272;
static_assert(S_OST + 64 * S_OLD <= RING_BYTES, "scan LDS");
DI void scan_unit(LAS unsigned char* lds_, int tid, const bf16* WNEG_, const bf16* QDEC_, const bf16* KDECT_, const bf16* QKM_, const bf16* UT_, const float* CD_, bf16* OF_, bf16* OB_, bf16* DUMP_, int bh, int dir) {
    const int lane = tid & 63, wave = __builtin_amdgcn_readfirstlane(tid >> 6);
    LAS unsigned char* L = lds_ + RING_OFF;
    const int b = bh >> 3, h = bh & 7;
    const int item0 = (bh * 2 + dir) * 32;
    const int r16 = lane & 15, g = lane >> 4;
    const int lt = tid - 256;
    const int e0 = wave * 32 + r16;
    if (wave >= 4) {
    v4u ldA[14], ldB[14];
#define SC_LOAD(ld, n_) do { const size_t it_ = (size_t)(item0 + (n_)); \
        _Pragma("unroll") for (int i_ = 0; i_ < 4; ++i_) { const int q_ = lt + 256 * i_; ld[i_] = *(const v4u*)(WNEG_ + it_ * 8192 + (size_t)q_ * 8); ld[4 + i_] = *(const v4u*)(QDEC_ + it_ * 8192 + (size_t)q_ * 8); ld[8 + i_] = *(const v4u*)(KDECT_ + it_ * 8192 + (size_t)q_ * 8); } \
        _Pragma("unroll") for (int i_ = 0; i_ < 2; ++i_) { const int q_ = lt + 256 * i_; ld[12 + i_] = *(const v4u*)(QKM_ + it_ * 4096 + (size_t)q_ * 8); } } while (0)
#define SC_WRITE(ld, bufo_) do { LAS unsigned char* B_ = L + (bufo_); \
        _Pragma("unroll") for (int i_ = 0; i_ < 4; ++i_) { const int q_ = lt + 256 * i_; *(LAS v4u*)(B_ + S_WN + (q_ >> 4) * 288 + (q_ & 15) * 16) = ld[i_]; *(LAS v4u*)(B_ + S_QD + (q_ >> 4) * 288 + (q_ & 15) * 16) = ld[4 + i_]; *(LAS v4u*)(B_ + S_KT + (q_ >> 3) * 144 + (q_ & 7) * 16) = ld[8 + i_]; } \
        _Pragma("unroll") for (int i_ = 0; i_ < 2; ++i_) { const int q_ = lt + 256 * i_; *(LAS v4u*)(B_ + S_QK + (q_ >> 3) * 144 + (q_ & 7) * 16) = ld[12 + i_]; } } while (0)
#define SC_SHIP(s_) do { const int np_ = dir ? 32 - (s_) : (s_) - 1; bf16* ob_ = ((s_) > 0) ? (dir ? OB_ : OF_) + ((size_t)b * SEQ + (size_t)np_ * 64) * 1024 + h * 128 : DUMP_; \
        _Pragma("unroll") for (int i_ = 0; i_ < 4; ++i_) { const int q_ = lt + 256 * i_, row_ = q_ >> 4, cc_ = q_ & 15; const v4u v_ = *(const LAS v4u*)(L + S_OST + row_ * S_OLD + cc_ * 16); \
            *(v4u*)(ob_ + (size_t)row_ * 1024 + cc_ * 8) = v_; } } while (0)
#define SC_CH(k_) (dir ? 31 - ((k_) < 31 ? (k_) : 31) : ((k_) < 31 ? (k_) : 31))
        SC_LOAD(ldA, SC_CH(0)); SC_WRITE(ldA, 0); SC_LOAD(ldB, SC_CH(1)); SC_SHIP(0); SC_LOAD(ldA, SC_CH(2));
        __syncthreads();
#pragma unroll 1
        for (int s = 0; s < 32; s += 2) {
            SC_SHIP(s);
            SC_WRITE(ldB, S_BUF); SC_LOAD(ldB, SC_CH(s + 3));
            LBAR(); LBAR();
            SC_SHIP(s + 1);
            SC_WRITE(ldA, 0); SC_LOAD(ldA, SC_CH(s + 4));
            LBAR(); LBAR();
        }
        asm volatile("s_waitcnt vmcnt(0)" ::: "memory");
#undef SC_SHIP
#undef SC_CH
    } else {
        f32x4 S[2][8];
#pragma unroll
        for (int c = 0; c < 2; ++c)
#pragma unroll
            for (int td = 0; td < 8; ++td) S[c][td] = (f32x4){0.f, 0.f, 0.f, 0.f};
        u32x2 un[2][4]; float cdn;
        { const int n0 = dir ? 31 : 0;
#pragma unroll
          for (int c = 0; c < 2; ++c) { const bf16* up = UT_ + ((size_t)(item0 + n0) * 128 + e0 + 16 * c) * 64 + 4 * g;
#pragma unroll
              for (int t = 0; t < 4; ++t) un[c][t] = *(const u32x2*)(up + 16 * t); }
          cdn = CD_[item0 + n0]; }
        __syncthreads();
#pragma unroll 1
        for (int s = 0; s < 32; ++s) {
            const LAS unsigned char* Bf = L + (s & 1) * S_BUF;
            const float cd = cdn;
            f32x4 vacc[2][4];
#pragma unroll
            for (int c = 0; c < 2; ++c)
#pragma unroll
                for (int t = 0; t < 4; ++t) { const u32x2 uu = un[c][t]; vacc[c][t] = (f32x4){bflo(uu.x), bfhi(uu.x), bflo(uu.y), bfhi(uu.y)}; }
            if (s + 1 < 32) { const int nn = dir ? 30 - s : s + 1;
#pragma unroll
                for (int c = 0; c < 2; ++c) { const bf16* up = UT_ + ((size_t)(item0 + nn) * 128 + e0 + 16 * c) * 64 + 4 * g;
#pragma unroll
                    for (int t = 0; t < 4; ++t) un[c][t] = *(const u32x2*)(up + 16 * t); }
                cdn = CD_[item0 + nn]; }
            bf16x8 Sb[2][4];
#pragma unroll
            for (int c = 0; c < 2; ++c)
#pragma unroll
                for (int ks = 0; ks < 4; ++ks) Sb[c][ks] = pack8(S[c][2 * ks], S[c][2 * ks + 1]);
            bf16x8 fa[4], fb[4];
#define SC_SB() __builtin_amdgcn_sched_barrier(0)
#define SC_LD4(dst, base_, row_, rstride_) do { dst[0] = ld_frag(Bf + (base_) + ((row_) + r16) * (rstride_) + g * 16); dst[1] = ld_frag(Bf + (base_) + ((row_) + r16) * (rstride_) + 64 + g * 16); \
        dst[2] = ld_frag(Bf + (base_) + ((row_) + r16) * (rstride_) + 128 + g * 16); dst[3] = ld_frag(Bf + (base_) + ((row_) + r16) * (rstride_) + 192 + g * 16); } while (0)
#define SC_MM4(acc_, src, t_) do { acc_[0][t_] = MFMA16(src[0], Sb[0][0], acc_[0][t_]); acc_[1][t_] = MFMA16(src[0], Sb[1][0], acc_[1][t_]); acc_[0][t_] = MFMA16(src[1], Sb[0][1], acc_[0][t_]); acc_[1][t_] = MFMA16(src[1], Sb[1][1], acc_[1][t_]); \
        acc_[0][t_] = MFMA16(src[2], Sb[0][2], acc_[0][t_]); acc_[1][t_] = MFMA16(src[2], Sb[1][2], acc_[1][t_]); acc_[0][t_] = MFMA16(src[3], Sb[0][3], acc_[0][t_]); acc_[1][t_] = MFMA16(src[3], Sb[1][3], acc_[1][t_]); } while (0)
#define SC_MMV(src, t_) SC_MM4(vacc, src, t_)
#define SC_MMO(src, t_) SC_MM4(oacc, src, t_)
#ifndef RSC1
#define RSC1 1
#endif
            f32x4 vsave[2][4];
            if (RSC1 > 1) { _Pragma("unroll") for (int c = 0; c < 2; ++c) _Pragma("unroll") for (int t = 0; t < 4; ++t) vsave[c][t] = vacc[c][t]; }
            for (int r5_ = 0; r5_ < RSC1; ++r5_) {
            if (RSC1 > 1) { _Pragma("unroll") for (int c = 0; c < 2; ++c) _Pragma("unroll") for (int t = 0; t < 4; ++t) vacc[c][t] = vsave[c][t]; }
            SC_LD4(fa, S_WN, 0, 288); SC_SB();
            SC_LD4(fb, S_WN, 16, 288); SC_SB(); SC_MMV(fa, 0); SC_SB();
            SC_LD4(fa, S_WN, 32, 288); SC_SB(); SC_MMV(fb, 1); SC_SB();
            SC_LD4(fb, S_WN, 48, 288); SC_SB(); SC_MMV(fa, 2); SC_SB();
            SC_LD4(fa, S_QD, 0, 288); SC_SB(); SC_MMV(fb, 3); SC_SB(); }
            bf16x8 Vb[2][2];
#pragma unroll
            for (int c = 0; c < 2; ++c)
#pragma unroll
                for (int kp = 0; kp < 2; ++kp) Vb[c][kp] = pack8(vacc[c][2 * kp], vacc[c][2 * kp + 1]);
            f32x4 oacc[2][4];
#pragma unroll
            for (int c = 0; c < 2; ++c)
#pragma unroll
                for (int t = 0; t < 4; ++t) oacc[c][t] = (f32x4){0.f, 0.f, 0.f, 0.f};
            SC_LD4(fb, S_QD, 16, 288); SC_SB(); SC_MMO(fa, 0); SC_SB();
            SC_LD4(fa, S_QD, 32, 288); SC_SB(); SC_MMO(fb, 1); SC_SB();
            SC_LD4(fb, S_QD, 48, 288); SC_SB(); SC_MMO(fa, 2); SC_SB();
#define SC_LDQK(dst, t0_) do { dst[0] = ld_frag(Bf + S_QK + (16 * (t0_) + r16) * 144 + g * 16); dst[1] = ld_frag(Bf + S_QK + (16 * (t0_) + r16) * 144 + 64 + g * 16); \
        dst[2] = ld_frag(Bf + S_QK + (16 * ((t0_) + 1) + r16) * 144 + g * 16); dst[3] = ld_frag(Bf + S_QK + (16 * ((t0_) + 1) + r16) * 144 + 64 + g * 16); } while (0)
#define SC_MMQK1(f0_, f1_, t_) do { oacc[0][t_] = MFMA16(f0_, Vb[0][0], oacc[0][t_]); oacc[1][t_] = MFMA16(f0_, Vb[1][0], oacc[1][t_]); oacc[0][t_] = MFMA16(f1_, Vb[0][1], oacc[0][t_]); oacc[1][t_] = MFMA16(f1_, Vb[1][1], oacc[1][t_]); } while (0)
#define SC_MMQK(src, t0_) do { SC_MMQK1(src[0], src[1], (t0_)); SC_MMQK1(src[2], src[3], (t0_) + 1); } while (0)
            SC_LDQK(fa, 0); SC_SB(); SC_MMO(fb, 3); SC_SB();
            SC_LDQK(fb, 2); SC_SB(); SC_MMQK(fa, 0); SC_SB();
#define SC_LDKT(dst, td0_) do { dst[0] = ld_frag(Bf + S_KT + (16 * (td0_) + r16) * 144 + g * 16); dst[1] = ld_frag(Bf + S_KT + (16 * (td0_) + r16) * 144 + 64 + g * 16); \
        dst[2] = ld_frag(Bf + S_KT + (16 * ((td0_) + 1) + r16) * 144 + g * 16); dst[3] = ld_frag(Bf + S_KT + (16 * ((td0_) + 1) + r16) * 144 + 64 + g * 16); } while (0)
#define SC_MMKT1(f0_, f1_, td_) do { f32x4 a0_ = S[0][td_] * cd, a1_ = S[1][td_] * cd; a0_ = MFMA16(f0_, Vb[0][0], a0_); a1_ = MFMA16(f0_, Vb[1][0], a1_); a0_ = MFMA16(f1_, Vb[0][1], a0_); a1_ = MFMA16(f1_, Vb[1][1], a1_); S[0][td_] = a0_; S[1][td_] = a1_; } while (0)
#define SC_MMKT(src, td0_) do { SC_MMKT1(src[0], src[1], (td0_)); SC_MMKT1(src[2], src[3], (td0_) + 1); } while (0)
            SC_LDKT(fa, 0); SC_SB(); SC_MMQK(fb, 2); SC_SB();
            LBAR();
#pragma unroll
            for (int c = 0; c < 2; ++c)
#pragma unroll
                for (int t = 0; t < 4; ++t) { const unsigned p01 = cvtpk(oacc[c][t][0], oacc[c][t][1]), p23 = cvtpk(oacc[c][t][2], oacc[c][t][3]); LAS unsigned char* op = L + S_OST + (16 * t + 4 * g) * S_OLD + (e0 + 16 * c) * 2;
                    *(LAS bf16*)(op) = (bf16)(p01 & 0xffffu); *(LAS bf16*)(op + S_OLD) = (bf16)(p01 >> 16); *(LAS bf16*)(op + 2 * S_OLD) = (bf16)(p23 & 0xffffu); *(LAS bf16*)(op + 3 * S_OLD) = (bf16)(p23 >> 16); }
            SC_SB();
            SC_LDKT(fb, 2); SC_SB(); SC_MMKT(fa, 0); SC_SB();
            SC_LDKT(fa, 4); SC_SB(); SC_MMKT(fb, 2); SC_SB();
            SC_LDKT(fb, 6); SC_SB(); SC_MMKT(fa, 4); SC_SB();
            SC_MMKT(fb, 6);
#undef SC_SB
#undef SC_LD4
#undef SC_MMV
#undef SC_MM4
#undef SC_MMO
#undef SC_LDQK
#undef SC_MMQK
#undef SC_MMQK1
#undef SC_MMKT1
#undef SC_LDKT
#undef SC_MMKT
            LBAR();
        }
    }
    { const int np = dir ? 0 : 31;
#pragma unroll
      for (int i = 0; i < 2; ++i) { const int q = tid + 512 * i, row = q >> 4, cc = q & 15; const v4u v = *(const LAS v4u*)(L + S_OST + row * S_OLD + cc * 16);
          *(v4u*)((dir ? OB_ : OF_) + ((size_t)b * SEQ + (size_t)np * 64 + row) * 1024 + h * 128 + cc * 8) = v; } }
    __syncthreads();
#undef SC_LOAD
#undef SC_WRITE
}

DI void combine_row(Frame& F, size_t m, bf16* MO) {
    const int lane = F.lane; const size_t off = m * 1024 + 16 * lane;
    const v4u f0 = *(const v4u*)(F.OF + off), f1 = *(const v4u*)(F.OF + off + 8), b0 = *(const v4u*)(F.OB + off), b1 = *(const v4u*)(F.OB + off + 8);
    const bf16* zp = F.MIX + m * 2048 + 16 * lane; const v4u z0 = *(const v4u*)zp, z1 = *(const v4u*)(zp + 8); bf16* mp = MO + m * 2048 + 16 * lane;
    float o[16];
    o[0] = bflo(f0.x) + bflo(b0.x); o[1] = bfhi(f0.x) + bfhi(b0.x); o[2] = bflo(f0.y) + bflo(b0.y); o[3] = bfhi(f0.y) + bfhi(b0.y);
    o[4] = bflo(f0.z) + bflo(b0.z); o[5] = bfhi(f0.z) + bfhi(b0.z); o[6] = bflo(f0.w) + bflo(b0.w); o[7] = bfhi(f0.w) + bfhi(b0.w);
    o[8] = bflo(f1.x) + bflo(b1.x); o[9] = bfhi(f1.x) + bfhi(b1.x); o[10] = bflo(f1.y) + bflo(b1.y); o[11] = bfhi(f1.y) + bfhi(b1.y);
    o[12] = bflo(f1.z) + bflo(b1.z); o[13] = bfhi(f1.z) + bfhi(b1.z); o[14] = bflo(f1.w) + bflo(b1.w); o[15] = bfhi(f1.w) + bfhi(b1.w);
    float ss = 0.f;
#pragma unroll
    for (int e = 0; e < 16; ++e) ss += o[e] * o[e];
    ss += __shfl_xor(ss, 1); ss += __shfl_xor(ss, 2); ss += __shfl_xor(ss, 4);
    const float rstd = 1.0f / sqrtf(ss * (1.0f / 128.0f) + EPS);
    float z[16];
    z[0] = bflo(z0.x); z[1] = bfhi(z0.x); z[2] = bflo(z0.y); z[3] = bfhi(z0.y); z[4] = bflo(z0.z); z[5] = bfhi(z0.z); z[6] = bflo(z0.w); z[7] = bfhi(z0.w);
    z[8] = bflo(z1.x); z[9] = bfhi(z1.x); z[10] = bflo(z1.y); z[11] = bfhi(z1.y); z[12] = bflo(z1.z); z[13] = bfhi(z1.z); z[14] = bflo(z1.w); z[15] = bfhi(z1.w);
    const int c0 = (16 * lane) & 127; float y[16];
#pragma unroll
    for (int e = 0; e < 16; ++e) y[e] = o[e] * rstd * F.o_norm_a[c0 + e] * z[e];
    v4u w0, w1; w0.x = cvtpk(y[0], y[1]); w0.y = cvtpk(y[2], y[3]); w0.z = cvtpk(y[4], y[5]); w0.w = cvtpk(y[6], y[7]);
    w1.x = cvtpk(y[8], y[9]); w1.y = cvtpk(y[10], y[11]); w1.z = cvtpk(y[12], y[13]); w1.w = cvtpk(y[14], y[15]);
    *(v4u*)mp = w0; *(v4u*)(mp + 8) = w1;
}

struct Args { const float* in[18]; float* out; unsigned char* ws; int ph_lo, ph_hi, li, pad; };
__global__ void __launch_bounds__(NWAVES * 64, 2) hybrid_fwd(Args args) {
    extern __shared__ __attribute__((aligned(16))) unsigned char lds[];
    Frame F;
    F.lds = (LAS unsigned char*)lds;
    F.MISC = (volatile LAS unsigned*)(F.lds + MISC_OFF);
    F.tid = threadIdx.x; F.lane = F.tid & 63; F.wave = __builtin_amdgcn_readfirstlane(F.tid >> 6);
    F.G = gridDim.x; { const int bx = blockIdx.x; F.vcu = (F.G % 8 == 0) ? (bx % 8) * (F.G / 8) + bx / 8 : bx; }
    unsigned char* ws = args.ws;
    F.ctl = (gu32*)(ws + WS_CTL);
    F.x = args.in[0]; F.mem = args.in[1]; F.norm_w = args.in[2]; F.w_in = args.in[3]; F.conv_w = args.in[4]; F.a_log_f = args.in[5]; F.a_log_b = args.in[6];
    F.dt_f = args.in[7]; F.dt_b = args.in[8]; F.o_norm_a = args.in[9]; F.q_norm_b = args.in[10]; F.k_norm_b = args.in[11]; F.sink_b = args.in[12];
    F.mem_norm_w = args.in[13]; F.w_mem_kv = args.in[14]; F.q_norm_c = args.in[15]; F.k_norm_c = args.in[16]; F.w_out = args.in[17]; F.out = args.out;
    F.WinT = (bf16*)(ws + WS_WIN); F.WmemT = (bf16*)(ws + WS_WMEM); F.WoutT = (bf16*)(ws + WS_WOUT); F.XN = (bf16*)(ws + WS_XN); F.MEMN = (bf16*)(ws + WS_MEMN);
    F.PA = (bf16*)(ws + WS_PA); F.PB = (bf16*)(ws + WS_PB); F.PC = (bf16*)(ws + WS_PC); F.MIX = (bf16*)(ws + WS_MIX); F.KVM = (bf16*)(ws + WS_KVM);
    F.UT = (bf16*)(ws + WS_UT); F.WNEG = (bf16*)(ws + WS_WNEG); F.QDEC = (bf16*)(ws + WS_QDEC); F.KDECT = (bf16*)(ws + WS_KDECT); F.QKM = (bf16*)(ws + WS_QKM);
    F.OF = (bf16*)(ws + WS_OF); F.OB = (bf16*)(ws + WS_OB);
    F.GATES = (float*)(ws + WS_GATES); F.ROPE = (float*)(ws + WS_ROPE); F.CD = (float*)(ws + WS_CD);
    for (int u = F.tid; u < (LDS_BYTES - LDSCTL_OFF) / 4; u += NWAVES * 64) ((LAS unsigned*)(F.lds + LDSCTL_OFF))[u] = 0u;
    __syncthreads();
    XcdBarrier bar; bar.bar = (unsigned*)(F.ctl + CW_BAR); bar.x = 0; bar.st = nullptr;
    if (N_LAUNCHES != PER_PHASE) bar = xcd_barrier_post((unsigned*)(F.ctl + CW_BAR), F.MISC + 8);
#define GRID_BAR() do { if (N_LAUNCHES == PER_PHASE) { if (F.tid == 0) __hip_atomic_store(F.ctl + CW_TMO, 0xBADBA0u, RLX_AGENT); } else { xcd_barrier(bar); } } while (0)
    const int lo = args.ph_lo, hi = args.ph_hi;
#define IN(k) (lo <= (k) && (k) < hi)
#define BOTH(k) (IN(k) && IN((k) + 1))

#ifndef REP0
#define REP0 1
#endif
#ifndef REP1
#define REP1 1
#endif
#ifndef REP2A
#define REP2A 1
#endif
#ifndef REP2B
#define REP2B 1
#endif
#ifndef REP2C
#define REP2C 1
#endif
#ifndef REP3
#define REP3 1
#endif
#ifndef REP4
#define REP4 1
#endif
#ifndef REP5
#define REP5 1
#endif
#ifndef REPBAR
#define REPBAR 1
#endif
    bf16* const DRY = (bf16*)F.out;
    if (IN(0)) { for (int rep = 0; rep < REP0; ++rep) p0_prologue(F); if (BOTH(0)) for (int rep = 0; rep < REPBAR; ++rep) GRID_BAR(); }

    if (IN(1)) {
        pg8::Gemm g{F.XN, F.WinT, M + NBATCH * MEMLEN, 6656 + 1024, DMODEL}; pg8::InOrder S; S.init(F.G, (int)blockIdx.x, REP1);
        pg8::EpiIn E{F.PA, F.PB, F.PC, F.MIX, F.KVM, F.GATES};
        pg8::gemm_phase<pg8::EpiIn, pg8::InOrder, true, true>(F.lds + RING_OFF, g, S, E);
        if (BOTH(1)) GRID_BAR();
    }

    if (IN(2)) {
        for (int rep = 0; rep < REP2A; ++rep) a_prep_phase(F);
        if (BOTH(2)) GRID_BAR();
    }

    if (IN(3)) {
        for (int rep = 0; rep < REP3; ++rep) for (int it = F.vcu; it < 128; it += F.G) scan_unit(F.lds, F.tid, F.WNEG, F.QDEC, F.KDECT, F.QKM, F.UT, F.CD, F.OF, F.OB, (bf16*)F.out + (size_t)blockIdx.x * 65536, it >> 1, it & 1);
        for (;;) {
            if (F.tid == 0) F.MISC[16] = __hip_atomic_fetch_add(F.ctl + CW_WQ, 1u, RLX_AGENT);
            __syncthreads();
            const unsigned id = F.MISC[16];
            __syncthreads();
            if (id >= 512u * REP2B) break;
            const int it = (int)(id & 255u);
            if ((id & 511u) < 256u) b_attn_unit(F, it >> 5, (it >> 1) & 15, it & 1, id < 512u ? F.MIX : DRY);
            else c_attn_unit(F, it >> 5, (it >> 3) & 3, it & 7, id < 512u ? F.MIX : DRY);
        }
        if (BOTH(3)) GRID_BAR();
    }

    if (IN(4)) {
        const int gw = F.vcu * NWAVES + F.wave, NGW = F.G * NWAVES;
        for (int rep = 0; rep < REP4; ++rep) for (int m = gw; m < M; m += NGW) combine_row(F, (size_t)m, rep == REP4 - 1 ? F.MIX : DRY);
        if (BOTH(4)) GRID_BAR();
    }

    if (IN(5)) {
        pg8::Gemm g{F.MIX, F.WoutT, M, DMODEL, DMODEL}; pg8::RepOrder S; S.init(M, DMODEL, F.G, (int)blockIdx.x, REP5);
        pg8::EpiOut E{F.x, F.out};
        pg8::gemm_phase<pg8::EpiOut, pg8::RepOrder, true, true>(F.lds + RING_OFF, g, S, E);
    }
#undef IN
#undef BOTH
}

extern "C" void kernel_launch(void* const* d_in, const int* in_sizes, int n_in, void* d_out, int out_size, void* d_ws, size_t ws_size, hipStream_t stream) {
    static int grid = 0;
    if (grid == 0) {
        if (n_in != 18 || in_sizes[0] != M * DMODEL || out_size != M * DMODEL || ws_size < WS_END) { fprintf(stderr, "kernel_launch: unexpected problem shape (n_in %d, in0 %d, out %d, ws %zu); nothing launched\n", n_in, n_in > 0 ? in_sizes[0] : -1, out_size, ws_size); grid = -1; return; }
        int dev = 0, cus = 0, per_cu = 0;
        if (hipGetDevice(&dev) != hipSuccess || hipDeviceGetAttribute(&cus, hipDeviceAttributeMultiprocessorCount, dev) != hipSuccess) { fprintf(stderr, "kernel_launch: device query failed\n"); grid = -1; return; }
        if (hipFuncSetAttribute((const void*)hybrid_fwd, hipFuncAttributeMaxDynamicSharedMemorySize, LDS_BYTES) != hipSuccess) { fprintf(stderr, "kernel_launch: hipFuncSetAttribute failed\n"); grid = -1; return; }
        if (hipOccupancyMaxActiveBlocksPerMultiprocessor(&per_cu, (const void*)hybrid_fwd, NWAVES * 64, LDS_BYTES) != hipSuccess || per_cu < 1)
            fprintf(stderr, "kernel_launch: note: occupancy query reports %d workgroups per CU\n", per_cu);
        (void)hipGetLastError();
        grid = cus;
    }
    if (grid < 0) return;
    if (hipMemsetAsync((char*)d_ws + WS_CTL, 0, CTL_ZERO_BYTES, stream) != hipSuccess) { fprintf(stderr, "kernel_launch: hipMemsetAsync failed\n"); return; }
    Args a{};
    for (int i = 0; i < 18; ++i) a.in[i] = (const float*)d_in[i];
    a.out = (float*)d_out; a.ws = (unsigned char*)d_ws;
    for (int li = 0; li < N_LAUNCHES; ++li) {
        a.ph_lo = (N_LAUNCHES == PER_PHASE) ? li : 0; a.ph_hi = (N_LAUNCHES == PER_PHASE) ? li + 1 : PER_PHASE; a.li = li;
        hipLaunchKernelGGL(hybrid_fwd, dim3(grid), dim3(NWAVES * 64), LDS_BYTES, stream, a);
        const hipError_t le = hipPeekAtLastError();
        if (le != hipSuccess) { fprintf(stderr, "kernel_launch: launch %d failed: %s\n", li, hipGetErrorName(le)); break; }
    }
}
```

```cpp
#define REP3 2
#include <hip/hip_runtime.h>
#include <cstdio>
#include <cstdint>
namespace pg8 {
#define PG8_LAS __attribute__((address_space(3)))
typedef unsigned short bf16_t;
typedef short bf16x8 __attribute__((ext_vector_type(8)));
typedef float f32x4 __attribute__((ext_vector_type(4)));
typedef unsigned u32x4 __attribute__((ext_vector_type(4)));
constexpr int BM = 256, BK = 64, HALF = 128, HTB = HALF * BK * 2  , STAGE_BYTES = 8 * HTB, NXCD = 8, WGM = 8;

__host__ __device__ __forceinline__ int lds_byte(int r, int c) { const int st = (r >> 4) * 2 + (c >> 5), rr = r & 15, cc = c & 31, ob = rr * 64 + cc * 2; return st * 1024 + (ob ^ (((ob >> 9) & 1) << 5)); }
__host__ __device__ __forceinline__ void stage_rc(int b, int& R, int& C) { const int st = b / 1024, sb = b % 1024, swz = sb ^ (((sb >> 9) & 1) << 5); R = (st >> 1) * 16 + swz / 64; C = (st & 1) * 32 + (swz % 64) / 2; }
__host__ __device__ __forceinline__ int perm32(int rho) { const int n = rho >> 4, i = rho & 15; return 8 * (i >> 2) + 4 * n + (i & 3); }

struct Unit { int pm, pn; };
struct Gemm { const bf16_t* A; const bf16_t* Bt; int M, N, K; };

struct StaticOrder {
    int nM, nN, nwg, G, c;
    __host__ __device__ void init(int M, int N, int G_, int c_) { nM = M / BM; nN = N / BM; nwg = nM * nN; G = G_; c = c_; }
    __host__ __device__ bool next(int i, Unit& u) const {
        const long L = (long)i * G + c; if (L >= nwg) return false;
        int wgid = (int)L; { const int q = nwg / NXCD, r = nwg % NXCD, xcd = wgid % NXCD, off = wgid / NXCD; wgid = (xcd < r ? xcd * (q + 1) : r * (q + 1) + (xcd - r) * q) + off; }
        const int nig = WGM * nN, gid = wgid / nig, fm = gid * WGM, gsz = (nM - fm) < WGM ? (nM - fm) : WGM;
        u.pm = fm + ((wgid % nig) % gsz); u.pn = (wgid % nig) / gsz; return true;
    }
    __device__ __forceinline__ void a_ready(const Unit&) const {}
    __device__ __forceinline__ void done(const Unit&) const {}
};

typedef float f32x2 __attribute__((ext_vector_type(2)));
typedef __bf16 bf16x2_t __attribute__((ext_vector_type(2)));
__device__ __forceinline__ unsigned cvt_pk_bf16(float lo, float hi) { f32x2 v = {lo, hi}; bf16x2_t b = __builtin_convertvector(v, bf16x2_t); return __builtin_bit_cast(unsigned, b); }
__device__ __forceinline__ float silu_f(float v) { return v * __builtin_amdgcn_rcpf(1.0f + __expf(-v)); }

struct EpiIn {
    static constexpr bool PERM = true, AFTER_DRAIN = false;
    bf16_t *PA, *PB, *PC, *MIX, *KVM; float* GATES;
    __device__ __forceinline__ void init(f32x4 (&acc)[2][2][4][2], const Unit&, int, int, int, int) const {
#pragma unroll
        for (int a = 0; a < 2; ++a)
#pragma unroll
            for (int b = 0; b < 2; ++b)
#pragma unroll
                for (int m = 0; m < 4; ++m)
#pragma unroll
                    for (int n = 0; n < 2; ++n) acc[a][b][m][n] = (f32x4){0.f, 0.f, 0.f, 0.f};
    }
    __device__ __forceinline__ void operator()(const f32x4 (&acc)[2][2][4][2], const Unit& u, int wr, int wc, int fr, int fq) const {
        const int row0 = u.pm * BM + wr * 64 + fr, cl = wc * 32 + 8 * fq, pn = u.pn;
        if (u.pm < 64 && pn == 25) {
            if (wc == 0) {
#pragma unroll
                for (int ai = 0; ai < 2; ++ai)
#pragma unroll
                    for (int m = 0; m < 4; ++m) { float* g = GATES + (size_t)(row0 + ai * HALF + m * 16) * 32 + 8 * fq;
                        *(f32x4*)g = acc[ai][0][m][0]; *(f32x4*)(g + 4) = acc[ai][0][m][1]; }
            }
            return;
        }
        bf16_t* base; int ldc; bool act = false;
        if (u.pm >= 64) { base = KVM + (size_t)(row0 - 16384) * 1024 + (pn - 26) * 256; ldc = 1024; }
        else if (pn < 12) { base = PA + (size_t)row0 * 3072 + pn * 256; ldc = 3072; }
        else if (pn < 16) { base = MIX + (size_t)row0 * 2048 + (pn - 12) * 256; ldc = 2048; act = true; }
        else if (pn < 19) { base = PB + (size_t)row0 * 768 + (pn - 16) * 256; ldc = 768; }
        else if (pn < 21) { base = MIX + (size_t)row0 * 2048 + 1024 + (pn - 19) * 256; ldc = 2048; act = true; }
        else if (pn < 23) { base = PC + (size_t)row0 * 512 + (pn - 21) * 256; ldc = 512; }
        else { base = MIX + (size_t)row0 * 2048 + 1536 + (pn - 23) * 256; ldc = 2048; act = true; }
        base += cl;
#pragma unroll
        for (int ai = 0; ai < 2; ++ai)
#pragma unroll
            for (int m = 0; m < 4; ++m) { bf16_t* rowp = base + (size_t)(ai * HALF + m * 16) * ldc;
#pragma unroll
                for (int bj = 0; bj < 2; ++bj) { f32x4 v0 = acc[ai][bj][m][0], v1 = acc[ai][bj][m][1];
                    if (act) { v0 = (f32x4){silu_f(v0[0]), silu_f(v0[1]), silu_f(v0[2]), silu_f(v0[3])}; v1 = (f32x4){silu_f(v1[0]), silu_f(v1[1]), silu_f(v1[2]), silu_f(v1[3])}; }
                    u32x4 w; w.x = cvt_pk_bf16(v0[0], v0[1]); w.y = cvt_pk_bf16(v0[2], v0[3]); w.z = cvt_pk_bf16(v1[0], v1[1]); w.w = cvt_pk_bf16(v1[2], v1[3]);
                    *(u32x4*)(rowp + bj * HALF) = w; } }
    }
};
struct EpiOut {
    static constexpr bool PERM = false, AFTER_DRAIN = false;
    const float* X; float* O;
    __device__ __forceinline__ void init(f32x4 (&acc)[2][2][4][2], const Unit& u, int wr, int wc, int fr, int fq) const {
        const int row0 = u.pm * BM + wr * 64 + fr, col0 = u.pn * BM + wc * 32 + 4 * fq;
#pragma unroll
        for (int ai = 0; ai < 2; ++ai)
#pragma unroll
            for (int m = 0; m < 4; ++m) { const size_t off = (size_t)(row0 + ai * HALF + m * 16) * 2048 + col0;
#pragma unroll
                for (int bj = 0; bj < 2; ++bj)
#pragma unroll
                    for (int n = 0; n < 2; ++n) acc[ai][bj][m][n] = *(const f32x4*)(X + off + bj * HALF + n * 16); }
    }
    __device__ __forceinline__ void operator()(const f32x4 (&acc)[2][2][4][2], const Unit& u, int wr, int wc, int fr, int fq) const {
        const int row0 = u.pm * BM + wr * 64 + fr, col0 = u.pn * BM + wc * 32 + 4 * fq;
#pragma unroll
        for (int ai = 0; ai < 2; ++ai)
#pragma unroll
            for (int m = 0; m < 4; ++m) { const size_t off = (size_t)(row0 + ai * HALF + m * 16) * 2048 + col0;
#pragma unroll
                for (int bj = 0; bj < 2; ++bj)
#pragma unroll
                    for (int n = 0; n < 2; ++n) *(f32x4*)(O + off + bj * HALF + n * 16) = acc[ai][bj][m][n]; }
    }
};
struct InOrder {
    StaticOrder base; int G, c, rep;
    __host__ __device__ void init(int G_, int c_, int rep_ = 1) { G = G_; c = c_; rep = rep_; base.init(16384, 6656, G_, 0); }
    __host__ __device__ bool next(int i, Unit& u) const {
        long L = (long)i * G + c; const long tot = base.nwg + 32;
        if (L >= tot * rep) return false;
        L %= tot;
        if (L < base.nwg) { StaticOrder b2 = base; b2.c = (int)(L % G); return b2.next((int)(L / G), u); }
        const int j = (int)(L - base.nwg);
        u.pm = 64 + (j >> 2); u.pn = 26 + (j & 3); return true;
    }
    __device__ __forceinline__ void a_ready(const Unit&) const {}
    __device__ __forceinline__ void done(const Unit&) const {}
};
struct RepOrder {
    StaticOrder base; int G, c, rep;
    __host__ __device__ void init(int M_, int N_, int G_, int c_, int rep_ = 1) { G = G_; c = c_; rep = rep_; base.init(M_, N_, G_, 0); }
    __host__ __device__ bool next(int i, Unit& u) const {
        long L = (long)i * G + c; if (L >= (long)base.nwg * rep) return false;
        L %= base.nwg; StaticOrder b2 = base; b2.c = (int)(L % G); return b2.next((int)(L / G), u);
    }
    __device__ __forceinline__ void a_ready(const Unit&) const {}
    __device__ __forceinline__ void done(const Unit&) const {}
};

template <class Epi, class Sched, bool ALIGN_EPI = false, bool SP2 = false>
__device__ __forceinline__ void gemm_phase(PG8_LAS unsigned char* lds, const Gemm g, const Sched& S, const Epi& E) {
    const int tid = threadIdx.x, wid = __builtin_amdgcn_readfirstlane(tid >> 6), lane = tid & 63, wr = wid >> 2, wc = wid & 3, fr = lane & 15, fq = lane >> 4;
    const int K = g.K, nt = K / BK;
    unsigned voffA[2], voffB[2];
#pragma unroll
    for (int i = 0; i < 2; ++i) { int R, C; stage_rc(tid * 16 + i * 8192, R, C); const int Rb = Epi::PERM ? ((R & ~31) + perm32(R & 31)) : R;
        voffA[i] = (unsigned)(R * K + C) * 2u; voffB[i] = (unsigned)(Rb * K + C) * 2u; }
    const size_t kstep = (size_t)(BK * 2);
    const size_t hstep = (size_t)HALF * K * 2;
    const size_t tstep = 2 * hstep;
    const unsigned ldsw = (unsigned)wid * 1024u;
    const int aoff = lds_byte(wr * 64 + fr, fq * 8), boff = lds_byte(wc * 32 + fr, fq * 8);
#define PG8_SA(b, h) (((b) * 2 + (h)) * HTB)
#define PG8_SB(b, h) ((4 + (b) * 2 + (h)) * HTB)
#define PG8_STAGE(bufoff, gbase, voff) do { _Pragma("unroll") for (int _i = 0; _i < 2; ++_i) \
        __builtin_amdgcn_global_load_lds((const unsigned*)((const char*)(gbase) + (voff)[_i]), (PG8_LAS unsigned*)(lds + (bufoff) + ldsw + _i * 8192), 16, 0, 0); } while (0)
#define PG8_LDA(dst, b, h) do { _Pragma("unroll") for (int m = 0; m < 4; ++m) _Pragma("unroll") for (int k = 0; k < 2; ++k) dst[m][k] = *(const PG8_LAS bf16x8*)(lds + PG8_SA(b, h) + aoff + m * 2048 + k * 1024); } while (0)
#define PG8_LDB(dst, b, h) do { _Pragma("unroll") for (int n = 0; n < 2; ++n) _Pragma("unroll") for (int k = 0; k < 2; ++k) dst[n][k] = *(const PG8_LAS bf16x8*)(lds + PG8_SB(b, h) + boff + n * 2048 + k * 1024); } while (0)
#define PG8_MMA(ai, bj, At, Bt) do { __builtin_amdgcn_s_setprio(1); _Pragma("unroll") for (int m = 0; m < 4; ++m) _Pragma("unroll") for (int n = 0; n < 2; ++n) _Pragma("unroll") for (int k = 0; k < 2; ++k) \
        acc[ai][bj][m][n] = __builtin_amdgcn_mfma_f32_16x16x32_bf16(Bt[n][k], At[m][k], acc[ai][bj][m][n], 0, 0, 0); __builtin_amdgcn_s_setprio(0); } while (0)
#define PG8_WAIT_V(n) asm volatile("s_waitcnt vmcnt(" #n ")" ::: "memory")
#define PG8_WAIT_L(n) asm volatile("s_waitcnt lgkmcnt(" #n ")" ::: "memory")
#define PG8_BAR __builtin_amdgcn_s_barrier()
#define PG8_SCHED __builtin_amdgcn_sched_barrier(0)
    Unit cur, nxt; int ui = 0;
    if (!S.next(0, cur)) return;
    f32x4 acc[2][2][4][2];
    E.init(acc, cur, wr, wc, fr, fq);
    bf16x8 At[4][2], B0[2][2], B1[2][2];
    const char* cA = (const char*)g.A + (size_t)cur.pm * tstep; const char* cB = (const char*)g.Bt + (size_t)cur.pn * tstep;
    S.a_ready(cur);
    if constexpr (SP2) {
        PG8_STAGE(PG8_SB(0, 0), cB, voffB); PG8_STAGE(PG8_SB(0, 1), cB + hstep, voffB); PG8_STAGE(PG8_SA(0, 0), cA, voffA); PG8_STAGE(PG8_SA(0, 1), cA + hstep, voffA);
        if (wr == 1) PG8_BAR;
        PG8_WAIT_V(2); PG8_BAR;
        PG8_STAGE(PG8_SB(1, 0), cB + kstep, voffB); PG8_STAGE(PG8_SA(1, 0), cA + kstep, voffA); PG8_STAGE(PG8_SB(1, 1), cB + hstep + kstep, voffB);
        PG8_WAIT_V(6); PG8_BAR;
    } else {
        PG8_STAGE(PG8_SB(0, 0), cB, voffB); PG8_STAGE(PG8_SA(0, 0), cA, voffA); PG8_STAGE(PG8_SB(0, 1), cB + hstep, voffB); PG8_STAGE(PG8_SA(0, 1), cA + hstep, voffA);
        if (wr == 1) PG8_BAR;
        PG8_WAIT_V(4); PG8_BAR;
        PG8_STAGE(PG8_SB(1, 0), cB + kstep, voffB); PG8_STAGE(PG8_SA(1, 0), cA + kstep, voffA); PG8_STAGE(PG8_SB(1, 1), cB + hstep + kstep, voffB);
        PG8_WAIT_V(6); PG8_BAR;
    }
    for (;;) {
        const bool has_next = S.next(ui + 1, nxt);
        const char* nA = has_next ? (const char*)g.A + (size_t)nxt.pm * tstep : cA; const char* nB = has_next ? (const char*)g.Bt + (size_t)nxt.pn * tstep : cB;
        for (int t = 0; t < nt; t += 2) {
            const bool last = (t == nt - 2);
            const char* a1 = cA + (size_t)(t + 1) * kstep;
            const char* a2 = last ? nA : cA + (size_t)(t + 2) * kstep; const char* b2 = last ? nB : cB + (size_t)(t + 2) * kstep;
            const char* a3 = a2 + kstep; const char* b3 = b2 + kstep;
            if (last && has_next) S.a_ready(nxt);
            if constexpr (SP2) {
            PG8_LDB(B0, 0, 0); PG8_LDB(B1, 0, 1); PG8_SCHED; PG8_LDA(At, 0, 0); PG8_STAGE(PG8_SA(1, 1), a1 + hstep, voffA);
            PG8_WAIT_V(8); PG8_WAIT_L(0); PG8_BAR; PG8_MMA(0, 0, At, B0); PG8_MMA(0, 1, At, B1); PG8_BAR; PG8_SCHED;
            PG8_LDA(At, 0, 1); PG8_STAGE(PG8_SB(0, 0), b2, voffB); PG8_STAGE(PG8_SB(0, 1), b2 + hstep, voffB); PG8_STAGE(PG8_SA(0, 0), a2, voffA);
            PG8_WAIT_V(8); PG8_WAIT_L(0); PG8_BAR; PG8_MMA(1, 0, At, B0); PG8_MMA(1, 1, At, B1); PG8_BAR; PG8_SCHED;
            PG8_LDB(B0, 1, 0); PG8_LDB(B1, 1, 1); PG8_SCHED; PG8_LDA(At, 1, 0); PG8_STAGE(PG8_SA(0, 1), a2 + hstep, voffA);
            PG8_WAIT_V(8); PG8_WAIT_L(0); PG8_BAR; PG8_MMA(0, 0, At, B0); PG8_MMA(0, 1, At, B1); PG8_BAR; PG8_SCHED;
            PG8_LDA(At, 1, 1); PG8_STAGE(PG8_SB(1, 0), b3, voffB); PG8_STAGE(PG8_SB(1, 1), b3 + hstep, voffB); PG8_STAGE(PG8_SA(1, 0), a3, voffA);
            PG8_WAIT_V(8); PG8_WAIT_L(0); PG8_BAR; PG8_MMA(1, 0, At, B0); PG8_MMA(1, 1, At, B1); PG8_BAR; PG8_SCHED;
            } else {
            PG8_LDB(B0, 0, 0); PG8_SCHED; PG8_LDA(At, 0, 0); PG8_STAGE(PG8_SA(1, 1), a1 + hstep, voffA);
            PG8_WAIT_L(8); PG8_BAR; PG8_WAIT_L(0); PG8_MMA(0, 0, At, B0); PG8_BAR; PG8_SCHED;
            PG8_LDB(B1, 0, 1); PG8_STAGE(PG8_SB(0, 0), b2, voffB);
            PG8_BAR; PG8_WAIT_L(0); PG8_MMA(0, 1, At, B1); PG8_BAR;
            PG8_LDA(At, 0, 1); PG8_STAGE(PG8_SA(0, 0), a2, voffA);
            PG8_BAR; PG8_WAIT_L(0); PG8_MMA(1, 0, At, B0); PG8_BAR; PG8_SCHED;
            PG8_STAGE(PG8_SB(0, 1), b2 + hstep, voffB);
            PG8_WAIT_V(6); PG8_BAR; PG8_MMA(1, 1, At, B1); PG8_BAR;
            PG8_LDB(B0, 1, 0); PG8_SCHED; PG8_LDA(At, 1, 0); PG8_STAGE(PG8_SA(0, 1), a2 + hstep, voffA);
            PG8_WAIT_L(8); PG8_BAR; PG8_WAIT_L(0); PG8_MMA(0, 0, At, B0); PG8_BAR; PG8_SCHED;
            PG8_LDB(B1, 1, 1); PG8_STAGE(PG8_SB(1, 0), b3, voffB);
            PG8_BAR; PG8_WAIT_L(0); PG8_MMA(0, 1, At, B1); PG8_BAR;
            PG8_LDA(At, 1, 1); PG8_STAGE(PG8_SA(1, 0), a3, voffA);
            PG8_BAR; PG8_WAIT_L(0); PG8_MMA(1, 0, At, B0); PG8_BAR; PG8_SCHED;
            PG8_STAGE(PG8_SB(1, 1), b3 + hstep, voffB);
            PG8_WAIT_V(6); PG8_BAR; PG8_MMA(1, 1, At, B1); PG8_BAR;
            }
        }
        if constexpr (ALIGN_EPI) { if (wr == 0) PG8_BAR; }
        if constexpr (!Epi::AFTER_DRAIN) { E(acc, cur, wr, wc, fr, fq); S.done(cur); }
        if (!has_next) break;
        cur = nxt; cA = nA; cB = nB; ++ui;
        E.init(acc, cur, wr, wc, fr, fq);
        if constexpr (ALIGN_EPI) { if (wr == 1) PG8_BAR; }
    }
    PG8_WAIT_V(0);
    if constexpr (!ALIGN_EPI) { if (wr == 0) PG8_BAR; }
    PG8_BAR;
    if constexpr (Epi::AFTER_DRAIN) { E.fused(acc, cur, wr, wc, fr, fq, lds, wid, lane); S.done(cur); }
#undef PG8_SA
#undef PG8_SB
#undef PG8_STAGE
#undef PG8_LDA
#undef PG8_LDB
#undef PG8_MMA
#undef PG8_WAIT_V
#undef PG8_WAIT_L
#undef PG8_BAR
#undef PG8_SCHED
}
}
#define GAS __attribute__((address_space(1)))
#define LAS __attribute__((address_space(3)))
typedef unsigned short bf16;
typedef unsigned v4u __attribute__((ext_vector_type(4)));
typedef float f32x4 __attribute__((ext_vector_type(4)));
typedef short bf16x8 __attribute__((ext_vector_type(8)));
typedef GAS unsigned gu32;
typedef GAS unsigned long long gu64;
#define RLX_AGENT __ATOMIC_RELAXED, __HIP_MEMORY_SCOPE_AGENT
#define LDS_WAIT() asm volatile("s_waitcnt lgkmcnt(0)" ::: "memory")
#define VM_WAIT() asm volatile("s_waitcnt vmcnt(0)" ::: "memory")
__device__ __forceinline__ unsigned long long rt() { return __builtin_amdgcn_s_memrealtime(); }
__device__ __forceinline__ unsigned f2bf(float f) { unsigned u = __builtin_bit_cast(unsigned, f); return (u + 0x7fffu + ((u >> 16) & 1u)) >> 16; }
__device__ __forceinline__ unsigned pk2(float lo, float hi) { return f2bf(lo) | (f2bf(hi) << 16); }

#define XB_TMO      128
#define XB_XCNT(j)  (256  + 64 * (j))
#define XB_XSUB(j)  (1280 + 64 * (j))
#define XB_XGEN(j)  (2304 + 64 * (j))
#define XB_TOP      3328
#define XB_TOPGEN   3392
#define XCD_BAR_WORDS 3456
#define XB_SPIN_CAP (1u << 18)

__device__ __forceinline__ unsigned xb_ld(unsigned* p)              { return __hip_atomic_load(p, __ATOMIC_RELAXED, __HIP_MEMORY_SCOPE_AGENT); }
__device__ __forceinline__ unsigned xb_add(unsigned* p, unsigned v) { return __hip_atomic_fetch_add(p, v, __ATOMIC_RELAXED, __HIP_MEMORY_SCOPE_AGENT); }
__device__ __forceinline__ unsigned xb_xcc_id() { return (unsigned)__builtin_amdgcn_s_getreg((3 << 11) | 20) & 0xFu; }
#define XB_SPIN(cond, bar) do { unsigned _sp = 0; while (cond) { __builtin_amdgcn_s_sleep(1); \
    if ((++_sp & 255u) == 0u) { if (xb_ld(&(bar)[XB_TMO])) break; if (_sp > XB_SPIN_CAP) { atomicAdd(&(bar)[XB_TMO], 1u); break; } } } } while (0)

struct XcdBarrier {
    unsigned* bar; unsigned x;
    volatile LAS unsigned* st;
};

__device__ __forceinline__ XcdBarrier xcd_barrier_post(unsigned* bar, volatile LAS unsigned* st) {
    XcdBarrier b; b.bar = bar; b.x = xb_xcc_id(); b.st = st;
    if (threadIdx.x == 0) (void)xb_add(&bar[XB_XCNT(b.x)], 1u);
    return b;
}
__device__ __forceinline__ void xcd_barrier_complete(unsigned* bar, unsigned x, unsigned& nloc, unsigned& nx) {
    const unsigned G = gridDim.x * gridDim.y * gridDim.z;
    unsigned sum, cnt, mine, sp = 0u;
    for (;;) {
        sum = 0u; cnt = 0u; mine = 0u;
#pragma unroll
        for (unsigned j = 0; j < 16; ++j) { const unsigned c = xb_ld(&bar[XB_XCNT(j)]); sum += c; cnt += (c > 0u) ? 1u : 0u; mine = (j == x) ? c : mine; }
        if (sum == G) break;
        __builtin_amdgcn_s_sleep(1);
        if ((++sp & 255u) == 0u) { if (xb_ld(&bar[XB_TMO])) break; if (sp > XB_SPIN_CAP) { atomicAdd(&bar[XB_TMO], 1u); break; } }
    }
    nloc = mine > 0u ? mine : 1u; nx = cnt > 0u ? cnt : 1u;
}

__device__ __forceinline__ void xcd_barrier(const XcdBarrier& b) {
    asm volatile("s_waitcnt vmcnt(0)" ::: "memory");
    __syncthreads();
    if (threadIdx.x == 0) {
        unsigned* bar = b.bar;
        __builtin_amdgcn_s_waitcnt(0);
        unsigned nloc = b.st[0], nx = b.st[1];
        if (nloc == 0u) { xcd_barrier_complete(bar, b.x, nloc, nx); b.st[0] = nloc; b.st[1] = nx; }
        const unsigned old = xb_add(&bar[XB_XSUB(b.x)], 1u);
        const unsigned gen = old / nloc;
        if (old + 1u == (gen + 1u) * nloc) {
            __builtin_amdgcn_fence(__ATOMIC_RELEASE, "agent");
            asm volatile("s_waitcnt vmcnt(0)" ::: "memory");
            const unsigned og = xb_add(&bar[XB_TOP], 1u);
            const unsigned tg = og / nx;
            if (og + 1u == (tg + 1u) * nx) xb_add(&bar[XB_TOPGEN], 1u);
            else XB_SPIN(xb_ld(&bar[XB_TOPGEN]) == tg, bar);
            __builtin_amdgcn_fence(__ATOMIC_ACQUIRE, "agent");
            xb_add(&bar[XB_XGEN(b.x)], 1u);
            asm volatile("s_waitcnt vmcnt(0)" ::: "memory");
        } else {
            XB_SPIN(xb_ld(&bar[XB_XGEN(b.x)]) == gen, bar);
            __builtin_amdgcn_fence(__ATOMIC_ACQUIRE, "agent");
            asm volatile("s_waitcnt vmcnt(0)" ::: "memory");
        }
    }
    __syncthreads();
}
constexpr int NWAVES = 8;
#ifndef MK_N_LAUNCHES
#define MK_N_LAUNCHES 1
#endif
constexpr int N_LAUNCHES = MK_N_LAUNCHES;
constexpr int PER_PHASE = 6;

constexpr int NBATCH = 8, SEQ = 2048, DMODEL = 2048, M = NBATCH * SEQ;
constexpr int MEMLEN = 256;
constexpr int NIN = 6432;
constexpr float EPS = 1e-6f;
constexpr float LOG2E = 1.4426950408889634f;

constexpr size_t MiB = 1u << 20;
constexpr size_t WS_CTL = 0, CTL_ZERO_BYTES = 1 * MiB;
constexpr size_t WS_WOUT = 1 * MiB;
constexpr size_t WS_WIN = 9 * MiB, WS_WMEM = 35 * MiB;
constexpr size_t WS_XN = 39 * MiB, WS_MEMN = 103 * MiB;
constexpr size_t WS_PA = 111 * MiB;
constexpr size_t WS_PB = 207 * MiB;
constexpr size_t WS_PC = 231 * MiB;
constexpr size_t WS_MIX = 247 * MiB;
constexpr size_t WS_GATES = 311 * MiB;
constexpr size_t WS_KVM = 313 * MiB;
constexpr size_t WS_ROPE = 317 * MiB;
constexpr size_t WS_CD = 317 * MiB + 512 * 1024;
constexpr size_t WS_UT = 318 * MiB, WS_WNEG = 382 * MiB, WS_QDEC = 446 * MiB;
constexpr size_t WS_KDECT = 9 * MiB, WS_QKM = 73 * MiB;
constexpr size_t WS_OF = 111 * MiB, WS_OB = 143 * MiB;
constexpr size_t WS_END = 510 * MiB;
constexpr int CW_TMO = 0, CW_CODE = 1, CW_WQ = 64, CW_BAR = 4096;

constexpr int RING_OFF = 0, RING_BYTES = 149504;
constexpr int LDSCTL_OFF = RING_BYTES, MISC_OFF = LDSCTL_OFF + 320;
constexpr int LDS_BYTES = 150528;
static_assert(MISC_OFF + 128 <= LDS_BYTES, "LDS map");

#define DI __device__ __forceinline__
typedef short s16x4 __attribute__((ext_vector_type(4)));
typedef unsigned u32x2 __attribute__((ext_vector_type(2)));
typedef float f32x2v __attribute__((ext_vector_type(2)));
#define MFMA16(a, b, c) __builtin_amdgcn_mfma_f32_16x16x32_bf16((a), (b), (c), 0, 0, 0)
DI unsigned cvtpk(float lo, float hi) { return pg8::cvt_pk_bf16(lo, hi); }
DI float bflo(unsigned v) { return __uint_as_float(v << 16); }
DI float bfhi(unsigned v) { return __uint_as_float(v & 0xffff0000u); }
DI float wave_sum(float v) {
#pragma unroll
    for (int o = 1; o < 64; o <<= 1) v += __shfl_xor(v, o);
    return v;
}
DI float silu_f(float v) { return pg8::silu_f(v); }
DI float softplus_f(float x) { return x > 20.f ? x : log1pf(expf(x)); }
DI float sigmoid_f(float x) { return 1.0f / (1.0f + expf(-x)); }
DI int perm32k(int k) { return (k & ~31) | (((k >> 2) & 3) << 3) | (((k >> 4) & 1) << 2) | (k & 3); }
typedef short v4i16_t __attribute__((ext_vector_type(4)));
DI s16x4 vtr(const LAS unsigned char* p) { return __builtin_bit_cast(s16x4, __builtin_amdgcn_ds_read_tr16_b64_v4i16((LAS v4i16_t*)p)); }
DI bf16x8 tr_frag(const LAS unsigned char* lo, int hi_off) { const s16x4 a = vtr(lo), b = vtr(lo + hi_off); return (bf16x8){a[0], a[1], a[2], a[3], b[0], b[1], b[2], b[3]}; }
DI bf16x8 ld_frag(const LAS unsigned char* p) { return *(const LAS bf16x8*)p; }
DI bf16x8 pack8(const f32x4& a, const f32x4& b) { v4u w; w.x = cvtpk(a[0], a[1]); w.y = cvtpk(a[2], a[3]); w.z = cvtpk(b[0], b[1]); w.w = cvtpk(b[2], b[3]); return __builtin_bit_cast(bf16x8, w); }

struct Frame {
    LAS unsigned char* lds;
    volatile LAS unsigned* MISC;
    gu32* ctl;
    int tid, lane, wave;
    int vcu, G;
    const float *x, *mem, *norm_w, *w_in, *conv_w, *a_log_f, *a_log_b, *dt_f, *dt_b, *o_norm_a, *q_norm_b, *k_norm_b, *sink_b, *mem_norm_w, *w_mem_kv, *q_norm_c, *k_norm_c, *w_out;
    float* out;
    bf16 *WinT, *WmemT, *WoutT, *XN, *MEMN, *PA, *PB, *PC, *MIX, *KVM, *UT, *WNEG, *QDEC, *KDECT, *QKM, *OF, *OB;
    float *GATES, *ROPE, *CD;
};

DI void p0_transpose_item(const float* W, int K, int N, bf16* WT, int k0, int n0, int drow0, LAS float* scr, int lane) {
#pragma unroll 8
    for (int i = 0; i < 32; ++i) { const int kk = 2 * i + (lane >> 5); scr[kk * 33 + (lane & 31)] = W[(size_t)(k0 + kk) * N + n0 + (lane & 31)]; }
    LDS_WAIT(); asm volatile("" ::: "memory");
    const int c = lane & 7;
#pragma unroll
    for (int j = 0; j < 4; ++j) { const int n = (lane >> 3) + 8 * j; const LAS float* s = scr + (8 * c) * 33 + n;
        v4u o; o.x = pk2(s[0 * 33], s[1 * 33]); o.y = pk2(s[2 * 33], s[3 * 33]); o.z = pk2(s[4 * 33], s[5 * 33]); o.w = pk2(s[6 * 33], s[7 * 33]);
        *(GAS v4u*)(WT + (size_t)(drow0 + n) * K + k0 + 8 * c) = o; }
    LDS_WAIT(); asm volatile("" ::: "memory");
}
DI void rms_row_to_bf16(const float* xrow, const float* w, bf16* orow, int lane) {
    const GAS f32x4* xr = (const GAS f32x4*)xrow + lane; const GAS f32x4* wr = (const GAS f32x4*)w + lane;
    f32x4 v[8]; float s = 0.f;
#pragma unroll
    for (int j = 0; j < 8; ++j) { v[j] = xr[64 * j]; s += (v[j].x * v[j].x + v[j].y * v[j].y) + (v[j].z * v[j].z + v[j].w * v[j].w); }
    const float rstd = 1.0f / sqrtf(wave_sum(s) * (1.0f / 2048.0f) + EPS);
    GAS unsigned long long* o8 = (GAS unsigned long long*)orow + lane;
#pragma unroll
    for (int j = 0; j < 8; ++j) { const f32x4 wv = wr[64 * j]; const f32x4 y = v[j] * rstd * wv;
        o8[64 * j] = (unsigned long long)cvtpk(y.x, y.y) | ((unsigned long long)cvtpk(y.z, y.w) << 32); }
}
DI void p0_prologue(Frame& F) {
    LAS float* scr = (LAS float*)(F.lds + RING_OFF + F.wave * 16384);
    const int gw = F.vcu * NWAVES + F.wave, NGW = F.G * NWAVES;
    constexpr int I_IN = 32 * 201, I_MEM = 32 * 32, I_OUT = 32 * 64, NITEMS = I_IN + I_MEM + I_OUT;
    for (int it = gw; it < NITEMS; it += NGW) {
        int r = it;
        if (r < I_IN) { const int kb = r / 201, sb = r % 201, n0 = 32 * sb; const int drow = n0 < 4096 ? n0 : (n0 < 4128 ? 6400 + (n0 - 4096) : n0 - 32);
            p0_transpose_item(F.w_in, 2048, NIN, F.WinT, 64 * kb, n0, drow, scr, F.lane); continue; }
        r -= I_IN;
        if (r < I_MEM) { p0_transpose_item(F.w_mem_kv, 2048, 1024, F.WmemT, 64 * (r / 32), 32 * (r % 32), 32 * (r % 32), scr, F.lane); continue; }
        r -= I_MEM;
        p0_transpose_item(F.w_out, 2048, 2048, F.WoutT, 64 * (r / 64), 32 * (r % 64), 32 * (r % 64), scr, F.lane);
    }
    { GAS v4u* z = (GAS v4u*)(F.WinT + (size_t)NIN * 2048); const int gt = F.vcu * 512 + F.tid, NT = F.G * 512;
      for (int i = gt; i < 224 * 256; i += NT) z[i] = (v4u){0u, 0u, 0u, 0u}; }
    for (int m = gw; m < M; m += NGW) rms_row_to_bf16(F.x + (size_t)m * DMODEL, F.norm_w, F.XN + (size_t)m * DMODEL, F.lane);
    for (int m = gw; m < NBATCH * MEMLEN; m += NGW) rms_row_to_bf16(F.mem + (size_t)m * DMODEL, F.mem_norm_w, F.MEMN + (size_t)m * DMODEL, F.lane);
    { const int gt = F.vcu * 512 + F.tid, NT = F.G * 512;
      for (int i = gt; i < SEQ * 32; i += NT) { const int pos = i >> 5, fi = i & 31; const float inv = powf(10000.0f, -(float)(2 * fi) / 64.0f); const float ang = (float)pos * inv;
          F.ROPE[2 * i] = cosf(ang); F.ROPE[2 * i + 1] = sinf(ang); } }
}

constexpr int AB_QH = 0, AB_KH = 17408, AB_VV = 34816, AB_BUF = 52224, AB_LD = 272;
constexpr int AD_F = 104448, AD_B = 122880, AD_T2 = 9216, AD_LDL = 72, AD_LDT = 144;
constexpr int AG_0 = 141312, AG_SZ = 2560, AG_RAW = 146432;
constexpr int ASCR_F = 0, ASCR_B = 5120;
static_assert(AG_RAW == AG_0 + 2 * AG_SZ && AG_RAW + 1024 <= RING_BYTES && AD_F == 2 * AB_BUF && AD_B == AD_F + 64 * 72 * 4 && AG_0 == AD_B + 64 * 72 * 4, "A-prep LDS map");
#define LBAR() asm volatile("s_waitcnt lgkmcnt(0)\n\ts_barrier" ::: "memory")

#define DPP_ADD(s, ctrl) (s) += __builtin_bit_cast(float, __builtin_amdgcn_update_dpp(0, __builtin_bit_cast(int, (s)), (ctrl), 0xf, 0xf, true))
DI float row16_sum(float s) { DPP_ADD(s, 0xB1); DPP_ADD(s, 0x4E); DPP_ADD(s, 0x141); DPP_ADD(s, 0x140); return s; }

template <bool BWD> DI void s3_solve(LAS unsigned char* L, LAS unsigned char* scr, const LAS float* GV, int lane) {
    int lane_o = lane; asm volatile("" : "+v"(lane_o));
    const int hb = lane_o >> 5, cc = lane_o & 31, r16 = lane_o & 15, g = lane_o >> 4;
    LAS unsigned char* D = L + (BWD ? AD_B : AD_F);
    const LAS float* LS = (const LAS float*)D;
    const LAS float* Lb = LS + hb * (32 * AD_LDL + 32);
    LAS unsigned char* SA = scr + (BWD ? ASCR_B : ASCR_F); LAS unsigned char* SB = SA + 2560;
    LAS unsigned char* T1 = D; LAS unsigned char* T2 = D + AD_T2;
    const LAS float* S1 = GV + (BWD ? 192 : 128); const LAS float* S2 = GV + (BWD ? 576 : 512);
    bf16x8 la[2];
#pragma unroll
    for (int ti = 0; ti < 2; ++ti) { const LAS float* lp = LS + (32 + 16 * ti + r16) * AD_LDL + 8 * g; const f32x4 x0 = *(const LAS f32x4*)lp, x1 = *(const LAS f32x4*)(lp + 4); la[ti] = pack8(x0, x1); }
#ifndef RS3L
#define RS3L 1
#endif
    float t[32];
    for (int r3_ = 0; r3_ < RS3L; ++r3_) {
    t[0] = (cc == 0) ? 1.f : 0.f;
    f32x4 rwA[8], rwB[8];
    rwB[0] = *(const LAS f32x4*)(Lb + AD_LDL);
#pragma unroll
    for (int i = 1; i < 32; ++i) {
        if (i + 1 < 32) {
#pragma unroll
            for (int q = 0; q < 8; ++q) if (4 * q < i + 1) { if ((i + 1) & 1) rwB[q] = *(const LAS f32x4*)(Lb + (i + 1) * AD_LDL + 4 * q); else rwA[q] = *(const LAS f32x4*)(Lb + (i + 1) * AD_LDL + 4 * q); } }
        __builtin_amdgcn_sched_barrier(0);
        float sa = (cc == i) ? 1.f : 0.f, sb = 0.f;
#pragma unroll
        for (int q = 0; q < 8; ++q)
#pragma unroll
            for (int e = 0; e < 4; ++e) if (4 * q + e < i) { const float lv = (i & 1) ? rwB[q][e] : rwA[q][e];
                if (e & 1) asm("v_fma_f32 %0, -%1, %2, %0" : "+v"(sb) : "v"(lv), "v"(t[4 * q + e])); else asm("v_fma_f32 %0, -%1, %2, %0" : "+v"(sa) : "v"(lv), "v"(t[4 * q + e])); }
        t[i] = sa + sb;
        __builtin_amdgcn_sched_barrier(0);
    }
    }
#ifndef RS3T
#define RS3T 1
#endif
    for (int r4_ = 0; r4_ < RS3T; ++r4_) {
    {
        const int R = BWD ? 32 * hb + cc : 63 - 32 * hb - cc, colb = BWD ? 32 * hb : 32 * (1 - hb);
#pragma unroll
        for (int q = 0; q < 4; ++q) { const f32x4 a0 = *(const LAS f32x4*)(S1 + colb + 8 * q), a1 = *(const LAS f32x4*)(S1 + colb + 8 * q + 4), b0 = *(const LAS f32x4*)(S2 + colb + 8 * q), b1 = *(const LAS f32x4*)(S2 + colb + 8 * q + 4);
            const f32x4 v0 = BWD ? (f32x4){t[8 * q], t[8 * q + 1], t[8 * q + 2], t[8 * q + 3]} : (f32x4){t[31 - 8 * q], t[30 - 8 * q], t[29 - 8 * q], t[28 - 8 * q]};
            const f32x4 v1 = BWD ? (f32x4){t[8 * q + 4], t[8 * q + 5], t[8 * q + 6], t[8 * q + 7]} : (f32x4){t[27 - 8 * q], t[26 - 8 * q], t[25 - 8 * q], t[24 - 8 * q]};
            *(LAS bf16x8*)(T1 + R * AD_LDT + (colb + 8 * q) * 2) = pack8(v0 * a0, v1 * a1); *(LAS bf16x8*)(T2 + R * AD_LDT + (colb + 8 * q) * 2) = pack8(v0 * b0, v1 * b1); }
    }
    __builtin_amdgcn_sched_barrier(0);
    if (hb == 0) {
#pragma unroll
        for (int q = 0; q < 4; ++q) *(LAS bf16x8*)(SA + cc * 80 + 16 * q) = pack8((f32x4){t[8 * q], t[8 * q + 1], t[8 * q + 2], t[8 * q + 3]}, (f32x4){t[8 * q + 4], t[8 * q + 5], t[8 * q + 6], t[8 * q + 7]});
    } else {
#pragma unroll
        for (int i = 0; i < 32; i += 2) { const unsigned pk = cvtpk(t[i], t[i + 1]); *(LAS bf16*)(SB + i * 80 + 2 * cc) = (bf16)(pk & 0xffffu); *(LAS bf16*)(SB + (i + 1) * 80 + 2 * cc) = (bf16)(pk >> 16); }
    }
    asm volatile("s_waitcnt lgkmcnt(0)" ::: "memory");
    __builtin_amdgcn_sched_barrier(0);
    bf16x8 tbf[2];
#pragma unroll
    for (int ti = 0; ti < 2; ++ti) tbf[ti] = ld_frag(SA + (16 * ti + r16) * 80 + 16 * g);
    f32x4 P[2][2];
#pragma unroll
    for (int ti = 0; ti < 2; ++ti)
#pragma unroll
        for (int tj = 0; tj < 2; ++tj) P[ti][tj] = MFMA16(la[ti], tbf[tj], ((f32x4){0.f, 0.f, 0.f, 0.f}));
    bf16x8 pbb[2];
#pragma unroll
    for (int tj = 0; tj < 2; ++tj) pbb[tj] = pack8(P[0][tj], P[1][tj]);
#pragma unroll
    for (int tip = 0; tip < 2; ++tip) {
        const u32x2 lo = *(const LAS u32x2*)(SB + (16 * tip + r16) * 80 + 8 * g), hi = *(const LAS u32x2*)(SB + (16 * tip + r16) * 80 + 32 + 8 * g);
        const v4u aw = (v4u){lo.x, lo.y, hi.x, hi.y}; const bf16x8 af = __builtin_bit_cast(bf16x8, aw);
#pragma unroll
        for (int tj = 0; tj < 2; ++tj) { const f32x4 X = MFMA16(af, pbb[tj], ((f32x4){0.f, 0.f, 0.f, 0.f})); const int b = 16 * tj + r16;
            const int Rn = BWD ? b : 63 - b, col0 = BWD ? 32 + 16 * tip + 4 * g : 28 - 16 * tip - 4 * g;
            const f32x4 a0 = *(const LAS f32x4*)(S1 + col0), b0 = *(const LAS f32x4*)(S2 + col0);
            const f32x4 xv = BWD ? (f32x4){-X[0], -X[1], -X[2], -X[3]} : (f32x4){-X[3], -X[2], -X[1], -X[0]};
            u32x2 o1, o2; o1.x = cvtpk(xv[0] * a0[0], xv[1] * a0[1]); o1.y = cvtpk(xv[2] * a0[2], xv[3] * a0[3]); o2.x = cvtpk(xv[0] * b0[0], xv[1] * b0[1]); o2.y = cvtpk(xv[2] * b0[2], xv[3] * b0[3]);
            *(LAS u32x2*)(T1 + Rn * AD_LDT + col0 * 2) = o1; *(LAS u32x2*)(T2 + Rn * AD_LDT + col0 * 2) = o2; }
    }
    }
}

DI void acons_s2(Frame& F, LAS unsigned char* L, LAS unsigned char* B, const LAS float* GV, int item_f, int wv, int lane) {
    int lane_o = lane; asm volatile("" : "+v"(lane_o));
    const int r16 = lane_o & 15, g = lane_o >> 4, item_b = item_f + 32;
    f32x4 accG[4], accQ[4];
#pragma unroll
    for (int tn = 0; tn < 4; ++tn) { accG[tn] = (f32x4){0.f, 0.f, 0.f, 0.f}; accQ[tn] = (f32x4){0.f, 0.f, 0.f, 0.f}; }
    const LAS unsigned char* Ab = B + AB_KH + (16 * wv + r16) * AB_LD + g * 16;
    const LAS unsigned char* Kb = B + AB_KH + r16 * AB_LD + g * 16;
    const LAS unsigned char* Qb = B + AB_QH + r16 * AB_LD + g * 16;
#pragma unroll
    for (int ks = 0; ks < 4; ++ks) { const bf16x8 a = ld_frag(Ab + ks * 64);
#pragma unroll
        for (int tn = 0; tn < 4; ++tn) { accG[tn] = MFMA16(a, ld_frag(Kb + tn * 16 * AB_LD + ks * 64), accG[tn]); accQ[tn] = MFMA16(a, ld_frag(Qb + tn * 16 * AB_LD + ks * 64), accQ[tn]); }
        __builtin_amdgcn_sched_barrier(0); }
    LAS float* LF = (LAS float*)(L + AD_F); LAS float* LB = (LAS float*)(L + AD_B);
#pragma unroll
    for (int tn = 0; tn < 4; ++tn) {
        const int j = 16 * tn + r16; const float gcfj = GV[j], gcbj = GV[64 + j];
#pragma unroll
        for (int reg = 0; reg < 4; ++reg) { const int i = 16 * wv + 4 * g + reg; const float G = accG[tn][reg];
            if (j < i) LF[(63 - j) * AD_LDL + (63 - i)] = GV[128 + i] * G * __expf(fminf(GV[i] - gcfj, 0.f));
            else if (j > i) LB[j * AD_LDL + i] = GV[192 + i] * G * __expf(fminf(GV[64 + i] - gcbj, 0.f)); } }
#pragma unroll
    for (int tn = 0; tn < 4; ++tn) {
        const int i = 16 * tn + r16; const float gcfi = GV[i], gcbi = GV[64 + i]; float qf[4], qb[4];
#pragma unroll
        for (int reg = 0; reg < 4; ++reg) { const int j = 16 * wv + 4 * g + reg; const float v = accQ[tn][reg];
            qf[reg] = (j <= i) ? v * __expf(fminf(gcfi - GV[j], 0.f)) : 0.f;
            qb[reg] = (j >= i) ? v * __expf(fminf(gcbi - GV[64 + j], 0.f)) : 0.f; }
        const int idx = 32 * (wv >> 1) + 8 * g + 4 * (wv & 1);
        u32x2 vf, vb; vf.x = cvtpk(qf[0], qf[1]); vf.y = cvtpk(qf[2], qf[3]); vb.x = cvtpk(qb[0], qb[1]); vb.y = cvtpk(qb[2], qb[3]);
        *(u32x2*)(F.QKM + ((size_t)item_f * 64 + i) * 64 + idx) = vf; *(u32x2*)(F.QKM + ((size_t)item_b * 64 + i) * 64 + idx) = vb; }
}
DI void acons_kdect(Frame& F, LAS unsigned char* B, const LAS float* GV, int item, int dirb, int lane) {
    int lane_o = lane; asm volatile("" : "+v"(lane_o));
    const int i16 = lane_o & 15, gg = lane_o >> 4, q4 = i16 >> 2, p4 = i16 & 3;
    const LAS float* KD = GV + (dirb ? 448 : 384);
#pragma unroll
    for (int s = 0; s < 2; ++s) { const f32x4 k0 = *(const LAS f32x4*)(KD + 32 * s + 4 * gg), k1 = *(const LAS f32x4*)(KD + 32 * s + 16 + 4 * gg);
#pragma unroll
        for (int dt = 0; dt < 8; ++dt) { const LAS unsigned char* ap = B + AB_KH + (32 * s + 4 * gg + q4) * AB_LD + (16 * dt + 4 * p4) * 2;
            const s16x4 lo = vtr(ap), hi = vtr(ap + 16 * AB_LD);
            const f32x4 a = (f32x4){bflo((unsigned)(unsigned short)lo[0]), bflo((unsigned)(unsigned short)lo[1]), bflo((unsigned)(unsigned short)lo[2]), bflo((unsigned)(unsigned short)lo[3])} * k0;
            const f32x4 c = (f32x4){bflo((unsigned)(unsigned short)hi[0]), bflo((unsigned)(unsigned short)hi[1]), bflo((unsigned)(unsigned short)hi[2]), bflo((unsigned)(unsigned short)hi[3])} * k1;
            v4u o; o.x = cvtpk(a[0], a[1]); o.y = cvtpk(a[2], a[3]); o.z = cvtpk(c[0], c[1]); o.w = cvtpk(c[2], c[3]);
            *(v4u*)(F.KDECT + ((size_t)item * 128 + 16 * dt + i16) * 64 + 32 * s + 8 * gg) = o; __builtin_amdgcn_sched_barrier(0); } }
}
DI void acons_s4(Frame& F, LAS unsigned char* L, LAS unsigned char* B, int item_f, int wv, int lane) {
    int lane_o = lane; asm volatile("" : "+v"(lane_o));
    const int dir = wv >> 1, tip = wv & 1, r16 = lane_o & 15, g = lane_o >> 4, q4 = r16 >> 2, p4 = r16 & 3;
    const int tiA = tip ? 1 : 0, tiB = tip ? 2 : 3;
    const LAS unsigned char* T1 = L + (dir ? AD_B : AD_F); const LAS unsigned char* T2 = T1 + AD_T2;
    const int item = item_f + 32 * dir;
    bf16x8 a1A[2], a1B[2], a2A[2], a2B[2];
#pragma unroll
    for (int ks = 0; ks < 2; ++ks) { a1A[ks] = ld_frag(T1 + (16 * tiA + r16) * AD_LDT + ks * 64 + g * 16); a1B[ks] = ld_frag(T1 + (16 * tiB + r16) * AD_LDT + ks * 64 + g * 16);
        a2A[ks] = ld_frag(T2 + (16 * tiA + r16) * AD_LDT + ks * 64 + g * 16); a2B[ks] = ld_frag(T2 + (16 * tiB + r16) * AD_LDT + ks * 64 + g * 16); }
    const bool A0 = true, A1 = (dir == 1), B0 = (dir == 0), B1 = true;
#pragma unroll
    for (int te = 0; te < 8; ++te) { f32x4 accA = (f32x4){0.f, 0.f, 0.f, 0.f}, accB = (f32x4){0.f, 0.f, 0.f, 0.f};
        const bf16x8 v0 = tr_frag(B + AB_VV + ((8 * g + q4) * 136 + 16 * te + 4 * p4) * 2, 4 * AB_LD), v1 = tr_frag(B + AB_VV + ((32 + 8 * g + q4) * 136 + 16 * te + 4 * p4) * 2, 4 * AB_LD);
        if (A0) accA = MFMA16(a1A[0], v0, accA); if (A1) accA = MFMA16(a1A[1], v1, accA);
        if (B0) accB = MFMA16(a1B[0], v0, accB); if (B1) accB = MFMA16(a1B[1], v1, accB);
        u32x2 o; o.x = cvtpk(accA[0], accA[1]); o.y = cvtpk(accA[2], accA[3]);
        *(u32x2*)(F.UT + ((size_t)item * 128 + 16 * te + r16) * 64 + 16 * tiA + 4 * g) = o;
        o.x = cvtpk(accB[0], accB[1]); o.y = cvtpk(accB[2], accB[3]);
        *(u32x2*)(F.UT + ((size_t)item * 128 + 16 * te + r16) * 64 + 16 * tiB + 4 * g) = o; __builtin_amdgcn_sched_barrier(0); }
#pragma unroll
    for (int td = 0; td < 8; ++td) { f32x4 accA = (f32x4){0.f, 0.f, 0.f, 0.f}, accB = (f32x4){0.f, 0.f, 0.f, 0.f};
        const bf16x8 k0 = tr_frag(B + AB_KH + ((8 * g + q4) * 136 + 16 * td + 4 * p4) * 2, 4 * AB_LD), k1 = tr_frag(B + AB_KH + ((32 + 8 * g + q4) * 136 + 16 * td + 4 * p4) * 2, 4 * AB_LD);
        if (A0) accA = MFMA16(k0, a2A[0], accA); if (A1) accA = MFMA16(k1, a2A[1], accA);
        if (B0) accB = MFMA16(k0, a2B[0], accB); if (B1) accB = MFMA16(k1, a2B[1], accB);
        const int idx = 32 * (td >> 1) + 8 * g + 4 * (td & 1);
        u32x2 o; o.x = cvtpk(-accA[0], -accA[1]); o.y = cvtpk(-accA[2], -accA[3]);
        *(u32x2*)(F.WNEG + ((size_t)item * 64 + 16 * tiA + r16) * 128 + idx) = o;
        o.x = cvtpk(-accB[0], -accB[1]); o.y = cvtpk(-accB[2], -accB[3]);
        *(u32x2*)(F.WNEG + ((size_t)item * 64 + 16 * tiB + r16) * 128 + idx) = o; __builtin_amdgcn_sched_barrier(0); }
}
DI void aprod_s0(Frame& F, LAS float* GV, const LAS float* RAW, int item_f, int h, int lane) {
    const float ga[4] = {RAW[lane], RAW[64 + lane], RAW[128 + lane], RAW[192 + lane]};
    const float xf_ = ga[0] + F.dt_f[h], xb_ = ga[1] + F.dt_b[h];
    const float gf = -__expf(F.a_log_f[h]) * (xf_ > 15.f ? xf_ : __logf(1.0f + __expf(xf_)));
    const float gb = -__expf(F.a_log_b[h]) * (xb_ > 15.f ? xb_ : __logf(1.0f + __expf(xb_)));
    float pf = gf, pb = gb;
#pragma unroll
    for (int o = 1; o < 64; o <<= 1) { const float tf = __shfl_up(pf, o), tb = __shfl_up(pb, o); if (lane >= o) { pf += tf; pb += tb; } }
    const float totf = __shfl(pf, 63), totb = __shfl(pb, 63);
    const float gcf = pf, gcb = totb - pb + gb;
    const float btf_ = __builtin_amdgcn_rcpf(1.0f + __expf(-ga[2])), btb_ = __builtin_amdgcn_rcpf(1.0f + __expf(-ga[3])), egf_ = __expf(gcf), egb_ = __expf(gcb);
    GV[lane] = gcf; GV[64 + lane] = gcb; GV[128 + lane] = btf_; GV[192 + lane] = btb_;
    GV[256 + lane] = egf_; GV[320 + lane] = egb_; GV[384 + lane] = __expf(totf - gcf); GV[448 + lane] = __expf(totb - gcb); GV[512 + lane] = btf_ * egf_; GV[576 + lane] = btb_ * egb_;
    if (lane == 0) { F.CD[item_f] = __expf(totf); F.CD[item_f + 32] = __expf(totb); }
}
DI void aprod_load(Frame& F, v4u (&x)[8], int b, int c, int h, int part, int p0, int c16) {
#pragma unroll
    for (int r = 0; r < 8; ++r) { const int t = c * 64 + p0 - 2 + r; v4u v = (v4u){0u, 0u, 0u, 0u};
        if (t >= 0 && t < SEQ) v = *(const v4u*)(F.PA + ((size_t)b * SEQ + t) * 3072 + part * 1024 + h * 128 + 8 * c16);
        x[r] = v; }
}
DI void aprod_conv(Frame& F, const v4u (&x)[8], float (&o)[4][8], int h, int part, int c16) {
#pragma unroll
    for (int j = 0; j < 4; ++j)
#pragma unroll
        for (int e = 0; e < 8; ++e) o[j][e] = 0.f;
#pragma unroll
    for (int k = 0; k < 5; ++k) { const float* wp = F.conv_w + k * 3072 + part * 1024 + h * 128 + 8 * c16; const f32x4 w0 = *(const f32x4*)wp, w1 = *(const f32x4*)(wp + 4);
#pragma unroll
        for (int j = 0; j < 4; ++j) { const v4u xr = x[j + k];
            o[j][0] += bflo(xr.x) * w0[0]; o[j][1] += bfhi(xr.x) * w0[1]; o[j][2] += bflo(xr.y) * w0[2]; o[j][3] += bfhi(xr.y) * w0[3];
            o[j][4] += bflo(xr.z) * w1[0]; o[j][5] += bfhi(xr.z) * w1[1]; o[j][6] += bflo(xr.w) * w1[2]; o[j][7] += bfhi(xr.w) * w1[3]; } }
#pragma unroll
    for (int j = 0; j < 4; ++j)
#pragma unroll
        for (int e = 0; e < 8; ++e) o[j][e] = silu_f(o[j][e]);
}
DI void aprod_store_rows(LAS unsigned char* img, const float (&o)[4][8], const float (&sc)[4], int p0, int c16) {
#pragma unroll
    for (int j = 0; j < 4; ++j) { v4u w; w.x = cvtpk(o[j][0] * sc[j], o[j][1] * sc[j]); w.y = cvtpk(o[j][2] * sc[j], o[j][3] * sc[j]); w.z = cvtpk(o[j][4] * sc[j], o[j][5] * sc[j]); w.w = cvtpk(o[j][6] * sc[j], o[j][7] * sc[j]);
        *(LAS v4u*)(img + (p0 + j) * AB_LD + c16 * 16) = w; }
}

#ifndef RCK
#define RCK 1
#endif
#ifndef RC2
#define RC2 1
#endif
#ifndef RC3
#define RC3 1
#endif
#ifndef RC4
#define RC4 1
#endif
#ifndef RP1
#define RP1 1
#endif
#ifndef RP2
#define RP2 1
#endif
#ifndef RP3
#define RP3 1
#endif
DI void a_prep_phase(Frame& F) {
    const int lane = F.lane, wave = F.wave;
    LAS unsigned char* L = F.lds + RING_OFF;
    const int nit = (F.vcu < 2048) ? (2048 - F.vcu + F.G - 1) / F.G : 0;
    if (wave < 4) {
#pragma unroll 1
        for (int k = -1; k < nit; ++k) {
            LAS unsigned char* Bc = L + (k & 1) * AB_BUF;
            const LAS float* GVc = (const LAS float*)(L + AG_0 + (k & 1) * AG_SZ);
            const int itc = F.vcu + k * F.G;
            const int item_c = (((itc >> 8) * 8 + (itc & 7)) * 2) * 32 + ((itc >> 3) & 31);
            const bool cons = (k >= 0);
            if (cons) for (int r_ = 0; r_ < RC2; ++r_) acons_s2(F, L, Bc, GVc, item_c, wave, lane);
            LBAR();
            if (cons) for (int r_ = 0; r_ < RC3; ++r_) { if (wave == 0) s3_solve<false>(L, Bc + AB_QH, GVc, lane); else if (wave == 1) s3_solve<true>(L, Bc + AB_QH, GVc, lane); else for (int r2_ = 0; r2_ < RCK; ++r2_) acons_kdect(F, Bc, GVc, item_c + 32 * (wave - 2), wave - 2, lane); }
            LBAR();
            if (cons) for (int r_ = 0; r_ < RC4; ++r_) acons_s4(F, L, Bc, item_c, wave, lane);
            LBAR();
        }
    } else {
        const int pw = wave - 4;
        LAS float* RAW = (LAS float*)(L + AG_RAW);
        v4u xq[8], xk[8], xv[8];
        { const int c16 = lane & 15, p0 = 16 * pw + 4 * (lane >> 4);
          if (nit > 0) { const int it = F.vcu; aprod_load(F, xk, it >> 8, (it >> 3) & 31, it & 7, 1, p0, c16); }
          if (wave == 4 && nit > 0) { const int it = F.vcu; const int b = it >> 8, c = (it >> 3) & 31, h = it & 7; const float* gr = F.GATES + ((size_t)b * SEQ + c * 64 + lane) * 32; RAW[lane] = gr[h]; RAW[64 + lane] = gr[8 + h]; RAW[128 + lane] = gr[16 + h]; RAW[192 + lane] = gr[24 + h]; } }
#pragma unroll 1
        for (int k = -1; k < nit; ++k) {
            LAS unsigned char* Bn = L + ((k + 1) & 1) * AB_BUF;
            LAS float* GVn = (LAS float*)(L + AG_0 + ((k + 1) & 1) * AG_SZ);
            const int itn = F.vcu + (k + 1) * F.G;
            const int bn = itn >> 8, cn = (itn >> 3) & 31, hn = itn & 7; const int item_n = ((bn * 8 + hn) * 2) * 32 + cn;
            const bool prod = (k + 1 < nit);
            int lo_ = lane; asm volatile("" : "+v"(lo_));
            const int gI = lo_ >> 4, c16 = lo_ & 15, p0 = 16 * pw + 4 * gI;
            if (prod) {
                if (wave == 4) aprod_s0(F, GVn, RAW, item_n, hn, lane);
                aprod_load(F, xq, bn, cn, hn, 0, p0, c16);
                for (int r_ = 0; r_ < RP1; ++r_) {
                float o[4][8]; aprod_conv(F, xk, o, hn, 1, c16);
                float sc[4];
#pragma unroll
                for (int j = 0; j < 4; ++j) { float ss = 0.f;
#pragma unroll
                    for (int e = 0; e < 8; ++e) ss += o[j][e] * o[j][e];
                    sc[j] = 1.0f / sqrtf(row16_sum(ss) + EPS); }
                aprod_store_rows(Bn + AB_KH, o, sc, p0, c16); }
            }
            LBAR();
            if (prod) {
                aprod_load(F, xv, bn, cn, hn, 2, p0, c16);
                float o[4][8]; float sc[4];
                for (int r_ = 0; r_ < RP2; ++r_) {
                aprod_conv(F, xq, o, hn, 0, c16);
#pragma unroll
                for (int j = 0; j < 4; ++j) { float ss = 0.f;
#pragma unroll
                    for (int e = 0; e < 8; ++e) ss += o[j][e] * o[j][e];
                    sc[j] = (1.0f / sqrtf(row16_sum(ss) + EPS)) * 0.08838834764831845f; }
                aprod_store_rows(Bn + AB_QH, o, sc, p0, c16); }
#ifndef RPQ
#define RPQ 1
#endif
                for (int r_ = 0; r_ < RPQ; ++r_) {
                const int idA = 32 * (c16 >> 2) + 8 * ((2 * c16) & 3) + 4 * ((c16 >> 1) & 1);
#pragma unroll
                for (int j = 0; j < 4; ++j) { const int pos = p0 + j; const float ef = GVn[256 + pos] * sc[j], eb = GVn[320 + pos] * sc[j];
                    u32x2 a, c2; a.x = cvtpk(o[j][0] * ef, o[j][1] * ef); a.y = cvtpk(o[j][2] * ef, o[j][3] * ef); c2.x = cvtpk(o[j][4] * ef, o[j][5] * ef); c2.y = cvtpk(o[j][6] * ef, o[j][7] * ef);
                    bf16* qp = F.QDEC + ((size_t)item_n * 64 + pos) * 128 + idA; *(u32x2*)qp = a; *(u32x2*)(qp + 8) = c2;
                    a.x = cvtpk(o[j][0] * eb, o[j][1] * eb); a.y = cvtpk(o[j][2] * eb, o[j][3] * eb); c2.x = cvtpk(o[j][4] * eb, o[j][5] * eb); c2.y = cvtpk(o[j][6] * eb, o[j][7] * eb);
                    qp += (size_t)32 * 64 * 128; *(u32x2*)qp = a; *(u32x2*)(qp + 8) = c2; } }
            }
            LBAR();
            {
                float g4[4] = {0.f, 0.f, 0.f, 0.f}; const bool more = (k + 2 < nit);
                if (more) { const int it2 = itn + F.G; const int b2 = it2 >> 8, c2 = (it2 >> 3) & 31, h2 = it2 & 7; aprod_load(F, xk, b2, c2, h2, 1, p0, c16);
                    if (wave == 4) { const float* gr = F.GATES + ((size_t)b2 * SEQ + c2 * 64 + lane) * 32; g4[0] = gr[h2]; g4[1] = gr[8 + h2]; g4[2] = gr[16 + h2]; g4[3] = gr[24 + h2]; } }
                if (prod) for (int r_ = 0; r_ < RP3; ++r_) { float o[4][8]; aprod_conv(F, xv, o, hn, 2, c16);
                    const float sc[4] = {1.f, 1.f, 1.f, 1.f};
                    aprod_store_rows(Bn + AB_VV, o, sc, p0, c16); }
                if (more && wave == 4) { RAW[lane] = g4[0]; RAW[64 + lane] = g4[1]; RAW[128 + lane] = g4[2]; RAW[192 + lane] = g4[3]; }
            }
            LBAR();
        }
    }
}

constexpr int B_KB = 0, B_VB = 55296;
DI void b_attn_unit(Frame& F, int b, int nb, int kvh, bf16* MO) {
    const int tid = F.tid, lane = F.lane, wave = F.wave;
    LAS unsigned char* L = F.lds + RING_OFF;
#pragma unroll
    for (int it = 0; it < 6; ++it) { const int q = tid + 512 * it, row = q >> 3, cc = q & 7; const int t = (nb - 1) * 128 + row; const bool valid = (t >= 0) && (t < SEQ);
        v4u kv = (v4u){0u, 0u, 0u, 0u}, vv = (v4u){0u, 0u, 0u, 0u};
        if (valid) { const bf16* rp = F.PB + ((size_t)b * SEQ + t) * 768 + 512 + kvh * 64 + 8 * cc; kv = *(const v4u*)rp; vv = *(const v4u*)(rp + 128); }
        float xk[8]; xk[0] = bflo(kv.x); xk[1] = bfhi(kv.x); xk[2] = bflo(kv.y); xk[3] = bfhi(kv.y); xk[4] = bflo(kv.z); xk[5] = bfhi(kv.z); xk[6] = bflo(kv.w); xk[7] = bfhi(kv.w);
        float ss = 0.f;
#pragma unroll
        for (int e = 0; e < 8; ++e) ss += xk[e] * xk[e];
        ss += __shfl_xor(ss, 1); ss += __shfl_xor(ss, 2); ss += __shfl_xor(ss, 4);
        const float rstd = 1.0f / sqrtf(ss * (1.0f / 64.0f) + EPS);
        const int tt = valid ? t : 0; float o[8];
#pragma unroll
        for (int e = 0; e < 8; ++e) { const float y = xk[e] * rstd * F.k_norm_b[8 * cc + e]; const float pr = __shfl_xor(y, 4);
            const f32x2v cs = *(const f32x2v*)(F.ROPE + ((size_t)tt * 32 + ((8 * cc + e) & 31)) * 2);
            o[e] = (cc < 4) ? (y * cs.x - pr * cs.y) : (y * cs.x + pr * cs.y); }
        v4u ok; ok.x = cvtpk(o[0], o[1]); ok.y = cvtpk(o[2], o[3]); ok.z = cvtpk(o[4], o[5]); ok.w = cvtpk(o[6], o[7]);
        if (!valid) ok = (v4u){0u, 0u, 0u, 0u};
        *(LAS v4u*)(L + B_KB + row * 144 + cc * 16) = ok; *(LAS v4u*)(L + B_VB + row * 144 + cc * 16) = vv; }
    if (tid < 128) *(LAS v4u*)(L + B_VB + (384 + (tid >> 3)) * 144 + (tid & 7) * 16) = (v4u){0u, 0u, 0u, 0u};
    __syncthreads();
    const int hq = kvh * 4 + (wave >> 1), r16 = lane & 15, g = lane >> 4, q4 = r16 >> 2, p4 = r16 & 3;
    const float sk = F.sink_b[hq] * LOG2E;
#pragma unroll 1
    for (int qt = 0; qt < 4; ++qt) {
        const int i0 = (wave & 1) * 64 + 16 * qt, iq = i0 + r16, pos = nb * 128 + iq; const size_t m = (size_t)b * SEQ + pos;
        bf16x8 qf[2];
        { const bf16* qp = F.PB + m * 768 + hq * 64 + 8 * g; const v4u a = *(const v4u*)qp, c2 = *(const v4u*)(qp + 32);
          float x0[8], x1[8]; x0[0] = bflo(a.x); x0[1] = bfhi(a.x); x0[2] = bflo(a.y); x0[3] = bfhi(a.y); x0[4] = bflo(a.z); x0[5] = bfhi(a.z); x0[6] = bflo(a.w); x0[7] = bfhi(a.w);
          x1[0] = bflo(c2.x); x1[1] = bfhi(c2.x); x1[2] = bflo(c2.y); x1[3] = bfhi(c2.y); x1[4] = bflo(c2.z); x1[5] = bfhi(c2.z); x1[6] = bflo(c2.w); x1[7] = bfhi(c2.w);
          float ss = 0.f;
#pragma unroll
          for (int e = 0; e < 8; ++e) ss += x0[e] * x0[e] + x1[e] * x1[e];
          ss += __shfl_xor(ss, 16); ss += __shfl_xor(ss, 32);
          const float rstd = (1.0f / sqrtf(ss * (1.0f / 64.0f) + EPS));
          float o0[8], o1[8];
#pragma unroll
          for (int e = 0; e < 8; ++e) { const float y0 = x0[e] * rstd * F.q_norm_b[8 * g + e], y1 = x1[e] * rstd * F.q_norm_b[32 + 8 * g + e];
              const f32x2v cs = *(const f32x2v*)(F.ROPE + ((size_t)pos * 32 + 8 * g + e) * 2);
              o0[e] = (y0 * cs.x - y1 * cs.y) * (0.125f * LOG2E); o1[e] = (y1 * cs.x + y0 * cs.y) * (0.125f * LOG2E); }
          v4u w0, w1; w0.x = cvtpk(o0[0], o0[1]); w0.y = cvtpk(o0[2], o0[3]); w0.z = cvtpk(o0[4], o0[5]); w0.w = cvtpk(o0[6], o0[7]);
          w1.x = cvtpk(o1[0], o1[1]); w1.y = cvtpk(o1[2], o1[3]); w1.z = cvtpk(o1[4], o1[5]); w1.w = cvtpk(o1[6], o1[7]);
          qf[0] = __builtin_bit_cast(bf16x8, w0); qf[1] = __builtin_bit_cast(bf16x8, w1); }
        f32x4 st[18];
#pragma unroll
        for (int c = 0; c < 17; ++c) { f32x4 acc = (f32x4){0.f, 0.f, 0.f, 0.f};
#pragma unroll
            for (int s = 0; s < 2; ++s) acc = MFMA16(ld_frag(L + B_KB + (i0 + 16 * c + r16) * 144 + s * 64 + g * 16), qf[s], acc);
            st[c] = acc; __builtin_amdgcn_sched_barrier(0); }
        st[17] = (f32x4){0.f, 0.f, 0.f, 0.f};
        float mx = sk;
#pragma unroll
        for (int c = 0; c < 17; ++c)
#pragma unroll
            for (int reg = 0; reg < 4; ++reg) { const int j = i0 + 16 * c + 4 * g + reg; const int kpos = (nb - 1) * 128 + j;
                const bool ok = (j >= iq) && (j <= iq + 256) && (kpos >= 0) && (kpos < SEQ);
                const float v = ok ? st[c][reg] : -INFINITY; st[c][reg] = v; mx = fmaxf(mx, v); }
        mx = fmaxf(mx, __shfl_xor(mx, 16)); mx = fmaxf(mx, __shfl_xor(mx, 32));
        float sum = 0.f;
#pragma unroll
        for (int c = 0; c < 17; ++c)
#pragma unroll
            for (int reg = 0; reg < 4; ++reg) { const float p = __builtin_amdgcn_exp2f(st[c][reg] - mx); st[c][reg] = p; sum += p; }
        sum += __shfl_xor(sum, 16); sum += __shfl_xor(sum, 32);
        const float inv = 1.0f / (sum + __builtin_amdgcn_exp2f(sk - mx));
        bf16x8 pb[9];
#pragma unroll
        for (int kp = 0; kp < 9; ++kp) pb[kp] = pack8(st[2 * kp], st[2 * kp + 1]);
#pragma unroll
        for (int td = 0; td < 4; ++td) { f32x4 acc = (f32x4){0.f, 0.f, 0.f, 0.f};
#pragma unroll
            for (int kp = 0; kp < 9; ++kp) acc = MFMA16(tr_frag(L + B_VB + ((i0 + 32 * kp + 4 * g + q4) * 72 + 16 * td + 4 * p4) * 2, 16 * 144), pb[kp], acc);
            const size_t mo = m * 2048 + 1024 + hq * 64 + 16 * td + 4 * g; const u32x2 z = *(const u32x2*)(F.MIX + mo); bf16* mp = MO + mo;
            u32x2 o; o.x = cvtpk(acc[0] * inv * bflo(z.x), acc[1] * inv * bfhi(z.x)); o.y = cvtpk(acc[2] * inv * bflo(z.y), acc[3] * inv * bfhi(z.y));
            *(u32x2*)mp = o; __builtin_amdgcn_sched_barrier(0); }
    }
    __syncthreads();
}

constexpr int C_KC = 0, C_VC = 69632;
DI void c_attn_unit(Frame& F, int b, int hc, int qblk, bf16* MO) {
    const int tid = F.tid, lane = F.lane, wave = F.wave;
    LAS unsigned char* L = F.lds + RING_OFF;
#pragma unroll
    for (int it = 0; it < 8; ++it) { const int q = tid + 512 * it, row = q >> 4, cc = q & 15;
        const bf16* rp = F.KVM + ((size_t)b * MEMLEN + row) * 1024 + hc * 128 + 8 * cc; const v4u kv = *(const v4u*)rp, vv = *(const v4u*)(rp + 512);
        float xk[8]; xk[0] = bflo(kv.x); xk[1] = bfhi(kv.x); xk[2] = bflo(kv.y); xk[3] = bfhi(kv.y); xk[4] = bflo(kv.z); xk[5] = bfhi(kv.z); xk[6] = bflo(kv.w); xk[7] = bfhi(kv.w);
        float ss = 0.f;
#pragma unroll
        for (int e = 0; e < 8; ++e) ss += xk[e] * xk[e];
        ss += __shfl_xor(ss, 1); ss += __shfl_xor(ss, 2); ss += __shfl_xor(ss, 4); ss += __shfl_xor(ss, 8);
        const float rstd = 1.0f / sqrtf(ss * (1.0f / 128.0f) + EPS);
        float o[8];
#pragma unroll
        for (int e = 0; e < 8; ++e) o[e] = xk[e] * rstd * F.k_norm_c[8 * cc + e];
        v4u ok; ok.x = cvtpk(o[0], o[1]); ok.y = cvtpk(o[2], o[3]); ok.z = cvtpk(o[4], o[5]); ok.w = cvtpk(o[6], o[7]);
        *(LAS v4u*)(L + C_KC + row * 272 + cc * 16) = ok; *(LAS v4u*)(L + C_VC + row * 272 + cc * 16) = vv; }
    __syncthreads();
    const int r16 = lane & 15, g = lane >> 4, q4 = r16 >> 2, p4 = r16 & 3;
#pragma unroll 1
    for (int qt = 0; qt < 2; ++qt) {
        const size_t m = (size_t)b * SEQ + qblk * 256 + wave * 32 + qt * 16 + r16;
        bf16x8 qf[4];
        { float xs[4][8]; float ss = 0.f;
#pragma unroll
          for (int s = 0; s < 4; ++s) { const v4u a = *(const v4u*)(F.PC + m * 512 + hc * 128 + 32 * s + 8 * g);
              xs[s][0] = bflo(a.x); xs[s][1] = bfhi(a.x); xs[s][2] = bflo(a.y); xs[s][3] = bfhi(a.y); xs[s][4] = bflo(a.z); xs[s][5] = bfhi(a.z); xs[s][6] = bflo(a.w); xs[s][7] = bfhi(a.w);
#pragma unroll
              for (int e = 0; e < 8; ++e) ss += xs[s][e] * xs[s][e]; }
          ss += __shfl_xor(ss, 16); ss += __shfl_xor(ss, 32);
          const float rstd = (1.0f / sqrtf(ss * (1.0f / 128.0f) + EPS)) * (0.08838834764831845f * LOG2E);
#pragma unroll
          for (int s = 0; s < 4; ++s) { float o[8];
#pragma unroll
              for (int e = 0; e < 8; ++e) o[e] = xs[s][e] * rstd * F.q_norm_c[32 * s + 8 * g + e];
              v4u w0; w0.x = cvtpk(o[0], o[1]); w0.y = cvtpk(o[2], o[3]); w0.z = cvtpk(o[4], o[5]); w0.w = cvtpk(o[6], o[7]); qf[s] = __builtin_bit_cast(bf16x8, w0); } }
        f32x4 st[16];
#pragma unroll
        for (int c = 0; c < 16; ++c) { f32x4 acc = (f32x4){0.f, 0.f, 0.f, 0.f};
#pragma unroll
            for (int s = 0; s < 4; ++s) acc = MFMA16(ld_frag(L + C_KC + (16 * c + r16) * 272 + s * 64 + g * 16), qf[s], acc);
            st[c] = acc; __builtin_amdgcn_sched_barrier(0); }
        float mx = -INFINITY;
#pragma unroll
        for (int c = 0; c < 16; ++c)
#pragma unroll
            for (int reg = 0; reg < 4; ++reg) mx = fmaxf(mx, st[c][reg]);
        mx = fmaxf(mx, __shfl_xor(mx, 16)); mx = fmaxf(mx, __shfl_xor(mx, 32));
        float sum = 0.f;
#pragma unroll
        for (int c = 0; c < 16; ++c)
#pragma unroll
            for (int reg = 0; reg < 4; ++reg) { const float p = __builtin_amdgcn_exp2f(st[c][reg] - mx); st[c][reg] = p; sum += p; }
        sum += __shfl_xor(sum, 16); sum += __shfl_xor(sum, 32);
        const float inv = 1.0f / sum;
        bf16x8 pb[8];
#pragma unroll
        for (int kp = 0; kp < 8; ++kp) pb[kp] = pack8(st[2 * kp], st[2 * kp + 1]);
#pragma unroll
        for (int td = 0; td < 8; ++td) { f32x4 acc = (f32x4){0.f, 0.f, 0.f, 0.f};
#pragma unroll
            for (int kp = 0; kp < 8; ++kp) acc = MFMA16(tr_frag(L + C_VC + ((32 * kp + 4 * g + q4) * 136 + 16 * td + 4 * p4) * 2, 16 * 272), pb[kp], acc);
            const size_t mo = m * 2048 + 1536 + hc * 128 + 16 * td + 4 * g; const u32x2 z = *(const u32x2*)(F.MIX + mo); bf16* mp = MO + mo;
            u32x2 o; o.x = cvtpk(acc[0] * inv * bflo(z.x), acc[1] * inv * bfhi(z.x)); o.y = cvtpk(acc[2] * inv * bflo(z.y), acc[3] * inv * bfhi(z.y));
            *(u32x2*)mp = o; __builtin_amdgcn_sched_barrier(0); }
    }
    __syncthreads();
}

constexpr int S_WN = 0, S_QD = 18432, S_KT = 36864, S_QK = 55296, S_BUF = 64512;
constexpr int S_OST = 2 * S_BUF, S_OLD = 272;
static_assert(S_OST + 64 * S_OLD <= RING_BYTES, "scan LDS");
DI void scan_unit(LAS unsigned char* lds_, int tid, const bf16* WNEG_, const bf16* QDEC_, const bf16* KDECT_, const bf16* QKM_, const bf16* UT_, const float* CD_, bf16* OF_, bf16* OB_, bf16* DUMP_, int bh, int dir) {
    const int lane = tid & 63, wave = __builtin_amdgcn_readfirstlane(tid >> 6);
    LAS unsigned char* L = lds_ + RING_OFF;
    const int b = bh >> 3, h = bh & 7;
    const int item0 = (bh * 2 + dir) * 32;
    const int r16 = lane & 15, g = lane >> 4;
    const int lt = tid - 256;
    const int e0 = wave * 32 + r16;
    if (wave >= 4) {
    v4u ldA[14], ldB[14];
#define SC_LOAD(ld, n_) do { const size_t it_ = (size_t)(item0 + (n_)); \
        _Pragma("unroll") for (int i_ = 0; i_ < 4; ++i_) { const int q_ = lt + 256 * i_; ld[i_] = *(const v4u*)(WNEG_ + it_ * 8192 + (size_t)q_ * 8); ld[4 + i_] = *(const v4u*)(QDEC_ + it_ * 8192 + (size_t)q_ * 8); ld[8 + i_] = *(const v4u*)(KDECT_ + it_ * 8192 + (size_t)q_ * 8); } \
        _Pragma("unroll") for (int i_ = 0; i_ < 2; ++i_) { const int q_ = lt + 256 * i_; ld[12 + i_] = *(const v4u*)(QKM_ + it_ * 4096 + (size_t)q_ * 8); } } while (0)
#define SC_WRITE(ld, bufo_) do { LAS unsigned char* B_ = L + (bufo_); \
        _Pragma("unroll") for (int i_ = 0; i_ < 4; ++i_) { const int q_ = lt + 256 * i_; *(LAS v4u*)(B_ + S_WN + (q_ >> 4) * 288 + (q_ & 15) * 16) = ld[i_]; *(LAS v4u*)(B_ + S_QD + (q_ >> 4) * 288 + (q_ & 15) * 16) = ld[4 + i_]; *(LAS v4u*)(B_ + S_KT + (q_ >> 3) * 144 + (q_ & 7) * 16) = ld[8 + i_]; } \
        _Pragma("unroll") for (int i_ = 0; i_ < 2; ++i_) { const int q_ = lt + 256 * i_; *(LAS v4u*)(B_ + S_QK + (q_ >> 3) * 144 + (q_ & 7) * 16) = ld[12 + i_]; } } while (0)
#define SC_SHIP(s_) do { const int np_ = dir ? 32 - (s_) : (s_) - 1; bf16* ob_ = ((s_) > 0) ? (dir ? OB_ : OF_) + ((size_t)b * SEQ + (size_t)np_ * 64) * 1024 + h * 128 : DUMP_; \
        _Pragma("unroll") for (int i_ = 0; i_ < 4; ++i_) { const int q_ = lt + 256 * i_, row_ = q_ >> 4, cc_ = q_ & 15; const v4u v_ = *(const LAS v4u*)(L + S_OST + row_ * S_OLD + cc_ * 16); \
            *(v4u*)(ob_ + (size_t)row_ * 1024 + cc_ * 8) = v_; } } while (0)
#define SC_CH(k_) (dir ? 31 - ((k_) < 31 ? (k_) : 31) : ((k_) < 31 ? (k_) : 31))
        SC_LOAD(ldA, SC_CH(0)); SC_WRITE(ldA, 0); SC_LOAD(ldB, SC_CH(1)); SC_SHIP(0); SC_LOAD(ldA, SC_CH(2));
        __syncthreads();
#pragma unroll 1
        for (int s = 0; s < 32; s += 2) {
            SC_SHIP(s);
            SC_WRITE(ldB, S_BUF); SC_LOAD(ldB, SC_CH(s + 3));
            LBAR(); LBAR();
            SC_SHIP(s + 1);
            SC_WRITE(ldA, 0); SC_LOAD(ldA, SC_CH(s + 4));
            LBAR(); LBAR();
        }
        asm volatile("s_waitcnt vmcnt(0)" ::: "memory");
#undef SC_SHIP
#undef SC_CH
    } else {
        f32x4 S[2][8];
#pragma unroll
        for (int c = 0; c < 2; ++c)
#pragma unroll
            for (int td = 0; td < 8; ++td) S[c][td] = (f32x4){0.f, 0.f, 0.f, 0.f};
        u32x2 un[2][4]; float cdn;
        { const int n0 = dir ? 31 : 0;
#pragma unroll
          for (int c = 0; c < 2; ++c) { const bf16* up = UT_ + ((size_t)(item0 + n0) * 128 + e0 + 16 * c) * 64 + 4 * g;
#pragma unroll
              for (int t = 0; t < 4; ++t) un[c][t] = *(const u32x2*)(up + 16 * t); }
          cdn = CD_[item0 + n0]; }
        __syncthreads();
#pragma unroll 1
        for (int s = 0; s < 32; ++s) {
            const LAS unsigned char* Bf = L + (s & 1) * S_BUF;
            const float cd = cdn;
            f32x4 vacc[2][4];
#pragma unroll
            for (int c = 0; c < 2; ++c)
#pragma unroll
                for (int t = 0; t < 4; ++t) { const u32x2 uu = un[c][t]; vacc[c][t] = (f32x4){bflo(uu.x), bfhi(uu.x), bflo(uu.y), bfhi(uu.y)}; }
            if (s + 1 < 32) { const int nn = dir ? 30 - s : s + 1;
#pragma unroll
                for (int c = 0; c < 2; ++c) { const bf16* up = UT_ + ((size_t)(item0 + nn) * 128 + e0 + 16 * c) * 64 + 4 * g;
#pragma unroll
                    for (int t = 0; t < 4; ++t) un[c][t] = *(const u32x2*)(up + 16 * t); }
                cdn = CD_[item0 + nn]; }
            bf16x8 Sb[2][4];
#pragma unroll
            for (int c = 0; c < 2; ++c)
#pragma unroll
                for (int ks = 0; ks < 4; ++ks) Sb[c][ks] = pack8(S[c][2 * ks], S[c][2 * ks + 1]);
            bf16x8 fa[4], fb[4];
#define SC_SB() __builtin_amdgcn_sched_barrier(0)
#define SC_LD4(dst, base_, row_, rstride_) do { dst[0] = ld_frag(Bf + (base_) + ((row_) + r16) * (rstride_) + g * 16); dst[1] = ld_frag(Bf + (base_) + ((row_) + r16) * (rstride_) + 64 + g * 16); \
        dst[2] = ld_frag(Bf + (base_) + ((row_) + r16) * (rstride_) + 128 + g * 16); dst[3] = ld_frag(Bf + (base_) + ((row_) + r16) * (rstride_) + 192 + g * 16); } while (0)
#define SC_MM4(acc_, src, t_) do { acc_[0][t_] = MFMA16(src[0], Sb[0][0], acc_[0][t_]); acc_[1][t_] = MFMA16(src[0], Sb[1][0], acc_[1][t_]); acc_[0][t_] = MFMA16(src[1], Sb[0][1], acc_[0][t_]); acc_[1][t_] = MFMA16(src[1], Sb[1][1], acc_[1][t_]); \
        acc_[0][t_] = MFMA16(src[2], Sb[0][2], acc_[0][t_]); acc_[1][t_] = MFMA16(src[2], Sb[1][2], acc_[1][t_]); acc_[0][t_] = MFMA16(src[3], Sb[0][3], acc_[0][t_]); acc_[1][t_] = MFMA16(src[3], Sb[1][3], acc_[1][t_]); } while (0)
#define SC_MMV(src, t_) SC_MM4(vacc, src, t_)
#define SC_MMO(src, t_) SC_MM4(oacc, src, t_)
#ifndef RSC1
#define RSC1 1
#endif
            f32x4 vsave[2][4];
            if (RSC1 > 1) { _Pragma("unroll") for (int c = 0; c < 2; ++c) _Pragma("unroll") for (int t = 0; t < 4; ++t) vsave[c][t] = vacc[c][t]; }
            for (int r5_ = 0; r5_ < RSC1; ++r5_) {
            if (RSC1 > 1) { _Pragma("unroll") for (int c = 0; c < 2; ++c) _Pragma("unroll") for (int t = 0; t < 4; ++t) vacc[c][t] = vsave[c][t]; }
            SC_LD4(fa, S_WN, 0, 288); SC_SB();
            SC_LD4(fb, S_WN, 16, 288); SC_SB(); SC_MMV(fa, 0); SC_SB();
            SC_LD4(fa, S_WN, 32, 288); SC_SB(); SC_MMV(fb, 1); SC_SB();
            SC_LD4(fb, S_WN, 48, 288); SC_SB(); SC_MMV(fa, 2); SC_SB();
            SC_LD4(fa, S_QD, 0, 288); SC_SB(); SC_MMV(fb, 3); SC_SB(); }
            bf16x8 Vb[2][2];
#pragma unroll
            for (int c = 0; c < 2; ++c)
#pragma unroll
                for (int kp = 0; kp < 2; ++kp) Vb[c][kp] = pack8(vacc[c][2 * kp], vacc[c][2 * kp + 1]);
            f32x4 oacc[2][4];
#pragma unroll
            for (int c = 0; c < 2; ++c)
#pragma unroll
                for (int t = 0; t < 4; ++t) oacc[c][t] = (f32x4){0.f, 0.f, 0.f, 0.f};
            SC_LD4(fb, S_QD, 16, 288); SC_SB(); SC_MMO(fa, 0); SC_SB();
            SC_LD4(fa, S_QD, 32, 288); SC_SB(); SC_MMO(fb, 1); SC_SB();
            SC_LD4(fb, S_QD, 48, 288); SC_SB(); SC_MMO(fa, 2); SC_SB();
#define SC_LDQK(dst, t0_) do { dst[0] = ld_frag(Bf + S_QK + (16 * (t0_) + r16) * 144 + g * 16); dst[1] = ld_frag(Bf + S_QK + (16 * (t0_) + r16) * 144 + 64 + g * 16); \
        dst[2] = ld_frag(Bf + S_QK + (16 * ((t0_) + 1) + r16) * 144 + g * 16); dst[3] = ld_frag(Bf + S_QK + (16 * ((t0_) + 1) + r16) * 144 + 64 + g * 16); } while (0)
#define SC_MMQK1(f0_, f1_, t_) do { oacc[0][t_] = MFMA16(f0_, Vb[0][0], oacc[0][t_]); oacc[1][t_] = MFMA16(f0_, Vb[1][0], oacc[1][t_]); oacc[0][t_] = MFMA16(f1_, Vb[0][1], oacc[0][t_]); oacc[1][t_] = MFMA16(f1_, Vb[1][1], oacc[1][t_]); } while (0)
#define SC_MMQK(src, t0_) do { SC_MMQK1(src[0], src[1], (t0_)); SC_MMQK1(src[2], src[3], (t0_) + 1); } while (0)
            SC_LDQK(fa, 0); SC_SB(); SC_MMO(fb, 3); SC_SB();
            SC_LDQK(fb, 2); SC_SB(); SC_MMQK(fa, 0); SC_SB();
#define SC_LDKT(dst, td0_) do { dst[0] = ld_frag(Bf + S_KT + (16 * (td0_) + r16) * 144 + g * 16); dst[1] = ld_frag(Bf + S_KT + (16 * (td0_) + r16) * 144 + 64 + g * 16); \
        dst[2] = ld_frag(Bf + S_KT + (16 * ((td0_) + 1) + r16) * 144 + g * 16); dst[3] = ld_frag(Bf + S_KT + (16 * ((td0_) + 1) + r16) * 144 + 64 + g * 16); } while (0)
#define SC_MMKT1(f0_, f1_, td_) do { f32x4 a0_ = S[0][td_] * cd, a1_ = S[1][td_] * cd; a0_ = MFMA16(f0_, Vb[0][0], a0_); a1_ = MFMA16(f0_, Vb[1][0], a1_); a0_ = MFMA16(f1_, Vb[0][1], a0_); a1_ = MFMA16(f1_, Vb[1][1], a1_); S[0][td_] = a0_; S[1][td_] = a1_; } while (0)
#define SC_MMKT(src, td0_) do { SC_MMKT1(src[0], src[1], (td0_)); SC_MMKT1(src[2], src[3], (td0_) + 1); } while (0)
            SC_LDKT(fa, 0); SC_SB(); SC_MMQK(fb, 2); SC_SB();
            LBAR();
#pragma unroll
            for (int c = 0; c < 2; ++c)
#pragma unroll
                for (int t = 0; t < 4; ++t) { const unsigned p01 = cvtpk(oacc[c][t][0], oacc[c][t][1]), p23 = cvtpk(oacc[c][t][2], oacc[c][t][3]); LAS unsigned char* op = L + S_OST + (16 * t + 4 * g) * S_OLD + (e0 + 16 * c) * 2;
                    *(LAS bf16*)(op) = (bf16)(p01 & 0xffffu); *(LAS bf16*)(op + S_OLD) = (bf16)(p01 >> 16); *(LAS bf16*)(op + 2 * S_OLD) = (bf16)(p23 & 0xffffu); *(LAS bf16*)(op + 3 * S_OLD) = (bf16)(p23 >> 16); }
            SC_SB();
            SC_LDKT(fb, 2); SC_SB(); SC_MMKT(fa, 0); SC_SB();
            SC_LDKT(fa, 4); SC_SB(); SC_MMKT(fb, 2); SC_SB();
            SC_LDKT(fb, 6); SC_SB(); SC_MMKT(fa, 4); SC_SB();
            SC_MMKT(fb, 6);
#undef SC_SB
#undef SC_LD4
#undef SC_MMV
#undef SC_MM4
#undef SC_MMO
#undef SC_LDQK
#undef SC_MMQK
#undef SC_MMQK1
#undef SC_MMKT1
#undef SC_LDKT
#undef SC_MMKT
            LBAR();
        }
    }
    { const int np = dir ? 0 : 31;
#pragma unroll
      for (int i = 0; i < 2; ++i) { const int q = tid + 512 * i, row = q >> 4, cc = q & 15; const v4u v = *(const LAS v4u*)(L + S_OST + row * S_OLD + cc * 16);
          *(v4u*)((dir ? OB_ : OF_) + ((size_t)b * SEQ + (size_t)np * 64 + row) * 1024 + h * 128 + cc * 8) = v; } }
    __syncthreads();
#undef SC_LOAD
#undef SC_WRITE
}

DI void combine_row(Frame& F, size_t m, bf16* MO) {
    const int lane = F.lane; const size_t off = m * 1024 + 16 * lane;
    const v4u f0 = *(const v4u*)(F.OF + off), f1 = *(const v4u*)(F.OF + off + 8), b0 = *(const v4u*)(F.OB + off), b1 = *(const v4u*)(F.OB + off + 8);
    const bf16* zp = F.MIX + m * 2048 + 16 * lane; const v4u z0 = *(const v4u*)zp, z1 = *(const v4u*)(zp + 8); bf16* mp = MO + m * 2048 + 16 * lane;
    float o[16];
    o[0] = bflo(f0.x) + bflo(b0.x); o[1] = bfhi(f0.x) + bfhi(b0.x); o[2] = bflo(f0.y) + bflo(b0.y); o[3] = bfhi(f0.y) + bfhi(b0.y);
    o[4] = bflo(f0.z) + bflo(b0.z); o[5] = bfhi(f0.z) + bfhi(b0.z); o[6] = bflo(f0.w) + bflo(b0.w); o[7] = bfhi(f0.w) + bfhi(b0.w);
    o[8] = bflo(f1.x) + bflo(b1.x); o[9] = bfhi(f1.x) + bfhi(b1.x); o[10] = bflo(f1.y) + bflo(b1.y); o[11] = bfhi(f1.y) + bfhi(b1.y);
    o[12] = bflo(f1.z) + bflo(b1.z); o[13] = bfhi(f1.z) + bfhi(b1.z); o[14] = bflo(f1.w) + bflo(b1.w); o[15] = bfhi(f1.w) + bfhi(b1.w);
    float ss = 0.f;
#pragma unroll
    for (int e = 0; e < 16; ++e) ss += o[e] * o[e];
    ss += __shfl_xor(ss, 1); ss += __shfl_xor(ss, 2); ss += __shfl_xor(ss, 4);
    const float rstd = 1.0f / sqrtf(ss * (1.0f / 128.0f) + EPS);
    float z[16];
    z[0] = bflo(z0.x); z[1] = bfhi(z0.x); z[2] = bflo(z0.y); z[3] = bfhi(z0.y); z[4] = bflo(z0.z); z[5] = bfhi(z0.z); z[6] = bflo(z0.w); z[7] = bfhi(z0.w);
    z[8] = bflo(z1.x); z[9] = bfhi(z1.x); z[10] = bflo(z1.y); z[11] = bfhi(z1.y); z[12] = bflo(z1.z); z[13] = bfhi(z1.z); z[14] = bflo(z1.w); z[15] = bfhi(z1.w);
    const int c0 = (16 * lane) & 127; float y[16];
#pragma unroll
    for (int e = 0; e < 16; ++e) y[e] = o[e] * rstd * F.o_norm_a[c0 + e] * z[e];
    v4u w0, w1; w0.x = cvtpk(y[0], y[1]); w0.y = cvtpk(y[2], y[3]); w0.z = cvtpk(y[4], y[5]); w0.w = cvtpk(y[6], y[7]);
    w1.x = cvtpk(y[8], y[9]); w1.y = cvtpk(y[10], y[11]); w1.z = cvtpk(y[12], y[13]); w1.w = cvtpk(y[14], y[15]);
    *(v4u*)mp = w0; *(v4u*)(mp + 8) = w1;
}

struct Args { const float* in[18]; float* out; unsigned char* ws; int ph_lo, ph_hi, li, pad; };
__global__ void __launch_bounds__(NWAVES * 64, 2) hybrid_fwd(Args args) {
    extern __shared__ __attribute__((aligned(16))) unsigned char lds[];
    Frame F;
    F.lds = (LAS unsigned char*)lds;
    F.MISC = (volatile LAS unsigned*)(F.lds + MISC_OFF);
    F.tid = threadIdx.x; F.lane = F.tid & 63; F.wave = __builtin_amdgcn_readfirstlane(F.tid >> 6);
    F.G = gridDim.x; { const int bx = blockIdx.x; F.vcu = (F.G % 8 == 0) ? (bx % 8) * (F.G / 8) + bx / 8 : bx; }
    unsigned char* ws = args.ws;
    F.ctl = (gu32*)(ws + WS_CTL);
    F.x = args.in[0]; F.mem = args.in[1]; F.norm_w = args.in[2]; F.w_in = args.in[3]; F.conv_w = args.in[4]; F.a_log_f = args.in[5]; F.a_log_b = args.in[6];
    F.dt_f = args.in[7]; F.dt_b = args.in[8]; F.o_norm_a = args.in[9]; F.q_norm_b = args.in[10]; F.k_norm_b = args.in[11]; F.sink_b = args.in[12];
    F.mem_norm_w = args.in[13]; F.w_mem_kv = args.in[14]; F.q_norm_c = args.in[15]; F.k_norm_c = args.in[16]; F.w_out = args.in[17]; F.out = args.out;
    F.WinT = (bf16*)(ws + WS_WIN); F.WmemT = (bf16*)(ws + WS_WMEM); F.WoutT = (bf16*)(ws + WS_WOUT); F.XN = (bf16*)(ws + WS_XN); F.MEMN = (bf16*)(ws + WS_MEMN);
    F.PA = (bf16*)(ws + WS_PA); F.PB = (bf16*)(ws + WS_PB); F.PC = (bf16*)(ws + WS_PC); F.MIX = (bf16*)(ws + WS_MIX); F.KVM = (bf16*)(ws + WS_KVM);
    F.UT = (bf16*)(ws + WS_UT); F.WNEG = (bf16*)(ws + WS_WNEG); F.QDEC = (bf16*)(ws + WS_QDEC); F.KDECT = (bf16*)(ws + WS_KDECT); F.QKM = (bf16*)(ws + WS_QKM);
    F.OF = (bf16*)(ws + WS_OF); F.OB = (bf16*)(ws + WS_OB);
    F.GATES = (float*)(ws + WS_GATES); F.ROPE = (float*)(ws + WS_ROPE); F.CD = (float*)(ws + WS_CD);
    for (int u = F.tid; u < (LDS_BYTES - LDSCTL_OFF) / 4; u += NWAVES * 64) ((LAS unsigned*)(F.lds + LDSCTL_OFF))[u] = 0u;
    __syncthreads();
    XcdBarrier bar; bar.bar = (unsigned*)(F.ctl + CW_BAR); bar.x = 0; bar.st = nullptr;
    if (N_LAUNCHES != PER_PHASE) bar = xcd_barrier_post((unsigned*)(F.ctl + CW_BAR), F.MISC + 8);
#define GRID_BAR() do { if (N_LAUNCHES == PER_PHASE) { if (F.tid == 0) __hip_atomic_store(F.ctl + CW_TMO, 0xBADBA0u, RLX_AGENT); } else { xcd_barrier(bar); } } while (0)
    const int lo = args.ph_lo, hi = args.ph_hi;
#define IN(k) (lo <= (k) && (k) < hi)
#define BOTH(k) (IN(k) && IN((k) + 1))

#ifndef REP0
#define REP0 1
#endif
#ifndef REP1
#define REP1 1
#endif
#ifndef REP2A
#define REP2A 1
#endif
#ifndef REP2B
#define REP2B 1
#endif
#ifndef REP2C
#define REP2C 1
#endif
#ifndef REP3
#define REP3 1
#endif
#ifndef REP4
#define REP4 1
#endif
#ifndef REP5
#define REP5 1
#endif
#ifndef REPBAR
#define REPBAR 1
#endif
    bf16* const DRY = (bf16*)F.out;
    if (IN(0)) { for (int rep = 0; rep < REP0; ++rep) p0_prologue(F); if (BOTH(0)) for (int rep = 0; rep < REPBAR; ++rep) GRID_BAR(); }

    if (IN(1)) {
        pg8::Gemm g{F.XN, F.WinT, M + NBATCH * MEMLEN, 6656 + 1024, DMODEL}; pg8::InOrder S; S.init(F.G, (int)blockIdx.x, REP1);
        pg8::EpiIn E{F.PA, F.PB, F.PC, F.MIX, F.KVM, F.GATES};
        pg8::gemm_phase<pg8::EpiIn, pg8::InOrder, true, true>(F.lds + RING_OFF, g, S, E);
        if (BOTH(1)) GRID_BAR();
    }

    if (IN(2)) {
        for (int rep = 0; rep < REP2A; ++rep) a_prep_phase(F);
        if (BOTH(2)) GRID_BAR();
    }

    if (IN(3)) {
        for (int rep = 0; rep < REP3; ++rep) for (int it = F.vcu; it < 128; it += F.G) scan_unit(F.lds, F.tid, F.WNEG, F.QDEC, F.KDECT, F.QKM, F.UT, F.CD, F.OF, F.OB, (bf16*)F.out + (size_t)blockIdx.x * 65536, it >> 1, it & 1);
        for (;;) {
            if (F.tid == 0) F.MISC[16] = __hip_atomic_fetch_add(F.ctl + CW_WQ, 1u, RLX_AGENT);
            __syncthreads();
            const unsigned id = F.MISC[16];
            __syncthreads();
            if (id >= 512u * REP2B) break;
            const int it = (int)(id & 255u);
            if ((id & 511u) < 256u) b_attn_unit(F, it >> 5, (it >> 1) & 15, it & 1, id < 512u ? F.MIX : DRY);
            else c_attn_unit(F, it >> 5, (it >> 3) & 3, it & 7, id < 512u ? F.MIX : DRY);
        }
        if (BOTH(3)) GRID_BAR();
    }

    if (IN(4)) {
        const int gw = F.vcu * NWAVES + F.wave, NGW = F.G * NWAVES;
        for (int rep = 0; rep < REP4; ++rep) for (int m = gw; m < M; m += NGW) combine_row(F, (size_t)m, rep == REP4 - 1 ? F.MIX : DRY);
        if (BOTH(4)) GRID_BAR();
    }

    if (IN(5)) {
        pg8::Gemm g{F.MIX, F.WoutT, M, DMODEL, DMODEL}; pg8::RepOrder S; S.init(M, DMODEL, F.G, (int)blockIdx.x, REP5);
        pg8::EpiOut E{F.x, F.out};
        pg8::gemm_phase<pg8::EpiOut, pg8::RepOrder, true, true>(F.lds + RING_OFF, g, S, E);
    }
#undef IN
#undef BOTH
}

extern "C" void kernel_launch(void* const* d_in, const int* in_sizes, int n_in, void* d_out, int out_size, void* d_ws, size_t ws_size, hipStream_t stream) {
    static int grid = 0;
    if (grid == 0) {
        if (n_in != 18 || in_sizes[0] != M * DMODEL || out_size != M * DMODEL || ws_size < WS_END) { fprintf(stderr, "kernel_launch: unexpected problem shape (n_in %d, in0 %d, out %d, ws %zu); nothing launched\n", n_in, n_in > 0 ? in_sizes[0] : -1, out_size, ws_size); grid = -1; return; }
        int dev = 0, cus = 0, per_cu = 0;
        if (hipGetDevice(&dev) != hipSuccess || hipDeviceGetAttribute(&cus, hipDeviceAttributeMultiprocessorCount, dev) != hipSuccess) { fprintf(stderr, "kernel_launch: device query failed\n"); grid = -1; return; }
        if (hipFuncSetAttribute((const void*)hybrid_fwd, hipFuncAttributeMaxDynamicSharedMemorySize, LDS_BYTES) != hipSuccess) { fprintf(stderr, "kernel_launch: hipFuncSetAttribute failed\n"); grid = -1; return; }
        if (hipOccupancyMaxActiveBlocksPerMultiprocessor(&per_cu, (const void*)hybrid_fwd, NWAVES * 64, LDS_BYTES) != hipSuccess || per_cu < 1)
            fprintf(stderr, "kernel_launch: note: occupancy query reports %d workgroups per CU\n", per_cu);
        (void)hipGetLastError();
        grid = cus;
    }
    if (grid < 0) return;
    if (hipMemsetAsync((char*)d_ws + WS_CTL, 0, CTL_ZERO_BYTES, stream) != hipSuccess) { fprintf(stderr, "kernel_launch: hipMemsetAsync failed\n"); return; }
    Args a{};
    for (int i = 0; i < 18; ++i) a.in[i] = (const float*)d_in[i];
    a.out = (float*)d_out; a.ws = (unsigned char*)d_ws;
    for (int li = 0; li < N_LAUNCHES; ++li) {
        a.ph_lo = (N_LAUNCHES == PER_PHASE) ? li : 0; a.ph_hi = (N_LAUNCHES == PER_PHASE) ? li + 1 : PER_PHASE; a.li = li;
        hipLaunchKernelGGL(hybrid_fwd, dim3(grid), dim3(NWAVES * 64), LDS_BYTES, stream, a);
        const hipError_t le = hipPeekAtLastError();
        if (le != hipSuccess) { fprintf(stderr, "kernel_launch: launch %d failed: %s\n", li, hipGetErrorName(le)); break; }
    }
}
```

```cpp
#include <hip/hip_runtime.h>
#include <cstdio>
#include <cstdint>
namespace pg8 {
#define PG8_LAS __attribute__((address_space(3)))
typedef unsigned short bf16_t;
typedef short bf16x8 __attribute__((ext_vector_type(8)));
typedef float f32x4 __attribute__((ext_vector_type(4)));
typedef unsigned u32x4 __attribute__((ext_vector_type(4)));
constexpr int BM = 256, BK = 64, HALF = 128, HTB = HALF * BK * 2  , STAGE_BYTES = 8 * HTB, NXCD = 8, WGM = 8;

__host__ __device__ __forceinline__ int lds_byte(int r, int c) { const int st = (r >> 4) * 2 + (c >> 5), rr = r & 15, cc = c & 31, ob = rr * 64 + cc * 2; return st * 1024 + (ob ^ (((ob >> 9) & 1) << 5)); }
__host__ __device__ __forceinline__ void stage_rc(int b, int& R, int& C) { const int st = b / 1024, sb = b % 1024, swz = sb ^ (((sb >> 9) & 1) << 5); R = (st >> 1) * 16 + swz / 64; C = (st & 1) * 32 + (swz % 64) / 2; }
__host__ __device__ __forceinline__ int perm32(int rho) { const int n = rho >> 4, i = rho & 15; return 8 * (i >> 2) + 4 * n + (i & 3); }

struct Unit { int pm, pn; };
struct Gemm { const bf16_t* A; const bf16_t* Bt; int M, N, K; };

struct StaticOrder {
    int nM, nN, nwg, G, c;
    __host__ __device__ void init(int M, int N, int G_, int c_) { nM = M / BM; nN = N / BM; nwg = nM * nN; G = G_; c = c_; }
    __host__ __device__ bool next(int i, Unit& u) const {
        const long L = (long)i * G + c; if (L >= nwg) return false;
        int wgid = (int)L; { const int q = nwg / NXCD, r = nwg % NXCD, xcd = wgid % NXCD, off = wgid / NXCD; wgid = (xcd < r ? xcd * (q + 1) : r * (q + 1) + (xcd - r) * q) + off; }
        const int nig = WGM * nN, gid = wgid / nig, fm = gid * WGM, gsz = (nM - fm) < WGM ? (nM - fm) : WGM;
        u.pm = fm + ((wgid % nig) % gsz); u.pn = (wgid % nig) / gsz; return true;
    }
    __device__ __forceinline__ void a_ready(const Unit&) const {}
    __device__ __forceinline__ void done(const Unit&) const {}
};

typedef float f32x2 __attribute__((ext_vector_type(2)));
typedef __bf16 bf16x2_t __attribute__((ext_vector_type(2)));
__device__ __forceinline__ unsigned cvt_pk_bf16(float lo, float hi) { f32x2 v = {lo, hi}; bf16x2_t b = __builtin_convertvector(v, bf16x2_t); return __builtin_bit_cast(unsigned, b); }
__device__ __forceinline__ float silu_f(float v) { return v * __builtin_amdgcn_rcpf(1.0f + __expf(-v)); }

struct EpiIn {
    static constexpr bool PERM = true, AFTER_DRAIN = false;
    bf16_t *PA, *PB, *PC, *MIX, *KVM; float* GATES;
    __device__ __forceinline__ void init(f32x4 (&acc)[2][2][4][2], const Unit&, int, int, int, int) const {
#pragma unroll
        for (int a = 0; a < 2; ++a)
#pragma unroll
            for (int b = 0; b < 2; ++b)
#pragma unroll
                for (int m = 0; m < 4; ++m)
#pragma unroll
                    for (int n = 0; n < 2; ++n) acc[a][b][m][n] = (f32x4){0.f, 0.f, 0.f, 0.f};
    }
    __device__ __forceinline__ void operator()(const f32x4 (&acc)[2][2][4][2], const Unit& u, int wr, int wc, int fr, int fq) const {
        const int row0 = u.pm * BM + wr * 64 + fr, cl = wc * 32 + 8 * fq, pn = u.pn;
        if (u.pm < 64 && pn == 25) {
            if (wc == 0) {
#pragma unroll
                for (int ai = 0; ai < 2; ++ai)
#pragma unroll
                    for (int m = 0; m < 4; ++m) { float* g = GATES + (size_t)(row0 + ai * HALF + m * 16) * 32 + 8 * fq;
                        *(f32x4*)g = acc[ai][0][m][0]; *(f32x4*)(g + 4) = acc[ai][0][m][1]; }
            }
            return;
        }
        bf16_t* base; int ldc; bool act = false;
        if (u.pm >= 64) { base = KVM + (size_t)(row0 - 16384) * 1024 + (pn - 26) * 256; ldc = 1024; }
        else if (pn < 12) { base = PA + (size_t)row0 * 3072 + pn * 256; ldc = 3072; }
        else if (pn < 16) { base = MIX + (size_t)row0 * 2048 + (pn - 12) * 256; ldc = 2048; act = true; }
        else if (pn < 19) { base = PB + (size_t)row0 * 768 + (pn - 16) * 256; ldc = 768; }
        else if (pn < 21) { base = MIX + (size_t)row0 * 2048 + 1024 + (pn - 19) * 256; ldc = 2048; act = true; }
        else if (pn < 23) { base = PC + (size_t)row0 * 512 + (pn - 21) * 256; ldc = 512; }
        else { base = MIX + (size_t)row0 * 2048 + 1536 + (pn - 23) * 256; ldc = 2048; act = true; }
        base += cl;
#pragma unroll
        for (int ai = 0; ai < 2; ++ai)
#pragma unroll
            for (int m = 0; m < 4; ++m) { bf16_t* rowp = base + (size_t)(ai * HALF + m * 16) * ldc;
#pragma unroll
                for (int bj = 0; bj < 2; ++bj) { f32x4 v0 = acc[ai][bj][m][0], v1 = acc[ai][bj][m][1];
                    if (act) { v0 = (f32x4){silu_f(v0[0]), silu_f(v0[1]), silu_f(v0[2]), silu_f(v0[3])}; v1 = (f32x4){silu_f(v1[0]), silu_f(v1[1]), silu_f(v1[2]), silu_f(v1[3])}; }
                    u32x4 w; w.x = cvt_pk_bf16(v0[0], v0[1]); w.y = cvt_pk_bf16(v0[2], v0[3]); w.z = cvt_pk_bf16(v1[0], v1[1]); w.w = cvt_pk_bf16(v1[2], v1[3]);
                    *(u32x4*)(rowp + bj * HALF) = w; } }
    }
};
struct EpiOut {
    static constexpr bool PERM = false, AFTER_DRAIN = false;
    const float* X; float* O;
    __device__ __forceinline__ void init(f32x4 (&acc)[2][2][4][2], const Unit& u, int wr, int wc, int fr, int fq) const {
        const int row0 = u.pm * BM + wr * 64 + fr, col0 = u.pn * BM + wc * 32 + 4 * fq;
#pragma unroll
        for (int ai = 0; ai < 2; ++ai)
#pragma unroll
            for (int m = 0; m < 4; ++m) { const size_t off = (size_t)(row0 + ai * HALF + m * 16) * 2048 + col0;
#pragma unroll
                for (int bj = 0; bj < 2; ++bj)
#pragma unroll
                    for (int n = 0; n < 2; ++n) acc[ai][bj][m][n] = *(const f32x4*)(X + off + bj * HALF + n * 16); }
    }
    __device__ __forceinline__ void operator()(const f32x4 (&acc)[2][2][4][2], const Unit& u, int wr, int wc, int fr, int fq) const {
        const int row0 = u.pm * BM + wr * 64 + fr, col0 = u.pn * BM + wc * 32 + 4 * fq;
#pragma unroll
        for (int ai = 0; ai < 2; ++ai)
#pragma unroll
            for (int m = 0; m < 4; ++m) { const size_t off = (size_t)(row0 + ai * HALF + m * 16) * 2048 + col0;
#pragma unroll
                for (int bj = 0; bj < 2; ++bj)
#pragma unroll
                    for (int n = 0; n < 2; ++n) *(f32x4*)(O + off + bj * HALF + n * 16) = acc[ai][bj][m][n]; }
    }
};
struct InOrder {
    StaticOrder base; int G, c, rep;
    __host__ __device__ void init(int G_, int c_, int rep_ = 1) { G = G_; c = c_; rep = rep_; base.init(16384, 6656, G_, 0); }
    __host__ __device__ bool next(int i, Unit& u) const {
        long L = (long)i * G + c; const long tot = base.nwg + 32;
        if (L >= tot * rep) return false;
        L %= tot;
        if (L < base.nwg) { StaticOrder b2 = base; b2.c = (int)(L % G); return b2.next((int)(L / G), u); }
        const int j = (int)(L - base.nwg);
        u.pm = 64 + (j >> 2); u.pn = 26 + (j & 3); return true;
    }
    __device__ __forceinline__ void a_ready(const Unit&) const {}
    __device__ __forceinline__ void done(const Unit&) const {}
};
struct RepOrder {
    StaticOrder base; int G, c, rep;
    __host__ __device__ void init(int M_, int N_, int G_, int c_, int rep_ = 1) { G = G_; c = c_; rep = rep_; base.init(M_, N_, G_, 0); }
    __host__ __device__ bool next(int i, Unit& u) const {
        long L = (long)i * G + c; if (L >= (long)base.nwg * rep) return false;
        L %= base.nwg; StaticOrder b2 = base; b2.c = (int)(L % G); return b2.next((int)(L / G), u);
    }
    __device__ __forceinline__ void a_ready(const Unit&) const {}
    __device__ __forceinline__ void done(const Unit&) const {}
};

template <class Epi, class Sched, bool ALIGN_EPI = false, bool SP2 = false>
__device__ __forceinline__ void gemm_phase(PG8_LAS unsigned char* lds, const Gemm g, const Sched& S, const Epi& E) {
    const int tid = threadIdx.x, wid = __builtin_amdgcn_readfirstlane(tid >> 6), lane = tid & 63, wr = wid >> 2, wc = wid & 3, fr = lane & 15, fq = lane >> 4;
    const int K = g.K, nt = K / BK;
    unsigned voffA[2], voffB[2];
#pragma unroll
    for (int i = 0; i < 2; ++i) { int R, C; stage_rc(tid * 16 + i * 8192, R, C); const int Rb = Epi::PERM ? ((R & ~31) + perm32(R & 31)) : R;
        voffA[i] = (unsigned)(R * K + C) * 2u; voffB[i] = (unsigned)(Rb * K + C) * 2u; }
    const size_t kstep = (size_t)(BK * 2);
    const size_t hstep = (size_t)HALF * K * 2;
    const size_t tstep = 2 * hstep;
    const unsigned ldsw = (unsigned)wid * 1024u;
    const int aoff = lds_byte(wr * 64 + fr, fq * 8), boff = lds_byte(wc * 32 + fr, fq * 8);
#define PG8_SA(b, h) (((b) * 2 + (h)) * HTB)
#define PG8_SB(b, h) ((4 + (b) * 2 + (h)) * HTB)
#define PG8_STAGE(bufoff, gbase, voff) do { _Pragma("unroll") for (int _i = 0; _i < 2; ++_i) \
        __builtin_amdgcn_global_load_lds((const unsigned*)((const char*)(gbase) + (voff)[_i]), (PG8_LAS unsigned*)(lds + (bufoff) + ldsw + _i * 8192), 16, 0, 0); } while (0)
#define PG8_LDA(dst, b, h) do { _Pragma("unroll") for (int m = 0; m < 4; ++m) _Pragma("unroll") for (int k = 0; k < 2; ++k) dst[m][k] = *(const PG8_LAS bf16x8*)(lds + PG8_SA(b, h) + aoff + m * 2048 + k * 1024); } while (0)
#define PG8_LDB(dst, b, h) do { _Pragma("unroll") for (int n = 0; n < 2; ++n) _Pragma("unroll") for (int k = 0; k < 2; ++k) dst[n][k] = *(const PG8_LAS bf16x8*)(lds + PG8_SB(b, h) + boff + n * 2048 + k * 1024); } while (0)
#define PG8_MMA(ai, bj, At, Bt) do { __builtin_amdgcn_s_setprio(1); _Pragma("unroll") for (int m = 0; m < 4; ++m) _Pragma("unroll") for (int n = 0; n < 2; ++n) _Pragma("unroll") for (int k = 0; k < 2; ++k) \
        acc[ai][bj][m][n] = __builtin_amdgcn_mfma_f32_16x16x32_bf16(Bt[n][k], At[m][k], acc[ai][bj][m][n], 0, 0, 0); __builtin_amdgcn_s_setprio(0); } while (0)
#define PG8_WAIT_V(n) asm volatile("s_waitcnt vmcnt(" #n ")" ::: "memory")
#define PG8_WAIT_L(n) asm volatile("s_waitcnt lgkmcnt(" #n ")" ::: "memory")
#define PG8_BAR __builtin_amdgcn_s_barrier()
#define PG8_SCHED __builtin_amdgcn_sched_barrier(0)
    Unit cur, nxt; int ui = 0;
    if (!S.next(0, cur)) return;
    f32x4 acc[2][2][4][2];
    E.init(acc, cur, wr, wc, fr, fq);
    bf16x8 At[4][2], B0[2][2], B1[2][2];
    const char* cA = (const char*)g.A + (size_t)cur.pm * tstep; const char* cB = (const char*)g.Bt + (size_t)cur.pn * tstep;
    S.a_ready(cur);
    if constexpr (SP2) {
        PG8_STAGE(PG8_SB(0, 0), cB, voffB); PG8_STAGE(PG8_SB(0, 1), cB + hstep, voffB); PG8_STAGE(PG8_SA(0, 0), cA, voffA); PG8_STAGE(PG8_SA(0, 1), cA + hstep, voffA);
        if (wr == 1) PG8_BAR;
        PG8_WAIT_V(2); PG8_BAR;
        PG8_STAGE(PG8_SB(1, 0), cB + kstep, voffB); PG8_STAGE(PG8_SA(1, 0), cA + kstep, voffA); PG8_STAGE(PG8_SB(1, 1), cB + hstep + kstep, voffB);
        PG8_WAIT_V(6); PG8_BAR;
    } else {
        PG8_STAGE(PG8_SB(0, 0), cB, voffB); PG8_STAGE(PG8_SA(0, 0), cA, voffA); PG8_STAGE(PG8_SB(0, 1), cB + hstep, voffB); PG8_STAGE(PG8_SA(0, 1), cA + hstep, voffA);
        if (wr == 1) PG8_BAR;
        PG8_WAIT_V(4); PG8_BAR;
        PG8_STAGE(PG8_SB(1, 0), cB + kstep, voffB); PG8_STAGE(PG8_SA(1, 0), cA + kstep, voffA); PG8_STAGE(PG8_SB(1, 1), cB + hstep + kstep, voffB);
        PG8_WAIT_V(6); PG8_BAR;
    }
    for (;;) {
        const bool has_next = S.next(ui + 1, nxt);
        const char* nA = has_next ? (const char*)g.A + (size_t)nxt.pm * tstep : cA; const char* nB = has_next ? (const char*)g.Bt + (size_t)nxt.pn * tstep : cB;
        for (int t = 0; t < nt; t += 2) {
            const bool last = (t == nt - 2);
            const char* a1 = cA + (size_t)(t + 1) * kstep;
            const char* a2 = last ? nA : cA + (size_t)(t + 2) * kstep; const char* b2 = last ? nB : cB + (size_t)(t + 2) * kstep;
            const char* a3 = a2 + kstep; const char* b3 = b2 + kstep;
            if (last && has_next) S.a_ready(nxt);
            if constexpr (SP2) {
            PG8_LDB(B0, 0, 0); PG8_LDB(B1, 0, 1); PG8_SCHED; PG8_LDA(At, 0, 0); PG8_STAGE(PG8_SA(1, 1), a1 + hstep, voffA);
            PG8_WAIT_V(8); PG8_WAIT_L(0); PG8_BAR; PG8_MMA(0, 0, At, B0); PG8_MMA(0, 1, At, B1); PG8_BAR; PG8_SCHED;
            PG8_LDA(At, 0, 1); PG8_STAGE(PG8_SB(0, 0), b2, voffB); PG8_STAGE(PG8_SB(0, 1), b2 + hstep, voffB); PG8_STAGE(PG8_SA(0, 0), a2, voffA);
            PG8_WAIT_V(8); PG8_WAIT_L(0); PG8_BAR; PG8_MMA(1, 0, At, B0); PG8_MMA(1, 1, At, B1); PG8_BAR; PG8_SCHED;
            PG8_LDB(B0, 1, 0); PG8_LDB(B1, 1, 1); PG8_SCHED; PG8_LDA(At, 1, 0); PG8_STAGE(PG8_SA(0, 1), a2 + hstep, voffA);
            PG8_WAIT_V(8); PG8_WAIT_L(0); PG8_BAR; PG8_MMA(0, 0, At, B0); PG8_MMA(0, 1, At, B1); PG8_BAR; PG8_SCHED;
            PG8_LDA(At, 1, 1); PG8_STAGE(PG8_SB(1, 0), b3, voffB); PG8_STAGE(PG8_SB(1, 1), b3 + hstep, voffB); PG8_STAGE(PG8_SA(1, 0), a3, voffA);
            PG8_WAIT_V(8); PG8_WAIT_L(0); PG8_BAR; PG8_MMA(1, 0, At, B0); PG8_MMA(1, 1, At, B1); PG8_BAR; PG8_SCHED;
            } else {
            PG8_LDB(B0, 0, 0); PG8_SCHED; PG8_LDA(At, 0, 0); PG8_STAGE(PG8_SA(1, 1), a1 + hstep, voffA);
            PG8_WAIT_L(8); PG8_BAR; PG8_WAIT_L(0); PG8_MMA(0, 0, At, B0); PG8_BAR; PG8_SCHED;
            PG8_LDB(B1, 0, 1); PG8_STAGE(PG8_SB(0, 0), b2, voffB);
            PG8_BAR; PG8_WAIT_L(0); PG8_MMA(0, 1, At, B1); PG8_BAR;
            PG8_LDA(At, 0, 1); PG8_STAGE(PG8_SA(0, 0), a2, voffA);
            PG8_BAR; PG8_WAIT_L(0); PG8_MMA(1, 0, At, B0); PG8_BAR; PG8_SCHED;
            PG8_STAGE(PG8_SB(0, 1), b2 + hstep, voffB);
            PG8_WAIT_V(6); PG8_BAR; PG8_MMA(1, 1, At, B1); PG8_BAR;
            PG8_LDB(B0, 1, 0); PG8_SCHED; PG8_LDA(At, 1, 0); PG8_STAGE(PG8_SA(0, 1), a2 + hstep, voffA);
            PG8_WAIT_L(8); PG8_BAR; PG8_WAIT_L(0); PG8_MMA(0, 0, At, B0); PG8_BAR; PG8_SCHED;
            PG8_LDB(B1, 1, 1); PG8_STAGE(PG8_SB(1, 0), b3, voffB);
            PG8_BAR; PG8_WAIT_L(0); PG8_MMA(0, 1, At, B1); PG8_BAR;
            PG8_LDA(At, 1, 1); PG8_STAGE(PG8_SA(1, 0), a3, voffA);
            PG8_BAR; PG8_WAIT_L(0); PG8_MMA(1, 0, At, B0); PG8_BAR; PG8_SCHED;
            PG8_STAGE(PG8_SB(1, 1), b3 + hstep, voffB);
            PG8_WAIT_V(6); PG8_BAR; PG8_MMA(1, 1, At, B1); PG8_BAR;
            }
        }
        if constexpr (ALIGN_EPI) { if (wr == 0) PG8_BAR; }
        if constexpr (!Epi::AFTER_DRAIN) { E(acc, cur, wr, wc, fr, fq); S.done(cur); }
        if (!has_next) break;
        cur = nxt; cA = nA; cB = nB; ++ui;
        E.init(acc, cur, wr, wc, fr, fq);
        if constexpr (ALIGN_EPI) { if (wr == 1) PG8_BAR; }
    }
    PG8_WAIT_V(0);
    if constexpr (!ALIGN_EPI) { if (wr == 0) PG8_BAR; }
    PG8_BAR;
    if constexpr (Epi::AFTER_DRAIN) { E.fused(acc, cur, wr, wc, fr, fq, lds, wid, lane); S.done(cur); }
#undef PG8_SA
#undef PG8_SB
#undef PG8_STAGE
#undef PG8_LDA
#undef PG8_LDB
#undef PG8_MMA
#undef PG8_WAIT_V
#undef PG8_WAIT_L
#undef PG8_BAR
#undef PG8_SCHED
}
}
#define GAS __attribute__((address_space(1)))
#define LAS __attribute__((address_space(3)))
typedef unsigned short bf16;
typedef unsigned v4u __attribute__((ext_vector_type(4)));
typedef float f32x4 __attribute__((ext_vector_type(4)));
typedef short bf16x8 __attribute__((ext_vector_type(8)));
typedef GAS unsigned gu32;
typedef GAS unsigned long long gu64;
#define RLX_AGENT __ATOMIC_RELAXED, __HIP_MEMORY_SCOPE_AGENT
#define LDS_WAIT() asm volatile("s_waitcnt lgkmcnt(0)" ::: "memory")
#define VM_WAIT() asm volatile("s_waitcnt vmcnt(0)" ::: "memory")
__device__ __forceinline__ unsigned long long rt() { return __builtin_amdgcn_s_memrealtime(); }
__device__ __forceinline__ unsigned f2bf(float f) { unsigned u = __builtin_bit_cast(unsigned, f); return (u + 0x7fffu + ((u >> 16) & 1u)) >> 16; }
__device__ __forceinline__ unsigned pk2(float lo, float hi) { return f2bf(lo) | (f2bf(hi) << 16); }

#define XB_TMO      128
#define XB_XCNT(j)  (256  + 64 * (j))
#define XB_XSUB(j)  (1280 + 64 * (j))
#define XB_XGEN(j)  (2304 + 64 * (j))
#define XB_TOP      3328
#define XB_TOPGEN   3392
#define XCD_BAR_WORDS 3456
#define XB_SPIN_CAP (1u << 18)

__device__ __forceinline__ unsigned xb_ld(unsigned* p)              { return __hip_atomic_load(p, __ATOMIC_RELAXED, __HIP_MEMORY_SCOPE_AGENT); }
__device__ __forceinline__ unsigned xb_add(unsigned* p, unsigned v) { return __hip_atomic_fetch_add(p, v, __ATOMIC_RELAXED, __HIP_MEMORY_SCOPE_AGENT); }
__device__ __forceinline__ unsigned xb_xcc_id() { return (unsigned)__builtin_amdgcn_s_getreg((3 << 11) | 20) & 0xFu; }
#define XB_SPIN(cond, bar) do { unsigned _sp = 0; while (cond) { __builtin_amdgcn_s_sleep(1); \
    if ((++_sp & 255u) == 0u) { if (xb_ld(&(bar)[XB_TMO])) break; if (_sp > XB_SPIN_CAP) { atomicAdd(&(bar)[XB_TMO], 1u); break; } } } } while (0)

struct XcdBarrier {
    unsigned* bar; unsigned x;
    volatile LAS unsigned* st;
};

__device__ __forceinline__ XcdBarrier xcd_barrier_post(unsigned* bar, volatile LAS unsigned* st) {
    XcdBarrier b; b.bar = bar; b.x = xb_xcc_id(); b.st = st;
    if (threadIdx.x == 0) (void)xb_add(&bar[XB_XCNT(b.x)], 1u);
    return b;
}
__device__ __forceinline__ void xcd_barrier_complete(unsigned* bar, unsigned x, unsigned& nloc, unsigned& nx) {
    const unsigned G = gridDim.x * gridDim.y * gridDim.z;
    unsigned sum, cnt, mine, sp = 0u;
    for (;;) {
        sum = 0u; cnt = 0u; mine = 0u;
#pragma unroll
        for (unsigned j = 0; j < 16; ++j) { const unsigned c = xb_ld(&bar[XB_XCNT(j)]); sum += c; cnt += (c > 0u) ? 1u : 0u; mine = (j == x) ? c : mine; }
        if (sum == G) break;
        __builtin_amdgcn_s_sleep(1);
        if ((++sp & 255u) == 0u) { if (xb_ld(&bar[XB_TMO])) break; if (sp > XB_SPIN_CAP) { atomicAdd(&bar[XB_TMO], 1u); break; } }
    }
    nloc = mine > 0u ? mine : 1u; nx = cnt > 0u ? cnt : 1u;
}

__device__ __forceinline__ void xcd_barrier(const XcdBarrier& b) {
    asm volatile("s_waitcnt vmcnt(0)" ::: "memory");
    __syncthreads();
    if (threadIdx.x == 0) {
        unsigned* bar = b.bar;
        __builtin_amdgcn_s_waitcnt(0);
        unsigned nloc = b.st[0], nx = b.st[1];
        if (nloc == 0u) { xcd_barrier_complete(bar, b.x, nloc, nx); b.st[0] = nloc; b.st[1] = nx; }
        const unsigned old = xb_add(&bar[XB_XSUB(b.x)], 1u);
        const unsigned gen = old / nloc;
        if (old + 1u == (gen + 1u) * nloc) {
            __builtin_amdgcn_fence(__ATOMIC_RELEASE, "agent");
            asm volatile("s_waitcnt vmcnt(0)" ::: "memory");
            const unsigned og = xb_add(&bar[XB_TOP], 1u);
            const unsigned tg = og / nx;
            if (og + 1u == (tg + 1u) * nx) xb_add(&bar[XB_TOPGEN], 1u);
            else XB_SPIN(xb_ld(&bar[XB_TOPGEN]) == tg, bar);
            __builtin_amdgcn_fence(__ATOMIC_ACQUIRE, "agent");
            xb_add(&bar[XB_XGEN(b.x)], 1u);
            asm volatile("s_waitcnt vmcnt(0)" ::: "memory");
        } else {
            XB_SPIN(xb_ld(&bar[XB_XGEN(b.x)]) == gen, bar);
            __builtin_amdgcn_fence(__ATOMIC_ACQUIRE, "agent");
            asm volatile("s_waitcnt vmcnt(0)" ::: "memory");
        }
    }
    __syncthreads();
}
constexpr int NWAVES = 8;
#ifndef MK_N_LAUNCHES
#define MK_N_LAUNCHES 1
#endif
constexpr int N_LAUNCHES = MK_N_LAUNCHES;
constexpr int PER_PHASE = 6;

constexpr int NBATCH = 8, SEQ = 2048, DMODEL = 2048, M = NBATCH * SEQ;
constexpr int MEMLEN = 256;
constexpr int NIN = 6432;
constexpr float EPS = 1e-6f;
constexpr float LOG2E = 1.4426950408889634f;

constexpr size_t MiB = 1u << 20;
constexpr size_t WS_CTL = 0, CTL_ZERO_BYTES = 20480;
constexpr size_t WS_WOUT = 1 * MiB;
constexpr size_t WS_WIN = 9 * MiB, WS_WMEM = 35 * MiB;
constexpr size_t WS_XN = 39 * MiB, WS_MEMN = 103 * MiB;
constexpr size_t WS_PA = 111 * MiB;
constexpr size_t WS_PB = 207 * MiB;
constexpr size_t WS_PC = 231 * MiB;
constexpr size_t WS_MIX = 247 * MiB;
constexpr size_t WS_GATES = 311 * MiB;
constexpr size_t WS_KVM = 313 * MiB;
constexpr size_t WS_ROPE = 317 * MiB;
constexpr size_t WS_CD = 317 * MiB + 512 * 1024;
constexpr size_t WS_UT = 318 * MiB, WS_WNEG = 382 * MiB, WS_QDEC = 446 * MiB;
constexpr size_t WS_KDECT = 9 * MiB, WS_QKM = 73 * MiB;
constexpr size_t WS_IA = 318 * MiB, WS_IB = 9 * MiB; constexpr int IB_SPLIT = 2730, IB_BYTES = 73728, IO_WN = 0, IO_QD = 8192, IO_KT = 16384, IO_QK = 24576, IO_UT = 28672;
static_assert(WS_IA + (size_t)IB_SPLIT * IB_BYTES <= 510 * MiB && WS_IB + (size_t)(4096 - IB_SPLIT) * IB_BYTES <= 111 * MiB, "scan operand blocks");
constexpr size_t WS_OF = 111 * MiB, WS_OB = 143 * MiB;
constexpr size_t WS_END = 510 * MiB;
constexpr int CW_TMO = 0, CW_CODE = 1, CW_WQ = 64, CW_BAR = 1024;

constexpr int RING_OFF = 0, RING_BYTES = 149504;
constexpr int LDSCTL_OFF = RING_BYTES, MISC_OFF = LDSCTL_OFF + 320;
constexpr int LDS_BYTES = 150528;
static_assert(MISC_OFF + 128 <= LDS_BYTES, "LDS map");

#define DI __device__ __forceinline__
typedef short s16x4 __attribute__((ext_vector_type(4)));
typedef unsigned u32x2 __attribute__((ext_vector_type(2)));
typedef float f32x2v __attribute__((ext_vector_type(2)));
#define MFMA16(a, b, c) __builtin_amdgcn_mfma_f32_16x16x32_bf16((a), (b), (c), 0, 0, 0)
DI unsigned cvtpk(float lo, float hi) { return pg8::cvt_pk_bf16(lo, hi); }
DI float bflo(unsigned v) { return __uint_as_float(v << 16); }
DI float bfhi(unsigned v) { return __uint_as_float(v & 0xffff0000u); }
DI float wave_sum(float v) {
#pragma unroll
    for (int o = 1; o < 64; o <<= 1) v += __shfl_xor(v, o);
    return v;
}
DI float silu_f(float v) { return pg8::silu_f(v); }
DI float softplus_f(float x) { return x > 20.f ? x : log1pf(expf(x)); }
DI float sigmoid_f(float x) { return 1.0f / (1.0f + expf(-x)); }
DI int perm32k(int k) { return (k & ~31) | (((k >> 2) & 3) << 3) | (((k >> 4) & 1) << 2) | (k & 3); }
typedef short v4i16_t __attribute__((ext_vector_type(4)));
DI s16x4 vtr(const LAS unsigned char* p) { return __builtin_bit_cast(s16x4, __builtin_amdgcn_ds_read_tr16_b64_v4i16((LAS v4i16_t*)p)); }
DI bf16x8 tr_frag(const LAS unsigned char* lo, int hi_off) { const s16x4 a = vtr(lo), b = vtr(lo + hi_off); return (bf16x8){a[0], a[1], a[2], a[3], b[0], b[1], b[2], b[3]}; }
DI bf16x8 ld_frag(const LAS unsigned char* p) { return *(const LAS bf16x8*)p; }
DI bf16x8 pack8(const f32x4& a, const f32x4& b) { v4u w; w.x = cvtpk(a[0], a[1]); w.y = cvtpk(a[2], a[3]); w.z = cvtpk(b[0], b[1]); w.w = cvtpk(b[2], b[3]); return __builtin_bit_cast(bf16x8, w); }

struct Frame {
    LAS unsigned char* lds;
    volatile LAS unsigned* MISC;
    gu32* ctl;
    int tid, lane, wave;
    int vcu, G;
    const float *x, *mem, *norm_w, *w_in, *conv_w, *a_log_f, *a_log_b, *dt_f, *dt_b, *o_norm_a, *q_norm_b, *k_norm_b, *sink_b, *mem_norm_w, *w_mem_kv, *q_norm_c, *k_norm_c, *w_out;
    float* out;
    bf16 *WinT, *WmemT, *WoutT, *XN, *MEMN, *PA, *PB, *PC, *MIX, *KVM, *UT, *WNEG, *QDEC, *KDECT, *QKM, *OF, *OB;
    float *GATES, *ROPE, *CD;
    unsigned char* wsb;
};
DI bf16* item_blk(unsigned char* wsb, int item) { return (bf16*)(wsb + (item < IB_SPLIT ? WS_IA + (size_t)item * IB_BYTES : WS_IB + (size_t)(item - IB_SPLIT) * IB_BYTES)); }

DI void p0_transpose_item(const float* W, int K, int N, bf16* WT, int k0, int n0, int drow0, LAS float* scr, int lane) {
#pragma unroll 8
    for (int i = 0; i < 32; ++i) { const int kk = 2 * i + (lane >> 5); scr[kk * 33 + (lane & 31)] = W[(size_t)(k0 + kk) * N + n0 + (lane & 31)]; }
    LDS_WAIT(); asm volatile("" ::: "memory");
    const int c = lane & 7;
#pragma unroll
    for (int j = 0; j < 4; ++j) { const int n = (lane >> 3) + 8 * j; const LAS float* s = scr + (8 * c) * 33 + n;
        v4u o; o.x = pk2(s[0 * 33], s[1 * 33]); o.y = pk2(s[2 * 33], s[3 * 33]); o.z = pk2(s[4 * 33], s[5 * 33]); o.w = pk2(s[6 * 33], s[7 * 33]);
        *(GAS v4u*)(WT + (size_t)(drow0 + n) * K + k0 + 8 * c) = o; }
    LDS_WAIT(); asm volatile("" ::: "memory");
}
DI void rms_row_to_bf16(const float* xrow, const float* w, bf16* orow, int lane) {
    const GAS f32x4* xr = (const GAS f32x4*)xrow + lane; const GAS f32x4* wr = (const GAS f32x4*)w + lane;
    f32x4 v[8]; float s = 0.f;
#pragma unroll
    for (int j = 0; j < 8; ++j) { v[j] = xr[64 * j]; s += (v[j].x * v[j].x + v[j].y * v[j].y) + (v[j].z * v[j].z + v[j].w * v[j].w); }
    const float rstd = 1.0f / sqrtf(wave_sum(s) * (1.0f / 2048.0f) + EPS);
    GAS unsigned long long* o8 = (GAS unsigned long long*)orow + lane;
#pragma unroll
    for (int j = 0; j < 8; ++j) { const f32x4 wv = wr[64 * j]; const f32x4 y = v[j] * rstd * wv;
        o8[64 * j] = (unsigned long long)cvtpk(y.x, y.y) | ((unsigned long long)cvtpk(y.z, y.w) << 32); }
}
DI void p0_prologue(Frame& F) {
    LAS float* scr = (LAS float*)(F.lds + RING_OFF + F.wave * 16384);
    const int gw = F.vcu * NWAVES + F.wave, NGW = F.G * NWAVES;
    constexpr int I_IN = 32 * 201, I_MEM = 32 * 32, I_OUT = 32 * 64, NITEMS = I_IN + I_MEM + I_OUT;
    for (int it = gw; it < NITEMS; it += NGW) {
        int r = it;
        if (r < I_IN) { const int kb = r / 201, sb = r % 201, n0 = 32 * sb; const int drow = n0 < 4096 ? n0 : (n0 < 4128 ? 6400 + (n0 - 4096) : n0 - 32);
            p0_transpose_item(F.w_in, 2048, NIN, F.WinT, 64 * kb, n0, drow, scr, F.lane); continue; }
        r -= I_IN;
        if (r < I_MEM) { p0_transpose_item(F.w_mem_kv, 2048, 1024, F.WmemT, 64 * (r / 32), 32 * (r % 32), 32 * (r % 32), scr, F.lane); continue; }
        r -= I_MEM;
        p0_transpose_item(F.w_out, 2048, 2048, F.WoutT, 64 * (r / 64), 32 * (r % 64), 32 * (r % 64), scr, F.lane);
    }
    { GAS v4u* z = (GAS v4u*)(F.WinT + (size_t)NIN * 2048); const int gt = F.vcu * 512 + F.tid, NT = F.G * 512;
      for (int i = gt; i < 224 * 256; i += NT) z[i] = (v4u){0u, 0u, 0u, 0u}; }
    for (int m = gw; m < M; m += NGW) rms_row_to_bf16(F.x + (size_t)m * DMODEL, F.norm_w, F.XN + (size_t)m * DMODEL, F.lane);
    for (int m = gw; m < NBATCH * MEMLEN; m += NGW) rms_row_to_bf16(F.mem + (size_t)m * DMODEL, F.mem_norm_w, F.MEMN + (size_t)m * DMODEL, F.lane);
    { const int gt = F.vcu * 512 + F.tid, NT = F.G * 512;
      for (int i = gt; i < SEQ * 32; i += NT) { const int pos = i >> 5, fi = i & 31; const float inv = powf(10000.0f, -(float)(2 * fi) / 64.0f); const float ang = (float)pos * inv;
          F.ROPE[2 * i] = cosf(ang); F.ROPE[2 * i + 1] = sinf(ang); } }
}

constexpr int AB_QH = 0, AB_KH = 17408, AB_VV = 34816, AB_BUF = 52224, AB_LD = 272;
constexpr int AD_F = 104448, AD_B = 122880, AD_T2 = 9216, AD_LDL = 72, AD_LDT = 144;
constexpr int AG_0 = 141312, AG_SZ = 2560, AG_RAW = 146432;
constexpr int ASCR_F = 0, ASCR_B = 5120;
static_assert(AG_RAW == AG_0 + 2 * AG_SZ && AG_RAW + 1024 <= RING_BYTES && AD_F == 2 * AB_BUF && AD_B == AD_F + 64 * 72 * 4 && AG_0 == AD_B + 64 * 72 * 4, "A-prep LDS map");
#define LBAR() asm volatile("s_waitcnt lgkmcnt(0)\n\ts_barrier" ::: "memory")

#define DPP_ADD(s, ctrl) (s) += __builtin_bit_cast(float, __builtin_amdgcn_update_dpp(0, __builtin_bit_cast(int, (s)), (ctrl), 0xf, 0xf, true))
DI float row16_sum(float s) { DPP_ADD(s, 0xB1); DPP_ADD(s, 0x4E); DPP_ADD(s, 0x141); DPP_ADD(s, 0x140); return s; }

template <bool BWD> DI void s3_solve(LAS unsigned char* L, LAS unsigned char* scr, const LAS float* GV, int lane) {
    int lane_o = lane; asm volatile("" : "+v"(lane_o));
    const int hb = lane_o >> 5, cc = lane_o & 31, r16 = lane_o & 15, g = lane_o >> 4;
    LAS unsigned char* D = L + (BWD ? AD_B : AD_F);
    const LAS float* LS = (const LAS float*)D;
    const LAS float* Lb = LS + hb * (32 * AD_LDL + 32);
    LAS unsigned char* SA = scr + (BWD ? ASCR_B : ASCR_F); LAS unsigned char* SB = SA + 2560;
    LAS unsigned char* T1 = D; LAS unsigned char* T2 = D + AD_T2;
    const LAS float* S1 = GV + (BWD ? 192 : 128); const LAS float* S2 = GV + (BWD ? 576 : 512);
    bf16x8 la[2];
#pragma unroll
    for (int ti = 0; ti < 2; ++ti) { const LAS float* lp = LS + (32 + 16 * ti + r16) * AD_LDL + 8 * g; const f32x4 x0 = *(const LAS f32x4*)lp, x1 = *(const LAS f32x4*)(lp + 4); la[ti] = pack8(x0, x1); }
#ifndef RS3L
#define RS3L 1
#endif
    float t[32];
    for (int r3_ = 0; r3_ < RS3L; ++r3_) { asm volatile("" ::: "memory"); int cc_o = cc; asm volatile("" : "+v"(cc_o));
    t[0] = (cc_o == 0) ? 1.f : 0.f;
    f32x4 rwA[8], rwB[8];
    rwB[0] = *(const LAS f32x4*)(Lb + AD_LDL);
#pragma unroll
    for (int i = 1; i < 32; ++i) {
        if (i + 1 < 32) {
#pragma unroll
            for (int q = 0; q < 8; ++q) if (4 * q < i + 1) { if ((i + 1) & 1) rwB[q] = *(const LAS f32x4*)(Lb + (i + 1) * AD_LDL + 4 * q); else rwA[q] = *(const LAS f32x4*)(Lb + (i + 1) * AD_LDL + 4 * q); } }
        __builtin_amdgcn_sched_barrier(0);
        float sa = (cc_o == i) ? 1.f : 0.f, sb = 0.f;
#pragma unroll
        for (int q = 0; q < 8; ++q)
#pragma unroll
            for (int e = 0; e < 4; ++e) if (4 * q + e < i) { const float lv = (i & 1) ? rwB[q][e] : rwA[q][e];
                if (e & 1) asm("v_fma_f32 %0, -%1, %2, %0" : "+v"(sb) : "v"(lv), "v"(t[4 * q + e])); else asm("v_fma_f32 %0, -%1, %2, %0" : "+v"(sa) : "v"(lv), "v"(t[4 * q + e])); }
        t[i] = sa + sb;
        __builtin_amdgcn_sched_barrier(0);
    }
    }
#ifndef RS3T
#define RS3T 1
#endif
    for (int r4_ = 0; r4_ < RS3T; ++r4_) { asm volatile("" ::: "memory");
    {
        const int R = BWD ? 32 * hb + cc : 63 - 32 * hb - cc, colb = BWD ? 32 * hb : 32 * (1 - hb);
#pragma unroll
        for (int q = 0; q < 4; ++q) { const f32x4 a0 = *(const LAS f32x4*)(S1 + colb + 8 * q), a1 = *(const LAS f32x4*)(S1 + colb + 8 * q + 4), b0 = *(const LAS f32x4*)(S2 + colb + 8 * q), b1 = *(const LAS f32x4*)(S2 + colb + 8 * q + 4);
            const f32x4 v0 = BWD ? (f32x4){t[8 * q], t[8 * q + 1], t[8 * q + 2], t[8 * q + 3]} : (f32x4){t[31 - 8 * q], t[30 - 8 * q], t[29 - 8 * q], t[28 - 8 * q]};
            const f32x4 v1 = BWD ? (f32x4){t[8 * q + 4], t[8 * q + 5], t[8 * q + 6], t[8 * q + 7]} : (f32x4){t[27 - 8 * q], t[26 - 8 * q], t[25 - 8 * q], t[24 - 8 * q]};
            *(LAS bf16x8*)(T1 + R * AD_LDT + (colb + 8 * q) * 2) = pack8(v0 * a0, v1 * a1); *(LAS bf16x8*)(T2 + R * AD_LDT + (colb + 8 * q) * 2) = pack8(v0 * b0, v1 * b1); }
    }
    __builtin_amdgcn_sched_barrier(0);
    if (hb == 0) {
#pragma unroll
        for (int q = 0; q < 4; ++q) *(LAS bf16x8*)(SA + cc * 80 + 16 * q) = pack8((f32x4){t[8 * q], t[8 * q + 1], t[8 * q + 2], t[8 * q + 3]}, (f32x4){t[8 * q + 4], t[8 * q + 5], t[8 * q + 6], t[8 * q + 7]});
    } else {
#pragma unroll
        for (int i = 0; i < 32; i += 2) { const unsigned pk = cvtpk(t[i], t[i + 1]); *(LAS bf16*)(SB + i * 80 + 2 * cc) = (bf16)(pk & 0xffffu); *(LAS bf16*)(SB + (i + 1) * 80 + 2 * cc) = (bf16)(pk >> 16); }
    }
    asm volatile("s_waitcnt lgkmcnt(0)" ::: "memory");
    __builtin_amdgcn_sched_barrier(0);
    bf16x8 tbf[2];
#pragma unroll
    for (int ti = 0; ti < 2; ++ti) tbf[ti] = ld_frag(SA + (16 * ti + r16) * 80 + 16 * g);
    f32x4 P[2][2];
#pragma unroll
    for (int ti = 0; ti < 2; ++ti)
#pragma unroll
        for (int tj = 0; tj < 2; ++tj) P[ti][tj] = MFMA16(la[ti], tbf[tj], ((f32x4){0.f, 0.f, 0.f, 0.f}));
    bf16x8 pbb[2];
#pragma unroll
    for (int tj = 0; tj < 2; ++tj) pbb[tj] = pack8(P[0][tj], P[1][tj]);
#pragma unroll
    for (int tip = 0; tip < 2; ++tip) {
        const u32x2 lo = *(const LAS u32x2*)(SB + (16 * tip + r16) * 80 + 8 * g), hi = *(const LAS u32x2*)(SB + (16 * tip + r16) * 80 + 32 + 8 * g);
        const v4u aw = (v4u){lo.x, lo.y, hi.x, hi.y}; const bf16x8 af = __builtin_bit_cast(bf16x8, aw);
#pragma unroll
        for (int tj = 0; tj < 2; ++tj) { const f32x4 X = MFMA16(af, pbb[tj], ((f32x4){0.f, 0.f, 0.f, 0.f})); const int b = 16 * tj + r16;
            const int Rn = BWD ? b : 63 - b, col0 = BWD ? 32 + 16 * tip + 4 * g : 28 - 16 * tip - 4 * g;
            const f32x4 a0 = *(const LAS f32x4*)(S1 + col0), b0 = *(const LAS f32x4*)(S2 + col0);
            const f32x4 xv = BWD ? (f32x4){-X[0], -X[1], -X[2], -X[3]} : (f32x4){-X[3], -X[2], -X[1], -X[0]};
            u32x2 o1, o2; o1.x = cvtpk(xv[0] * a0[0], xv[1] * a0[1]); o1.y = cvtpk(xv[2] * a0[2], xv[3] * a0[3]); o2.x = cvtpk(xv[0] * b0[0], xv[1] * b0[1]); o2.y = cvtpk(xv[2] * b0[2], xv[3] * b0[3]);
            *(LAS u32x2*)(T1 + Rn * AD_LDT + col0 * 2) = o1; *(LAS u32x2*)(T2 + Rn * AD_LDT + col0 * 2) = o2; }
    }
    }
}

DI void acons_s2(Frame& F, LAS unsigned char* L, LAS unsigned char* B, const LAS float* GV, int item_f, int wv, int lane) {
    int lane_o = lane; asm volatile("" : "+v"(lane_o));
    const int r16 = lane_o & 15, g = lane_o >> 4, item_b = item_f + 32;
    f32x4 accG[4], accQ[4];
#pragma unroll
    for (int tn = 0; tn < 4; ++tn) { accG[tn] = (f32x4){0.f, 0.f, 0.f, 0.f}; accQ[tn] = (f32x4){0.f, 0.f, 0.f, 0.f}; }
    const LAS unsigned char* Ab = B + AB_KH + (16 * wv + r16) * AB_LD + g * 16;
    const LAS unsigned char* Kb = B + AB_KH + r16 * AB_LD + g * 16;
    const LAS unsigned char* Qb = B + AB_QH + r16 * AB_LD + g * 16;
    bf16x8 fr[2][9];
#define S2_LD(dst, ks_) do { dst[0] = ld_frag(Ab + (ks_) * 64); _Pragma("unroll") for (int tn_ = 0; tn_ < 4; ++tn_) { dst[1 + tn_] = ld_frag(Kb + tn_ * 16 * AB_LD + (ks_) * 64); dst[5 + tn_] = ld_frag(Qb + tn_ * 16 * AB_LD + (ks_) * 64); } } while (0)
    S2_LD(fr[0], 0);
#pragma unroll
    for (int ks = 0; ks < 4; ++ks) {
        if (ks + 1 < 4) S2_LD(fr[(ks + 1) & 1], ks + 1);
        __builtin_amdgcn_sched_barrier(0);
#pragma unroll
        for (int tn = 0; tn < 4; ++tn) { accG[tn] = MFMA16(fr[ks & 1][0], fr[ks & 1][1 + tn], accG[tn]); accQ[tn] = MFMA16(fr[ks & 1][0], fr[ks & 1][5 + tn], accQ[tn]); }
        __builtin_amdgcn_sched_barrier(0); }
#undef S2_LD
    LAS float* LF = (LAS float*)(L + AD_F);
    f32x4 gfi, gbi, bfi, bbi;
    { const LAS float* gp = GV + 16 * wv + 4 * g; gfi = *(const LAS f32x4*)gp; gbi = *(const LAS f32x4*)(gp + 64); bfi = *(const LAS f32x4*)(gp + 128); bbi = *(const LAS f32x4*)(gp + 192); }
#pragma unroll
    for (int tn = 0; tn < 4; ++tn) {
        const int j = 16 * tn + r16; const float gcfj = GV[j], gcbj = GV[64 + j];
#pragma unroll
        for (int reg = 0; reg < 4; ++reg) { const int i = 16 * wv + 4 * g + reg; const bool low = (j <= i);
            const float arg = low ? gfi[reg] - gcfj : gbi[reg] - gcbj, bt = low ? bfi[reg] : bbi[reg];
            const int off = low ? (63 - j) * AD_LDL + (63 - i) : (AD_B - AD_F) / 4 + j * AD_LDL + i;
            LF[off] = bt * accG[tn][reg] * __expf(fminf(arg, 0.f)); } }
#pragma unroll
    for (int tn = 0; tn < 4; ++tn) {
        const int i = 16 * tn + r16; const float gcfi = GV[i], gcbi = GV[64 + i]; float qf[4], qb[4];
#pragma unroll
        for (int reg = 0; reg < 4; ++reg) { const int j = 16 * wv + 4 * g + reg; const float v = accQ[tn][reg];
            const float ef = __expf(fminf(gcfi - gfi[reg], 0.f)), eb = __expf(fminf(gcbi - gbi[reg], 0.f));
            qf[reg] = v * ef * ((j <= i) ? 1.f : 0.f); qb[reg] = v * eb * ((j >= i) ? 1.f : 0.f); }
        const int idx = 32 * (wv >> 1) + 8 * g + 4 * (wv & 1);
        u32x2 vf, vb; vf.x = cvtpk(qf[0], qf[1]); vf.y = cvtpk(qf[2], qf[3]); vb.x = cvtpk(qb[0], qb[1]); vb.y = cvtpk(qb[2], qb[3]);
        *(u32x2*)(item_blk(F.wsb, item_f) + IO_QK + i * 64 + idx) = vf; *(u32x2*)(item_blk(F.wsb, item_b) + IO_QK + i * 64 + idx) = vb; }
}
DI void acons_kdect(Frame& F, LAS unsigned char* B, const LAS float* GV, int item, int dirb, int lane) {
    int lane_o = lane; asm volatile("" : "+v"(lane_o));
    const int i16 = lane_o & 15, gg = lane_o >> 4, q4 = i16 >> 2, p4 = i16 & 3;
    const LAS float* KD = GV + (dirb ? 448 : 384);
#pragma unroll
    for (int s = 0; s < 2; ++s) { const f32x4 k0 = *(const LAS f32x4*)(KD + 32 * s + 4 * gg), k1 = *(const LAS f32x4*)(KD + 32 * s + 16 + 4 * gg);
#pragma unroll
        for (int dt = 0; dt < 8; ++dt) { const LAS unsigned char* ap = B + AB_KH + (32 * s + 4 * gg + q4) * AB_LD + (16 * dt + 4 * p4) * 2;
            const s16x4 lo = vtr(ap), hi = vtr(ap + 16 * AB_LD);
            const f32x4 a = (f32x4){bflo((unsigned)(unsigned short)lo[0]), bflo((unsigned)(unsigned short)lo[1]), bflo((unsigned)(unsigned short)lo[2]), bflo((unsigned)(unsigned short)lo[3])} * k0;
            const f32x4 c = (f32x4){bflo((unsigned)(unsigned short)hi[0]), bflo((unsigned)(unsigned short)hi[1]), bflo((unsigned)(unsigned short)hi[2]), bflo((unsigned)(unsigned short)hi[3])} * k1;
            v4u o; o.x = cvtpk(a[0], a[1]); o.y = cvtpk(a[2], a[3]); o.z = cvtpk(c[0], c[1]); o.w = cvtpk(c[2], c[3]);
            *(v4u*)(item_blk(F.wsb, item) + IO_KT + (16 * dt + i16) * 64 + 32 * s + 8 * gg) = o; __builtin_amdgcn_sched_barrier(0); } }
}
template <int DIRT> DI void acons_s4(Frame& F, LAS unsigned char* L, LAS unsigned char* B, LAS unsigned char* stg_all, int item_f, int wv, int lane) {
    int lane_o = lane; asm volatile("" : "+v"(lane_o));
    constexpr int dir = DIRT; const int hw = wv & 1, r16 = lane_o & 15, g = lane_o >> 4, q4 = r16 >> 2, p4 = r16 & 3;
    const LAS unsigned char* T1 = L + (dir ? AD_B : AD_F); const LAS unsigned char* T2 = T1 + AD_T2;
    LAS unsigned char* stg = stg_all + wv * 4352;
    bf16* const blk = item_blk(F.wsb, item_f + 32 * dir);
    const int rrow = lane_o >> 3, rpc = lane_o & 7;
#define S4_LDV(dst, te_) do { dst[0] = tr_frag(B + AB_VV + ((8 * g + q4) * 136 + 16 * (te_) + 4 * p4) * 2, 4 * AB_LD); dst[1] = tr_frag(B + AB_VV + ((32 + 8 * g + q4) * 136 + 16 * (te_) + 4 * p4) * 2, 4 * AB_LD); } while (0)
#define S4_LDK(dst, td_) do { dst[0] = tr_frag(B + AB_KH + ((8 * g + q4) * 136 + 16 * (td_) + 4 * p4) * 2, 4 * AB_LD); dst[1] = tr_frag(B + AB_KH + ((32 + 8 * g + q4) * 136 + 16 * (td_) + 4 * p4) * 2, 4 * AB_LD); } while (0)
#define S4_OUT(gptr_) do { _Pragma("unroll") for (int p_ = 0; p_ < 4; ++p_) { const LAS unsigned char* sp_ = stg + (rrow + 8 * p_) * 136 + rpc * 16; const u32x2 lo_ = *(const LAS u32x2*)sp_, hi_ = *(const LAS u32x2*)(sp_ + 8); \
        *(v4u*)((gptr_) + (size_t)(rrow + 8 * p_) * ROWE + rpc * 8) = (v4u){lo_.x, lo_.y, hi_.x, hi_.y}; } } while (0)
    {
        bf16x8 a1[4][2];
#pragma unroll
        for (int ti = 0; ti < 4; ++ti)
#pragma unroll
            for (int ks = 0; ks < 2; ++ks) a1[ti][ks] = ld_frag(T1 + (16 * ti + r16) * AD_LDT + ks * 64 + g * 16);
        bf16x8 fx[2][2];
        S4_LDV(fx[0], 4 * hw);
#pragma unroll
        for (int t4 = 0; t4 < 4; ++t4) {
            if (t4 + 1 < 4) S4_LDV(fx[(t4 + 1) & 1], 4 * hw + t4 + 1);
            __builtin_amdgcn_sched_barrier(0);
            const bf16x8 v0 = fx[t4 & 1][0], v1 = fx[t4 & 1][1];
#pragma unroll
            for (int ti = 0; ti < 4; ++ti) { f32x4 acc = (f32x4){0.f, 0.f, 0.f, 0.f};
                if (!(dir == 1 && ti >= 2)) acc = MFMA16(a1[ti][0], v0, acc);
                if (!(dir == 0 && ti < 2)) acc = MFMA16(a1[ti][1], v1, acc);
                u32x2 o; o.x = cvtpk(acc[0], acc[1]); o.y = cvtpk(acc[2], acc[3]);
                *(LAS u32x2*)(stg + (16 * (t4 & 1) + r16) * 136 + (16 * ti + 4 * g) * 2) = o; }
            __builtin_amdgcn_sched_barrier(0);
            if (t4 & 1) { constexpr int ROWE = 64; S4_OUT(blk + IO_UT + (size_t)(64 * hw + 16 * (t4 - 1)) * 64); __builtin_amdgcn_sched_barrier(0); }
        }
    }
    {
        const int tiA = hw ? 1 : 0, tiB = hw ? 2 : 3;
        constexpr bool A0 = true, A1 = (dir == 1), B0 = (dir == 0), B1 = true;
        bf16x8 a2A[2], a2B[2];
#pragma unroll
        for (int ks = 0; ks < 2; ++ks) { a2A[ks] = ld_frag(T2 + (16 * tiA + r16) * AD_LDT + ks * 64 + g * 16); a2B[ks] = ld_frag(T2 + (16 * tiB + r16) * AD_LDT + ks * 64 + g * 16); }
        bf16x8 fx[2][2];
        S4_LDK(fx[0], 0);
#pragma unroll
        for (int td = 0; td < 8; ++td) {
            if (td + 1 < 8) S4_LDK(fx[(td + 1) & 1], td + 1);
            __builtin_amdgcn_sched_barrier(0);
            f32x4 accA = (f32x4){0.f, 0.f, 0.f, 0.f}, accB = (f32x4){0.f, 0.f, 0.f, 0.f};
            const bf16x8 k0 = fx[td & 1][0], k1 = fx[td & 1][1];
            if (A0) accA = MFMA16(k0, a2A[0], accA); if (B0) accB = MFMA16(k0, a2B[0], accB);
            if (A1) accA = MFMA16(k1, a2A[1], accA); if (B1) accB = MFMA16(k1, a2B[1], accB);
            const int idl = 32 * ((td & 3) >> 1) + 8 * g + 4 * (td & 1);
            u32x2 o; o.x = cvtpk(-accA[0], -accA[1]); o.y = cvtpk(-accA[2], -accA[3]);
            *(LAS u32x2*)(stg + r16 * 136 + idl * 2) = o;
            o.x = cvtpk(-accB[0], -accB[1]); o.y = cvtpk(-accB[2], -accB[3]);
            *(LAS u32x2*)(stg + (16 + r16) * 136 + idl * 2) = o;
            __builtin_amdgcn_sched_barrier(0);
            if ((td & 3) == 3) {
                const int hf = td >> 2;
#pragma unroll
                for (int p_ = 0; p_ < 4; ++p_) { const int sr = rrow + 8 * p_; const LAS unsigned char* sp_ = stg + sr * 136 + rpc * 16; const u32x2 lo_ = *(const LAS u32x2*)sp_, hi_ = *(const LAS u32x2*)(sp_ + 8);
                    const int grow = 16 * (sr < 16 ? tiA : tiB) + (sr & 15);
                    *(v4u*)(blk + IO_WN + (size_t)grow * 128 + 64 * hf + rpc * 8) = (v4u){lo_.x, lo_.y, hi_.x, hi_.y}; }
                __builtin_amdgcn_sched_barrier(0); }
        }
    }
#undef S4_LDV
#undef S4_LDK
#undef S4_OUT
}
DI void aprod_s0(Frame& F, LAS float* GV, const LAS float* RAW, int item_f, int h, int lane) {
    const float ga[4] = {RAW[lane], RAW[64 + lane], RAW[128 + lane], RAW[192 + lane]};
    const float xf_ = ga[0] + F.dt_f[h], xb_ = ga[1] + F.dt_b[h];
    const float gf = -__expf(F.a_log_f[h]) * (xf_ > 15.f ? xf_ : __logf(1.0f + __expf(xf_)));
    const float gb = -__expf(F.a_log_b[h]) * (xb_ > 15.f ? xb_ : __logf(1.0f + __expf(xb_)));
    float pf = gf, pb = gb;
#pragma unroll
    for (int o = 1; o < 64; o <<= 1) { const float tf = __shfl_up(pf, o), tb = __shfl_up(pb, o); if (lane >= o) { pf += tf; pb += tb; } }
    const float totf = __shfl(pf, 63), totb = __shfl(pb, 63);
    const float gcf = pf, gcb = totb - pb + gb;
    const float btf_ = __builtin_amdgcn_rcpf(1.0f + __expf(-ga[2])), btb_ = __builtin_amdgcn_rcpf(1.0f + __expf(-ga[3])), egf_ = __expf(gcf), egb_ = __expf(gcb);
    GV[lane] = gcf; GV[64 + lane] = gcb; GV[128 + lane] = btf_; GV[192 + lane] = btb_;
    GV[256 + lane] = egf_; GV[320 + lane] = egb_; GV[384 + lane] = __expf(totf - gcf); GV[448 + lane] = __expf(totb - gcb); GV[512 + lane] = btf_ * egf_; GV[576 + lane] = btb_ * egb_;
    if (lane == 0) { F.CD[item_f] = __expf(totf); F.CD[item_f + 32] = __expf(totb); }
}
DI void aprod_load(Frame& F, v4u (&x)[8], int b, int c, int h, int part, int p0, int c16) {
#pragma unroll
    for (int r = 0; r < 8; ++r) { const int t = c * 64 + p0 - 2 + r; v4u v = (v4u){0u, 0u, 0u, 0u};
        if (t >= 0 && t < SEQ) v = *(const v4u*)(F.PA + ((size_t)b * SEQ + t) * 3072 + part * 1024 + h * 128 + 8 * c16);
        x[r] = v; }
}
DI void aprod_conv(Frame& F, const v4u (&x)[8], float (&o)[4][8], int h, int part, int c16) {
#pragma unroll
    for (int j = 0; j < 4; ++j)
#pragma unroll
        for (int e = 0; e < 8; ++e) o[j][e] = 0.f;
#pragma unroll
    for (int k = 0; k < 5; ++k) { const float* wp = F.conv_w + k * 3072 + part * 1024 + h * 128 + 8 * c16; const f32x4 w0 = *(const f32x4*)wp, w1 = *(const f32x4*)(wp + 4);
#pragma unroll
        for (int j = 0; j < 4; ++j) { const v4u xr = x[j + k];
            o[j][0] += bflo(xr.x) * w0[0]; o[j][1] += bfhi(xr.x) * w0[1]; o[j][2] += bflo(xr.y) * w0[2]; o[j][3] += bfhi(xr.y) * w0[3];
            o[j][4] += bflo(xr.z) * w1[0]; o[j][5] += bfhi(xr.z) * w1[1]; o[j][6] += bflo(xr.w) * w1[2]; o[j][7] += bfhi(xr.w) * w1[3]; } }
#pragma unroll
    for (int j = 0; j < 4; ++j)
#pragma unroll
        for (int e = 0; e < 8; ++e) o[j][e] = silu_f(o[j][e]);
}
DI void aprod_store_rows(LAS unsigned char* img, const float (&o)[4][8], const float (&sc)[4], int p0, int c16) {
#pragma unroll
    for (int j = 0; j < 4; ++j) { v4u w; w.x = cvtpk(o[j][0] * sc[j], o[j][1] * sc[j]); w.y = cvtpk(o[j][2] * sc[j], o[j][3] * sc[j]); w.z = cvtpk(o[j][4] * sc[j], o[j][5] * sc[j]); w.w = cvtpk(o[j][6] * sc[j], o[j][7] * sc[j]);
        *(LAS v4u*)(img + (p0 + j) * AB_LD + c16 * 16) = w; }
}

#ifndef RCK
#define RCK 1
#endif
#ifndef RC2
#define RC2 1
#endif
#ifndef RC3
#define RC3 1
#endif
#ifndef RC4
#define RC4 1
#endif
#ifndef RP1
#define RP1 1
#endif
#ifndef RP2
#define RP2 1
#endif
#ifndef RP3
#define RP3 1
#endif
DI void a_prep_phase(Frame& F) {
    const int lane = F.lane, wave = F.wave;
    LAS unsigned char* L = F.lds + RING_OFF;
    const int nit = (F.vcu < 2048) ? (2048 - F.vcu + F.G - 1) / F.G : 0;
    if (wave < 4) {
#pragma unroll 1
        for (int k = -1; k < nit; ++k) {
            LAS unsigned char* Bc = L + (k & 1) * AB_BUF;
            const LAS float* GVc = (const LAS float*)(L + AG_0 + (k & 1) * AG_SZ);
            const int itc = F.vcu + k * F.G;
            const int item_c = (((itc >> 8) * 8 + (itc & 7)) * 2) * 32 + ((itc >> 3) & 31);
            const bool cons = (k >= 0);
            if (cons) for (int r_ = 0; r_ < RC2; ++r_) { asm volatile("" ::: "memory"); acons_s2(F, L, Bc, GVc, item_c, wave, lane); }
            LBAR();
            if (cons) for (int r_ = 0; r_ < RC3; ++r_) { if (wave == 0) s3_solve<false>(L, Bc + AB_QH, GVc, lane); else if (wave == 1) s3_solve<true>(L, Bc + AB_QH, GVc, lane); else for (int r2_ = 0; r2_ < RCK; ++r2_) { asm volatile("" ::: "memory"); acons_kdect(F, Bc, GVc, item_c + 32 * (wave - 2), wave - 2, lane); } }
            LBAR();
            if (cons) for (int r_ = 0; r_ < RC4; ++r_) { asm volatile("" ::: "memory"); if (wave < 2) acons_s4<0>(F, L, Bc, Bc + AB_QH, item_c, wave, lane); else acons_s4<1>(F, L, Bc, Bc + AB_QH, item_c, wave, lane); }
            LBAR();
        }
    } else {
        const int pw = wave - 4;
        LAS float* RAW = (LAS float*)(L + AG_RAW);
        v4u xq[8], xk[8], xv[8];
        { const int c16 = lane & 15, p0 = 16 * pw + 4 * (lane >> 4);
          if (nit > 0) { const int it = F.vcu; aprod_load(F, xk, it >> 8, (it >> 3) & 31, it & 7, 1, p0, c16); }
          if (wave == 4 && nit > 0) { const int it = F.vcu; const int b = it >> 8, c = (it >> 3) & 31, h = it & 7; const float* gr = F.GATES + ((size_t)b * SEQ + c * 64 + lane) * 32; RAW[lane] = gr[h]; RAW[64 + lane] = gr[8 + h]; RAW[128 + lane] = gr[16 + h]; RAW[192 + lane] = gr[24 + h]; } }
#pragma unroll 1
        for (int k = -1; k < nit; ++k) {
            LAS unsigned char* Bn = L + ((k + 1) & 1) * AB_BUF;
            LAS float* GVn = (LAS float*)(L + AG_0 + ((k + 1) & 1) * AG_SZ);
            const int itn = F.vcu + (k + 1) * F.G;
            const int bn = itn >> 8, cn = (itn >> 3) & 31, hn = itn & 7; const int item_n = ((bn * 8 + hn) * 2) * 32 + cn;
            const bool prod = (k + 1 < nit);
            int lo_ = lane; asm volatile("" : "+v"(lo_));
            const int gI = lo_ >> 4, c16 = lo_ & 15, p0 = 16 * pw + 4 * gI;
            if (prod) {
                if (wave == 4) aprod_s0(F, GVn, RAW, item_n, hn, lane);
                aprod_load(F, xq, bn, cn, hn, 0, p0, c16);
                for (int r_ = 0; r_ < RP1; ++r_) { asm volatile("" ::: "memory");
                float o[4][8]; aprod_conv(F, xk, o, hn, 1, c16);
                float sc[4];
#pragma unroll
                for (int j = 0; j < 4; ++j) { float ss = 0.f;
#pragma unroll
                    for (int e = 0; e < 8; ++e) ss += o[j][e] * o[j][e];
                    sc[j] = 1.0f / sqrtf(row16_sum(ss) + EPS); }
                aprod_store_rows(Bn + AB_KH, o, sc, p0, c16); }
            }
            LBAR();
            if (prod) {
                aprod_load(F, xv, bn, cn, hn, 2, p0, c16);
                float o[4][8]; float sc[4];
                for (int r_ = 0; r_ < RP2; ++r_) { asm volatile("" ::: "memory");
                aprod_conv(F, xq, o, hn, 0, c16);
#pragma unroll
                for (int j = 0; j < 4; ++j) { float ss = 0.f;
#pragma unroll
                    for (int e = 0; e < 8; ++e) ss += o[j][e] * o[j][e];
                    sc[j] = (1.0f / sqrtf(row16_sum(ss) + EPS)) * 0.08838834764831845f; }
                aprod_store_rows(Bn + AB_QH, o, sc, p0, c16); }
#ifndef RPQ
#define RPQ 1
#endif
                for (int r_ = 0; r_ < RPQ; ++r_) { asm volatile("" ::: "memory");
                const int b1 = (c16 >> 1) & 1, qoff = 32 * (c16 >> 2) + 8 * (2 * (c16 & 1) + b1);
#pragma unroll
                for (int j = 0; j < 4; ++j) { const int pos = p0 + j; const float ef = GVn[256 + pos] * sc[j], eb = GVn[320 + pos] * sc[j];
#pragma unroll
                    for (int dd = 0; dd < 2; ++dd) { const float e_ = dd ? eb : ef;
                        const unsigned r0x = cvtpk(o[j][0] * e_, o[j][1] * e_), r0y = cvtpk(o[j][2] * e_, o[j][3] * e_), r1x = cvtpk(o[j][4] * e_, o[j][5] * e_), r1y = cvtpk(o[j][6] * e_, o[j][7] * e_);
                        const unsigned sx = b1 ? r0x : r1x, sy = b1 ? r0y : r1y;
                        const unsigned gx = (unsigned)__builtin_amdgcn_update_dpp(0, (int)sx, 0x4E, 0xf, 0xf, true), gy = (unsigned)__builtin_amdgcn_update_dpp(0, (int)sy, 0x4E, 0xf, 0xf, true);
                        const v4u w = b1 ? (v4u){gx, gy, r1x, r1y} : (v4u){r0x, r0y, gx, gy};
                        *(v4u*)(item_blk(F.wsb, item_n + 32 * dd) + IO_QD + pos * 128 + qoff) = w; } }
                }
            }
            LBAR();
            {
                float g4[4] = {0.f, 0.f, 0.f, 0.f}; const bool more = (k + 2 < nit);
                if (more) { const int it2 = itn + F.G; const int b2 = it2 >> 8, c2 = (it2 >> 3) & 31, h2 = it2 & 7; aprod_load(F, xk, b2, c2, h2, 1, p0, c16);
                    if (wave == 4) { const float* gr = F.GATES + ((size_t)b2 * SEQ + c2 * 64 + lane) * 32; g4[0] = gr[h2]; g4[1] = gr[8 + h2]; g4[2] = gr[16 + h2]; g4[3] = gr[24 + h2]; } }
                if (prod) for (int r_ = 0; r_ < RP3; ++r_) { asm volatile("" ::: "memory"); float o[4][8]; aprod_conv(F, xv, o, hn, 2, c16);
                    const float sc[4] = {1.f, 1.f, 1.f, 1.f};
                    aprod_store_rows(Bn + AB_VV, o, sc, p0, c16); }
                if (more && wave == 4) { RAW[lane] = g4[0]; RAW[64 + lane] = g4[1]; RAW[128 + lane] = g4[2]; RAW[192 + lane] = g4[3]; }
            }
            LBAR();
        }
    }
}

constexpr int B_KB = 0, B_VB = 55296;
DI void b_attn_unit(Frame& F, int b, int nb, int kvh, bf16* MO) {
    const int tid = F.tid, lane = F.lane, wave = F.wave;
    LAS unsigned char* L = F.lds + RING_OFF;
#pragma unroll
    for (int it = 0; it < 6; ++it) { const int q = tid + 512 * it, row = q >> 3, cc = q & 7; const int t = (nb - 1) * 128 + row; const bool valid = (t >= 0) && (t < SEQ);
        v4u kv = (v4u){0u, 0u, 0u, 0u}, vv = (v4u){0u, 0u, 0u, 0u};
        if (valid) { const bf16* rp = F.PB + ((size_t)b * SEQ + t) * 768 + 512 + kvh * 64 + 8 * cc; kv = *(const v4u*)rp; vv = *(const v4u*)(rp + 128); }
        float xk[8]; xk[0] = bflo(kv.x); xk[1] = bfhi(kv.x); xk[2] = bflo(kv.y); xk[3] = bfhi(kv.y); xk[4] = bflo(kv.z); xk[5] = bfhi(kv.z); xk[6] = bflo(kv.w); xk[7] = bfhi(kv.w);
        float ss = 0.f;
#pragma unroll
        for (int e = 0; e < 8; ++e) ss += xk[e] * xk[e];
        ss += __shfl_xor(ss, 1); ss += __shfl_xor(ss, 2); ss += __shfl_xor(ss, 4);
        const float rstd = 1.0f / sqrtf(ss * (1.0f / 64.0f) + EPS);
        const int tt = valid ? t : 0; float o[8];
#pragma unroll
        for (int e = 0; e < 8; ++e) { const float y = xk[e] * rstd * F.k_norm_b[8 * cc + e]; const float pr = __shfl_xor(y, 4);
            const f32x2v cs = *(const f32x2v*)(F.ROPE + ((size_t)tt * 32 + ((8 * cc + e) & 31)) * 2);
            o[e] = (cc < 4) ? (y * cs.x - pr * cs.y) : (y * cs.x + pr * cs.y); }
        v4u ok; ok.x = cvtpk(o[0], o[1]); ok.y = cvtpk(o[2], o[3]); ok.z = cvtpk(o[4], o[5]); ok.w = cvtpk(o[6], o[7]);
        if (!valid) ok = (v4u){0u, 0u, 0u, 0u};
        *(LAS v4u*)(L + B_KB + row * 144 + cc * 16) = ok; *(LAS v4u*)(L + B_VB + row * 144 + cc * 16) = vv; }
    if (tid < 128) *(LAS v4u*)(L + B_VB + (384 + (tid >> 3)) * 144 + (tid & 7) * 16) = (v4u){0u, 0u, 0u, 0u};
    __syncthreads();
    const int hq = kvh * 4 + (wave >> 1), r16 = lane & 15, g = lane >> 4, q4 = r16 >> 2, p4 = r16 & 3;
    const float sk = F.sink_b[hq] * LOG2E;
#pragma unroll 1
    for (int qt = 0; qt < 4; ++qt) {
        const int i0 = (wave & 1) * 64 + 16 * qt, iq = i0 + r16, pos = nb * 128 + iq; const size_t m = (size_t)b * SEQ + pos;
        bf16x8 qf[2];
        { const bf16* qp = F.PB + m * 768 + hq * 64 + 8 * g; const v4u a = *(const v4u*)qp, c2 = *(const v4u*)(qp + 32);
          float x0[8], x1[8]; x0[0] = bflo(a.x); x0[1] = bfhi(a.x); x0[2] = bflo(a.y); x0[3] = bfhi(a.y); x0[4] = bflo(a.z); x0[5] = bfhi(a.z); x0[6] = bflo(a.w); x0[7] = bfhi(a.w);
          x1[0] = bflo(c2.x); x1[1] = bfhi(c2.x); x1[2] = bflo(c2.y); x1[3] = bfhi(c2.y); x1[4] = bflo(c2.z); x1[5] = bfhi(c2.z); x1[6] = bflo(c2.w); x1[7] = bfhi(c2.w);
          float ss = 0.f;
#pragma unroll
          for (int e = 0; e < 8; ++e) ss += x0[e] * x0[e] + x1[e] * x1[e];
          ss += __shfl_xor(ss, 16); ss += __shfl_xor(ss, 32);
          const float rstd = (1.0f / sqrtf(ss * (1.0f / 64.0f) + EPS));
          float o0[8], o1[8];
#pragma unroll
          for (int e = 0; e < 8; ++e) { const float y0 = x0[e] * rstd * F.q_norm_b[8 * g + e], y1 = x1[e] * rstd * F.q_norm_b[32 + 8 * g + e];
              const f32x2v cs = *(const f32x2v*)(F.ROPE + ((size_t)pos * 32 + 8 * g + e) * 2);
              o0[e] = (y0 * cs.x - y1 * cs.y) * (0.125f * LOG2E); o1[e] = (y1 * cs.x + y0 * cs.y) * (0.125f * LOG2E); }
          v4u w0, w1; w0.x = cvtpk(o0[0], o0[1]); w0.y = cvtpk(o0[2], o0[3]); w0.z = cvtpk(o0[4], o0[5]); w0.w = cvtpk(o0[6], o0[7]);
          w1.x = cvtpk(o1[0], o1[1]); w1.y = cvtpk(o1[2], o1[3]); w1.z = cvtpk(o1[4], o1[5]); w1.w = cvtpk(o1[6], o1[7]);
          qf[0] = __builtin_bit_cast(bf16x8, w0); qf[1] = __builtin_bit_cast(bf16x8, w1); }
        f32x4 st[18];
#pragma unroll
        for (int c = 0; c < 17; ++c) { f32x4 acc = (f32x4){0.f, 0.f, 0.f, 0.f};
#pragma unroll
            for (int s = 0; s < 2; ++s) acc = MFMA16(ld_frag(L + B_KB + (i0 + 16 * c + r16) * 144 + s * 64 + g * 16), qf[s], acc);
            st[c] = acc; __builtin_amdgcn_sched_barrier(0); }
        st[17] = (f32x4){0.f, 0.f, 0.f, 0.f};
        float mx = sk;
#pragma unroll
        for (int c = 0; c < 17; ++c)
#pragma unroll
            for (int reg = 0; reg < 4; ++reg) { const int j = i0 + 16 * c + 4 * g + reg; const int kpos = (nb - 1) * 128 + j;
                const bool ok = (j >= iq) && (j <= iq + 256) && (kpos >= 0) && (kpos < SEQ);
                const float v = ok ? st[c][reg] : -INFINITY; st[c][reg] = v; mx = fmaxf(mx, v); }
        mx = fmaxf(mx, __shfl_xor(mx, 16)); mx = fmaxf(mx, __shfl_xor(mx, 32));
        float sum = 0.f;
#pragma unroll
        for (int c = 0; c < 17; ++c)
#pragma unroll
            for (int reg = 0; reg < 4; ++reg) { const float p = __builtin_amdgcn_exp2f(st[c][reg] - mx); st[c][reg] = p; sum += p; }
        sum += __shfl_xor(sum, 16); sum += __shfl_xor(sum, 32);
        const float inv = 1.0f / (sum + __builtin_amdgcn_exp2f(sk - mx));
        bf16x8 pb[9];
#pragma unroll
        for (int kp = 0; kp < 9; ++kp) pb[kp] = pack8(st[2 * kp], st[2 * kp + 1]);
#pragma unroll
        for (int td = 0; td < 4; ++td) { f32x4 acc = (f32x4){0.f, 0.f, 0.f, 0.f};
#pragma unroll
            for (int kp = 0; kp < 9; ++kp) acc = MFMA16(tr_frag(L + B_VB + ((i0 + 32 * kp + 4 * g + q4) * 72 + 16 * td + 4 * p4) * 2, 16 * 144), pb[kp], acc);
            const size_t mo = m * 2048 + 1024 + hq * 64 + 16 * td + 4 * g; const u32x2 z = *(const u32x2*)(F.MIX + mo); bf16* mp = MO + mo;
            u32x2 o; o.x = cvtpk(acc[0] * inv * bflo(z.x), acc[1] * inv * bfhi(z.x)); o.y = cvtpk(acc[2] * inv * bflo(z.y), acc[3] * inv * bfhi(z.y));
            *(u32x2*)mp = o; __builtin_amdgcn_sched_barrier(0); }
    }
    __syncthreads();
}

constexpr int C_KC = 0, C_VC = 69632;
DI void c_attn_unit(Frame& F, int b, int hc, int qblk, bf16* MO) {
    const int tid = F.tid, lane = F.lane, wave = F.wave;
    LAS unsigned char* L = F.lds + RING_OFF;
#pragma unroll
    for (int it = 0; it < 8; ++it) { const int q = tid + 512 * it, row = q >> 4, cc = q & 15;
        const bf16* rp = F.KVM + ((size_t)b * MEMLEN + row) * 1024 + hc * 128 + 8 * cc; const v4u kv = *(const v4u*)rp, vv = *(const v4u*)(rp + 512);
        float xk[8]; xk[0] = bflo(kv.x); xk[1] = bfhi(kv.x); xk[2] = bflo(kv.y); xk[3] = bfhi(kv.y); xk[4] = bflo(kv.z); xk[5] = bfhi(kv.z); xk[6] = bflo(kv.w); xk[7] = bfhi(kv.w);
        float ss = 0.f;
#pragma unroll
        for (int e = 0; e < 8; ++e) ss += xk[e] * xk[e];
        ss += __shfl_xor(ss, 1); ss += __shfl_xor(ss, 2); ss += __shfl_xor(ss, 4); ss += __shfl_xor(ss, 8);
        const float rstd = 1.0f / sqrtf(ss * (1.0f / 128.0f) + EPS);
        float o[8];
#pragma unroll
        for (int e = 0; e < 8; ++e) o[e] = xk[e] * rstd * F.k_norm_c[8 * cc + e];
        v4u ok; ok.x = cvtpk(o[0], o[1]); ok.y = cvtpk(o[2], o[3]); ok.z = cvtpk(o[4], o[5]); ok.w = cvtpk(o[6], o[7]);
        *(LAS v4u*)(L + C_KC + row * 272 + cc * 16) = ok; *(LAS v4u*)(L + C_VC + row * 272 + cc * 16) = vv; }
    __syncthreads();
    const int r16 = lane & 15, g = lane >> 4, q4 = r16 >> 2, p4 = r16 & 3;
#pragma unroll 1
    for (int qt = 0; qt < 2; ++qt) {
        const size_t m = (size_t)b * SEQ + qblk * 256 + wave * 32 + qt * 16 + r16;
        bf16x8 qf[4];
        { float xs[4][8]; float ss = 0.f;
#pragma unroll
          for (int s = 0; s < 4; ++s) { const v4u a = *(const v4u*)(F.PC + m * 512 + hc * 128 + 32 * s + 8 * g);
              xs[s][0] = bflo(a.x); xs[s][1] = bfhi(a.x); xs[s][2] = bflo(a.y); xs[s][3] = bfhi(a.y); xs[s][4] = bflo(a.z); xs[s][5] = bfhi(a.z); xs[s][6] = bflo(a.w); xs[s][7] = bfhi(a.w);
#pragma unroll
              for (int e = 0; e < 8; ++e) ss += xs[s][e] * xs[s][e]; }
          ss += __shfl_xor(ss, 16); ss += __shfl_xor(ss, 32);
          const float rstd = (1.0f / sqrtf(ss * (1.0f / 128.0f) + EPS)) * (0.08838834764831845f * LOG2E);
#pragma unroll
          for (int s = 0; s < 4; ++s) { float o[8];
#pragma unroll
              for (int e = 0; e < 8; ++e) o[e] = xs[s][e] * rstd * F.q_norm_c[32 * s + 8 * g + e];
              v4u w0; w0.x = cvtpk(o[0], o[1]); w0.y = cvtpk(o[2], o[3]); w0.z = cvtpk(o[4], o[5]); w0.w = cvtpk(o[6], o[7]); qf[s] = __builtin_bit_cast(bf16x8, w0); } }
        f32x4 st[16];
#pragma unroll
        for (int c = 0; c < 16; ++c) { f32x4 acc = (f32x4){0.f, 0.f, 0.f, 0.f};
#pragma unroll
            for (int s = 0; s < 4; ++s) acc = MFMA16(ld_frag(L + C_KC + (16 * c + r16) * 272 + s * 64 + g * 16), qf[s], acc);
            st[c] = acc; __builtin_amdgcn_sched_barrier(0); }
        float mx = -INFINITY;
#pragma unroll
        for (int c = 0; c < 16; ++c)
#pragma unroll
            for (int reg = 0; reg < 4; ++reg) mx = fmaxf(mx, st[c][reg]);
        mx = fmaxf(mx, __shfl_xor(mx, 16)); mx = fmaxf(mx, __shfl_xor(mx, 32));
        float sum = 0.f;
#pragma unroll
        for (int c = 0; c < 16; ++c)
#pragma unroll
            for (int reg = 0; reg < 4; ++reg) { const float p = __builtin_amdgcn_exp2f(st[c][reg] - mx); st[c][reg] = p; sum += p; }
        sum += __shfl_xor(sum, 16); sum += __shfl_xor(sum, 32);
        const float inv = 1.0f / sum;
        bf16x8 pb[8];
#pragma unroll
        for (int kp = 0; kp < 8; ++kp) pb[kp] = pack8(st[2 * kp], st[2 * kp + 1]);
#pragma unroll
        for (int td = 0; td < 8; ++td) { f32x4 acc = (f32x4){0.f, 0.f, 0.f, 0.f};
#pragma unroll
            for (int kp = 0; kp < 8; ++kp) acc = MFMA16(tr_frag(L + C_VC + ((32 * kp + 4 * g + q4) * 136 + 16 * td + 4 * p4) * 2, 16 * 272), pb[kp], acc);
            const size_t mo = m * 2048 + 1536 + hc * 128 + 16 * td + 4 * g; const u32x2 z = *(const u32x2*)(F.MIX + mo); bf16* mp = MO + mo;
            u32x2 o; o.x = cvtpk(acc[0] * inv * bflo(z.x), acc[1] * inv * bfhi(z.x)); o.y = cvtpk(acc[2] * inv * bflo(z.y), acc[3] * inv * bfhi(z.y));
            *(u32x2*)mp = o; __builtin_amdgcn_sched_barrier(0); }
    }
    __syncthreads();
}

constexpr int S_WN = 0, S_QD = 18432, S_KT = 36864, S_QK = 55296, S_BUF = 64512;
constexpr int S_OST = 2 * S_BUF, S_OLD = 272;
static_assert(S_OST + 64 * S_OLD <= RING_BYTES, "scan LDS");
#ifdef XBARS
#define XBAR() do { LBAR(); LBAR(); LBAR(); LBAR(); } while (0)
#else
#define XBAR() do {} while (0)
#endif
DI void scan_unit(LAS unsigned char* lds_, int tid, unsigned char* wsb_, const float* CD_, bf16* OF_, bf16* OB_, bf16* DUMP_, int bh, int dir) {
    const int lane = tid & 63, wave = __builtin_amdgcn_readfirstlane(tid >> 6);
    LAS unsigned char* L = lds_ + RING_OFF;
    const int b = bh >> 3, h = bh & 7;
    const int item0 = (bh * 2 + dir) * 32;
    const int r16 = lane & 15, g = lane >> 4;
    const int lt = tid - 256;
    const int e0 = wave * 32 + r16;
    if (wave == 7) {
        __syncthreads();
#pragma unroll 1
        for (int s = 0; s < 32; ++s) {
            if (s > 0) { const int np = dir ? 32 - s : s - 1; bf16* ob = (dir ? OB_ : OF_) + ((size_t)b * SEQ + (size_t)np * 64) * 1024 + h * 128;
#pragma unroll
                for (int i = 0; i < 16; ++i) { const int q = lane + 64 * i, row = q >> 4, cc = q & 15; const v4u v = *(const LAS v4u*)(L + S_OST + row * S_OLD + cc * 16);
                    *(v4u*)(ob + (size_t)row * 1024 + cc * 8) = v; } }
            LBAR(); LBAR(); XBAR();
        }
    } else if (wave >= 4) {
        const int l3 = tid - 256;
#define SC_DOF(p_) ((p_) < 2048 ? (unsigned)(((p_) >> 10) * S_QD + (((p_) & 1023) >> 4) * 288 + ((p_) & 15) * 16) : (p_) < 3072 ? (unsigned)(S_KT + (((p_) - 2048) >> 3) * 144 + ((p_) & 7) * 16) : (unsigned)(S_QK + ((((p_) - 3072) & 511) >> 3) * 144 + ((p_) & 7) * 16))
        const bool last_ok = (l3 + 192 * 18) < 3584;
        v4u ldA[19], ldB[19];
#define SC_LOAD(ld, n_) do { const v4u* ib_ = (const v4u*)item_blk(wsb_, item0 + (n_)) + l3; \
        _Pragma("unroll") for (int i_ = 0; i_ < 18; ++i_) ld[i_] = ib_[192 * i_]; \
        ld[18] = ib_[last_ok ? 192 * 18 : 0]; } while (0)
#define SC_WRITE(ld, bufo_) do { LAS unsigned char* B_ = L + (bufo_); int lo_ = l3; asm volatile("" : "+v"(lo_)); \
        _Pragma("unroll") for (int i_ = 0; i_ < 18; ++i_) { const int p_ = lo_ + 192 * i_; *(LAS v4u*)(B_ + SC_DOF(p_)) = ld[i_]; } \
        if (last_ok) { const int p_ = lo_ + 192 * 18; *(LAS v4u*)(B_ + SC_DOF(p_)) = ld[18]; } } while (0)
#define SC_CH(k_) (dir ? 31 - ((k_) < 31 ? (k_) : 31) : ((k_) < 31 ? (k_) : 31))
        SC_LOAD(ldA, SC_CH(0)); SC_WRITE(ldA, 0); SC_LOAD(ldB, SC_CH(1)); SC_LOAD(ldA, SC_CH(2));
        __syncthreads();
#pragma unroll 1
        for (int s = 0; s < 32; s += 2) {
            SC_WRITE(ldB, S_BUF); SC_LOAD(ldB, SC_CH(s + 3));
            LBAR(); LBAR(); XBAR();
            SC_WRITE(ldA, 0); SC_LOAD(ldA, SC_CH(s + 4));
            LBAR(); LBAR(); XBAR();
        }
        asm volatile("s_waitcnt vmcnt(0)" ::: "memory");
#undef SC_CH
#undef SC_DOF
    } else {
        f32x4 S[2][8];
#pragma unroll
        for (int c = 0; c < 2; ++c)
#pragma unroll
            for (int td = 0; td < 8; ++td) S[c][td] = (f32x4){0.f, 0.f, 0.f, 0.f};
        u32x2 un[2][4]; float cdn;
        { const int n0 = dir ? 31 : 0;
#pragma unroll
          for (int c = 0; c < 2; ++c) { const bf16* up = item_blk(wsb_, item0 + n0) + IO_UT + (e0 + 16 * c) * 64 + 4 * g;
#pragma unroll
              for (int t = 0; t < 4; ++t) un[c][t] = *(const u32x2*)(up + 16 * t); }
          cdn = CD_[item0 + n0]; }
        __syncthreads();
#pragma unroll 1
        for (int s = 0; s < 32; ++s) {
            const LAS unsigned char* Bf = L + (s & 1) * S_BUF;
            const float cd = cdn;
            f32x4 vacc[2][4];
#pragma unroll
            for (int c = 0; c < 2; ++c)
#pragma unroll
                for (int t = 0; t < 4; ++t) { const u32x2 uu = un[c][t]; vacc[c][t] = (f32x4){bflo(uu.x), bfhi(uu.x), bflo(uu.y), bfhi(uu.y)}; }
            if (s + 1 < 32) { const int nn = dir ? 30 - s : s + 1;
#pragma unroll
                for (int c = 0; c < 2; ++c) { const bf16* up = item_blk(wsb_, item0 + nn) + IO_UT + (e0 + 16 * c) * 64 + 4 * g;
#pragma unroll
                    for (int t = 0; t < 4; ++t) un[c][t] = *(const u32x2*)(up + 16 * t); }
                cdn = CD_[item0 + nn]; }
            bf16x8 Sb[2][4];
#pragma unroll
            for (int c = 0; c < 2; ++c)
#pragma unroll
                for (int ks = 0; ks < 4; ++ks) Sb[c][ks] = pack8(S[c][2 * ks], S[c][2 * ks + 1]);
            bf16x8 fa[4], fb[4];
#define SC_SB() __builtin_amdgcn_sched_barrier(0)
#define SC_LD4(dst, base_, row_, rstride_) do { dst[0] = ld_frag(Bf + (base_) + ((row_) + r16) * (rstride_) + g * 16); dst[1] = ld_frag(Bf + (base_) + ((row_) + r16) * (rstride_) + 64 + g * 16); \
        dst[2] = ld_frag(Bf + (base_) + ((row_) + r16) * (rstride_) + 128 + g * 16); dst[3] = ld_frag(Bf + (base_) + ((row_) + r16) * (rstride_) + 192 + g * 16); } while (0)
#define SC_MM4(acc_, src, t_) do { acc_[0][t_] = MFMA16(src[0], Sb[0][0], acc_[0][t_]); acc_[1][t_] = MFMA16(src[0], Sb[1][0], acc_[1][t_]); acc_[0][t_] = MFMA16(src[1], Sb[0][1], acc_[0][t_]); acc_[1][t_] = MFMA16(src[1], Sb[1][1], acc_[1][t_]); \
        acc_[0][t_] = MFMA16(src[2], Sb[0][2], acc_[0][t_]); acc_[1][t_] = MFMA16(src[2], Sb[1][2], acc_[1][t_]); acc_[0][t_] = MFMA16(src[3], Sb[0][3], acc_[0][t_]); acc_[1][t_] = MFMA16(src[3], Sb[1][3], acc_[1][t_]); } while (0)
#define SC_MMV(src, t_) SC_MM4(vacc, src, t_)
#define SC_MMO(src, t_) SC_MM4(oacc, src, t_)
#ifndef RSC1
#define RSC1 1
#endif
            f32x4 vsave[2][4];
            if (RSC1 > 1) { _Pragma("unroll") for (int c = 0; c < 2; ++c) _Pragma("unroll") for (int t = 0; t < 4; ++t) vsave[c][t] = vacc[c][t]; }
            for (int r5_ = 0; r5_ < RSC1; ++r5_) {
            if (RSC1 > 1) { _Pragma("unroll") for (int c = 0; c < 2; ++c) _Pragma("unroll") for (int t = 0; t < 4; ++t) vacc[c][t] = vsave[c][t]; asm volatile("" : "+v"(Sb[0][0]), "+v"(Sb[1][0]), "+v"(Sb[0][1]), "+v"(Sb[1][1]), "+v"(Sb[0][2]), "+v"(Sb[1][2]), "+v"(Sb[0][3]), "+v"(Sb[1][3]) :: "memory"); }
            SC_LD4(fa, S_WN, 0, 288); SC_SB();
            SC_LD4(fb, S_WN, 16, 288); SC_SB(); SC_MMV(fa, 0); SC_SB();
            SC_LD4(fa, S_WN, 32, 288); SC_SB(); SC_MMV(fb, 1); SC_SB();
            SC_LD4(fb, S_WN, 48, 288); SC_SB(); SC_MMV(fa, 2); SC_SB();
            SC_LD4(fa, S_QD, 0, 288); SC_SB(); SC_MMV(fb, 3); SC_SB(); }
            bf16x8 Vb[2][2];
#pragma unroll
            for (int c = 0; c < 2; ++c)
#pragma unroll
                for (int kp = 0; kp < 2; ++kp) Vb[c][kp] = pack8(vacc[c][2 * kp], vacc[c][2 * kp + 1]);
            f32x4 oacc[2][4];
#pragma unroll
            for (int c = 0; c < 2; ++c)
#pragma unroll
                for (int t = 0; t < 4; ++t) oacc[c][t] = (f32x4){0.f, 0.f, 0.f, 0.f};
            SC_LD4(fb, S_QD, 16, 288); SC_SB(); SC_MMO(fa, 0); SC_SB();
            SC_LD4(fa, S_QD, 32, 288); SC_SB(); SC_MMO(fb, 1); SC_SB();
            SC_LD4(fb, S_QD, 48, 288); SC_SB(); SC_MMO(fa, 2); SC_SB();
#define SC_LDQK(dst, t0_) do { dst[0] = ld_frag(Bf + S_QK + (16 * (t0_) + r16) * 144 + g * 16); dst[1] = ld_frag(Bf + S_QK + (16 * (t0_) + r16) * 144 + 64 + g * 16); \
        dst[2] = ld_frag(Bf + S_QK + (16 * ((t0_) + 1) + r16) * 144 + g * 16); dst[3] = ld_frag(Bf + S_QK + (16 * ((t0_) + 1) + r16) * 144 + 64 + g * 16); } while (0)
#define SC_MMQK1(f0_, f1_, t_) do { oacc[0][t_] = MFMA16(f0_, Vb[0][0], oacc[0][t_]); oacc[1][t_] = MFMA16(f0_, Vb[1][0], oacc[1][t_]); oacc[0][t_] = MFMA16(f1_, Vb[0][1], oacc[0][t_]); oacc[1][t_] = MFMA16(f1_, Vb[1][1], oacc[1][t_]); } while (0)
#define SC_MMQK(src, t0_) do { SC_MMQK1(src[0], src[1], (t0_)); SC_MMQK1(src[2], src[3], (t0_) + 1); } while (0)
            SC_LDQK(fa, 0); SC_SB(); SC_MMO(fb, 3); SC_SB();
            SC_LDQK(fb, 2); SC_SB(); SC_MMQK(fa, 0); SC_SB();
#define SC_LDKT(dst, td0_) do { dst[0] = ld_frag(Bf + S_KT + (16 * (td0_) + r16) * 144 + g * 16); dst[1] = ld_frag(Bf + S_KT + (16 * (td0_) + r16) * 144 + 64 + g * 16); \
        dst[2] = ld_frag(Bf + S_KT + (16 * ((td0_) + 1) + r16) * 144 + g * 16); dst[3] = ld_frag(Bf + S_KT + (16 * ((td0_) + 1) + r16) * 144 + 64 + g * 16); } while (0)
#define SC_MMKT1(f0_, f1_, td_) do { f32x4 a0_ = S[0][td_] * cd, a1_ = S[1][td_] * cd; a0_ = MFMA16(f0_, Vb[0][0], a0_); a1_ = MFMA16(f0_, Vb[1][0], a1_); a0_ = MFMA16(f1_, Vb[0][1], a0_); a1_ = MFMA16(f1_, Vb[1][1], a1_); S[0][td_] = a0_; S[1][td_] = a1_; } while (0)
#define SC_MMKT(src, td0_) do { SC_MMKT1(src[0], src[1], (td0_)); SC_MMKT1(src[2], src[3], (td0_) + 1); } while (0)
            SC_LDKT(fa, 0); SC_SB(); SC_MMQK(fb, 2); SC_SB();
            LBAR();
#pragma unroll
            for (int c = 0; c < 2; ++c)
#pragma unroll
                for (int t = 0; t < 4; ++t) { const unsigned p01 = cvtpk(oacc[c][t][0], oacc[c][t][1]), p23 = cvtpk(oacc[c][t][2], oacc[c][t][3]); LAS unsigned char* op = L + S_OST + (16 * t + 4 * g) * S_OLD + (e0 + 16 * c) * 2;
                    *(LAS bf16*)(op) = (bf16)(p01 & 0xffffu); *(LAS bf16*)(op + S_OLD) = (bf16)(p01 >> 16); *(LAS bf16*)(op + 2 * S_OLD) = (bf16)(p23 & 0xffffu); *(LAS bf16*)(op + 3 * S_OLD) = (bf16)(p23 >> 16); }
            SC_SB();
            SC_LDKT(fb, 2); SC_SB(); SC_MMKT(fa, 0); SC_SB();
            SC_LDKT(fa, 4); SC_SB(); SC_MMKT(fb, 2); SC_SB();
            SC_LDKT(fb, 6); SC_SB(); SC_MMKT(fa, 4); SC_SB();
            SC_MMKT(fb, 6);
#undef SC_SB
#undef SC_LD4
#undef SC_MMV
#undef SC_MM4
#undef SC_MMO
#undef SC_LDQK
#undef SC_MMQK
#undef SC_MMQK1
#undef SC_MMKT1
#undef SC_LDKT
#undef SC_MMKT
            LBAR(); XBAR();
        }
    }
    { const int np = dir ? 0 : 31;
#pragma unroll
      for (int i = 0; i < 2; ++i) { const int q = tid + 512 * i, row = q >> 4, cc = q & 15; const v4u v = *(const LAS v4u*)(L + S_OST + row * S_OLD + cc * 16);
          *(v4u*)((dir ? OB_ : OF_) + ((size_t)b * SEQ + (size_t)np * 64 + row) * 1024 + h * 128 + cc * 8) = v; } }
    __syncthreads();
#undef SC_LOAD
#undef SC_WRITE
}

DI void combine_row(Frame& F, size_t m, bf16* MO) {
    const int lane = F.lane; const size_t off = m * 1024 + 16 * lane;
    const v4u f0 = *(const v4u*)(F.OF + off), f1 = *(const v4u*)(F.OF + off + 8), b0 = *(const v4u*)(F.OB + off), b1 = *(const v4u*)(F.OB + off + 8);
    const bf16* zp = F.MIX + m * 2048 + 16 * lane; const v4u z0 = *(const v4u*)zp, z1 = *(const v4u*)(zp + 8); bf16* mp = MO + m * 2048 + 16 * lane;
    float o[16];
    o[0] = bflo(f0.x) + bflo(b0.x); o[1] = bfhi(f0.x) + bfhi(b0.x); o[2] = bflo(f0.y) + bflo(b0.y); o[3] = bfhi(f0.y) + bfhi(b0.y);
    o[4] = bflo(f0.z) + bflo(b0.z); o[5] = bfhi(f0.z) + bfhi(b0.z); o[6] = bflo(f0.w) + bflo(b0.w); o[7] = bfhi(f0.w) + bfhi(b0.w);
    o[8] = bflo(f1.x) + bflo(b1.x); o[9] = bfhi(f1.x) + bfhi(b1.x); o[10] = bflo(f1.y) + bflo(b1.y); o[11] = bfhi(f1.y) + bfhi(b1.y);
    o[12] = bflo(f1.z) + bflo(b1.z); o[13] = bfhi(f1.z) + bfhi(b1.z); o[14] = bflo(f1.w) + bflo(b1.w); o[15] = bfhi(f1.w) + bfhi(b1.w);
    float ss = 0.f;
#pragma unroll
    for (int e = 0; e < 16; ++e) ss += o[e] * o[e];
    ss += __shfl_xor(ss, 1); ss += __shfl_xor(ss, 2); ss += __shfl_xor(ss, 4);
    const float rstd = 1.0f / sqrtf(ss * (1.0f / 128.0f) + EPS);
    float z[16];
    z[0] = bflo(z0.x); z[1] = bfhi(z0.x); z[2] = bflo(z0.y); z[3] = bfhi(z0.y); z[4] = bflo(z0.z); z[5] = bfhi(z0.z); z[6] = bflo(z0.w); z[7] = bfhi(z0.w);
    z[8] = bflo(z1.x); z[9] = bfhi(z1.x); z[10] = bflo(z1.y); z[11] = bfhi(z1.y); z[12] = bflo(z1.z); z[13] = bfhi(z1.z); z[14] = bflo(z1.w); z[15] = bfhi(z1.w);
    const int c0 = (16 * lane) & 127; float y[16];
#pragma unroll
    for (int e = 0; e < 16; ++e) y[e] = o[e] * rstd * F.o_norm_a[c0 + e] * z[e];
    v4u w0, w1; w0.x = cvtpk(y[0], y[1]); w0.y = cvtpk(y[2], y[3]); w0.z = cvtpk(y[4], y[5]); w0.w = cvtpk(y[6], y[7]);
    w1.x = cvtpk(y[8], y[9]); w1.y = cvtpk(y[10], y[11]); w1.z = cvtpk(y[12], y[13]); w1.w = cvtpk(y[14], y[15]);
    *(v4u*)mp = w0; *(v4u*)(mp + 8) = w1;
}

struct Args { const float* in[18]; float* out; unsigned char* ws; int ph_lo, ph_hi, li, pad; };
__global__ void __launch_bounds__(NWAVES * 64, 2) hybrid_fwd(Args args) {
    extern __shared__ __attribute__((aligned(16))) unsigned char lds[];
    Frame F;
    F.lds = (LAS unsigned char*)lds;
    F.MISC = (volatile LAS unsigned*)(F.lds + MISC_OFF);
    F.tid = threadIdx.x; F.lane = F.tid & 63; F.wave = __builtin_amdgcn_readfirstlane(F.tid >> 6);
    F.G = gridDim.x; { const int bx = blockIdx.x; F.vcu = (F.G % 8 == 0) ? (bx % 8) * (F.G / 8) + bx / 8 : bx; }
    unsigned char* ws = args.ws;
    F.ctl = (gu32*)(ws + WS_CTL); F.wsb = ws;
    F.x = args.in[0]; F.mem = args.in[1]; F.norm_w = args.in[2]; F.w_in = args.in[3]; F.conv_w = args.in[4]; F.a_log_f = args.in[5]; F.a_log_b = args.in[6];
    F.dt_f = args.in[7]; F.dt_b = args.in[8]; F.o_norm_a = args.in[9]; F.q_norm_b = args.in[10]; F.k_norm_b = args.in[11]; F.sink_b = args.in[12];
    F.mem_norm_w = args.in[13]; F.w_mem_kv = args.in[14]; F.q_norm_c = args.in[15]; F.k_norm_c = args.in[16]; F.w_out = args.in[17]; F.out = args.out;
    F.WinT = (bf16*)(ws + WS_WIN); F.WmemT = (bf16*)(ws + WS_WMEM); F.WoutT = (bf16*)(ws + WS_WOUT); F.XN = (bf16*)(ws + WS_XN); F.MEMN = (bf16*)(ws + WS_MEMN);
    F.PA = (bf16*)(ws + WS_PA); F.PB = (bf16*)(ws + WS_PB); F.PC = (bf16*)(ws + WS_PC); F.MIX = (bf16*)(ws + WS_MIX); F.KVM = (bf16*)(ws + WS_KVM);
    F.UT = (bf16*)(ws + WS_UT); F.WNEG = (bf16*)(ws + WS_WNEG); F.QDEC = (bf16*)(ws + WS_QDEC); F.KDECT = (bf16*)(ws + WS_KDECT); F.QKM = (bf16*)(ws + WS_QKM);
    F.OF = (bf16*)(ws + WS_OF); F.OB = (bf16*)(ws + WS_OB);
    F.GATES = (float*)(ws + WS_GATES); F.ROPE = (float*)(ws + WS_ROPE); F.CD = (float*)(ws + WS_CD);
    for (int u = F.tid; u < (LDS_BYTES - LDSCTL_OFF) / 4; u += NWAVES * 64) ((LAS unsigned*)(F.lds + LDSCTL_OFF))[u] = 0u;
    __syncthreads();
    XcdBarrier bar; bar.bar = (unsigned*)(F.ctl + CW_BAR); bar.x = 0; bar.st = nullptr;
    if (N_LAUNCHES != PER_PHASE) bar = xcd_barrier_post((unsigned*)(F.ctl + CW_BAR), F.MISC + 8);
#define GRID_BAR() do { if (N_LAUNCHES == PER_PHASE) { if (F.tid == 0) __hip_atomic_store(F.ctl + CW_TMO, 0xBADBA0u, RLX_AGENT); } else { xcd_barrier(bar); } } while (0)
    const int lo = args.ph_lo, hi = args.ph_hi;
#define IN(k) (lo <= (k) && (k) < hi)
#define BOTH(k) (IN(k) && IN((k) + 1))

#ifndef REP0
#define REP0 1
#endif
#ifndef REP1
#define REP1 1
#endif
#ifndef REP2A
#define REP2A 1
#endif
#ifndef REP2B
#define REP2B 1
#endif
#ifndef REP2C
#define REP2C 1
#endif
#ifndef REP3
#define REP3 1
#endif
#ifndef REP4
#define REP4 1
#endif
#ifndef REP5
#define REP5 1
#endif
#ifndef REPBAR
#define REPBAR 1
#endif
#ifndef DUMMY
#define DUMMY 0
#endif
    if (DUMMY > 0) {
        f32x4 da[4]; bf16x8 dx = (bf16x8){(short)F.lane, 1, 2, 3, 4, 5, 6, 7};
        for (int q = 0; q < 4; ++q) da[q] = (f32x4){0.f, 0.f, 0.f, 0.f};
        for (int it = 0; it < DUMMY; ++it) {
#pragma unroll
            for (int r = 0; r < 16; ++r) { da[0] = MFMA16(dx, dx, da[0]); da[1] = MFMA16(dx, dx, da[1]); da[2] = MFMA16(dx, dx, da[2]); da[3] = MFMA16(dx, dx, da[3]); } }
        asm volatile("" :: "v"(da[0]), "v"(da[1]), "v"(da[2]), "v"(da[3]));
    }
    bf16* const DRY = (bf16*)F.out;
    if (IN(0)) { for (int rep = 0; rep < REP0; ++rep) p0_prologue(F); if (BOTH(0)) for (int rep = 0; rep < REPBAR; ++rep) GRID_BAR(); }

    if (IN(1)) {
        pg8::Gemm g{F.XN, F.WinT, M + NBATCH * MEMLEN, 6656 + 1024, DMODEL}; pg8::InOrder S; S.init(F.G, (int)blockIdx.x, REP1);
        pg8::EpiIn E{F.PA, F.PB, F.PC, F.MIX, F.KVM, F.GATES};
        pg8::gemm_phase<pg8::EpiIn, pg8::InOrder, true, true>(F.lds + RING_OFF, g, S, E);
        if (BOTH(1)) GRID_BAR();
    }

    if (IN(2)) {
        for (int rep = 0; rep < REP2A; ++rep) a_prep_phase(F);
        if (BOTH(2)) GRID_BAR();
    }

    if (IN(3)) {
        for (int rep = 0; rep < REP3; ++rep) for (int it = F.vcu; it < 128; it += F.G) scan_unit(F.lds, F.tid, F.wsb, F.CD, F.OF, F.OB, (bf16*)F.out + (size_t)blockIdx.x * 65536, it >> 1, it & 1);
        for (;;) {
            if (F.tid == 0) F.MISC[16] = __hip_atomic_fetch_add(F.ctl + CW_WQ, 1u, RLX_AGENT);
            __syncthreads();
            const unsigned id = F.MISC[16];
            __syncthreads();
            if (id >= 512u * REP2B) break;
            const int it = (int)(id & 255u);
            if ((id & 511u) < 256u) b_attn_unit(F, it >> 5, (it >> 1) & 15, it & 1, id < 512u ? F.MIX : DRY);
            else c_attn_unit(F, it >> 5, (it >> 3) & 3, it & 7, id < 512u ? F.MIX : DRY);
        }
        if (BOTH(3)) GRID_BAR();
    }

#ifdef BWTEST
    if (IN(3)) {
        if ((int)F.vcu < BWTEST) {
            const size_t total = (size_t)IB_SPLIT * IB_BYTES / 16;
            const v4u* base = (const v4u*)(ws + WS_IA);
            const size_t per = total / BWTEST; const v4u* p = base + per * F.vcu; v4u acc = (v4u){0u, 0u, 0u, 0u};
            for (size_t i = F.tid; i + 512 * (BW_DEPTH - 1) < per; i += 512 * BW_DEPTH) {
                v4u t[BW_DEPTH];
#pragma unroll
                for (int k = 0; k < BW_DEPTH; ++k) t[k] = p[i + 512 * k];
#pragma unroll
                for (int k = 0; k < BW_DEPTH; ++k) acc ^= t[k]; }
            if (acc.x == 0x12345678u && acc.y == 0x9abcdef0u) F.ctl[200] = acc.z;
        }
        GRID_BAR();
    }
#endif
    if (IN(4)) {
        const int gw = F.vcu * NWAVES + F.wave, NGW = F.G * NWAVES;
        for (int rep = 0; rep < REP4; ++rep) for (int m = gw; m < M; m += NGW) combine_row(F, (size_t)m, rep == REP4 - 1 ? F.MIX : DRY);
        if (BOTH(4)) GRID_BAR();
    }

    if (IN(5)) {
        pg8::Gemm g{F.MIX, F.WoutT, M, DMODEL, DMODEL}; pg8::RepOrder S; S.init(M, DMODEL, F.G, (int)blockIdx.x, REP5);
        pg8::EpiOut E{F.x, F.out};
        pg8::gemm_phase<pg8::EpiOut, pg8::RepOrder, true, true>(F.lds + RING_OFF, g, S, E);
    }
#undef IN
#undef BOTH
}

extern "C" void kernel_launch(void* const* d_in, const int* in_sizes, int n_in, void* d_out, int out_size, void* d_ws, size_t ws_size, hipStream_t stream) {
    static int grid = 0;
    if (grid == 0) {
        if (n_in != 18 || in_sizes[0] != M * DMODEL || out_size != M * DMODEL || ws_size < WS_END) { fprintf(stderr, "kernel_launch: unexpected problem shape (n_in %d, in0 %d, out %d, ws %zu); nothing launched\n", n_in, n_in > 0 ? in_sizes[0] : -1, out_size, ws_size); grid = -1; return; }
        int dev = 0, cus = 0, per_cu = 0;
        if (hipGetDevice(&dev) != hipSuccess || hipDeviceGetAttribute(&cus, hipDeviceAttributeMultiprocessorCount, dev) != hipSuccess) { fprintf(stderr, "kernel_launch: device query failed\n"); grid = -1; return; }
        if (hipFuncSetAttribute((const void*)hybrid_fwd, hipFuncAttributeMaxDynamicSharedMemorySize, LDS_BYTES) != hipSuccess) { fprintf(stderr, "kernel_launch: hipFuncSetAttribute failed\n"); grid = -1; return; }
        if (hipOccupancyMaxActiveBlocksPerMultiprocessor(&per_cu, (const void*)hybrid_fwd, NWAVES * 64, LDS_BYTES) != hipSuccess || per_cu < 1)
            fprintf(stderr, "kernel_launch: note: occupancy query reports %d workgroups per CU\n", per_cu);
        (void)hipGetLastError();
        grid = cus;
    }
    if (grid < 0) return;
    if (hipMemsetAsync((char*)d_ws + WS_CTL, 0, CTL_ZERO_BYTES, stream) != hipSuccess) { fprintf(stderr, "kernel_launch: hipMemsetAsync failed\n"); return; }
    Args a{};
    for (int i = 0; i < 18; ++i) a.in[i] = (const float*)d_in[i];
    a.out = (float*)d_out; a.ws = (unsigned char*)d_ws;
    for (int li = 0; li < N_LAUNCHES; ++li) {
        a.ph_lo = (N_LAUNCHES == PER_PHASE) ? li : 0; a.ph_hi = (N_LAUNCHES == PER_PHASE) ? li + 1 : PER_PHASE; a.li = li;
        hipLaunchKernelGGL(hybrid_fwd, dim3(grid), dim3(NWAVES * 64), LDS_BYTES, stream, a);
        const hipError_t le = hipPeekAtLastError();
        if (le != hipSuccess) { fprintf(stderr, "kernel_launch: launch %d failed: %s\n", li, hipGetErrorName(le)); break; }
    }
}
```

```cpp
#include <hip/hip_runtime.h>
#include <cstdio>
#include <cstdint>
namespace pg8 {
#define PG8_LAS __attribute__((address_space(3)))
typedef unsigned short bf16_t;
typedef short bf16x8 __attribute__((ext_vector_type(8)));
typedef float f32x4 __attribute__((ext_vector_type(4)));
typedef unsigned u32x4 __attribute__((ext_vector_type(4)));
constexpr int BM = 256, BK = 64, HALF = 128, HTB = HALF * BK * 2  , STAGE_BYTES = 8 * HTB, NXCD = 8, WGM = 8;

__host__ __device__ __forceinline__ int lds_byte(int r, int c) { const int st = (r >> 4) * 2 + (c >> 5), rr = r & 15, cc = c & 31, ob = rr * 64 + cc * 2; return st * 1024 + (ob ^ (((ob >> 9) & 1) << 5)); }
__host__ __device__ __forceinline__ void stage_rc(int b, int& R, int& C) { const int st = b / 1024, sb = b % 1024, swz = sb ^ (((sb >> 9) & 1) << 5); R = (st >> 1) * 16 + swz / 64; C = (st & 1) * 32 + (swz % 64) / 2; }
__host__ __device__ __forceinline__ int perm32(int rho) { const int n = rho >> 4, i = rho & 15; return 8 * (i >> 2) + 4 * n + (i & 3); }

struct Unit { int pm, pn; };
struct Gemm { const bf16_t* A; const bf16_t* Bt; int M, N, K; };

struct StaticOrder {
    int nM, nN, nwg, G, c;
    __host__ __device__ void init(int M, int N, int G_, int c_) { nM = M / BM; nN = N / BM; nwg = nM * nN; G = G_; c = c_; }
    __host__ __device__ bool next(int i, Unit& u) const {
        const long L = (long)i * G + c; if (L >= nwg) return false;
        int wgid = (int)L; { const int q = nwg / NXCD, r = nwg % NXCD, xcd = wgid % NXCD, off = wgid / NXCD; wgid = (xcd < r ? xcd * (q + 1) : r * (q + 1) + (xcd - r) * q) + off; }
        const int nig = WGM * nN, gid = wgid / nig, fm = gid * WGM, gsz = (nM - fm) < WGM ? (nM - fm) : WGM;
        u.pm = fm + ((wgid % nig) % gsz); u.pn = (wgid % nig) / gsz; return true;
    }
    __device__ __forceinline__ void a_ready(const Unit&) const {}
    __device__ __forceinline__ void done(const Unit&) const {}
};

typedef float f32x2 __attribute__((ext_vector_type(2)));
typedef __bf16 bf16x2_t __attribute__((ext_vector_type(2)));
__device__ __forceinline__ unsigned cvt_pk_bf16(float lo, float hi) { f32x2 v = {lo, hi}; bf16x2_t b = __builtin_convertvector(v, bf16x2_t); return __builtin_bit_cast(unsigned, b); }
__device__ __forceinline__ float silu_f(float v) { return v * __builtin_amdgcn_rcpf(1.0f + __expf(-v)); }

struct EpiIn {
    static constexpr bool PERM = true, AFTER_DRAIN = false;
    bf16_t *PA, *PB, *PC, *MIX, *KVM; float* GATES;
    __device__ __forceinline__ void init(f32x4 (&acc)[2][2][4][2], const Unit&, int, int, int, int) const {
#pragma unroll
        for (int a = 0; a < 2; ++a)
#pragma unroll
            for (int b = 0; b < 2; ++b)
#pragma unroll
                for (int m = 0; m < 4; ++m)
#pragma unroll
                    for (int n = 0; n < 2; ++n) acc[a][b][m][n] = (f32x4){0.f, 0.f, 0.f, 0.f};
    }
    __device__ __forceinline__ void operator()(const f32x4 (&acc)[2][2][4][2], const Unit& u, int wr, int wc, int fr, int fq) const {
        const int row0 = u.pm * BM + wr * 64 + fr, cl = wc * 32 + 8 * fq, pn = u.pn;
        if (u.pm < 64 && pn == 25) {
            if (wc == 0) {
#pragma unroll
                for (int ai = 0; ai < 2; ++ai)
#pragma unroll
                    for (int m = 0; m < 4; ++m) { float* g = GATES + (size_t)(row0 + ai * HALF + m * 16) * 32 + 8 * fq;
                        *(f32x4*)g = acc[ai][0][m][0]; *(f32x4*)(g + 4) = acc[ai][0][m][1]; }
            }
            return;
        }
        bf16_t* base; int ldc; bool act = false;
        if (u.pm >= 64) { base = KVM + (size_t)(row0 - 16384) * 1024 + (pn - 26) * 256; ldc = 1024; }
        else if (pn < 12) { base = PA + (size_t)row0 * 3072 + pn * 256; ldc = 3072; }
        else if (pn < 16) { base = MIX + (size_t)row0 * 2048 + (pn - 12) * 256; ldc = 2048; act = true; }
        else if (pn < 19) { base = PB + (size_t)row0 * 768 + (pn - 16) * 256; ldc = 768; }
        else if (pn < 21) { base = MIX + (size_t)row0 * 2048 + 1024 + (pn - 19) * 256; ldc = 2048; act = true; }
        else if (pn < 23) { base = PC + (size_t)row0 * 512 + (pn - 21) * 256; ldc = 512; }
        else { base = MIX + (size_t)row0 * 2048 + 1536 + (pn - 23) * 256; ldc = 2048; act = true; }
        base += cl;
#pragma unroll
        for (int ai = 0; ai < 2; ++ai)
#pragma unroll
            for (int m = 0; m < 4; ++m) { bf16_t* rowp = base + (size_t)(ai * HALF + m * 16) * ldc;
#pragma unroll
                for (int bj = 0; bj < 2; ++bj) { f32x4 v0 = acc[ai][bj][m][0], v1 = acc[ai][bj][m][1];
                    if (act) { v0 = (f32x4){silu_f(v0[0]), silu_f(v0[1]), silu_f(v0[2]), silu_f(v0[3])}; v1 = (f32x4){silu_f(v1[0]), silu_f(v1[1]), silu_f(v1[2]), silu_f(v1[3])}; }
                    u32x4 w; w.x = cvt_pk_bf16(v0[0], v0[1]); w.y = cvt_pk_bf16(v0[2], v0[3]); w.z = cvt_pk_bf16(v1[0], v1[1]); w.w = cvt_pk_bf16(v1[2], v1[3]);
                    *(u32x4*)(rowp + bj * HALF) = w; } }
    }
};
struct EpiOut {
    static constexpr bool PERM = false, AFTER_DRAIN = false;
    const float* X; float* O;
    __device__ __forceinline__ void init(f32x4 (&acc)[2][2][4][2], const Unit& u, int wr, int wc, int fr, int fq) const {
        const int row0 = u.pm * BM + wr * 64 + fr, col0 = u.pn * BM + wc * 32 + 4 * fq;
#pragma unroll
        for (int ai = 0; ai < 2; ++ai)
#pragma unroll
            for (int m = 0; m < 4; ++m) { const size_t off = (size_t)(row0 + ai * HALF + m * 16) * 2048 + col0;
#pragma unroll
                for (int bj = 0; bj < 2; ++bj)
#pragma unroll
                    for (int n = 0; n < 2; ++n) acc[ai][bj][m][n] = *(const f32x4*)(X + off + bj * HALF + n * 16); }
    }
    __device__ __forceinline__ void operator()(const f32x4 (&acc)[2][2][4][2], const Unit& u, int wr, int wc, int fr, int fq) const {
        const int row0 = u.pm * BM + wr * 64 + fr, col0 = u.pn * BM + wc * 32 + 4 * fq;
#pragma unroll
        for (int ai = 0; ai < 2; ++ai)
#pragma unroll
            for (int m = 0; m < 4; ++m) { const size_t off = (size_t)(row0 + ai * HALF + m * 16) * 2048 + col0;
#pragma unroll
                for (int bj = 0; bj < 2; ++bj)
#pragma unroll
                    for (int n = 0; n < 2; ++n) *(f32x4*)(O + off + bj * HALF + n * 16) = acc[ai][bj][m][n]; }
    }
};
struct InOrder {
    StaticOrder base; int G, c, rep;
    __host__ __device__ void init(int G_, int c_, int rep_ = 1) { G = G_; c = c_; rep = rep_; base.init(16384, 6656, G_, 0); }
    __host__ __device__ bool next(int i, Unit& u) const {
        long L = (long)i * G + c; const long tot = base.nwg + 32;
        if (L >= tot * rep) return false;
        L %= tot;
        if (L < base.nwg) { StaticOrder b2 = base; b2.c = (int)(L % G); return b2.next((int)(L / G), u); }
        const int j = (int)(L - base.nwg);
        u.pm = 64 + (j >> 2); u.pn = 26 + (j & 3); return true;
    }
    __device__ __forceinline__ void a_ready(const Unit&) const {}
    __device__ __forceinline__ void done(const Unit&) const {}
};
struct RepOrder {
    StaticOrder base; int G, c, rep;
    __host__ __device__ void init(int M_, int N_, int G_, int c_, int rep_ = 1) { G = G_; c = c_; rep = rep_; base.init(M_, N_, G_, 0); }
    __host__ __device__ bool next(int i, Unit& u) const {
        long L = (long)i * G + c; if (L >= (long)base.nwg * rep) return false;
        L %= base.nwg; StaticOrder b2 = base; b2.c = (int)(L % G); return b2.next((int)(L / G), u);
    }
    __device__ __forceinline__ void a_ready(const Unit&) const {}
    __device__ __forceinline__ void done(const Unit&) const {}
};

template <class Epi, class Sched, bool ALIGN_EPI = false, bool SP2 = false>
__device__ __forceinline__ void gemm_phase(PG8_LAS unsigned char* lds, const Gemm g, const Sched& S, const Epi& E) {
    const int tid = threadIdx.x, wid = __builtin_amdgcn_readfirstlane(tid >> 6), lane = tid & 63, wr = wid >> 2, wc = wid & 3, fr = lane & 15, fq = lane >> 4;
    const int K = g.K, nt = K / BK;
    unsigned voffA[2], voffB[2];
#pragma unroll
    for (int i = 0; i < 2; ++i) { int R, C; stage_rc(tid * 16 + i * 8192, R, C); const int Rb = Epi::PERM ? ((R & ~31) + perm32(R & 31)) : R;
        voffA[i] = (unsigned)(R * K + C) * 2u; voffB[i] = (unsigned)(Rb * K + C) * 2u; }
    const size_t kstep = (size_t)(BK * 2);
    const size_t hstep = (size_t)HALF * K * 2;
    const size_t tstep = 2 * hstep;
    const unsigned ldsw = (unsigned)wid * 1024u;
    const int aoff = lds_byte(wr * 64 + fr, fq * 8), boff = lds_byte(wc * 32 + fr, fq * 8);
#define PG8_SA(b, h) (((b) * 2 + (h)) * HTB)
#define PG8_SB(b, h) ((4 + (b) * 2 + (h)) * HTB)
#define PG8_STAGE(bufoff, gbase, voff) do { _Pragma("unroll") for (int _i = 0; _i < 2; ++_i) \
        __builtin_amdgcn_global_load_lds((const unsigned*)((const char*)(gbase) + (voff)[_i]), (PG8_LAS unsigned*)(lds + (bufoff) + ldsw + _i * 8192), 16, 0, 0); } while (0)
#define PG8_LDA(dst, b, h) do { _Pragma("unroll") for (int m = 0; m < 4; ++m) _Pragma("unroll") for (int k = 0; k < 2; ++k) dst[m][k] = *(const PG8_LAS bf16x8*)(lds + PG8_SA(b, h) + aoff + m * 2048 + k * 1024); } while (0)
#define PG8_LDB(dst, b, h) do { _Pragma("unroll") for (int n = 0; n < 2; ++n) _Pragma("unroll") for (int k = 0; k < 2; ++k) dst[n][k] = *(const PG8_LAS bf16x8*)(lds + PG8_SB(b, h) + boff + n * 2048 + k * 1024); } while (0)
#define PG8_MMA(ai, bj, At, Bt) do { __builtin_amdgcn_s_setprio(1); _Pragma("unroll") for (int m = 0; m < 4; ++m) _Pragma("unroll") for (int n = 0; n < 2; ++n) _Pragma("unroll") for (int k = 0; k < 2; ++k) \
        acc[ai][bj][m][n] = __builtin_amdgcn_mfma_f32_16x16x32_bf16(Bt[n][k], At[m][k], acc[ai][bj][m][n], 0, 0, 0); __builtin_amdgcn_s_setprio(0); } while (0)
#define PG8_WAIT_V(n) asm volatile("s_waitcnt vmcnt(" #n ")" ::: "memory")
#define PG8_WAIT_L(n) asm volatile("s_waitcnt lgkmcnt(" #n ")" ::: "memory")
#define PG8_BAR __builtin_amdgcn_s_barrier()
#define PG8_SCHED __builtin_amdgcn_sched_barrier(0)
    Unit cur, nxt; int ui = 0;
    if (!S.next(0, cur)) return;
    f32x4 acc[2][2][4][2];
    E.init(acc, cur, wr, wc, fr, fq);
    bf16x8 At[4][2], B0[2][2], B1[2][2];
    const char* cA = (const char*)g.A + (size_t)cur.pm * tstep; const char* cB = (const char*)g.Bt + (size_t)cur.pn * tstep;
    S.a_ready(cur);
    if constexpr (SP2) {
        PG8_STAGE(PG8_SB(0, 0), cB, voffB); PG8_STAGE(PG8_SB(0, 1), cB + hstep, voffB); PG8_STAGE(PG8_SA(0, 0), cA, voffA); PG8_STAGE(PG8_SA(0, 1), cA + hstep, voffA);
        if (wr == 1) PG8_BAR;
        PG8_WAIT_V(2); PG8_BAR;
        PG8_STAGE(PG8_SB(1, 0), cB + kstep, voffB); PG8_STAGE(PG8_SA(1, 0), cA + kstep, voffA); PG8_STAGE(PG8_SB(1, 1), cB + hstep + kstep, voffB);
        PG8_WAIT_V(6); PG8_BAR;
    } else {
        PG8_STAGE(PG8_SB(0, 0), cB, voffB); PG8_STAGE(PG8_SA(0, 0), cA, voffA); PG8_STAGE(PG8_SB(0, 1), cB + hstep, voffB); PG8_STAGE(PG8_SA(0, 1), cA + hstep, voffA);
        if (wr == 1) PG8_BAR;
        PG8_WAIT_V(4); PG8_BAR;
        PG8_STAGE(PG8_SB(1, 0), cB + kstep, voffB); PG8_STAGE(PG8_SA(1, 0), cA + kstep, voffA); PG8_STAGE(PG8_SB(1, 1), cB + hstep + kstep, voffB);
        PG8_WAIT_V(6); PG8_BAR;
    }
    for (;;) {
        const bool has_next = S.next(ui + 1, nxt);
        const char* nA = has_next ? (const char*)g.A + (size_t)nxt.pm * tstep : cA; const char* nB = has_next ? (const char*)g.Bt + (size_t)nxt.pn * tstep : cB;
        for (int t = 0; t < nt; t += 2) {
            const bool last = (t == nt - 2);
            const char* a1 = cA + (size_t)(t + 1) * kstep;
            const char* a2 = last ? nA : cA + (size_t)(t + 2) * kstep; const char* b2 = last ? nB : cB + (size_t)(t + 2) * kstep;
            const char* a3 = a2 + kstep; const char* b3 = b2 + kstep;
            if (last && has_next) S.a_ready(nxt);
            if constexpr (SP2) {
            PG8_LDB(B0, 0, 0); PG8_LDB(B1, 0, 1); PG8_SCHED; PG8_LDA(At, 0, 0); PG8_STAGE(PG8_SA(1, 1), a1 + hstep, voffA);
            PG8_WAIT_V(8); PG8_WAIT_L(0); PG8_BAR; PG8_MMA(0, 0, At, B0); PG8_MMA(0, 1, At, B1); PG8_BAR; PG8_SCHED;
            PG8_LDA(At, 0, 1); PG8_STAGE(PG8_SB(0, 0), b2, voffB); PG8_STAGE(PG8_SB(0, 1), b2 + hstep, voffB); PG8_STAGE(PG8_SA(0, 0), a2, voffA);
            PG8_WAIT_V(8); PG8_WAIT_L(0); PG8_BAR; PG8_MMA(1, 0, At, B0); PG8_MMA(1, 1, At, B1); PG8_BAR; PG8_SCHED;
            PG8_LDB(B0, 1, 0); PG8_LDB(B1, 1, 1); PG8_SCHED; PG8_LDA(At, 1, 0); PG8_STAGE(PG8_SA(0, 1), a2 + hstep, voffA);
            PG8_WAIT_V(8); PG8_WAIT_L(0); PG8_BAR; PG8_MMA(0, 0, At, B0); PG8_MMA(0, 1, At, B1); PG8_BAR; PG8_SCHED;
            PG8_LDA(At, 1, 1); PG8_STAGE(PG8_SB(1, 0), b3, voffB); PG8_STAGE(PG8_SB(1, 1), b3 + hstep, voffB); PG8_STAGE(PG8_SA(1, 0), a3, voffA);
            PG8_WAIT_V(8); PG8_WAIT_L(0); PG8_BAR; PG8_MMA(1, 0, At, B0); PG8_MMA(1, 1, At, B1); PG8_BAR; PG8_SCHED;
            } else {
            PG8_LDB(B0, 0, 0); PG8_SCHED; PG8_LDA(At, 0, 0); PG8_STAGE(PG8_SA(1, 1), a1 + hstep, voffA);
            PG8_WAIT_L(8); PG8_BAR; PG8_WAIT_L(0); PG8_MMA(0, 0, At, B0); PG8_BAR; PG8_SCHED;
            PG8_LDB(B1, 0, 1); PG8_STAGE(PG8_SB(0, 0), b2, voffB);
            PG8_BAR; PG8_WAIT_L(0); PG8_MMA(0, 1, At, B1); PG8_BAR;
            PG8_LDA(At, 0, 1); PG8_STAGE(PG8_SA(0, 0), a2, voffA);
            PG8_BAR; PG8_WAIT_L(0); PG8_MMA(1, 0, At, B0); PG8_BAR; PG8_SCHED;
            PG8_STAGE(PG8_SB(0, 1), b2 + hstep, voffB);
            PG8_WAIT_V(6); PG8_BAR; PG8_MMA(1, 1, At, B1); PG8_BAR;
            PG8_LDB(B0, 1, 0); PG8_SCHED; PG8_LDA(At, 1, 0); PG8_STAGE(PG8_SA(0, 1), a2 + hstep, voffA);
            PG8_WAIT_L(8); PG8_BAR; PG8_WAIT_L(0); PG8_MMA(0, 0, At, B0); PG8_BAR; PG8_SCHED;
            PG8_LDB(B1, 1, 1); PG8_STAGE(PG8_SB(1, 0), b3, voffB);
            PG8_BAR; PG8_WAIT_L(0); PG8_MMA(0, 1, At, B1); PG8_BAR;
            PG8_LDA(At, 1, 1); PG8_STAGE(PG8_SA(1, 0), a3, voffA);
            PG8_BAR; PG8_WAIT_L(0); PG8_MMA(1, 0, At, B0); PG8_BAR; PG8_SCHED;
            PG8_STAGE(PG8_SB(1, 1), b3 + hstep, voffB);
            PG8_WAIT_V(6); PG8_BAR; PG8_MMA(1, 1, At, B1); PG8_BAR;
            }
        }
        if constexpr (ALIGN_EPI) { if (wr == 0) PG8_BAR; }
        if constexpr (!Epi::AFTER_DRAIN) { E(acc, cur, wr, wc, fr, fq); S.done(cur); }
        if (!has_next) break;
        cur = nxt; cA = nA; cB = nB; ++ui;
        E.init(acc, cur, wr, wc, fr, fq);
        if constexpr (ALIGN_EPI) { if (wr == 1) PG8_BAR; }
    }
    PG8_WAIT_V(0);
    if constexpr (!ALIGN_EPI) { if (wr == 0) PG8_BAR; }
    PG8_BAR;
    if constexpr (Epi::AFTER_DRAIN) { E.fused(acc, cur, wr, wc, fr, fq, lds, wid, lane); S.done(cur); }
#undef PG8_SA
#undef PG8_SB
#undef PG8_STAGE
#undef PG8_LDA
#undef PG8_LDB
#undef PG8_MMA
#undef PG8_WAIT_V
#undef PG8_WAIT_L
#undef PG8_BAR
#undef PG8_SCHED
}
}
#define GAS __attribute__((address_space(1)))
#define LAS __attribute__((address_space(3)))
typedef unsigned short bf16;
typedef unsigned v4u __attribute__((ext_vector_type(4)));
typedef float f32x4 __attribute__((ext_vector_type(4)));
typedef short bf16x8 __attribute__((ext_vector_type(8)));
typedef GAS unsigned gu32;
typedef GAS unsigned long long gu64;
#define RLX_AGENT __ATOMIC_RELAXED, __HIP_MEMORY_SCOPE_AGENT
#define LDS_WAIT() asm volatile("s_waitcnt lgkmcnt(0)" ::: "memory")
#define VM_WAIT() asm volatile("s_waitcnt vmcnt(0)" ::: "memory")
__device__ __forceinline__ unsigned long long rt() { return __builtin_amdgcn_s_memrealtime(); }
__device__ __forceinline__ unsigned f2bf(float f) { unsigned u = __builtin_bit_cast(unsigned, f); return (u + 0x7fffu + ((u >> 16) & 1u)) >> 16; }
__device__ __forceinline__ unsigned pk2(float lo, float hi) { return f2bf(lo) | (f2bf(hi) << 16); }

#define XB_TMO      128
#define XB_XCNT(j)  (256  + 64 * (j))
#define XB_XSUB(j)  (1280 + 64 * (j))
#define XB_XGEN(j)  (2304 + 64 * (j))
#define XB_TOP      3328
#define XB_TOPGEN   3392
#define XCD_BAR_WORDS 3456
#define XB_SPIN_CAP (1u << 18)

__device__ __forceinline__ unsigned xb_ld(unsigned* p)              { return __hip_atomic_load(p, __ATOMIC_RELAXED, __HIP_MEMORY_SCOPE_AGENT); }
__device__ __forceinline__ unsigned xb_add(unsigned* p, unsigned v) { return __hip_atomic_fetch_add(p, v, __ATOMIC_RELAXED, __HIP_MEMORY_SCOPE_AGENT); }
__device__ __forceinline__ unsigned xb_xcc_id() { return (unsigned)__builtin_amdgcn_s_getreg((3 << 11) | 20) & 0xFu; }
#define XB_SPIN(cond, bar) do { unsigned _sp = 0; while (cond) { __builtin_amdgcn_s_sleep(1); \
    if ((++_sp & 255u) == 0u) { if (xb_ld(&(bar)[XB_TMO])) break; if (_sp > XB_SPIN_CAP) { atomicAdd(&(bar)[XB_TMO], 1u); break; } } } } while (0)

struct XcdBarrier {
    unsigned* bar; unsigned x;
    volatile LAS unsigned* st;
};

__device__ __forceinline__ XcdBarrier xcd_barrier_post(unsigned* bar, volatile LAS unsigned* st) {
    XcdBarrier b; b.bar = bar; b.x = xb_xcc_id(); b.st = st;
    if (threadIdx.x == 0) (void)xb_add(&bar[XB_XCNT(b.x)], 1u);
    return b;
}
__device__ __forceinline__ void xcd_barrier_complete(unsigned* bar, unsigned x, unsigned& nloc, unsigned& nx) {
    const unsigned G = gridDim.x * gridDim.y * gridDim.z;
    unsigned sum, cnt, mine, sp = 0u;
    for (;;) {
        sum = 0u; cnt = 0u; mine = 0u;
#pragma unroll
        for (unsigned j = 0; j < 16; ++j) { const unsigned c = xb_ld(&bar[XB_XCNT(j)]); sum += c; cnt += (c > 0u) ? 1u : 0u; mine = (j == x) ? c : mine; }
        if (sum == G) break;
        __builtin_amdgcn_s_sleep(1);
        if ((++sp & 255u) == 0u) { if (xb_ld(&bar[XB_TMO])) break; if (sp > XB_SPIN_CAP) { atomicAdd(&bar[XB_TMO], 1u); break; } }
    }
    nloc = mine > 0u ? mine : 1u; nx = cnt > 0u ? cnt : 1u;
}

__device__ __forceinline__ void xcd_barrier(const XcdBarrier& b) {
    asm volatile("s_waitcnt vmcnt(0)" ::: "memory");
    __syncthreads();
    if (threadIdx.x == 0) {
        unsigned* bar = b.bar;
        __builtin_amdgcn_s_waitcnt(0);
        unsigned nloc = b.st[0], nx = b.st[1];
        if (nloc == 0u) { xcd_barrier_complete(bar, b.x, nloc, nx); b.st[0] = nloc; b.st[1] = nx; }
        const unsigned old = xb_add(&bar[XB_XSUB(b.x)], 1u);
        const unsigned gen = old / nloc;
        if (old + 1u == (gen + 1u) * nloc) {
            __builtin_amdgcn_fence(__ATOMIC_RELEASE, "agent");
            asm volatile("s_waitcnt vmcnt(0)" ::: "memory");
            const unsigned og = xb_add(&bar[XB_TOP], 1u);
            const unsigned tg = og / nx;
            if (og + 1u == (tg + 1u) * nx) xb_add(&bar[XB_TOPGEN], 1u);
            else XB_SPIN(xb_ld(&bar[XB_TOPGEN]) == tg, bar);
            __builtin_amdgcn_fence(__ATOMIC_ACQUIRE, "agent");
            xb_add(&bar[XB_XGEN(b.x)], 1u);
            asm volatile("s_waitcnt vmcnt(0)" ::: "memory");
        } else {
            XB_SPIN(xb_ld(&bar[XB_XGEN(b.x)]) == gen, bar);
            __builtin_amdgcn_fence(__ATOMIC_ACQUIRE, "agent");
            asm volatile("s_waitcnt vmcnt(0)" ::: "memory");
        }
    }
    __syncthreads();
}
constexpr int NWAVES = 8;
#ifndef MK_N_LAUNCHES
#define MK_N_LAUNCHES 1
#endif
constexpr int N_LAUNCHES = MK_N_LAUNCHES;
constexpr int PER_PHASE = 6;

constexpr int NBATCH = 8, SEQ = 2048, DMODEL = 2048, M = NBATCH * SEQ;
constexpr int MEMLEN = 256;
constexpr int NIN = 6432;
constexpr float EPS = 1e-6f;
constexpr float LOG2E = 1.4426950408889634f;

constexpr size_t MiB = 1u << 20;
constexpr size_t WS_CTL = 0, CTL_ZERO_BYTES = 20480;
constexpr size_t WS_WOUT = 1 * MiB;
constexpr size_t WS_WIN = 9 * MiB, WS_WMEM = 35 * MiB;
constexpr size_t WS_XN = 39 * MiB, WS_MEMN = 103 * MiB;
constexpr size_t WS_PA = 111 * MiB;
constexpr size_t WS_PB = 207 * MiB;
constexpr size_t WS_PC = 231 * MiB;
constexpr size_t WS_MIX = 247 * MiB;
constexpr size_t WS_GATES = 311 * MiB;
constexpr size_t WS_KVM = 313 * MiB;
constexpr size_t WS_ROPE = 317 * MiB;
constexpr size_t WS_CD = 317 * MiB + 512 * 1024;
constexpr size_t WS_UT = 318 * MiB, WS_WNEG = 382 * MiB, WS_QDEC = 446 * MiB;
constexpr size_t WS_KDECT = 9 * MiB, WS_QKM = 73 * MiB;
constexpr size_t WS_IA = 318 * MiB, WS_IB = 9 * MiB; constexpr int IB_SPLIT = 2730, IB_BYTES = 73728, IO_WN = 0, IO_QD = 8192, IO_KT = 16384, IO_QK = 24576, IO_UT = 28672;
static_assert(WS_IA + (size_t)IB_SPLIT * IB_BYTES <= 510 * MiB && WS_IB + (size_t)(4096 - IB_SPLIT) * IB_BYTES <= 111 * MiB, "scan operand blocks");
constexpr size_t WS_OF = 111 * MiB, WS_OB = 143 * MiB;
constexpr size_t WS_END = 510 * MiB;
constexpr int CW_TMO = 0, CW_CODE = 1, CW_WQ = 64, CW_BAR = 1024;

constexpr int RING_OFF = 0, RING_BYTES = 149504;
constexpr int LDSCTL_OFF = RING_BYTES, MISC_OFF = LDSCTL_OFF + 320;
constexpr int LDS_BYTES = 150528;
static_assert(MISC_OFF + 128 <= LDS_BYTES, "LDS map");

#define DI __device__ __forceinline__
typedef short s16x4 __attribute__((ext_vector_type(4)));
typedef unsigned u32x2 __attribute__((ext_vector_type(2)));
typedef float f32x2v __attribute__((ext_vector_type(2)));
#define MFMA16(a, b, c) __builtin_amdgcn_mfma_f32_16x16x32_bf16((a), (b), (c), 0, 0, 0)
DI unsigned cvtpk(float lo, float hi) { return pg8::cvt_pk_bf16(lo, hi); }
DI float bflo(unsigned v) { return __uint_as_float(v << 16); }
DI float bfhi(unsigned v) { return __uint_as_float(v & 0xffff0000u); }
DI float wave_sum(float v) {
#pragma unroll
    for (int o = 1; o < 64; o <<= 1) v += __shfl_xor(v, o);
    return v;
}
DI float silu_f(float v) { return pg8::silu_f(v); }
DI float softplus_f(float x) { return x > 20.f ? x : log1pf(expf(x)); }
DI float sigmoid_f(float x) { return 1.0f / (1.0f + expf(-x)); }
DI int perm32k(int k) { return (k & ~31) | (((k >> 2) & 3) << 3) | (((k >> 4) & 1) << 2) | (k & 3); }
typedef short v4i16_t __attribute__((ext_vector_type(4)));
DI s16x4 vtr(const LAS unsigned char* p) { return __builtin_bit_cast(s16x4, __builtin_amdgcn_ds_read_tr16_b64_v4i16((LAS v4i16_t*)p)); }
DI bf16x8 tr_frag(const LAS unsigned char* lo, int hi_off) { const s16x4 a = vtr(lo), b = vtr(lo + hi_off); return (bf16x8){a[0], a[1], a[2], a[3], b[0], b[1], b[2], b[3]}; }
DI bf16x8 ld_frag(const LAS unsigned char* p) { return *(const LAS bf16x8*)p; }
DI bf16x8 pack8(const f32x4& a, const f32x4& b) { v4u w; w.x = cvtpk(a[0], a[1]); w.y = cvtpk(a[2], a[3]); w.z = cvtpk(b[0], b[1]); w.w = cvtpk(b[2], b[3]); return __builtin_bit_cast(bf16x8, w); }

struct Frame {
    LAS unsigned char* lds;
    volatile LAS unsigned* MISC;
    gu32* ctl;
    int tid, lane, wave;
    int vcu, G;
    const float *x, *mem, *norm_w, *w_in, *conv_w, *a_log_f, *a_log_b, *dt_f, *dt_b, *o_norm_a, *q_norm_b, *k_norm_b, *sink_b, *mem_norm_w, *w_mem_kv, *q_norm_c, *k_norm_c, *w_out;
    float* out;
    bf16 *WinT, *WmemT, *WoutT, *XN, *MEMN, *PA, *PB, *PC, *MIX, *KVM, *UT, *WNEG, *QDEC, *KDECT, *QKM, *OF, *OB;
    float *GATES, *ROPE, *CD;
    unsigned char* wsb;
};
DI bf16* item_blk(unsigned char* wsb, int item) { return (bf16*)(wsb + (item < IB_SPLIT ? WS_IA + (size_t)item * IB_BYTES : WS_IB + (size_t)(item - IB_SPLIT) * IB_BYTES)); }

DI void p0_transpose_item(const float* W, int K, int N, bf16* WT, int k0, int n0, int drow0, LAS float* scr, int lane) {
#pragma unroll 8
    for (int i = 0; i < 32; ++i) { const int kk = 2 * i + (lane >> 5); scr[kk * 33 + (lane & 31)] = W[(size_t)(k0 + kk) * N + n0 + (lane & 31)]; }
    LDS_WAIT(); asm volatile("" ::: "memory");
    const int c = lane & 7;
#pragma unroll
    for (int j = 0; j < 4; ++j) { const int n = (lane >> 3) + 8 * j; const LAS float* s = scr + (8 * c) * 33 + n;
        v4u o; o.x = pk2(s[0 * 33], s[1 * 33]); o.y = pk2(s[2 * 33], s[3 * 33]); o.z = pk2(s[4 * 33], s[5 * 33]); o.w = pk2(s[6 * 33], s[7 * 33]);
        *(GAS v4u*)(WT + (size_t)(drow0 + n) * K + k0 + 8 * c) = o; }
    LDS_WAIT(); asm volatile("" ::: "memory");
}
DI void rms_row_to_bf16(const float* xrow, const float* w, bf16* orow, int lane) {
    const GAS f32x4* xr = (const GAS f32x4*)xrow + lane; const GAS f32x4* wr = (const GAS f32x4*)w + lane;
    f32x4 v[8]; float s = 0.f;
#pragma unroll
    for (int j = 0; j < 8; ++j) { v[j] = xr[64 * j]; s += (v[j].x * v[j].x + v[j].y * v[j].y) + (v[j].z * v[j].z + v[j].w * v[j].w); }
    const float rstd = 1.0f / sqrtf(wave_sum(s) * (1.0f / 2048.0f) + EPS);
    GAS unsigned long long* o8 = (GAS unsigned long long*)orow + lane;
#pragma unroll
    for (int j = 0; j < 8; ++j) { const f32x4 wv = wr[64 * j]; const f32x4 y = v[j] * rstd * wv;
        o8[64 * j] = (unsigned long long)cvtpk(y.x, y.y) | ((unsigned long long)cvtpk(y.z, y.w) << 32); }
}
DI void p0_prologue(Frame& F) {
    LAS float* scr = (LAS float*)(F.lds + RING_OFF + F.wave * 16384);
    const int gw = F.vcu * NWAVES + F.wave, NGW = F.G * NWAVES;
    constexpr int I_IN = 32 * 201, I_MEM = 32 * 32, I_OUT = 32 * 64, NITEMS = I_IN + I_MEM + I_OUT;
    for (int it = gw; it < NITEMS; it += NGW) {
        int r = it;
        if (r < I_IN) { const int kb = r / 201, sb = r % 201, n0 = 32 * sb; const int drow = n0 < 4096 ? n0 : (n0 < 4128 ? 6400 + (n0 - 4096) : n0 - 32);
            p0_transpose_item(F.w_in, 2048, NIN, F.WinT, 64 * kb, n0, drow, scr, F.lane); continue; }
        r -= I_IN;
        if (r < I_MEM) { p0_transpose_item(F.w_mem_kv, 2048, 1024, F.WmemT, 64 * (r / 32), 32 * (r % 32), 32 * (r % 32), scr, F.lane); continue; }
        r -= I_MEM;
        p0_transpose_item(F.w_out, 2048, 2048, F.WoutT, 64 * (r / 64), 32 * (r % 64), 32 * (r % 64), scr, F.lane);
    }
    { GAS v4u* z = (GAS v4u*)(F.WinT + (size_t)NIN * 2048); const int gt = F.vcu * 512 + F.tid, NT = F.G * 512;
      for (int i = gt; i < 224 * 256; i += NT) z[i] = (v4u){0u, 0u, 0u, 0u}; }
    for (int m = gw; m < M; m += NGW) rms_row_to_bf16(F.x + (size_t)m * DMODEL, F.norm_w, F.XN + (size_t)m * DMODEL, F.lane);
    for (int m = gw; m < NBATCH * MEMLEN; m += NGW) rms_row_to_bf16(F.mem + (size_t)m * DMODEL, F.mem_norm_w, F.MEMN + (size_t)m * DMODEL, F.lane);
    { const int gt = F.vcu * 512 + F.tid, NT = F.G * 512;
      for (int i = gt; i < SEQ * 32; i += NT) { const int pos = i >> 5, fi = i & 31; const float inv = powf(10000.0f, -(float)(2 * fi) / 64.0f); const float ang = (float)pos * inv;
          F.ROPE[2 * i] = cosf(ang); F.ROPE[2 * i + 1] = sinf(ang); } }
}

constexpr int AB_QH = 0, AB_KH = 17408, AB_VV = 34816, AB_BUF = 52224, AB_LD = 272;
constexpr int AD_F = 104448, AD_B = 122880, AD_T2 = 9216, AD_LDL = 72, AD_LDT = 144;
constexpr int AG_0 = 141312, AG_SZ = 2560, AG_RAW = 146432;
constexpr int ASCR_F = 0, ASCR_B = 5120;
static_assert(AG_RAW == AG_0 + 2 * AG_SZ && AG_RAW + 1024 <= RING_BYTES && AD_F == 2 * AB_BUF && AD_B == AD_F + 64 * 72 * 4 && AG_0 == AD_B + 64 * 72 * 4, "A-prep LDS map");
#define LBAR() asm volatile("s_waitcnt lgkmcnt(0)\n\ts_barrier" ::: "memory")

#define DPP_ADD(s, ctrl) (s) += __builtin_bit_cast(float, __builtin_amdgcn_update_dpp(0, __builtin_bit_cast(int, (s)), (ctrl), 0xf, 0xf, true))
DI float row16_sum(float s) { DPP_ADD(s, 0xB1); DPP_ADD(s, 0x4E); DPP_ADD(s, 0x141); DPP_ADD(s, 0x140); return s; }

template <bool BWD> DI void s3_solve(LAS unsigned char* L, LAS unsigned char* scr, const LAS float* GV, int lane) {
    int lane_o = lane; asm volatile("" : "+v"(lane_o));
    const int hb = lane_o >> 5, cc = lane_o & 31, r16 = lane_o & 15, g = lane_o >> 4;
    LAS unsigned char* D = L + (BWD ? AD_B : AD_F);
    const LAS float* LS = (const LAS float*)D;
    const LAS float* Lb = LS + hb * (32 * AD_LDL + 32);
    LAS unsigned char* SA = scr + (BWD ? ASCR_B : ASCR_F); LAS unsigned char* SB = SA + 2560;
    LAS unsigned char* T1 = D; LAS unsigned char* T2 = D + AD_T2;
    const LAS float* S1 = GV + (BWD ? 192 : 128); const LAS float* S2 = GV + (BWD ? 576 : 512);
    bf16x8 la[2];
#pragma unroll
    for (int ti = 0; ti < 2; ++ti) { const LAS float* lp = LS + (32 + 16 * ti + r16) * AD_LDL + 8 * g; const f32x4 x0 = *(const LAS f32x4*)lp, x1 = *(const LAS f32x4*)(lp + 4); la[ti] = pack8(x0, x1); }
#ifndef RS3L
#define RS3L 1
#endif
    float t[32];
    for (int r3_ = 0; r3_ < RS3L; ++r3_) { asm volatile("" ::: "memory"); int cc_o = cc; asm volatile("" : "+v"(cc_o));
    t[0] = (cc_o == 0) ? 1.f : 0.f;
    f32x4 rwA[8], rwB[8];
    rwB[0] = *(const LAS f32x4*)(Lb + AD_LDL);
#pragma unroll
    for (int i = 1; i < 32; ++i) {
        if (i + 1 < 32) {
#pragma unroll
            for (int q = 0; q < 8; ++q) if (4 * q < i + 1) { if ((i + 1) & 1) rwB[q] = *(const LAS f32x4*)(Lb + (i + 1) * AD_LDL + 4 * q); else rwA[q] = *(const LAS f32x4*)(Lb + (i + 1) * AD_LDL + 4 * q); } }
        __builtin_amdgcn_sched_barrier(0);
        float sa = (cc_o == i) ? 1.f : 0.f, sb = 0.f;
#pragma unroll
        for (int q = 0; q < 8; ++q)
#pragma unroll
            for (int e = 0; e < 4; ++e) if (4 * q + e < i) { const float lv = (i & 1) ? rwB[q][e] : rwA[q][e];
                if (e & 1) asm("v_fma_f32 %0, -%1, %2, %0" : "+v"(sb) : "v"(lv), "v"(t[4 * q + e])); else asm("v_fma_f32 %0, -%1, %2, %0" : "+v"(sa) : "v"(lv), "v"(t[4 * q + e])); }
        t[i] = sa + sb;
        __builtin_amdgcn_sched_barrier(0);
    }
    }
#ifndef RS3T
#define RS3T 1
#endif
    for (int r4_ = 0; r4_ < RS3T; ++r4_) { asm volatile("" ::: "memory");
    {
        const int R = BWD ? 32 * hb + cc : 63 - 32 * hb - cc, colb = BWD ? 32 * hb : 32 * (1 - hb);
#pragma unroll
        for (int q = 0; q < 4; ++q) { const f32x4 a0 = *(const LAS f32x4*)(S1 + colb + 8 * q), a1 = *(const LAS f32x4*)(S1 + colb + 8 * q + 4), b0 = *(const LAS f32x4*)(S2 + colb + 8 * q), b1 = *(const LAS f32x4*)(S2 + colb + 8 * q + 4);
            const f32x4 v0 = BWD ? (f32x4){t[8 * q], t[8 * q + 1], t[8 * q + 2], t[8 * q + 3]} : (f32x4){t[31 - 8 * q], t[30 - 8 * q], t[29 - 8 * q], t[28 - 8 * q]};
            const f32x4 v1 = BWD ? (f32x4){t[8 * q + 4], t[8 * q + 5], t[8 * q + 6], t[8 * q + 7]} : (f32x4){t[27 - 8 * q], t[26 - 8 * q], t[25 - 8 * q], t[24 - 8 * q]};
            *(LAS bf16x8*)(T1 + R * AD_LDT + (colb + 8 * q) * 2) = pack8(v0 * a0, v1 * a1); *(LAS bf16x8*)(T2 + R * AD_LDT + (colb + 8 * q) * 2) = pack8(v0 * b0, v1 * b1); }
    }
    __builtin_amdgcn_sched_barrier(0);
    if (hb == 0) {
#pragma unroll
        for (int q = 0; q < 4; ++q) *(LAS bf16x8*)(SA + cc * 80 + 16 * q) = pack8((f32x4){t[8 * q], t[8 * q + 1], t[8 * q + 2], t[8 * q + 3]}, (f32x4){t[8 * q + 4], t[8 * q + 5], t[8 * q + 6], t[8 * q + 7]});
    } else {
#pragma unroll
        for (int i = 0; i < 32; i += 2) { const unsigned pk = cvtpk(t[i], t[i + 1]); *(LAS bf16*)(SB + i * 80 + 2 * cc) = (bf16)(pk & 0xffffu); *(LAS bf16*)(SB + (i + 1) * 80 + 2 * cc) = (bf16)(pk >> 16); }
    }
    asm volatile("s_waitcnt lgkmcnt(0)" ::: "memory");
    __builtin_amdgcn_sched_barrier(0);
    bf16x8 tbf[2];
#pragma unroll
    for (int ti = 0; ti < 2; ++ti) tbf[ti] = ld_frag(SA + (16 * ti + r16) * 80 + 16 * g);
    f32x4 P[2][2];
#pragma unroll
    for (int ti = 0; ti < 2; ++ti)
#pragma unroll
        for (int tj = 0; tj < 2; ++tj) P[ti][tj] = MFMA16(la[ti], tbf[tj], ((f32x4){0.f, 0.f, 0.f, 0.f}));
    bf16x8 pbb[2];
#pragma unroll
    for (int tj = 0; tj < 2; ++tj) pbb[tj] = pack8(P[0][tj], P[1][tj]);
#pragma unroll
    for (int tip = 0; tip < 2; ++tip) {
        const u32x2 lo = *(const LAS u32x2*)(SB + (16 * tip + r16) * 80 + 8 * g), hi = *(const LAS u32x2*)(SB + (16 * tip + r16) * 80 + 32 + 8 * g);
        const v4u aw = (v4u){lo.x, lo.y, hi.x, hi.y}; const bf16x8 af = __builtin_bit_cast(bf16x8, aw);
#pragma unroll
        for (int tj = 0; tj < 2; ++tj) { const f32x4 X = MFMA16(af, pbb[tj], ((f32x4){0.f, 0.f, 0.f, 0.f})); const int b = 16 * tj + r16;
            const int Rn = BWD ? b : 63 - b, col0 = BWD ? 32 + 16 * tip + 4 * g : 28 - 16 * tip - 4 * g;
            const f32x4 a0 = *(const LAS f32x4*)(S1 + col0), b0 = *(const LAS f32x4*)(S2 + col0);
            const f32x4 xv = BWD ? (f32x4){-X[0], -X[1], -X[2], -X[3]} : (f32x4){-X[3], -X[2], -X[1], -X[0]};
            u32x2 o1, o2; o1.x = cvtpk(xv[0] * a0[0], xv[1] * a0[1]); o1.y = cvtpk(xv[2] * a0[2], xv[3] * a0[3]); o2.x = cvtpk(xv[0] * b0[0], xv[1] * b0[1]); o2.y = cvtpk(xv[2] * b0[2], xv[3] * b0[3]);
            *(LAS u32x2*)(T1 + Rn * AD_LDT + col0 * 2) = o1; *(LAS u32x2*)(T2 + Rn * AD_LDT + col0 * 2) = o2; }
    }
    }
}

DI void acons_s2(Frame& F, LAS unsigned char* L, LAS unsigned char* B, const LAS float* GV, int item_f, int wv, int lane) {
    int lane_o = lane; asm volatile("" : "+v"(lane_o));
    const int r16 = lane_o & 15, g = lane_o >> 4, item_b = item_f + 32;
    f32x4 accG[4], accQ[4];
#pragma unroll
    for (int tn = 0; tn < 4; ++tn) { accG[tn] = (f32x4){0.f, 0.f, 0.f, 0.f}; accQ[tn] = (f32x4){0.f, 0.f, 0.f, 0.f}; }
    const LAS unsigned char* Ab = B + AB_KH + (16 * wv + r16) * AB_LD + g * 16;
    const LAS unsigned char* Kb = B + AB_KH + r16 * AB_LD + g * 16;
    const LAS unsigned char* Qb = B + AB_QH + r16 * AB_LD + g * 16;
    bf16x8 fr[2][9];
#define S2_LD(dst, ks_) do { dst[0] = ld_frag(Ab + (ks_) * 64); _Pragma("unroll") for (int tn_ = 0; tn_ < 4; ++tn_) { dst[1 + tn_] = ld_frag(Kb + tn_ * 16 * AB_LD + (ks_) * 64); dst[5 + tn_] = ld_frag(Qb + tn_ * 16 * AB_LD + (ks_) * 64); } } while (0)
    S2_LD(fr[0], 0);
#pragma unroll
    for (int ks = 0; ks < 4; ++ks) {
        if (ks + 1 < 4) S2_LD(fr[(ks + 1) & 1], ks + 1);
        __builtin_amdgcn_sched_barrier(0);
#pragma unroll
        for (int tn = 0; tn < 4; ++tn) { accG[tn] = MFMA16(fr[ks & 1][0], fr[ks & 1][1 + tn], accG[tn]); accQ[tn] = MFMA16(fr[ks & 1][0], fr[ks & 1][5 + tn], accQ[tn]); }
        __builtin_amdgcn_sched_barrier(0); }
#undef S2_LD
    LAS float* LF = (LAS float*)(L + AD_F);
    f32x4 gfi, gbi, bfi, bbi;
    { const LAS float* gp = GV + 16 * wv + 4 * g; gfi = *(const LAS f32x4*)gp; gbi = *(const LAS f32x4*)(gp + 64); bfi = *(const LAS f32x4*)(gp + 128); bbi = *(const LAS f32x4*)(gp + 192); }
#pragma unroll
    for (int tn = 0; tn < 4; ++tn) {
        const int j = 16 * tn + r16; const float gcfj = GV[j], gcbj = GV[64 + j];
#pragma unroll
        for (int reg = 0; reg < 4; ++reg) { const int i = 16 * wv + 4 * g + reg; const bool low = (j <= i);
            const float arg = low ? gfi[reg] - gcfj : gbi[reg] - gcbj, bt = low ? bfi[reg] : bbi[reg];
            const int off = low ? (63 - j) * AD_LDL + (63 - i) : (AD_B - AD_F) / 4 + j * AD_LDL + i;
            LF[off] = bt * accG[tn][reg] * __expf(fminf(arg, 0.f)); } }
#pragma unroll
    for (int tn = 0; tn < 4; ++tn) {
        const int i = 16 * tn + r16; const float gcfi = GV[i], gcbi = GV[64 + i]; float qf[4], qb[4];
#pragma unroll
        for (int reg = 0; reg < 4; ++reg) { const int j = 16 * wv + 4 * g + reg; const float v = accQ[tn][reg];
            const float ef = __expf(fminf(gcfi - gfi[reg], 0.f)), eb = __expf(fminf(gcbi - gbi[reg], 0.f));
            qf[reg] = v * ef * ((j <= i) ? 1.f : 0.f); qb[reg] = v * eb * ((j >= i) ? 1.f : 0.f); }
        const int idx = 32 * (wv >> 1) + 8 * g + 4 * (wv & 1);
        u32x2 vf, vb; vf.x = cvtpk(qf[0], qf[1]); vf.y = cvtpk(qf[2], qf[3]); vb.x = cvtpk(qb[0], qb[1]); vb.y = cvtpk(qb[2], qb[3]);
        *(u32x2*)(item_blk(F.wsb, item_f) + IO_QK + i * 64 + idx) = vf; *(u32x2*)(item_blk(F.wsb, item_b) + IO_QK + i * 64 + idx) = vb; }
}
DI void acons_kdect(Frame& F, LAS unsigned char* B, const LAS float* GV, int item, int dirb, int lane) {
    int lane_o = lane; asm volatile("" : "+v"(lane_o));
    const int i16 = lane_o & 15, gg = lane_o >> 4, q4 = i16 >> 2, p4 = i16 & 3;
    const LAS float* KD = GV + (dirb ? 448 : 384);
#pragma unroll
    for (int s = 0; s < 2; ++s) { const f32x4 k0 = *(const LAS f32x4*)(KD + 32 * s + 4 * gg), k1 = *(const LAS f32x4*)(KD + 32 * s + 16 + 4 * gg);
#pragma unroll
        for (int dt = 0; dt < 8; ++dt) { const LAS unsigned char* ap = B + AB_KH + (32 * s + 4 * gg + q4) * AB_LD + (16 * dt + 4 * p4) * 2;
            const s16x4 lo = vtr(ap), hi = vtr(ap + 16 * AB_LD);
            const f32x4 a = (f32x4){bflo((unsigned)(unsigned short)lo[0]), bflo((unsigned)(unsigned short)lo[1]), bflo((unsigned)(unsigned short)lo[2]), bflo((unsigned)(unsigned short)lo[3])} * k0;
            const f32x4 c = (f32x4){bflo((unsigned)(unsigned short)hi[0]), bflo((unsigned)(unsigned short)hi[1]), bflo((unsigned)(unsigned short)hi[2]), bflo((unsigned)(unsigned short)hi[3])} * k1;
            v4u o; o.x = cvtpk(a[0], a[1]); o.y = cvtpk(a[2], a[3]); o.z = cvtpk(c[0], c[1]); o.w = cvtpk(c[2], c[3]);
            *(v4u*)(item_blk(F.wsb, item) + IO_KT + (16 * dt + i16) * 64 + 32 * s + 8 * gg) = o; __builtin_amdgcn_sched_barrier(0); } }
}
template <int DIRT> DI void acons_s4(Frame& F, LAS unsigned char* L, LAS unsigned char* B, LAS unsigned char* stg_all, int item_f, int wv, int lane) {
    int lane_o = lane; asm volatile("" : "+v"(lane_o));
    constexpr int dir = DIRT; const int hw = wv & 1, r16 = lane_o & 15, g = lane_o >> 4, q4 = r16 >> 2, p4 = r16 & 3;
    const LAS unsigned char* T1 = L + (dir ? AD_B : AD_F); const LAS unsigned char* T2 = T1 + AD_T2;
    LAS unsigned char* stg = stg_all + wv * 4352;
    bf16* const blk = item_blk(F.wsb, item_f + 32 * dir);
    const int rrow = lane_o >> 3, rpc = lane_o & 7;
#define S4_LDV(dst, te_) do { dst[0] = tr_frag(B + AB_VV + ((8 * g + q4) * 136 + 16 * (te_) + 4 * p4) * 2, 4 * AB_LD); dst[1] = tr_frag(B + AB_VV + ((32 + 8 * g + q4) * 136 + 16 * (te_) + 4 * p4) * 2, 4 * AB_LD); } while (0)
#define S4_LDK(dst, td_) do { dst[0] = tr_frag(B + AB_KH + ((8 * g + q4) * 136 + 16 * (td_) + 4 * p4) * 2, 4 * AB_LD); dst[1] = tr_frag(B + AB_KH + ((32 + 8 * g + q4) * 136 + 16 * (td_) + 4 * p4) * 2, 4 * AB_LD); } while (0)
#define S4_OUT(gptr_) do { _Pragma("unroll") for (int p_ = 0; p_ < 4; ++p_) { const LAS unsigned char* sp_ = stg + (rrow + 8 * p_) * 136 + rpc * 16; const u32x2 lo_ = *(const LAS u32x2*)sp_, hi_ = *(const LAS u32x2*)(sp_ + 8); \
        *(v4u*)((gptr_) + (size_t)(rrow + 8 * p_) * ROWE + rpc * 8) = (v4u){lo_.x, lo_.y, hi_.x, hi_.y}; } } while (0)
    {
        bf16x8 a1[4][2];
#pragma unroll
        for (int ti = 0; ti < 4; ++ti)
#pragma unroll
            for (int ks = 0; ks < 2; ++ks) a1[ti][ks] = ld_frag(T1 + (16 * ti + r16) * AD_LDT + ks * 64 + g * 16);
        bf16x8 fx[2][2];
        S4_LDV(fx[0], 4 * hw);
#pragma unroll
        for (int t4 = 0; t4 < 4; ++t4) {
            if (t4 + 1 < 4) S4_LDV(fx[(t4 + 1) & 1], 4 * hw + t4 + 1);
            __builtin_amdgcn_sched_barrier(0);
            const bf16x8 v0 = fx[t4 & 1][0], v1 = fx[t4 & 1][1];
#pragma unroll
            for (int ti = 0; ti < 4; ++ti) { f32x4 acc = (f32x4){0.f, 0.f, 0.f, 0.f};
                if (!(dir == 1 && ti >= 2)) acc = MFMA16(a1[ti][0], v0, acc);
                if (!(dir == 0 && ti < 2)) acc = MFMA16(a1[ti][1], v1, acc);
                u32x2 o; o.x = cvtpk(acc[0], acc[1]); o.y = cvtpk(acc[2], acc[3]);
                *(LAS u32x2*)(stg + (16 * (t4 & 1) + r16) * 136 + (16 * ti + 4 * g) * 2) = o; }
            __builtin_amdgcn_sched_barrier(0);
            if (t4 & 1) { constexpr int ROWE = 64; S4_OUT(blk + IO_UT + (size_t)(64 * hw + 16 * (t4 - 1)) * 64); __builtin_amdgcn_sched_barrier(0); }
        }
    }
    {
        const int tiA = hw ? 1 : 0, tiB = hw ? 2 : 3;
        constexpr bool A0 = true, A1 = (dir == 1), B0 = (dir == 0), B1 = true;
        bf16x8 a2A[2], a2B[2];
#pragma unroll
        for (int ks = 0; ks < 2; ++ks) { a2A[ks] = ld_frag(T2 + (16 * tiA + r16) * AD_LDT + ks * 64 + g * 16); a2B[ks] = ld_frag(T2 + (16 * tiB + r16) * AD_LDT + ks * 64 + g * 16); }
        bf16x8 fx[2][2];
        S4_LDK(fx[0], 0);
#pragma unroll
        for (int td = 0; td < 8; ++td) {
            if (td + 1 < 8) S4_LDK(fx[(td + 1) & 1], td + 1);
            __builtin_amdgcn_sched_barrier(0);
            f32x4 accA = (f32x4){0.f, 0.f, 0.f, 0.f}, accB = (f32x4){0.f, 0.f, 0.f, 0.f};
            const bf16x8 k0 = fx[td & 1][0], k1 = fx[td & 1][1];
            if (A0) accA = MFMA16(k0, a2A[0], accA); if (B0) accB = MFMA16(k0, a2B[0], accB);
            if (A1) accA = MFMA16(k1, a2A[1], accA); if (B1) accB = MFMA16(k1, a2B[1], accB);
            const int idl = 32 * ((td & 3) >> 1) + 8 * g + 4 * (td & 1);
            u32x2 o; o.x = cvtpk(-accA[0], -accA[1]); o.y = cvtpk(-accA[2], -accA[3]);
            *(LAS u32x2*)(stg + r16 * 136 + idl * 2) = o;
            o.x = cvtpk(-accB[0], -accB[1]); o.y = cvtpk(-accB[2], -accB[3]);
            *(LAS u32x2*)(stg + (16 + r16) * 136 + idl * 2) = o;
            __builtin_amdgcn_sched_barrier(0);
            if ((td & 3) == 3) {
                const int hf = td >> 2;
#pragma unroll
                for (int p_ = 0; p_ < 4; ++p_) { const int sr = rrow + 8 * p_; const LAS unsigned char* sp_ = stg + sr * 136 + rpc * 16; const u32x2 lo_ = *(const LAS u32x2*)sp_, hi_ = *(const LAS u32x2*)(sp_ + 8);
                    const int grow = 16 * (sr < 16 ? tiA : tiB) + (sr & 15);
                    *(v4u*)(blk + IO_WN + (size_t)grow * 128 + 64 * hf + rpc * 8) = (v4u){lo_.x, lo_.y, hi_.x, hi_.y}; }
                __builtin_amdgcn_sched_barrier(0); }
        }
    }
#undef S4_LDV
#undef S4_LDK
#undef S4_OUT
}
DI void aprod_s0(Frame& F, LAS float* GV, const LAS float* RAW, int item_f, int h, int lane) {
    const float ga[4] = {RAW[lane], RAW[64 + lane], RAW[128 + lane], RAW[192 + lane]};
    const float xf_ = ga[0] + F.dt_f[h], xb_ = ga[1] + F.dt_b[h];
    const float gf = -__expf(F.a_log_f[h]) * (xf_ > 15.f ? xf_ : __logf(1.0f + __expf(xf_)));
    const float gb = -__expf(F.a_log_b[h]) * (xb_ > 15.f ? xb_ : __logf(1.0f + __expf(xb_)));
    float pf = gf, pb = gb;
#pragma unroll
    for (int o = 1; o < 64; o <<= 1) { const float tf = __shfl_up(pf, o), tb = __shfl_up(pb, o); if (lane >= o) { pf += tf; pb += tb; } }
    const float totf = __shfl(pf, 63), totb = __shfl(pb, 63);
    const float gcf = pf, gcb = totb - pb + gb;
    const float btf_ = __builtin_amdgcn_rcpf(1.0f + __expf(-ga[2])), btb_ = __builtin_amdgcn_rcpf(1.0f + __expf(-ga[3])), egf_ = __expf(gcf), egb_ = __expf(gcb);
    GV[lane] = gcf; GV[64 + lane] = gcb; GV[128 + lane] = btf_; GV[192 + lane] = btb_;
    GV[256 + lane] = egf_; GV[320 + lane] = egb_; GV[384 + lane] = __expf(totf - gcf); GV[448 + lane] = __expf(totb - gcb); GV[512 + lane] = btf_ * egf_; GV[576 + lane] = btb_ * egb_;
    if (lane == 0) { F.CD[item_f] = __expf(totf); F.CD[item_f + 32] = __expf(totb); }
}
DI void aprod_load(Frame& F, v4u (&x)[8], int b, int c, int h, int part, int p0, int c16) {
#pragma unroll
    for (int r = 0; r < 8; ++r) { const int t = c * 64 + p0 - 2 + r; v4u v = (v4u){0u, 0u, 0u, 0u};
        if (t >= 0 && t < SEQ) v = *(const v4u*)(F.PA + ((size_t)b * SEQ + t) * 3072 + part * 1024 + h * 128 + 8 * c16);
        x[r] = v; }
}
DI void aprod_conv(Frame& F, const v4u (&x)[8], float (&o)[4][8], int h, int part, int c16) {
#pragma unroll
    for (int j = 0; j < 4; ++j)
#pragma unroll
        for (int e = 0; e < 8; ++e) o[j][e] = 0.f;
#pragma unroll
    for (int k = 0; k < 5; ++k) { const float* wp = F.conv_w + k * 3072 + part * 1024 + h * 128 + 8 * c16; const f32x4 w0 = *(const f32x4*)wp, w1 = *(const f32x4*)(wp + 4);
#pragma unroll
        for (int j = 0; j < 4; ++j) { const v4u xr = x[j + k];
            o[j][0] += bflo(xr.x) * w0[0]; o[j][1] += bfhi(xr.x) * w0[1]; o[j][2] += bflo(xr.y) * w0[2]; o[j][3] += bfhi(xr.y) * w0[3];
            o[j][4] += bflo(xr.z) * w1[0]; o[j][5] += bfhi(xr.z) * w1[1]; o[j][6] += bflo(xr.w) * w1[2]; o[j][7] += bfhi(xr.w) * w1[3]; } }
#pragma unroll
    for (int j = 0; j < 4; ++j)
#pragma unroll
        for (int e = 0; e < 8; ++e) o[j][e] = silu_f(o[j][e]);
}
DI void aprod_store_rows(LAS unsigned char* img, const float (&o)[4][8], const float (&sc)[4], int p0, int c16) {
#pragma unroll
    for (int j = 0; j < 4; ++j) { v4u w; w.x = cvtpk(o[j][0] * sc[j], o[j][1] * sc[j]); w.y = cvtpk(o[j][2] * sc[j], o[j][3] * sc[j]); w.z = cvtpk(o[j][4] * sc[j], o[j][5] * sc[j]); w.w = cvtpk(o[j][6] * sc[j], o[j][7] * sc[j]);
        *(LAS v4u*)(img + (p0 + j) * AB_LD + c16 * 16) = w; }
}

#ifndef RCK
#define RCK 1
#endif
#ifndef RC2
#define RC2 1
#endif
#ifndef RC3
#define RC3 1
#endif
#ifndef RC4
#define RC4 1
#endif
#ifndef RP1
#define RP1 1
#endif
#ifndef RP2
#define RP2 1
#endif
#ifndef RP3
#define RP3 1
#endif
DI void a_prep_phase(Frame& F) {
    const int lane = F.lane, wave = F.wave;
    LAS unsigned char* L = F.lds + RING_OFF;
    const int nit = (F.vcu < 2048) ? (2048 - F.vcu + F.G - 1) / F.G : 0;
    if (wave < 4) {
#pragma unroll 1
        for (int k = -1; k < nit; ++k) {
            LAS unsigned char* Bc = L + (k & 1) * AB_BUF;
            const LAS float* GVc = (const LAS float*)(L + AG_0 + (k & 1) * AG_SZ);
            const int itc = F.vcu + k * F.G;
            const int item_c = (((itc >> 8) * 8 + (itc & 7)) * 2) * 32 + ((itc >> 3) & 31);
            const bool cons = (k >= 0);
            if (cons) for (int r_ = 0; r_ < RC2; ++r_) { asm volatile("" ::: "memory"); acons_s2(F, L, Bc, GVc, item_c, wave, lane); }
            LBAR();
            if (cons) for (int r_ = 0; r_ < RC3; ++r_) { if (wave == 0) s3_solve<false>(L, Bc + AB_QH, GVc, lane); else if (wave == 1) s3_solve<true>(L, Bc + AB_QH, GVc, lane); else for (int r2_ = 0; r2_ < RCK; ++r2_) { asm volatile("" ::: "memory"); acons_kdect(F, Bc, GVc, item_c + 32 * (wave - 2), wave - 2, lane); } }
            LBAR();
            if (cons) for (int r_ = 0; r_ < RC4; ++r_) { asm volatile("" ::: "memory"); if (wave < 2) acons_s4<0>(F, L, Bc, Bc + AB_QH, item_c, wave, lane); else acons_s4<1>(F, L, Bc, Bc + AB_QH, item_c, wave, lane); }
            LBAR();
        }
    } else {
        const int pw = wave - 4;
        LAS float* RAW = (LAS float*)(L + AG_RAW);
        v4u xq[8], xk[8], xv[8];
        { const int c16 = lane & 15, p0 = 16 * pw + 4 * (lane >> 4);
          if (nit > 0) { const int it = F.vcu; aprod_load(F, xk, it >> 8, (it >> 3) & 31, it & 7, 1, p0, c16); }
          if (wave == 4 && nit > 0) {
              { const int it = F.vcu; const int b = it >> 8, c = (it >> 3) & 31, h = it & 7; const float* gr = F.GATES + ((size_t)b * SEQ + c * 64 + lane) * 32; RAW[lane] = gr[h]; RAW[64 + lane] = gr[8 + h]; RAW[128 + lane] = gr[16 + h]; RAW[192 + lane] = gr[24 + h];
                aprod_s0(F, (LAS float*)(L + AG_0), RAW, ((b * 8 + h) * 2) * 32 + c, h, lane); }
              if (nit > 1) { const int it = F.vcu + F.G; const int b = it >> 8, c = (it >> 3) & 31, h = it & 7; const float* gr = F.GATES + ((size_t)b * SEQ + c * 64 + lane) * 32; const float g0 = gr[h], g1 = gr[8 + h], g2 = gr[16 + h], g3 = gr[24 + h];
                RAW[lane] = g0; RAW[64 + lane] = g1; RAW[128 + lane] = g2; RAW[192 + lane] = g3; } } }
#pragma unroll 1
        for (int k = -1; k < nit; ++k) {
            LAS unsigned char* Bn = L + ((k + 1) & 1) * AB_BUF;
            LAS float* GVn = (LAS float*)(L + AG_0 + ((k + 1) & 1) * AG_SZ);
            const int itn = F.vcu + (k + 1) * F.G;
            const int bn = itn >> 8, cn = (itn >> 3) & 31, hn = itn & 7; const int item_n = ((bn * 8 + hn) * 2) * 32 + cn;
            const bool prod = (k + 1 < nit);
            int lo_ = lane; asm volatile("" : "+v"(lo_));
            const int gI = lo_ >> 4, c16 = lo_ & 15, p0 = 16 * pw + 4 * gI;
            if (prod) {
                aprod_load(F, xq, bn, cn, hn, 0, p0, c16);
                for (int r_ = 0; r_ < RP1; ++r_) { asm volatile("" ::: "memory");
                float o[4][8]; aprod_conv(F, xk, o, hn, 1, c16);
                float sc[4];
#pragma unroll
                for (int j = 0; j < 4; ++j) { float ss = 0.f;
#pragma unroll
                    for (int e = 0; e < 8; ++e) ss += o[j][e] * o[j][e];
                    sc[j] = 1.0f / sqrtf(row16_sum(ss) + EPS); }
                aprod_store_rows(Bn + AB_KH, o, sc, p0, c16); }
            }
            LBAR();
            if (prod) {
                aprod_load(F, xv, bn, cn, hn, 2, p0, c16);
                float o[4][8]; float sc[4];
                for (int r_ = 0; r_ < RP2; ++r_) { asm volatile("" ::: "memory");
                aprod_conv(F, xq, o, hn, 0, c16);
#pragma unroll
                for (int j = 0; j < 4; ++j) { float ss = 0.f;
#pragma unroll
                    for (int e = 0; e < 8; ++e) ss += o[j][e] * o[j][e];
                    sc[j] = (1.0f / sqrtf(row16_sum(ss) + EPS)) * 0.08838834764831845f; }
                aprod_store_rows(Bn + AB_QH, o, sc, p0, c16); }
#ifndef RPQ
#define RPQ 1
#endif
                for (int r_ = 0; r_ < RPQ; ++r_) { asm volatile("" ::: "memory");
                const int b1 = (c16 >> 1) & 1, qoff = 32 * (c16 >> 2) + 8 * (2 * (c16 & 1) + b1);
#pragma unroll
                for (int j = 0; j < 4; ++j) { const int pos = p0 + j; const float ef = GVn[256 + pos] * sc[j], eb = GVn[320 + pos] * sc[j];
#pragma unroll
                    for (int dd = 0; dd < 2; ++dd) { const float e_ = dd ? eb : ef;
                        const unsigned r0x = cvtpk(o[j][0] * e_, o[j][1] * e_), r0y = cvtpk(o[j][2] * e_, o[j][3] * e_), r1x = cvtpk(o[j][4] * e_, o[j][5] * e_), r1y = cvtpk(o[j][6] * e_, o[j][7] * e_);
                        const unsigned sx = b1 ? r0x : r1x, sy = b1 ? r0y : r1y;
                        const unsigned gx = (unsigned)__builtin_amdgcn_update_dpp(0, (int)sx, 0x4E, 0xf, 0xf, true), gy = (unsigned)__builtin_amdgcn_update_dpp(0, (int)sy, 0x4E, 0xf, 0xf, true);
                        const v4u w = b1 ? (v4u){gx, gy, r1x, r1y} : (v4u){r0x, r0y, gx, gy};
                        *(v4u*)(item_blk(F.wsb, item_n + 32 * dd) + IO_QD + pos * 128 + qoff) = w; } }
                }
            }
            LBAR();
            {
                float g4[4] = {0.f, 0.f, 0.f, 0.f}; const bool more = (k + 2 < nit), more3 = (k + 3 < nit);
                if (more) { const int it2 = itn + F.G; const int b2 = it2 >> 8, c2 = (it2 >> 3) & 31, h2 = it2 & 7; aprod_load(F, xk, b2, c2, h2, 1, p0, c16);
                    if (wave == 4) { aprod_s0(F, (LAS float*)(L + AG_0 + (k & 1) * AG_SZ), RAW, ((b2 * 8 + h2) * 2) * 32 + c2, h2, lane);
                        if (more3) { const int it3 = it2 + F.G; const int b3 = it3 >> 8, c3 = (it3 >> 3) & 31, h3 = it3 & 7; const float* gr = F.GATES + ((size_t)b3 * SEQ + c3 * 64 + lane) * 32; g4[0] = gr[h3]; g4[1] = gr[8 + h3]; g4[2] = gr[16 + h3]; g4[3] = gr[24 + h3]; } } }
                if (prod) for (int r_ = 0; r_ < RP3; ++r_) { asm volatile("" ::: "memory"); float o[4][8]; aprod_conv(F, xv, o, hn, 2, c16);
                    const float sc[4] = {1.f, 1.f, 1.f, 1.f};
                    aprod_store_rows(Bn + AB_VV, o, sc, p0, c16); }
                if (more3 && wave == 4) { RAW[lane] = g4[0]; RAW[64 + lane] = g4[1]; RAW[128 + lane] = g4[2]; RAW[192 + lane] = g4[3]; }
            }
            LBAR();
        }
    }
}

constexpr int B_KB = 0, B_VB = 55296;
DI void b_attn_unit(Frame& F, int b, int nb, int kvh, bf16* MO) {
    const int tid = F.tid, lane = F.lane, wave = F.wave;
    LAS unsigned char* L = F.lds + RING_OFF;
#pragma unroll
    for (int it = 0; it < 6; ++it) { const int q = tid + 512 * it, row = q >> 3, cc = q & 7; const int t = (nb - 1) * 128 + row; const bool valid = (t >= 0) && (t < SEQ);
        v4u kv = (v4u){0u, 0u, 0u, 0u}, vv = (v4u){0u, 0u, 0u, 0u};
        if (valid) { const bf16* rp = F.PB + ((size_t)b * SEQ + t) * 768 + 512 + kvh * 64 + 8 * cc; kv = *(const v4u*)rp; vv = *(const v4u*)(rp + 128); }
        float xk[8]; xk[0] = bflo(kv.x); xk[1] = bfhi(kv.x); xk[2] = bflo(kv.y); xk[3] = bfhi(kv.y); xk[4] = bflo(kv.z); xk[5] = bfhi(kv.z); xk[6] = bflo(kv.w); xk[7] = bfhi(kv.w);
        float ss = 0.f;
#pragma unroll
        for (int e = 0; e < 8; ++e) ss += xk[e] * xk[e];
        ss += __shfl_xor(ss, 1); ss += __shfl_xor(ss, 2); ss += __shfl_xor(ss, 4);
        const float rstd = 1.0f / sqrtf(ss * (1.0f / 64.0f) + EPS);
        const int tt = valid ? t : 0; float o[8];
#pragma unroll
        for (int e = 0; e < 8; ++e) { const float y = xk[e] * rstd * F.k_norm_b[8 * cc + e]; const float pr = __shfl_xor(y, 4);
            const f32x2v cs = *(const f32x2v*)(F.ROPE + ((size_t)tt * 32 + ((8 * cc + e) & 31)) * 2);
            o[e] = (cc < 4) ? (y * cs.x - pr * cs.y) : (y * cs.x + pr * cs.y); }
        v4u ok; ok.x = cvtpk(o[0], o[1]); ok.y = cvtpk(o[2], o[3]); ok.z = cvtpk(o[4], o[5]); ok.w = cvtpk(o[6], o[7]);
        if (!valid) ok = (v4u){0u, 0u, 0u, 0u};
        *(LAS v4u*)(L + B_KB + row * 144 + cc * 16) = ok; *(LAS v4u*)(L + B_VB + row * 144 + cc * 16) = vv; }
    if (tid < 128) *(LAS v4u*)(L + B_VB + (384 + (tid >> 3)) * 144 + (tid & 7) * 16) = (v4u){0u, 0u, 0u, 0u};
    __syncthreads();
    const int hq = kvh * 4 + (wave >> 1), r16 = lane & 15, g = lane >> 4, q4 = r16 >> 2, p4 = r16 & 3;
    const float sk = F.sink_b[hq] * LOG2E;
#pragma unroll 1
    for (int qt = 0; qt < 4; ++qt) {
        const int i0 = (wave & 1) * 64 + 16 * qt, iq = i0 + r16, pos = nb * 128 + iq; const size_t m = (size_t)b * SEQ + pos;
        bf16x8 qf[2];
        { const bf16* qp = F.PB + m * 768 + hq * 64 + 8 * g; const v4u a = *(const v4u*)qp, c2 = *(const v4u*)(qp + 32);
          float x0[8], x1[8]; x0[0] = bflo(a.x); x0[1] = bfhi(a.x); x0[2] = bflo(a.y); x0[3] = bfhi(a.y); x0[4] = bflo(a.z); x0[5] = bfhi(a.z); x0[6] = bflo(a.w); x0[7] = bfhi(a.w);
          x1[0] = bflo(c2.x); x1[1] = bfhi(c2.x); x1[2] = bflo(c2.y); x1[3] = bfhi(c2.y); x1[4] = bflo(c2.z); x1[5] = bfhi(c2.z); x1[6] = bflo(c2.w); x1[7] = bfhi(c2.w);
          float ss = 0.f;
#pragma unroll
          for (int e = 0; e < 8; ++e) ss += x0[e] * x0[e] + x1[e] * x1[e];
          ss += __shfl_xor(ss, 16); ss += __shfl_xor(ss, 32);
          const float rstd = (1.0f / sqrtf(ss * (1.0f / 64.0f) + EPS));
          float o0[8], o1[8];
#pragma unroll
          for (int e = 0; e < 8; ++e) { const float y0 = x0[e] * rstd * F.q_norm_b[8 * g + e], y1 = x1[e] * rstd * F.q_norm_b[32 + 8 * g + e];
              const f32x2v cs = *(const f32x2v*)(F.ROPE + ((size_t)pos * 32 + 8 * g + e) * 2);
              o0[e] = (y0 * cs.x - y1 * cs.y) * (0.125f * LOG2E); o1[e] = (y1 * cs.x + y0 * cs.y) * (0.125f * LOG2E); }
          v4u w0, w1; w0.x = cvtpk(o0[0], o0[1]); w0.y = cvtpk(o0[2], o0[3]); w0.z = cvtpk(o0[4], o0[5]); w0.w = cvtpk(o0[6], o0[7]);
          w1.x = cvtpk(o1[0], o1[1]); w1.y = cvtpk(o1[2], o1[3]); w1.z = cvtpk(o1[4], o1[5]); w1.w = cvtpk(o1[6], o1[7]);
          qf[0] = __builtin_bit_cast(bf16x8, w0); qf[1] = __builtin_bit_cast(bf16x8, w1); }
        f32x4 st[18];
#pragma unroll
        for (int c = 0; c < 17; ++c) { f32x4 acc = (f32x4){0.f, 0.f, 0.f, 0.f};
#pragma unroll
            for (int s = 0; s < 2; ++s) acc = MFMA16(ld_frag(L + B_KB + (i0 + 16 * c + r16) * 144 + s * 64 + g * 16), qf[s], acc);
            st[c] = acc; __builtin_amdgcn_sched_barrier(0); }
        st[17] = (f32x4){0.f, 0.f, 0.f, 0.f};
        float mx = sk;
#pragma unroll
        for (int c = 0; c < 17; ++c)
#pragma unroll
            for (int reg = 0; reg < 4; ++reg) { const int j = i0 + 16 * c + 4 * g + reg; const int kpos = (nb - 1) * 128 + j;
                const bool ok = (j >= iq) && (j <= iq + 256) && (kpos >= 0) && (kpos < SEQ);
                const float v = ok ? st[c][reg] : -INFINITY; st[c][reg] = v; mx = fmaxf(mx, v); }
        mx = fmaxf(mx, __shfl_xor(mx, 16)); mx = fmaxf(mx, __shfl_xor(mx, 32));
        float sum = 0.f;
#pragma unroll
        for (int c = 0; c < 17; ++c)
#pragma unroll
            for (int reg = 0; reg < 4; ++reg) { const float p = __builtin_amdgcn_exp2f(st[c][reg] - mx); st[c][reg] = p; sum += p; }
        sum += __shfl_xor(sum, 16); sum += __shfl_xor(sum, 32);
        const float inv = 1.0f / (sum + __builtin_amdgcn_exp2f(sk - mx));
        bf16x8 pb[9];
#pragma unroll
        for (int kp = 0; kp < 9; ++kp) pb[kp] = pack8(st[2 * kp], st[2 * kp + 1]);
#pragma unroll
        for (int td = 0; td < 4; ++td) { f32x4 acc = (f32x4){0.f, 0.f, 0.f, 0.f};
#pragma unroll
            for (int kp = 0; kp < 9; ++kp) acc = MFMA16(tr_frag(L + B_VB + ((i0 + 32 * kp + 4 * g + q4) * 72 + 16 * td + 4 * p4) * 2, 16 * 144), pb[kp], acc);
            const size_t mo = m * 2048 + 1024 + hq * 64 + 16 * td + 4 * g; const u32x2 z = *(const u32x2*)(F.MIX + mo); bf16* mp = MO + mo;
            u32x2 o; o.x = cvtpk(acc[0] * inv * bflo(z.x), acc[1] * inv * bfhi(z.x)); o.y = cvtpk(acc[2] * inv * bflo(z.y), acc[3] * inv * bfhi(z.y));
            *(u32x2*)mp = o; __builtin_amdgcn_sched_barrier(0); }
    }
    __syncthreads();
}

constexpr int C_KC = 0, C_VC = 69632;
DI void c_attn_unit(Frame& F, int b, int hc, int qblk, bf16* MO) {
    const int tid = F.tid, lane = F.lane, wave = F.wave;
    LAS unsigned char* L = F.lds + RING_OFF;
#pragma unroll
    for (int it = 0; it < 8; ++it) { const int q = tid + 512 * it, row = q >> 4, cc = q & 15;
        const bf16* rp = F.KVM + ((size_t)b * MEMLEN + row) * 1024 + hc * 128 + 8 * cc; const v4u kv = *(const v4u*)rp, vv = *(const v4u*)(rp + 512);
        float xk[8]; xk[0] = bflo(kv.x); xk[1] = bfhi(kv.x); xk[2] = bflo(kv.y); xk[3] = bfhi(kv.y); xk[4] = bflo(kv.z); xk[5] = bfhi(kv.z); xk[6] = bflo(kv.w); xk[7] = bfhi(kv.w);
        float ss = 0.f;
#pragma unroll
        for (int e = 0; e < 8; ++e) ss += xk[e] * xk[e];
        ss += __shfl_xor(ss, 1); ss += __shfl_xor(ss, 2); ss += __shfl_xor(ss, 4); ss += __shfl_xor(ss, 8);
        const float rstd = 1.0f / sqrtf(ss * (1.0f / 128.0f) + EPS);
        float o[8];
#pragma unroll
        for (int e = 0; e < 8; ++e) o[e] = xk[e] * rstd * F.k_norm_c[8 * cc + e];
        v4u ok; ok.x = cvtpk(o[0], o[1]); ok.y = cvtpk(o[2], o[3]); ok.z = cvtpk(o[4], o[5]); ok.w = cvtpk(o[6], o[7]);
        *(LAS v4u*)(L + C_KC + row * 272 + cc * 16) = ok; *(LAS v4u*)(L + C_VC + row * 272 + cc * 16) = vv; }
    __syncthreads();
    const int r16 = lane & 15, g = lane >> 4, q4 = r16 >> 2, p4 = r16 & 3;
#pragma unroll 1
    for (int qt = 0; qt < 2; ++qt) {
        const size_t m = (size_t)b * SEQ + qblk * 256 + wave * 32 + qt * 16 + r16;
        bf16x8 qf[4];
        { float xs[4][8]; float ss = 0.f;
#pragma unroll
          for (int s = 0; s < 4; ++s) { const v4u a = *(const v4u*)(F.PC + m * 512 + hc * 128 + 32 * s + 8 * g);
              xs[s][0] = bflo(a.x); xs[s][1] = bfhi(a.x); xs[s][2] = bflo(a.y); xs[s][3] = bfhi(a.y); xs[s][4] = bflo(a.z); xs[s][5] = bfhi(a.z); xs[s][6] = bflo(a.w); xs[s][7] = bfhi(a.w);
#pragma unroll
              for (int e = 0; e < 8; ++e) ss += xs[s][e] * xs[s][e]; }
          ss += __shfl_xor(ss, 16); ss += __shfl_xor(ss, 32);
          const float rstd = (1.0f / sqrtf(ss * (1.0f / 128.0f) + EPS)) * (0.08838834764831845f * LOG2E);
#pragma unroll
          for (int s = 0; s < 4; ++s) { float o[8];
#pragma unroll
              for (int e = 0; e < 8; ++e) o[e] = xs[s][e] * rstd * F.q_norm_c[32 * s + 8 * g + e];
              v4u w0; w0.x = cvtpk(o[0], o[1]); w0.y = cvtpk(o[2], o[3]); w0.z = cvtpk(o[4], o[5]); w0.w = cvtpk(o[6], o[7]); qf[s] = __builtin_bit_cast(bf16x8, w0); } }
        f32x4 st[16];
#pragma unroll
        for (int c = 0; c < 16; ++c) { f32x4 acc = (f32x4){0.f, 0.f, 0.f, 0.f};
#pragma unroll
            for (int s = 0; s < 4; ++s) acc = MFMA16(ld_frag(L + C_KC + (16 * c + r16) * 272 + s * 64 + g * 16), qf[s], acc);
            st[c] = acc; __builtin_amdgcn_sched_barrier(0); }
        float mx = -INFINITY;
#pragma unroll
        for (int c = 0; c < 16; ++c)
#pragma unroll
            for (int reg = 0; reg < 4; ++reg) mx = fmaxf(mx, st[c][reg]);
        mx = fmaxf(mx, __shfl_xor(mx, 16)); mx = fmaxf(mx, __shfl_xor(mx, 32));
        float sum = 0.f;
#pragma unroll
        for (int c = 0; c < 16; ++c)
#pragma unroll
            for (int reg = 0; reg < 4; ++reg) { const float p = __builtin_amdgcn_exp2f(st[c][reg] - mx); st[c][reg] = p; sum += p; }
        sum += __shfl_xor(sum, 16); sum += __shfl_xor(sum, 32);
        const float inv = 1.0f / sum;
        bf16x8 pb[8];
#pragma unroll
        for (int kp = 0; kp < 8; ++kp) pb[kp] = pack8(st[2 * kp], st[2 * kp + 1]);
#pragma unroll
        for (int td = 0; td < 8; ++td) { f32x4 acc = (f32x4){0.f, 0.f, 0.f, 0.f};
#pragma unroll
            for (int kp = 0; kp < 8; ++kp) acc = MFMA16(tr_frag(L + C_VC + ((32 * kp + 4 * g + q4) * 136 + 16 * td + 4 * p4) * 2, 16 * 272), pb[kp], acc);
            const size_t mo = m * 2048 + 1536 + hc * 128 + 16 * td + 4 * g; const u32x2 z = *(const u32x2*)(F.MIX + mo); bf16* mp = MO + mo;
            u32x2 o; o.x = cvtpk(acc[0] * inv * bflo(z.x), acc[1] * inv * bfhi(z.x)); o.y = cvtpk(acc[2] * inv * bflo(z.y), acc[3] * inv * bfhi(z.y));
            *(u32x2*)mp = o; __builtin_amdgcn_sched_barrier(0); }
    }
    __syncthreads();
}

constexpr int S_WN = 0, S_QD = 18432, S_KT = 36864, S_QK = 55296, S_BUF = 64512;
constexpr int S_OST = 2 * S_BUF, S_OLD = 272;
static_assert(S_OST + 64 * S_OLD <= RING_BYTES, "scan LDS");
#ifdef XBARS
#define XBAR() do { LBAR(); LBAR(); LBAR(); LBAR(); } while (0)
#else
#define XBAR() do {} while (0)
#endif
DI void scan_unit(LAS unsigned char* lds_, int tid, unsigned char* wsb_, const float* CD_, bf16* OF_, bf16* OB_, bf16* DUMP_, int bh, int dir) {
    const int lane = tid & 63, wave = __builtin_amdgcn_readfirstlane(tid >> 6);
    LAS unsigned char* L = lds_ + RING_OFF;
    const int b = bh >> 3, h = bh & 7;
    const int item0 = (bh * 2 + dir) * 32;
    const int r16 = lane & 15, g = lane >> 4;
    const int lt = tid - 256;
    const int e0 = wave * 32 + r16;
    if (wave == 7) {
        __syncthreads();
#pragma unroll 1
        for (int s = 0; s < 32; ++s) {
            if (s > 0) { const int np = dir ? 32 - s : s - 1; bf16* ob = (dir ? OB_ : OF_) + ((size_t)b * SEQ + (size_t)np * 64) * 1024 + h * 128;
#pragma unroll
                for (int i = 0; i < 16; ++i) { const int q = lane + 64 * i, row = q >> 4, cc = q & 15; const v4u v = *(const LAS v4u*)(L + S_OST + row * S_OLD + cc * 16);
                    *(v4u*)(ob + (size_t)row * 1024 + cc * 8) = v; } }
            LBAR(); LBAR(); XBAR();
        }
    } else if (wave >= 4) {
        const int l3 = tid - 256;
#define SC_DOF(p_) ((p_) < 2048 ? (unsigned)(((p_) >> 10) * S_QD + (((p_) & 1023) >> 4) * 288 + ((p_) & 15) * 16) : (p_) < 3072 ? (unsigned)(S_KT + (((p_) - 2048) >> 3) * 144 + ((p_) & 7) * 16) : (unsigned)(S_QK + ((((p_) - 3072) & 511) >> 3) * 144 + ((p_) & 7) * 16))
        const bool last_ok = (l3 + 192 * 18) < 3584;
        v4u ldA[19], ldB[19];
#define SC_LOAD(ld, n_) do { const v4u* ib_ = (const v4u*)item_blk(wsb_, item0 + (n_)) + l3; \
        _Pragma("unroll") for (int i_ = 0; i_ < 18; ++i_) ld[i_] = ib_[192 * i_]; \
        ld[18] = ib_[last_ok ? 192 * 18 : 0]; } while (0)
#define SC_WRITE(ld, bufo_) do { LAS unsigned char* B_ = L + (bufo_); int lo_ = l3; asm volatile("" : "+v"(lo_)); \
        _Pragma("unroll") for (int i_ = 0; i_ < 18; ++i_) { const int p_ = lo_ + 192 * i_; *(LAS v4u*)(B_ + SC_DOF(p_)) = ld[i_]; } \
        if (last_ok) { const int p_ = lo_ + 192 * 18; *(LAS v4u*)(B_ + SC_DOF(p_)) = ld[18]; } } while (0)
#define SC_CH(k_) (dir ? 31 - ((k_) < 31 ? (k_) : 31) : ((k_) < 31 ? (k_) : 31))
        SC_LOAD(ldA, SC_CH(0)); SC_WRITE(ldA, 0); SC_LOAD(ldB, SC_CH(1)); SC_LOAD(ldA, SC_CH(2));
        __syncthreads();
#pragma unroll 1
        for (int s = 0; s < 32; s += 2) {
            SC_WRITE(ldB, S_BUF); SC_LOAD(ldB, SC_CH(s + 3));
            LBAR(); LBAR(); XBAR();
            SC_WRITE(ldA, 0); SC_LOAD(ldA, SC_CH(s + 4));
            LBAR(); LBAR(); XBAR();
        }
        asm volatile("s_waitcnt vmcnt(0)" ::: "memory");
#undef SC_CH
#undef SC_DOF
    } else {
        f32x4 S[2][8];
#pragma unroll
        for (int c = 0; c < 2; ++c)
#pragma unroll
            for (int td = 0; td < 8; ++td) S[c][td] = (f32x4){0.f, 0.f, 0.f, 0.f};
        u32x2 un[2][4]; float cdn;
        { const int n0 = dir ? 31 : 0;
#pragma unroll
          for (int c = 0; c < 2; ++c) { const bf16* up = item_blk(wsb_, item0 + n0) + IO_UT + (e0 + 16 * c) * 64 + 4 * g;
#pragma unroll
              for (int t = 0; t < 4; ++t) un[c][t] = *(const u32x2*)(up + 16 * t); }
          cdn = CD_[item0 + n0]; }
        __syncthreads();
#pragma unroll 1
        for (int s = 0; s < 32; ++s) {
            const LAS unsigned char* Bf = L + (s & 1) * S_BUF;
            const float cd = cdn;
            f32x4 vacc[2][4];
#pragma unroll
            for (int c = 0; c < 2; ++c)
#pragma unroll
                for (int t = 0; t < 4; ++t) { const u32x2 uu = un[c][t]; vacc[c][t] = (f32x4){bflo(uu.x), bfhi(uu.x), bflo(uu.y), bfhi(uu.y)}; }
            if (s + 1 < 32) { const int nn = dir ? 30 - s : s + 1;
#pragma unroll
                for (int c = 0; c < 2; ++c) { const bf16* up = item_blk(wsb_, item0 + nn) + IO_UT + (e0 + 16 * c) * 64 + 4 * g;
#pragma unroll
                    for (int t = 0; t < 4; ++t) un[c][t] = *(const u32x2*)(up + 16 * t); }
                cdn = CD_[item0 + nn]; }
            bf16x8 Sb[2][4];
#pragma unroll
            for (int c = 0; c < 2; ++c)
#pragma unroll
                for (int ks = 0; ks < 4; ++ks) Sb[c][ks] = pack8(S[c][2 * ks], S[c][2 * ks + 1]);
            bf16x8 fa[4], fb[4];
#define SC_SB() __builtin_amdgcn_sched_barrier(0)
#define SC_LD4(dst, base_, row_, rstride_) do { dst[0] = ld_frag(Bf + (base_) + ((row_) + r16) * (rstride_) + g * 16); dst[1] = ld_frag(Bf + (base_) + ((row_) + r16) * (rstride_) + 64 + g * 16); \
        dst[2] = ld_frag(Bf + (base_) + ((row_) + r16) * (rstride_) + 128 + g * 16); dst[3] = ld_frag(Bf + (base_) + ((row_) + r16) * (rstride_) + 192 + g * 16); } while (0)
#define SC_MM4(acc_, src, t_) do { acc_[0][t_] = MFMA16(src[0], Sb[0][0], acc_[0][t_]); acc_[1][t_] = MFMA16(src[0], Sb[1][0], acc_[1][t_]); acc_[0][t_] = MFMA16(src[1], Sb[0][1], acc_[0][t_]); acc_[1][t_] = MFMA16(src[1], Sb[1][1], acc_[1][t_]); \
        acc_[0][t_] = MFMA16(src[2], Sb[0][2], acc_[0][t_]); acc_[1][t_] = MFMA16(src[2], Sb[1][2], acc_[1][t_]); acc_[0][t_] = MFMA16(src[3], Sb[0][3], acc_[0][t_]); acc_[1][t_] = MFMA16(src[3], Sb[1][3], acc_[1][t_]); } while (0)
#define SC_MMV(src, t_) SC_MM4(vacc, src, t_)
#define SC_MMO(src, t_) SC_MM4(oacc, src, t_)
#ifndef RSC1
#define RSC1 1
#endif
            f32x4 vsave[2][4];
            if (RSC1 > 1) { _Pragma("unroll") for (int c = 0; c < 2; ++c) _Pragma("unroll") for (int t = 0; t < 4; ++t) vsave[c][t] = vacc[c][t]; }
            for (int r5_ = 0; r5_ < RSC1; ++r5_) {
            if (RSC1 > 1) { _Pragma("unroll") for (int c = 0; c < 2; ++c) _Pragma("unroll") for (int t = 0; t < 4; ++t) vacc[c][t] = vsave[c][t]; asm volatile("" : "+v"(Sb[0][0]), "+v"(Sb[1][0]), "+v"(Sb[0][1]), "+v"(Sb[1][1]), "+v"(Sb[0][2]), "+v"(Sb[1][2]), "+v"(Sb[0][3]), "+v"(Sb[1][3]) :: "memory"); }
            SC_LD4(fa, S_WN, 0, 288); SC_SB();
            SC_LD4(fb, S_WN, 16, 288); SC_SB(); SC_MMV(fa, 0); SC_SB();
            SC_LD4(fa, S_WN, 32, 288); SC_SB(); SC_MMV(fb, 1); SC_SB();
            SC_LD4(fb, S_WN, 48, 288); SC_SB(); SC_MMV(fa, 2); SC_SB();
            SC_LD4(fa, S_QD, 0, 288); SC_SB(); SC_MMV(fb, 3); SC_SB(); }
            bf16x8 Vb[2][2];
#pragma unroll
            for (int c = 0; c < 2; ++c)
#pragma unroll
                for (int kp = 0; kp < 2; ++kp) Vb[c][kp] = pack8(vacc[c][2 * kp], vacc[c][2 * kp + 1]);
            f32x4 oacc[2][4];
#pragma unroll
            for (int c = 0; c < 2; ++c)
#pragma unroll
                for (int t = 0; t < 4; ++t) oacc[c][t] = (f32x4){0.f, 0.f, 0.f, 0.f};
            SC_LD4(fb, S_QD, 16, 288); SC_SB(); SC_MMO(fa, 0); SC_SB();
            SC_LD4(fa, S_QD, 32, 288); SC_SB(); SC_MMO(fb, 1); SC_SB();
            SC_LD4(fb, S_QD, 48, 288); SC_SB(); SC_MMO(fa, 2); SC_SB();
#define SC_LDQK(dst, t0_) do { dst[0] = ld_frag(Bf + S_QK + (16 * (t0_) + r16) * 144 + g * 16); dst[1] = ld_frag(Bf + S_QK + (16 * (t0_) + r16) * 144 + 64 + g * 16); \
        dst[2] = ld_frag(Bf + S_QK + (16 * ((t0_) + 1) + r16) * 144 + g * 16); dst[3] = ld_frag(Bf + S_QK + (16 * ((t0_) + 1) + r16) * 144 + 64 + g * 16); } while (0)
#define SC_MMQK1(f0_, f1_, t_) do { oacc[0][t_] = MFMA16(f0_, Vb[0][0], oacc[0][t_]); oacc[1][t_] = MFMA16(f0_, Vb[1][0], oacc[1][t_]); oacc[0][t_] = MFMA16(f1_, Vb[0][1], oacc[0][t_]); oacc[1][t_] = MFMA16(f1_, Vb[1][1], oacc[1][t_]); } while (0)
#define SC_MMQK(src, t0_) do { SC_MMQK1(src[0], src[1], (t0_)); SC_MMQK1(src[2], src[3], (t0_) + 1); } while (0)
            SC_LDQK(fa, 0); SC_SB(); SC_MMO(fb, 3); SC_SB();
            SC_LDQK(fb, 2); SC_SB(); SC_MMQK(fa, 0); SC_SB();
#define SC_LDKT(dst, td0_) do { dst[0] = ld_frag(Bf + S_KT + (16 * (td0_) + r16) * 144 + g * 16); dst[1] = ld_frag(Bf + S_KT + (16 * (td0_) + r16) * 144 + 64 + g * 16); \
        dst[2] = ld_frag(Bf + S_KT + (16 * ((td0_) + 1) + r16) * 144 + g * 16); dst[3] = ld_frag(Bf + S_KT + (16 * ((td0_) + 1) + r16) * 144 + 64 + g * 16); } while (0)
#define SC_MMKT1(f0_, f1_, td_) do { f32x4 a0_ = S[0][td_] * cd, a1_ = S[1][td_] * cd; a0_ = MFMA16(f0_, Vb[0][0], a0_); a1_ = MFMA16(f0_, Vb[1][0], a1_); a0_ = MFMA16(f1_, Vb[0][1], a0_); a1_ = MFMA16(f1_, Vb[1][1], a1_); S[0][td_] = a0_; S[1][td_] = a1_; } while (0)
#define SC_MMKT(src, td0_) do { SC_MMKT1(src[0], src[1], (td0_)); SC_MMKT1(src[2], src[3], (td0_) + 1); } while (0)
            SC_LDKT(fa, 0); SC_SB(); SC_MMQK(fb, 2); SC_SB();
            LBAR();
#pragma unroll
            for (int c = 0; c < 2; ++c)
#pragma unroll
                for (int t = 0; t < 4; ++t) { const unsigned p01 = cvtpk(oacc[c][t][0], oacc[c][t][1]), p23 = cvtpk(oacc[c][t][2], oacc[c][t][3]); LAS unsigned char* op = L + S_OST + (16 * t + 4 * g) * S_OLD + (e0 + 16 * c) * 2;
                    *(LAS bf16*)(op) = (bf16)(p01 & 0xffffu); *(LAS bf16*)(op + S_OLD) = (bf16)(p01 >> 16); *(LAS bf16*)(op + 2 * S_OLD) = (bf16)(p23 & 0xffffu); *(LAS bf16*)(op + 3 * S_OLD) = (bf16)(p23 >> 16); }
            SC_SB();
            SC_LDKT(fb, 2); SC_SB(); SC_MMKT(fa, 0); SC_SB();
            SC_LDKT(fa, 4); SC_SB(); SC_MMKT(fb, 2); SC_SB();
            SC_LDKT(fb, 6); SC_SB(); SC_MMKT(fa, 4); SC_SB();
            SC_MMKT(fb, 6);
#undef SC_SB
#undef SC_LD4
#undef SC_MMV
#undef SC_MM4
#undef SC_MMO
#undef SC_LDQK
#undef SC_MMQK
#undef SC_MMQK1
#undef SC_MMKT1
#undef SC_LDKT
#undef SC_MMKT
            LBAR(); XBAR();
        }
    }
    { const int np = dir ? 0 : 31;
#pragma unroll
      for (int i = 0; i < 2; ++i) { const int q = tid + 512 * i, row = q >> 4, cc = q & 15; const v4u v = *(const LAS v4u*)(L + S_OST + row * S_OLD + cc * 16);
          *(v4u*)((dir ? OB_ : OF_) + ((size_t)b * SEQ + (size_t)np * 64 + row) * 1024 + h * 128 + cc * 8) = v; } }
    __syncthreads();
#undef SC_LOAD
#undef SC_WRITE
}

DI void combine_row(Frame& F, size_t m, bf16* MO) {
    const int lane = F.lane; const size_t off = m * 1024 + 16 * lane;
    const v4u f0 = *(const v4u*)(F.OF + off), f1 = *(const v4u*)(F.OF + off + 8), b0 = *(const v4u*)(F.OB + off), b1 = *(const v4u*)(F.OB + off + 8);
    const bf16* zp = F.MIX + m * 2048 + 16 * lane; const v4u z0 = *(const v4u*)zp, z1 = *(const v4u*)(zp + 8); bf16* mp = MO + m * 2048 + 16 * lane;
    float o[16];
    o[0] = bflo(f0.x) + bflo(b0.x); o[1] = bfhi(f0.x) + bfhi(b0.x); o[2] = bflo(f0.y) + bflo(b0.y); o[3] = bfhi(f0.y) + bfhi(b0.y);
    o[4] = bflo(f0.z) + bflo(b0.z); o[5] = bfhi(f0.z) + bfhi(b0.z); o[6] = bflo(f0.w) + bflo(b0.w); o[7] = bfhi(f0.w) + bfhi(b0.w);
    o[8] = bflo(f1.x) + bflo(b1.x); o[9] = bfhi(f1.x) + bfhi(b1.x); o[10] = bflo(f1.y) + bflo(b1.y); o[11] = bfhi(f1.y) + bfhi(b1.y);
    o[12] = bflo(f1.z) + bflo(b1.z); o[13] = bfhi(f1.z) + bfhi(b1.z); o[14] = bflo(f1.w) + bflo(b1.w); o[15] = bfhi(f1.w) + bfhi(b1.w);
    float ss = 0.f;
#pragma unroll
    for (int e = 0; e < 16; ++e) ss += o[e] * o[e];
    ss += __shfl_xor(ss, 1); ss += __shfl_xor(ss, 2); ss += __shfl_xor(ss, 4);
    const float rstd = 1.0f / sqrtf(ss * (1.0f / 128.0f) + EPS);
    float z[16];
    z[0] = bflo(z0.x); z[1] = bfhi(z0.x); z[2] = bflo(z0.y); z[3] = bfhi(z0.y); z[4] = bflo(z0.z); z[5] = bfhi(z0.z); z[6] = bflo(z0.w); z[7] = bfhi(z0.w);
    z[8] = bflo(z1.x); z[9] = bfhi(z1.x); z[10] = bflo(z1.y); z[11] = bfhi(z1.y); z[12] = bflo(z1.z); z[13] = bfhi(z1.z); z[14] = bflo(z1.w); z[15] = bfhi(z1.w);
    const int c0 = (16 * lane) & 127; float y[16];
#pragma unroll
    for (int e = 0; e < 16; ++e) y[e] = o[e] * rstd * F.o_norm_a[c0 + e] * z[e];
    v4u w0, w1; w0.x = cvtpk(y[0], y[1]); w0.y = cvtpk(y[2], y[3]); w0.z = cvtpk(y[4], y[5]); w0.w = cvtpk(y[6], y[7]);
    w1.x = cvtpk(y[8], y[9]); w1.y = cvtpk(y[10], y[11]); w1.z = cvtpk(y[12], y[13]); w1.w = cvtpk(y[14], y[15]);
    *(v4u*)mp = w0; *(v4u*)(mp + 8) = w1;
}

struct Args { const float* in[18]; float* out; unsigned char* ws; int ph_lo, ph_hi, li, pad; };
__global__ void __launch_bounds__(NWAVES * 64, 2) hybrid_fwd(Args args) {
    extern __shared__ __attribute__((aligned(16))) unsigned char lds[];
    Frame F;
    F.lds = (LAS unsigned char*)lds;
    F.MISC = (volatile LAS unsigned*)(F.lds + MISC_OFF);
    F.tid = threadIdx.x; F.lane = F.tid & 63; F.wave = __builtin_amdgcn_readfirstlane(F.tid >> 6);
    F.G = gridDim.x; { const int bx = blockIdx.x; F.vcu = (F.G % 8 == 0) ? (bx % 8) * (F.G / 8) + bx / 8 : bx; }
    unsigned char* ws = args.ws;
    F.ctl = (gu32*)(ws + WS_CTL); F.wsb = ws;
    F.x = args.in[0]; F.mem = args.in[1]; F.norm_w = args.in[2]; F.w_in = args.in[3]; F.conv_w = args.in[4]; F.a_log_f = args.in[5]; F.a_log_b = args.in[6];
    F.dt_f = args.in[7]; F.dt_b = args.in[8]; F.o_norm_a = args.in[9]; F.q_norm_b = args.in[10]; F.k_norm_b = args.in[11]; F.sink_b = args.in[12];
    F.mem_norm_w = args.in[13]; F.w_mem_kv = args.in[14]; F.q_norm_c = args.in[15]; F.k_norm_c = args.in[16]; F.w_out = args.in[17]; F.out = args.out;
    F.WinT = (bf16*)(ws + WS_WIN); F.WmemT = (bf16*)(ws + WS_WMEM); F.WoutT = (bf16*)(ws + WS_WOUT); F.XN = (bf16*)(ws + WS_XN); F.MEMN = (bf16*)(ws + WS_MEMN);
    F.PA = (bf16*)(ws + WS_PA); F.PB = (bf16*)(ws + WS_PB); F.PC = (bf16*)(ws + WS_PC); F.MIX = (bf16*)(ws + WS_MIX); F.KVM = (bf16*)(ws + WS_KVM);
    F.UT = (bf16*)(ws + WS_UT); F.WNEG = (bf16*)(ws + WS_WNEG); F.QDEC = (bf16*)(ws + WS_QDEC); F.KDECT = (bf16*)(ws + WS_KDECT); F.QKM = (bf16*)(ws + WS_QKM);
    F.OF = (bf16*)(ws + WS_OF); F.OB = (bf16*)(ws + WS_OB);
    F.GATES = (float*)(ws + WS_GATES); F.ROPE = (float*)(ws + WS_ROPE); F.CD = (float*)(ws + WS_CD);
    for (int u = F.tid; u < (LDS_BYTES - LDSCTL_OFF) / 4; u += NWAVES * 64) ((LAS unsigned*)(F.lds + LDSCTL_OFF))[u] = 0u;
    __syncthreads();
    XcdBarrier bar; bar.bar = (unsigned*)(F.ctl + CW_BAR); bar.x = 0; bar.st = nullptr;
    if (N_LAUNCHES != PER_PHASE) bar = xcd_barrier_post((unsigned*)(F.ctl + CW_BAR), F.MISC + 8);
#define GRID_BAR() do { if (N_LAUNCHES == PER_PHASE) { if (F.tid == 0) __hip_atomic_store(F.ctl + CW_TMO, 0xBADBA0u, RLX_AGENT); } else { xcd_barrier(bar); } } while (0)
    const int lo = args.ph_lo, hi = args.ph_hi;
#define IN(k) (lo <= (k) && (k) < hi)
#define BOTH(k) (IN(k) && IN((k) + 1))

#ifndef REP0
#define REP0 1
#endif
#ifndef REP1
#define REP1 1
#endif
#ifndef REP2A
#define REP2A 1
#endif
#ifndef REP2B
#define REP2B 1
#endif
#ifndef REP2C
#define REP2C 1
#endif
#ifndef REP3
#define REP3 1
#endif
#ifndef REP4
#define REP4 1
#endif
#ifndef REP5
#define REP5 1
#endif
#ifndef REPBAR
#define REPBAR 1
#endif
#ifndef DUMMY
#define DUMMY 0
#endif
    if (DUMMY > 0) {
        f32x4 da[4]; bf16x8 dx = (bf16x8){(short)F.lane, 1, 2, 3, 4, 5, 6, 7};
        for (int q = 0; q < 4; ++q) da[q] = (f32x4){0.f, 0.f, 0.f, 0.f};
        for (int it = 0; it < DUMMY; ++it) {
#pragma unroll
            for (int r = 0; r < 16; ++r) { da[0] = MFMA16(dx, dx, da[0]); da[1] = MFMA16(dx, dx, da[1]); da[2] = MFMA16(dx, dx, da[2]); da[3] = MFMA16(dx, dx, da[3]); } }
        asm volatile("" :: "v"(da[0]), "v"(da[1]), "v"(da[2]), "v"(da[3]));
    }
#ifdef PRETOUCH
    {
        unsigned acc_ = 0u; const size_t st_ = (size_t)PRETOUCH;
        const unsigned char* bufs_[5] = {(const unsigned char*)F.x, (const unsigned char*)F.w_in, (const unsigned char*)F.w_out, (const unsigned char*)F.out, (const unsigned char*)ws};
        const size_t lens_[5] = {(size_t)M * DMODEL * 4, (size_t)DMODEL * NIN * 4, (size_t)DMODEL * DMODEL * 4, (size_t)M * DMODEL * 4, (size_t)510 * MiB};
#pragma unroll
        for (int q_ = 0; q_ < 5; ++q_) for (size_t o_ = (size_t)F.tid * st_; o_ < lens_[q_]; o_ += 512 * st_) acc_ ^= *(const unsigned*)(bufs_[q_] + o_);
        if (acc_ == 0x13572468u) F.ctl[201] = acc_;
    }
#endif
    bf16* const DRY = (bf16*)F.out;
    if (IN(0)) { for (int rep = 0; rep < REP0; ++rep) p0_prologue(F); if (BOTH(0)) for (int rep = 0; rep < REPBAR; ++rep) GRID_BAR(); }

    if (IN(1)) {
        pg8::Gemm g{F.XN, F.WinT, M + NBATCH * MEMLEN, 6656 + 1024, DMODEL}; pg8::InOrder S; S.init(F.G, (int)blockIdx.x, REP1);
        pg8::EpiIn E{F.PA, F.PB, F.PC, F.MIX, F.KVM, F.GATES};
        pg8::gemm_phase<pg8::EpiIn, pg8::InOrder, true, true>(F.lds + RING_OFF, g, S, E);
        if (BOTH(1)) GRID_BAR();
    }

    if (IN(2)) {
        for (int rep = 0; rep < REP2A; ++rep) a_prep_phase(F);
        if (BOTH(2)) GRID_BAR();
    }

    if (IN(3)) {
        for (int rep = 0; rep < REP3; ++rep) for (int it = F.vcu; it < 128; it += F.G) scan_unit(F.lds, F.tid, F.wsb, F.CD, F.OF, F.OB, (bf16*)F.out + (size_t)blockIdx.x * 65536, it >> 1, it & 1);
        for (;;) {
            if (F.tid == 0) F.MISC[16] = __hip_atomic_fetch_add(F.ctl + CW_WQ, 1u, RLX_AGENT);
            __syncthreads();
            const unsigned id = F.MISC[16];
            __syncthreads();
            if (id >= 512u * REP2B) break;
            const int it = (int)(id & 255u);
            if ((id & 511u) < 256u) b_attn_unit(F, it >> 5, (it >> 1) & 15, it & 1, id < 512u ? F.MIX : DRY);
            else c_attn_unit(F, it >> 5, (it >> 3) & 3, it & 7, id < 512u ? F.MIX : DRY);
        }
        if (BOTH(3)) GRID_BAR();
    }

#ifdef BWTEST
    if (IN(3)) {
        if ((int)F.vcu < BWTEST) {
            const size_t total = (size_t)IB_SPLIT * IB_BYTES / 16;
            const v4u* base = (const v4u*)(ws + WS_IA);
            const size_t per = total / BWTEST; const v4u* p = base + per * F.vcu; v4u acc = (v4u){0u, 0u, 0u, 0u};
            for (size_t i = F.tid; i + 512 * (BW_DEPTH - 1) < per; i += 512 * BW_DEPTH) {
                v4u t[BW_DEPTH];
#pragma unroll
                for (int k = 0; k < BW_DEPTH; ++k) t[k] = p[i + 512 * k];
#pragma unroll
                for (int k = 0; k < BW_DEPTH; ++k) acc ^= t[k]; }
            if (acc.x == 0x12345678u && acc.y == 0x9abcdef0u) F.ctl[200] = acc.z;
        }
        GRID_BAR();
    }
#endif
    if (IN(4)) {
        const int gw = F.vcu * NWAVES + F.wave, NGW = F.G * NWAVES;
        for (int rep = 0; rep < REP4; ++rep) for (int m = gw; m < M; m += NGW) combine_row(F, (size_t)m, rep == REP4 - 1 ? F.MIX : DRY);
        if (BOTH(4)) GRID_BAR();
    }

    if (IN(5)) {
        pg8::Gemm g{F.MIX, F.WoutT, M, DMODEL, DMODEL}; pg8::RepOrder S; S.init(M, DMODEL, F.G, (int)blockIdx.x, REP5);
        pg8::EpiOut E{F.x, F.out};
        pg8::gemm_phase<pg8::EpiOut, pg8::RepOrder, false, true>(F.lds + RING_OFF, g, S, E);
    }
#undef IN
#undef BOTH
}

extern "C" void kernel_launch(void* const* d_in, const int* in_sizes, int n_in, void* d_out, int out_size, void* d_ws, size_t ws_size, hipStream_t stream) {
    static int grid = 0;
    if (grid == 0) {
        if (n_in != 18 || in_sizes[0] != M * DMODEL || out_size != M * DMODEL || ws_size < WS_END) { fprintf(stderr, "kernel_launch: unexpected problem shape (n_in %d, in0 %d, out %d, ws %zu); nothing launched\n", n_in, n_in > 0 ? in_sizes[0] : -1, out_size, ws_size); grid = -1; return; }
        int dev = 0, cus = 0, per_cu = 0;
        if (hipGetDevice(&dev) != hipSuccess || hipDeviceGetAttribute(&cus, hipDeviceAttributeMultiprocessorCount, dev) != hipSuccess) { fprintf(stderr, "kernel_launch: device query failed\n"); grid = -1; return; }
        if (hipFuncSetAttribute((const void*)hybrid_fwd, hipFuncAttributeMaxDynamicSharedMemorySize, LDS_BYTES) != hipSuccess) { fprintf(stderr, "kernel_launch: hipFuncSetAttribute failed\n"); grid = -1; return; }
        if (hipOccupancyMaxActiveBlocksPerMultiprocessor(&per_cu, (const void*)hybrid_fwd, NWAVES * 64, LDS_BYTES) != hipSuccess || per_cu < 1)
            fprintf(stderr, "kernel_launch: note: occupancy query reports %d workgroups per CU\n", per_cu);
        (void)hipGetLastError();
        grid = cus;
    }
    if (grid < 0) return;
    if (hipMemsetAsync((char*)d_ws + WS_CTL, 0, CTL_ZERO_BYTES, stream) != hipSuccess) { fprintf(stderr, "kernel_launch: hipMemsetAsync failed\n"); return; }
    Args a{};
    for (int i = 0; i < 18; ++i) a.in[i] = (const float*)d_in[i];
    a.out = (float*)d_out; a.ws = (unsigned char*)d_ws;
    for (int li = 0; li < N_LAUNCHES; ++li) {
        a.ph_lo = (N_LAUNCHES == PER_PHASE) ? li : 0; a.ph_hi = (N_LAUNCHES == PER_PHASE) ? li + 1 : PER_PHASE; a.li = li;
        hipLaunchKernelGGL(hybrid_fwd, dim3(grid), dim3(NWAVES * 64), LDS_BYTES, stream, a);
        const hipError_t le = hipPeekAtLastError();
        if (le != hipSuccess) { fprintf(stderr, "kernel_launch: launch %d failed: %s\n", li, hipGetErrorName(le)); break; }
    }
}
```

```cpp
#include <hip/hip_runtime.h>
#include <cstdio>
#include <cstdint>
#define GAS __attribute__((address_space(1)))
#define LAS __attribute__((address_space(3)))
typedef unsigned short bf16;
typedef unsigned v4u __attribute__((ext_vector_type(4)));
typedef float f32x4 __attribute__((ext_vector_type(4)));
typedef short bf16x8 __attribute__((ext_vector_type(8)));
typedef GAS unsigned gu32;
typedef GAS unsigned long long gu64;
#define RLX_AGENT __ATOMIC_RELAXED, __HIP_MEMORY_SCOPE_AGENT
#define LDS_WAIT() asm volatile("s_waitcnt lgkmcnt(0)" ::: "memory")
#define VM_WAIT() asm volatile("s_waitcnt vmcnt(0)" ::: "memory")
__device__ __forceinline__ unsigned long long rt() { return __builtin_amdgcn_s_memrealtime(); }
__device__ __forceinline__ unsigned f2bf(float f) { unsigned u = __builtin_bit_cast(unsigned, f); return (u + 0x7fffu + ((u >> 16) & 1u)) >> 16; }
__device__ __forceinline__ unsigned pk2(float lo, float hi) { return f2bf(lo) | (f2bf(hi) << 16); }

#define XB_TMO      128
#define XB_XCNT(j)  (256  + 64 * (j))
#define XB_XSUB(j)  (1280 + 64 * (j))
#define XB_XGEN(j)  (2304 + 64 * (j))
#define XB_TOP      3328
#define XB_TOPGEN   3392
#define XCD_BAR_WORDS 3456
#define XB_SPIN_CAP (1u << 18)

__device__ __forceinline__ unsigned xb_ld(unsigned* p)              { return __hip_atomic_load(p, __ATOMIC_RELAXED, __HIP_MEMORY_SCOPE_AGENT); }
__device__ __forceinline__ unsigned xb_add(unsigned* p, unsigned v) { return __hip_atomic_fetch_add(p, v, __ATOMIC_RELAXED, __HIP_MEMORY_SCOPE_AGENT); }
__device__ __forceinline__ unsigned xb_xcc_id() { return (unsigned)__builtin_amdgcn_s_getreg((3 << 11) | 20) & 0xFu; }
#define XB_SPIN(cond, bar) do { unsigned _sp = 0; while (cond) { __builtin_amdgcn_s_sleep(1); \
    if ((++_sp & 255u) == 0u) { if (xb_ld(&(bar)[XB_TMO])) break; if (_sp > XB_SPIN_CAP) { atomicAdd(&(bar)[XB_TMO], 1u); break; } } } } while (0)

struct XcdBarrier {
    unsigned* bar; unsigned x;
    volatile LAS unsigned* st;
};

__device__ __forceinline__ XcdBarrier xcd_barrier_post(unsigned* bar, volatile LAS unsigned* st) {
    XcdBarrier b; b.bar = bar; b.x = xb_xcc_id(); b.st = st;
    if (threadIdx.x == 0) (void)xb_add(&bar[XB_XCNT(b.x)], 1u);
    return b;
}
__device__ __forceinline__ void xcd_barrier_complete(unsigned* bar, unsigned x, unsigned& nloc, unsigned& nx) {
    const unsigned G = gridDim.x * gridDim.y * gridDim.z;
    unsigned sum, cnt, mine, sp = 0u;
    for (;;) {
        sum = 0u; cnt = 0u; mine = 0u;
#pragma unroll
        for (unsigned j = 0; j < 16; ++j) { const unsigned c = xb_ld(&bar[XB_XCNT(j)]); sum += c; cnt += (c > 0u) ? 1u : 0u; mine = (j == x) ? c : mine; }
        if (sum == G) break;
        __builtin_amdgcn_s_sleep(1);
        if ((++sp & 255u) == 0u) { if (xb_ld(&bar[XB_TMO])) break; if (sp > XB_SPIN_CAP) { atomicAdd(&bar[XB_TMO], 1u); break; } }
    }
    nloc = mine > 0u ? mine : 1u; nx = cnt > 0u ? cnt : 1u;
}

__device__ __forceinline__ void xcd_barrier(const XcdBarrier& b) {
    asm volatile("s_waitcnt vmcnt(0)" ::: "memory");
    __syncthreads();
    if (threadIdx.x == 0) {
        unsigned* bar = b.bar;
        __builtin_amdgcn_s_waitcnt(0);
        unsigned nloc = b.st[0], nx = b.st[1];
        if (nloc == 0u) { xcd_barrier_complete(bar, b.x, nloc, nx); b.st[0] = nloc; b.st[1] = nx; }
        const unsigned old = xb_add(&bar[XB_XSUB(b.x)], 1u);
        const unsigned gen = old / nloc;
        if (old + 1u == (gen + 1u) * nloc) {
            __builtin_amdgcn_fence(__ATOMIC_RELEASE, "agent");
            asm volatile("s_waitcnt vmcnt(0)" ::: "memory");
            const unsigned og = xb_add(&bar[XB_TOP], 1u);
            const unsigned tg = og / nx;
            if (og + 1u == (tg + 1u) * nx) xb_add(&bar[XB_TOPGEN], 1u);
            else XB_SPIN(xb_ld(&bar[XB_TOPGEN]) == tg, bar);
            __builtin_amdgcn_fence(__ATOMIC_ACQUIRE, "agent");
            xb_add(&bar[XB_XGEN(b.x)], 1u);
            asm volatile("s_waitcnt vmcnt(0)" ::: "memory");
        } else {
            XB_SPIN(xb_ld(&bar[XB_XGEN(b.x)]) == gen, bar);
            __builtin_amdgcn_fence(__ATOMIC_ACQUIRE, "agent");
            asm volatile("s_waitcnt vmcnt(0)" ::: "memory");
        }
    }
    __syncthreads();
}
namespace pg8 {
#define PG8_LAS __attribute__((address_space(3)))
typedef unsigned short bf16_t;
typedef short bf16x8 __attribute__((ext_vector_type(8)));
typedef float f32x4 __attribute__((ext_vector_type(4)));
typedef unsigned u32x4 __attribute__((ext_vector_type(4)));
constexpr int BM = 256, BK = 64, HALF = 128, HTB = HALF * BK * 2  , STAGE_BYTES = 8 * HTB, NXCD = 8, WGM = 8;

__host__ __device__ __forceinline__ int lds_byte(int r, int c) { const int st = (r >> 4) * 2 + (c >> 5), rr = r & 15, cc = c & 31, ob = rr * 64 + cc * 2; return st * 1024 + (ob ^ (((ob >> 9) & 1) << 5)); }
__host__ __device__ __forceinline__ void stage_rc(int b, int& R, int& C) { const int st = b / 1024, sb = b % 1024, swz = sb ^ (((sb >> 9) & 1) << 5); R = (st >> 1) * 16 + swz / 64; C = (st & 1) * 32 + (swz % 64) / 2; }
__host__ __device__ __forceinline__ int perm32(int rho) { const int n = rho >> 4, i = rho & 15; return 8 * (i >> 2) + 4 * n + (i & 3); }

struct Unit { int pm, pn; };
struct Gemm { const bf16_t* A; const bf16_t* Bt; int M, N, K; };

struct StaticOrder {
    int nM, nN, nwg, G, c;
    __host__ __device__ void init(int M, int N, int G_, int c_) { nM = M / BM; nN = N / BM; nwg = nM * nN; G = G_; c = c_; }
    __host__ __device__ bool next(int i, Unit& u) const {
        const long L = (long)i * G + c; if (L >= nwg) return false;
        int wgid = (int)L; { const int q = nwg / NXCD, r = nwg % NXCD, xcd = wgid % NXCD, off = wgid / NXCD; wgid = (xcd < r ? xcd * (q + 1) : r * (q + 1) + (xcd - r) * q) + off; }
        const int nig = WGM * nN, gid = wgid / nig, fm = gid * WGM, gsz = (nM - fm) < WGM ? (nM - fm) : WGM;
        u.pm = fm + ((wgid % nig) % gsz); u.pn = (wgid % nig) / gsz; return true;
    }
    __device__ __forceinline__ void a_ready(const Unit&) const {}
    __device__ __forceinline__ void pre_epi(int) const {}
    __device__ __forceinline__ void done(const Unit&) const {}
};

typedef float f32x2 __attribute__((ext_vector_type(2)));
typedef __bf16 bf16x2_t __attribute__((ext_vector_type(2)));
__device__ __forceinline__ unsigned cvt_pk_bf16(float lo, float hi) { f32x2 v = {lo, hi}; bf16x2_t b = __builtin_convertvector(v, bf16x2_t); return __builtin_bit_cast(unsigned, b); }
__device__ __forceinline__ float silu_f(float v) { return v * __builtin_amdgcn_rcpf(1.0f + __expf(-v)); }

struct EpiIn {
    static constexpr bool PERM = true, AFTER_DRAIN = false;
    bf16_t *PA, *PB, *PC, *MIX, *KVM; float* GATES;
    __device__ __forceinline__ void init(f32x4 (&acc)[2][2][4][2], const Unit&, int, int, int, int) const {
#pragma unroll
        for (int a = 0; a < 2; ++a)
#pragma unroll
            for (int b = 0; b < 2; ++b)
#pragma unroll
                for (int m = 0; m < 4; ++m)
#pragma unroll
                    for (int n = 0; n < 2; ++n) acc[a][b][m][n] = (f32x4){0.f, 0.f, 0.f, 0.f};
    }
    __device__ __forceinline__ void operator()(const f32x4 (&acc)[2][2][4][2], const Unit& u, int wr, int wc, int fr, int fq) const {
        const int row0 = u.pm * BM + wr * 64 + fr, cl = wc * 32 + 8 * fq, pn = u.pn;
        if (u.pm < 64 && pn == 25) {
            if (wc == 0) {
#pragma unroll
                for (int ai = 0; ai < 2; ++ai)
#pragma unroll
                    for (int m = 0; m < 4; ++m) { float* g = GATES + (size_t)(row0 + ai * HALF + m * 16) * 32 + 8 * fq;
                        *(f32x4*)g = acc[ai][0][m][0]; *(f32x4*)(g + 4) = acc[ai][0][m][1]; }
            }
            return;
        }
        bf16_t* base; int ldc; bool act = false;
        if (u.pm >= 64) { base = KVM + (size_t)(row0 - 16384) * 1024 + (pn - 26) * 256; ldc = 1024; }
        else if (pn < 12) { base = PA + (size_t)row0 * 3072 + pn * 256; ldc = 3072; }
        else if (pn < 16) { base = MIX + (size_t)row0 * 2048 + (pn - 12) * 256; ldc = 2048; act = true; }
        else if (pn < 19) { base = PB + (size_t)row0 * 768 + (pn - 16) * 256; ldc = 768; }
        else if (pn < 21) { base = MIX + (size_t)row0 * 2048 + 1024 + (pn - 19) * 256; ldc = 2048; act = true; }
        else if (pn < 23) { base = PC + (size_t)row0 * 512 + (pn - 21) * 256; ldc = 512; }
        else { base = MIX + (size_t)row0 * 2048 + 1536 + (pn - 23) * 256; ldc = 2048; act = true; }
        base += cl;
#pragma unroll
        for (int ai = 0; ai < 2; ++ai)
#pragma unroll
            for (int m = 0; m < 4; ++m) { bf16_t* rowp = base + (size_t)(ai * HALF + m * 16) * ldc;
#pragma unroll
                for (int bj = 0; bj < 2; ++bj) { f32x4 v0 = acc[ai][bj][m][0], v1 = acc[ai][bj][m][1];
                    if (act) { v0 = (f32x4){silu_f(v0[0]), silu_f(v0[1]), silu_f(v0[2]), silu_f(v0[3])}; v1 = (f32x4){silu_f(v1[0]), silu_f(v1[1]), silu_f(v1[2]), silu_f(v1[3])}; }
                    u32x4 w; w.x = cvt_pk_bf16(v0[0], v0[1]); w.y = cvt_pk_bf16(v0[2], v0[3]); w.z = cvt_pk_bf16(v1[0], v1[1]); w.w = cvt_pk_bf16(v1[2], v1[3]);
                    *(u32x4*)(rowp + bj * HALF) = w; } }
    }
};
struct EpiOut {
    static constexpr bool PERM = false, AFTER_DRAIN = false;
    const float* X; float* O;
    __device__ __forceinline__ void init(f32x4 (&acc)[2][2][4][2], const Unit& u, int wr, int wc, int fr, int fq) const {
        const int row0 = u.pm * BM + wr * 64 + fr, col0 = u.pn * BM + wc * 32 + 4 * fq;
#pragma unroll
        for (int ai = 0; ai < 2; ++ai)
#pragma unroll
            for (int m = 0; m < 4; ++m) { const size_t off = (size_t)(row0 + ai * HALF + m * 16) * 2048 + col0;
#pragma unroll
                for (int bj = 0; bj < 2; ++bj)
#pragma unroll
                    for (int n = 0; n < 2; ++n) acc[ai][bj][m][n] = *(const f32x4*)(X + off + bj * HALF + n * 16); }
    }
    __device__ __forceinline__ void operator()(const f32x4 (&acc)[2][2][4][2], const Unit& u, int wr, int wc, int fr, int fq) const {
        const int row0 = u.pm * BM + wr * 64 + fr, col0 = u.pn * BM + wc * 32 + 4 * fq;
#pragma unroll
        for (int ai = 0; ai < 2; ++ai)
#pragma unroll
            for (int m = 0; m < 4; ++m) { const size_t off = (size_t)(row0 + ai * HALF + m * 16) * 2048 + col0;
#pragma unroll
                for (int bj = 0; bj < 2; ++bj)
#pragma unroll
                    for (int n = 0; n < 2; ++n) *(f32x4*)(O + off + bj * HALF + n * 16) = acc[ai][bj][m][n]; }
    }
};
struct InOrder {
    StaticOrder base; int G, c, rep, sig_ui; unsigned* ctl; volatile PG8_LAS unsigned* st;
    static constexpr int NL = 64 * 13, ADONE_G = 128, ADONE_X = 5120;
    __device__ __forceinline__ void init(int G_, int c_, int rep_, unsigned* ctl_, volatile PG8_LAS unsigned* st_) { G = G_; c = c_; rep = rep_; ctl = ctl_; st = st_; base.init(16384, 13 * 256, G_, 0);
        sig_ui = c_ < NL ? (NL - c_ + G_ - 1) / G_ : 0; }
    __device__ __forceinline__ bool late() const { const int tot = 2 * NL + 32; const int nu = c < tot ? (tot - c + G - 1) / G : 0; return nu <= sig_ui; }
    __device__ __forceinline__ bool next(int i, Unit& u) const {
        long L = (long)i * G + c; const long tot = 2 * NL + 32;
        if (L >= tot * rep) return false;
        L %= tot;
        if (L < 2 * NL) { const bool second = L >= NL; if (second) L -= NL; StaticOrder b2 = base; b2.c = (int)(L % G); b2.next((int)(L / G), u);
            u.pn = second ? u.pn + 12 : (u.pn == 12 ? 25 : u.pn); return true; }
        const int j = (int)(L - 2 * NL);
        u.pm = 64 + (j >> 2); u.pn = 26 + (j & 3); return true;
    }
    __device__ __forceinline__ void announce() const {
        const unsigned x = xb_xcc_id(), nloc = st[0];
        const unsigned old = xb_add(&ctl[ADONE_X + 64 * x], 1u);
        if (old + 1u == nloc) { __builtin_amdgcn_fence(__ATOMIC_RELEASE, "agent"); asm volatile("s_waitcnt vmcnt(0)" ::: "memory"); xb_add(&ctl[ADONE_G], 1u); }
    }
    __device__ __forceinline__ void a_ready(const Unit&) const {}
    __device__ __forceinline__ void pre_epi(int ui) const { if (ui == sig_ui && threadIdx.x == 0) announce(); }
    __device__ __forceinline__ void done(const Unit&) const {}
};
struct RepOrder {
    StaticOrder base; int G, c, rep;
    __host__ __device__ void init(int M_, int N_, int G_, int c_, int rep_ = 1) { G = G_; c = c_; rep = rep_; base.init(M_, N_, G_, 0); }
    __host__ __device__ bool next(int i, Unit& u) const {
        long L = (long)i * G + c; if (L >= (long)base.nwg * rep) return false;
        L %= base.nwg; StaticOrder b2 = base; b2.c = (int)(L % G); return b2.next((int)(L / G), u);
    }
    __device__ __forceinline__ void a_ready(const Unit&) const {}
    __device__ __forceinline__ void pre_epi(int) const {}
    __device__ __forceinline__ void done(const Unit&) const {}
};

template <class Epi, class Sched, bool ALIGN_EPI = false, bool SP2 = false>
__device__ __forceinline__ void gemm_phase(PG8_LAS unsigned char* lds, const Gemm g, const Sched& S, const Epi& E) {
    const int tid = threadIdx.x, wid = __builtin_amdgcn_readfirstlane(tid >> 6), lane = tid & 63, wr = wid >> 2, wc = wid & 3, fr = lane & 15, fq = lane >> 4;
    const int K = g.K, nt = K / BK;
    unsigned voffA[2], voffB[2];
#pragma unroll
    for (int i = 0; i < 2; ++i) { int R, C; stage_rc(tid * 16 + i * 8192, R, C); const int Rb = Epi::PERM ? ((R & ~31) + perm32(R & 31)) : R;
        voffA[i] = (unsigned)(R * K + C) * 2u; voffB[i] = (unsigned)(Rb * K + C) * 2u; }
    const size_t kstep = (size_t)(BK * 2);
    const size_t hstep = (size_t)HALF * K * 2;
    const size_t tstep = 2 * hstep;
    const unsigned ldsw = (unsigned)wid * 1024u;
    const int aoff = lds_byte(wr * 64 + fr, fq * 8), boff = lds_byte(wc * 32 + fr, fq * 8);
#define PG8_SA(b, h) (((b) * 2 + (h)) * HTB)
#define PG8_SB(b, h) ((4 + (b) * 2 + (h)) * HTB)
#define PG8_STAGE(bufoff, gbase, voff) do { _Pragma("unroll") for (int _i = 0; _i < 2; ++_i) \
        __builtin_amdgcn_global_load_lds((const unsigned*)((const char*)(gbase) + (voff)[_i]), (PG8_LAS unsigned*)(lds + (bufoff) + ldsw + _i * 8192), 16, 0, 0); } while (0)
#define PG8_LDA(dst, b, h) do { _Pragma("unroll") for (int m = 0; m < 4; ++m) _Pragma("unroll") for (int k = 0; k < 2; ++k) dst[m][k] = *(const PG8_LAS bf16x8*)(lds + PG8_SA(b, h) + aoff + m * 2048 + k * 1024); } while (0)
#define PG8_LDB(dst, b, h) do { _Pragma("unroll") for (int n = 0; n < 2; ++n) _Pragma("unroll") for (int k = 0; k < 2; ++k) dst[n][k] = *(const PG8_LAS bf16x8*)(lds + PG8_SB(b, h) + boff + n * 2048 + k * 1024); } while (0)
#define PG8_MMA(ai, bj, At, Bt) do { __builtin_amdgcn_s_setprio(1); _Pragma("unroll") for (int m = 0; m < 4; ++m) _Pragma("unroll") for (int n = 0; n < 2; ++n) _Pragma("unroll") for (int k = 0; k < 2; ++k) \
        acc[ai][bj][m][n] = __builtin_amdgcn_mfma_f32_16x16x32_bf16(Bt[n][k], At[m][k], acc[ai][bj][m][n], 0, 0, 0); __builtin_amdgcn_s_setprio(0); } while (0)
#define PG8_WAIT_V(n) asm volatile("s_waitcnt vmcnt(" #n ")" ::: "memory")
#define PG8_WAIT_L(n) asm volatile("s_waitcnt lgkmcnt(" #n ")" ::: "memory")
#define PG8_BAR __builtin_amdgcn_s_barrier()
#define PG8_SCHED __builtin_amdgcn_sched_barrier(0)
    Unit cur, nxt; int ui = 0;
    if (!S.next(0, cur)) return;
    f32x4 acc[2][2][4][2];
    E.init(acc, cur, wr, wc, fr, fq);
    bf16x8 At[4][2], B0[2][2], B1[2][2];
    const char* cA = (const char*)g.A + (size_t)cur.pm * tstep; const char* cB = (const char*)g.Bt + (size_t)cur.pn * tstep;
    S.a_ready(cur);
    if constexpr (SP2) {
        PG8_STAGE(PG8_SB(0, 0), cB, voffB); PG8_STAGE(PG8_SB(0, 1), cB + hstep, voffB); PG8_STAGE(PG8_SA(0, 0), cA, voffA); PG8_STAGE(PG8_SA(0, 1), cA + hstep, voffA);
        if (wr == 1) PG8_BAR;
        PG8_WAIT_V(2); PG8_BAR;
        PG8_STAGE(PG8_SB(1, 0), cB + kstep, voffB); PG8_STAGE(PG8_SA(1, 0), cA + kstep, voffA); PG8_STAGE(PG8_SB(1, 1), cB + hstep + kstep, voffB);
        PG8_WAIT_V(6); PG8_BAR;
    } else {
        PG8_STAGE(PG8_SB(0, 0), cB, voffB); PG8_STAGE(PG8_SA(0, 0), cA, voffA); PG8_STAGE(PG8_SB(0, 1), cB + hstep, voffB); PG8_STAGE(PG8_SA(0, 1), cA + hstep, voffA);
        if (wr == 1) PG8_BAR;
        PG8_WAIT_V(4); PG8_BAR;
        PG8_STAGE(PG8_SB(1, 0), cB + kstep, voffB); PG8_STAGE(PG8_SA(1, 0), cA + kstep, voffA); PG8_STAGE(PG8_SB(1, 1), cB + hstep + kstep, voffB);
        PG8_WAIT_V(6); PG8_BAR;
    }
    for (;;) {
        const bool has_next = S.next(ui + 1, nxt);
        const char* nA = has_next ? (const char*)g.A + (size_t)nxt.pm * tstep : cA; const char* nB = has_next ? (const char*)g.Bt + (size_t)nxt.pn * tstep : cB;
        for (int t = 0; t < nt; t += 2) {
            const bool last = (t == nt - 2);
            const char* a1 = cA + (size_t)(t + 1) * kstep;
            const char* a2 = last ? nA : cA + (size_t)(t + 2) * kstep; const char* b2 = last ? nB : cB + (size_t)(t + 2) * kstep;
            const char* a3 = a2 + kstep; const char* b3 = b2 + kstep;
            if (last && has_next) S.a_ready(nxt);
            if constexpr (SP2) {
            PG8_LDB(B0, 0, 0); PG8_LDB(B1, 0, 1); PG8_SCHED; PG8_LDA(At, 0, 0); PG8_STAGE(PG8_SA(1, 1), a1 + hstep, voffA);
            PG8_WAIT_V(8); PG8_WAIT_L(0); PG8_BAR; PG8_MMA(0, 0, At, B0); PG8_MMA(0, 1, At, B1); PG8_BAR; PG8_SCHED;
            PG8_LDA(At, 0, 1); PG8_STAGE(PG8_SB(0, 0), b2, voffB); PG8_STAGE(PG8_SB(0, 1), b2 + hstep, voffB); PG8_STAGE(PG8_SA(0, 0), a2, voffA);
            PG8_WAIT_V(8); PG8_WAIT_L(0); PG8_BAR; PG8_MMA(1, 0, At, B0); PG8_MMA(1, 1, At, B1); PG8_BAR; PG8_SCHED;
            PG8_LDB(B0, 1, 0); PG8_LDB(B1, 1, 1); PG8_SCHED; PG8_LDA(At, 1, 0); PG8_STAGE(PG8_SA(0, 1), a2 + hstep, voffA);
            PG8_WAIT_V(8); PG8_WAIT_L(0); PG8_BAR; PG8_MMA(0, 0, At, B0); PG8_MMA(0, 1, At, B1); PG8_BAR; PG8_SCHED;
            PG8_LDA(At, 1, 1); PG8_STAGE(PG8_SB(1, 0), b3, voffB); PG8_STAGE(PG8_SB(1, 1), b3 + hstep, voffB); PG8_STAGE(PG8_SA(1, 0), a3, voffA);
            PG8_WAIT_V(8); PG8_WAIT_L(0); PG8_BAR; PG8_MMA(1, 0, At, B0); PG8_MMA(1, 1, At, B1); PG8_BAR; PG8_SCHED;
            } else {
            PG8_LDB(B0, 0, 0); PG8_SCHED; PG8_LDA(At, 0, 0); PG8_STAGE(PG8_SA(1, 1), a1 + hstep, voffA);
            PG8_WAIT_L(8); PG8_BAR; PG8_WAIT_L(0); PG8_MMA(0, 0, At, B0); PG8_BAR; PG8_SCHED;
            PG8_LDB(B1, 0, 1); PG8_STAGE(PG8_SB(0, 0), b2, voffB);
            PG8_BAR; PG8_WAIT_L(0); PG8_MMA(0, 1, At, B1); PG8_BAR;
            PG8_LDA(At, 0, 1); PG8_STAGE(PG8_SA(0, 0), a2, voffA);
            PG8_BAR; PG8_WAIT_L(0); PG8_MMA(1, 0, At, B0); PG8_BAR; PG8_SCHED;
            PG8_STAGE(PG8_SB(0, 1), b2 + hstep, voffB);
            PG8_WAIT_V(6); PG8_BAR; PG8_MMA(1, 1, At, B1); PG8_BAR;
            PG8_LDB(B0, 1, 0); PG8_SCHED; PG8_LDA(At, 1, 0); PG8_STAGE(PG8_SA(0, 1), a2 + hstep, voffA);
            PG8_WAIT_L(8); PG8_BAR; PG8_WAIT_L(0); PG8_MMA(0, 0, At, B0); PG8_BAR; PG8_SCHED;
            PG8_LDB(B1, 1, 1); PG8_STAGE(PG8_SB(1, 0), b3, voffB);
            PG8_BAR; PG8_WAIT_L(0); PG8_MMA(0, 1, At, B1); PG8_BAR;
            PG8_LDA(At, 1, 1); PG8_STAGE(PG8_SA(1, 0), a3, voffA);
            PG8_BAR; PG8_WAIT_L(0); PG8_MMA(1, 0, At, B0); PG8_BAR; PG8_SCHED;
            PG8_STAGE(PG8_SB(1, 1), b3 + hstep, voffB);
            PG8_WAIT_V(6); PG8_BAR; PG8_MMA(1, 1, At, B1); PG8_BAR;
            }
        }
        S.pre_epi(ui);
        if constexpr (ALIGN_EPI) { if (wr == 0) PG8_BAR; }
        if constexpr (!Epi::AFTER_DRAIN) { E(acc, cur, wr, wc, fr, fq);
#ifdef REPEPI
            for (int re_ = 1; re_ < REPEPI; ++re_) { asm volatile("" ::: "memory"); E(acc, cur, wr, wc, fr, fq); }
#endif
            S.done(cur); }
        if (!has_next) break;
        cur = nxt; cA = nA; cB = nB; ++ui;
        E.init(acc, cur, wr, wc, fr, fq);
        if constexpr (ALIGN_EPI) { if (wr == 1) PG8_BAR; }
    }
    PG8_WAIT_V(0);
    if constexpr (!ALIGN_EPI) { if (wr == 0) PG8_BAR; }
    PG8_BAR;
    if constexpr (Epi::AFTER_DRAIN) { E.fused(acc, cur, wr, wc, fr, fq, lds, wid, lane); S.done(cur); }
#undef PG8_SA
#undef PG8_SB
#undef PG8_STAGE
#undef PG8_LDA
#undef PG8_LDB
#undef PG8_MMA
#undef PG8_WAIT_V
#undef PG8_WAIT_L
#undef PG8_BAR
#undef PG8_SCHED
}
}
constexpr int NWAVES = 8;
#ifndef MK_N_LAUNCHES
#define MK_N_LAUNCHES 1
#endif
constexpr int N_LAUNCHES = MK_N_LAUNCHES;
constexpr int PER_PHASE = 6;

constexpr int NBATCH = 8, SEQ = 2048, DMODEL = 2048, M = NBATCH * SEQ;
constexpr int MEMLEN = 256;
constexpr int NIN = 6432;
constexpr float EPS = 1e-6f;
constexpr float LOG2E = 1.4426950408889634f;

constexpr size_t MiB = 1u << 20;
constexpr size_t WS_CTL = 0, CTL_ZERO_BYTES = 24576;
constexpr size_t WS_WOUT = 1 * MiB;
constexpr size_t WS_WIN = 9 * MiB, WS_WMEM = 35 * MiB;
constexpr size_t WS_XN = 39 * MiB, WS_MEMN = 103 * MiB;
constexpr size_t WS_PA = 111 * MiB;
constexpr size_t WS_PB = 207 * MiB;
constexpr size_t WS_PC = 231 * MiB;
constexpr size_t WS_MIX = 247 * MiB;
constexpr size_t WS_GATES = 311 * MiB;
constexpr size_t WS_KVM = 313 * MiB;
constexpr size_t WS_ROPE = 317 * MiB;
constexpr size_t WS_CD = 317 * MiB + 512 * 1024;
constexpr size_t WS_UT = 318 * MiB, WS_WNEG = 382 * MiB, WS_QDEC = 446 * MiB;
constexpr size_t WS_KDECT = 9 * MiB, WS_QKM = 73 * MiB;
constexpr size_t WS_SB = 318 * MiB, WS_DA = 382 * MiB, WS_DB2 = 0  ; constexpr int SB_BYTES = 32768, DB_SPLIT = 3236, DB_BYTES = 41472;
constexpr int SO_QD = 0, SO_KT = 8192;
constexpr int IO_WN = 0, IO_QK = 8192, IO_SC = 12288, IO_UT = 12544;
static_assert(WS_DA + (size_t)DB_SPLIT * DB_BYTES <= 510 * MiB && WS_DB2 + (size_t)(4096 - DB_SPLIT) * DB_BYTES <= 128 * MiB && WS_SB + (size_t)2048 * SB_BYTES <= WS_DA, "scan operand blocks");
constexpr size_t WS_OF = 111 * MiB, WS_OB = 143 * MiB;
constexpr size_t WS_END = 510 * MiB;
constexpr int CW_TMO = 0, CW_CODE = 1, CW_WQ = 64, CW_ADONE = 128, CW_PROG = 256, CW_BAR = 1024;

constexpr int RING_OFF = 0, RING_BYTES = 149504;
constexpr int LDSCTL_OFF = RING_BYTES, MISC_OFF = LDSCTL_OFF + 320;
constexpr int LDS_BYTES = 150528;
static_assert(MISC_OFF + 128 <= LDS_BYTES, "LDS map");

#define DI __device__ __forceinline__
typedef short s16x4 __attribute__((ext_vector_type(4)));
typedef unsigned u32x2 __attribute__((ext_vector_type(2)));
typedef float f32x2v __attribute__((ext_vector_type(2)));
#define MFMA16(a, b, c) __builtin_amdgcn_mfma_f32_16x16x32_bf16((a), (b), (c), 0, 0, 0)
DI unsigned cvtpk(float lo, float hi) { return pg8::cvt_pk_bf16(lo, hi); }
DI float bflo(unsigned v) { return __uint_as_float(v << 16); }
DI float bfhi(unsigned v) { return __uint_as_float(v & 0xffff0000u); }
DI float wave_sum(float v) {
#pragma unroll
    for (int o = 1; o < 64; o <<= 1) v += __shfl_xor(v, o);
    return v;
}
DI float silu_f(float v) { return pg8::silu_f(v); }
DI float softplus_f(float x) { return x > 20.f ? x : log1pf(expf(x)); }
DI float sigmoid_f(float x) { return 1.0f / (1.0f + expf(-x)); }
DI int perm32k(int k) { return (k & ~31) | (((k >> 2) & 3) << 3) | (((k >> 4) & 1) << 2) | (k & 3); }
typedef short v4i16_t __attribute__((ext_vector_type(4)));
DI s16x4 vtr(const LAS unsigned char* p) { return __builtin_bit_cast(s16x4, __builtin_amdgcn_ds_read_tr16_b64_v4i16((LAS v4i16_t*)p)); }
DI bf16x8 tr_frag(const LAS unsigned char* lo, int hi_off) { const s16x4 a = vtr(lo), b = vtr(lo + hi_off); return (bf16x8){a[0], a[1], a[2], a[3], b[0], b[1], b[2], b[3]}; }
DI bf16x8 ld_frag(const LAS unsigned char* p) { return *(const LAS bf16x8*)p; }
DI bf16x8 pack8(const f32x4& a, const f32x4& b) { v4u w; w.x = cvtpk(a[0], a[1]); w.y = cvtpk(a[2], a[3]); w.z = cvtpk(b[0], b[1]); w.w = cvtpk(b[2], b[3]); return __builtin_bit_cast(bf16x8, w); }

struct Frame {
    LAS unsigned char* lds;
    volatile LAS unsigned* MISC;
    gu32* ctl;
    int tid, lane, wave;
    int vcu, G;
    int ap_it0, ap_stride, ap_nit;
    const float *x, *mem, *norm_w, *w_in, *conv_w, *a_log_f, *a_log_b, *dt_f, *dt_b, *o_norm_a, *q_norm_b, *k_norm_b, *sink_b, *mem_norm_w, *w_mem_kv, *q_norm_c, *k_norm_c, *w_out;
    float* out;
    bf16 *WinT, *WmemT, *WoutT, *XN, *MEMN, *PA, *PB, *PC, *MIX, *KVM, *UT, *WNEG, *QDEC, *KDECT, *QKM, *OF, *OB;
    float *GATES, *ROPE, *CD;
    unsigned char* wsb; unsigned char* dbo;
};
DI bf16* item_blk(unsigned char* wsb, unsigned char* dbo, int item) { return (bf16*)(item < DB_SPLIT ? wsb + WS_DA + (size_t)item * DB_BYTES : dbo + WS_DB2 + (size_t)(item - DB_SPLIT) * DB_BYTES); }
DI bf16* shared_blk(unsigned char* wsb, int item) { return (bf16*)(wsb + WS_SB + (size_t)(((item >> 6) << 5) | (item & 31)) * SB_BYTES); }

DI void p0_transpose_item(const float* W, int K, int N, bf16* WT, int k0, int n0, int drow0, LAS float* scr, int lane) {
#pragma unroll 8
    for (int i = 0; i < 32; ++i) { const int kk = 2 * i + (lane >> 5); scr[kk * 33 + (lane & 31)] = W[(size_t)(k0 + kk) * N + n0 + (lane & 31)]; }
    LDS_WAIT(); asm volatile("" ::: "memory");
    const int c = lane & 7;
#pragma unroll
    for (int j = 0; j < 4; ++j) { const int n = (lane >> 3) + 8 * j; const LAS float* s = scr + (8 * c) * 33 + n;
        v4u o; o.x = pk2(s[0 * 33], s[1 * 33]); o.y = pk2(s[2 * 33], s[3 * 33]); o.z = pk2(s[4 * 33], s[5 * 33]); o.w = pk2(s[6 * 33], s[7 * 33]);
        *(GAS v4u*)(WT + (size_t)(drow0 + n) * K + k0 + 8 * c) = o; }
    LDS_WAIT(); asm volatile("" ::: "memory");
}
DI void rms_row_to_bf16(const float* xrow, const float* w, bf16* orow, int lane) {
    const GAS f32x4* xr = (const GAS f32x4*)xrow + lane; const GAS f32x4* wr = (const GAS f32x4*)w + lane;
    f32x4 v[8]; float s = 0.f;
#pragma unroll
    for (int j = 0; j < 8; ++j) { v[j] = xr[64 * j]; s += (v[j].x * v[j].x + v[j].y * v[j].y) + (v[j].z * v[j].z + v[j].w * v[j].w); }
    const float rstd = 1.0f / sqrtf(wave_sum(s) * (1.0f / 2048.0f) + EPS);
    GAS unsigned long long* o8 = (GAS unsigned long long*)orow + lane;
#pragma unroll
    for (int j = 0; j < 8; ++j) { const f32x4 wv = wr[64 * j]; const f32x4 y = v[j] * rstd * wv;
        o8[64 * j] = (unsigned long long)cvtpk(y.x, y.y) | ((unsigned long long)cvtpk(y.z, y.w) << 32); }
}
DI void p0_prologue(Frame& F) {
    LAS float* scr = (LAS float*)(F.lds + RING_OFF + F.wave * 16384);
    const int gw = F.vcu * NWAVES + F.wave, NGW = F.G * NWAVES;
    constexpr int I_IN = 32 * 201, I_MEM = 32 * 32, I_OUT = 32 * 64, NITEMS = I_IN + I_MEM + I_OUT;
    for (int it = gw; it < NITEMS; it += NGW) {
        int r = it;
        if (r < I_IN) { const int kb = r / 201, sb = r % 201, n0 = 32 * sb; const int drow = n0 < 4096 ? n0 : (n0 < 4128 ? 6400 + (n0 - 4096) : n0 - 32);
            p0_transpose_item(F.w_in, 2048, NIN, F.WinT, 64 * kb, n0, drow, scr, F.lane); continue; }
        r -= I_IN;
        if (r < I_MEM) { p0_transpose_item(F.w_mem_kv, 2048, 1024, F.WmemT, 64 * (r / 32), 32 * (r % 32), 32 * (r % 32), scr, F.lane); continue; }
        r -= I_MEM;
        p0_transpose_item(F.w_out, 2048, 2048, F.WoutT, 64 * (r / 64), 32 * (r % 64), 32 * (r % 64), scr, F.lane);
    }
    { GAS v4u* z = (GAS v4u*)(F.WinT + (size_t)NIN * 2048); const int gt = F.vcu * 512 + F.tid, NT = F.G * 512;
      for (int i = gt; i < 224 * 256; i += NT) z[i] = (v4u){0u, 0u, 0u, 0u}; }
    for (int m = gw; m < M; m += NGW) rms_row_to_bf16(F.x + (size_t)m * DMODEL, F.norm_w, F.XN + (size_t)m * DMODEL, F.lane);
    for (int m = gw; m < NBATCH * MEMLEN; m += NGW) rms_row_to_bf16(F.mem + (size_t)m * DMODEL, F.mem_norm_w, F.MEMN + (size_t)m * DMODEL, F.lane);
    { const int gt = F.vcu * 512 + F.tid, NT = F.G * 512;
      for (int i = gt; i < SEQ * 32; i += NT) { const int pos = i >> 5, fi = i & 31; const float inv = powf(10000.0f, -(float)(2 * fi) / 64.0f); const float ang = (float)pos * inv;
          F.ROPE[2 * i] = cosf(ang); F.ROPE[2 * i + 1] = sinf(ang); } }
}

constexpr int AB_QH = 0, AB_KH = 17408, AB_VV = 34816, AB_BUF = 52224, AB_LD = 272;
constexpr int AD_F = 104448, AD_B = 122880, AD_T2 = 9216, AD_LDL = 72, AD_LDT = 144;
constexpr int AG_0 = 141312, AG_SZ = 2560, AG_RAW = 146432;
constexpr int ASCR_F = 0, ASCR_B = 5120;
static_assert(AG_RAW == AG_0 + 2 * AG_SZ && AG_RAW + 1024 <= RING_BYTES && AD_F == 2 * AB_BUF && AD_B == AD_F + 64 * 72 * 4 && AG_0 == AD_B + 64 * 72 * 4, "A-prep LDS map");
#define LBAR() asm volatile("s_waitcnt lgkmcnt(0)\n\ts_barrier" ::: "memory")

#define DPP_ADD(s, ctrl) (s) += __builtin_bit_cast(float, __builtin_amdgcn_update_dpp(0, __builtin_bit_cast(int, (s)), (ctrl), 0xf, 0xf, true))
DI float row16_sum(float s) { DPP_ADD(s, 0xB1); DPP_ADD(s, 0x4E); DPP_ADD(s, 0x141); DPP_ADD(s, 0x140); return s; }

DI void s3_solve(const bool BWD, LAS unsigned char* L, LAS unsigned char* scr, const LAS float* GV, int lane) {
    int lane_o = lane; asm volatile("" : "+v"(lane_o));
    const int hb = lane_o >> 5, cc = lane_o & 31, r16 = lane_o & 15, g = lane_o >> 4;
    LAS unsigned char* D = L + (BWD ? AD_B : AD_F);
    const LAS float* LS = (const LAS float*)D;
    const LAS float* Lb = LS + hb * (32 * AD_LDL + 32);
    LAS unsigned char* SA = scr + (BWD ? ASCR_B : ASCR_F); LAS unsigned char* SB = SA + 2560;
    LAS unsigned char* T1 = D; LAS unsigned char* T2 = D + AD_T2;
    const LAS float* S1 = GV + (BWD ? 192 : 128); const LAS float* S2 = GV + (BWD ? 576 : 512);
    bf16x8 la[2];
#pragma unroll
    for (int ti = 0; ti < 2; ++ti) { const LAS float* lp = LS + (32 + 16 * ti + r16) * AD_LDL + 8 * g; const f32x4 x0 = *(const LAS f32x4*)lp, x1 = *(const LAS f32x4*)(lp + 4); la[ti] = pack8(x0, x1); }
#ifndef RS3L
#define RS3L 1
#endif
    float t[32];
    for (int r3_ = 0; r3_ < RS3L; ++r3_) { asm volatile("" ::: "memory"); int cc_o = cc; asm volatile("" : "+v"(cc_o));
    t[0] = (cc_o == 0) ? 1.f : 0.f;
    f32x4 rwA[8], rwB[8];
    rwB[0] = *(const LAS f32x4*)(Lb + AD_LDL);
#pragma unroll
    for (int i = 1; i < 32; ++i) {
        if (i + 1 < 32) {
#pragma unroll
            for (int q = 0; q < 8; ++q) if (4 * q < i + 1) { if ((i + 1) & 1) rwB[q] = *(const LAS f32x4*)(Lb + (i + 1) * AD_LDL + 4 * q); else rwA[q] = *(const LAS f32x4*)(Lb + (i + 1) * AD_LDL + 4 * q); } }
        __builtin_amdgcn_sched_barrier(0);
        float sa = (cc_o == i) ? 1.f : 0.f, sb = 0.f;
#pragma unroll
        for (int q = 0; q < 8; ++q)
#pragma unroll
            for (int e = 0; e < 4; ++e) if (4 * q + e < i) { const float lv = (i & 1) ? rwB[q][e] : rwA[q][e];
                if (e & 1) asm("v_fma_f32 %0, -%1, %2, %0" : "+v"(sb) : "v"(lv), "v"(t[4 * q + e])); else asm("v_fma_f32 %0, -%1, %2, %0" : "+v"(sa) : "v"(lv), "v"(t[4 * q + e])); }
        t[i] = sa + sb;
        __builtin_amdgcn_sched_barrier(0);
    }
    }
#ifndef RS3T
#define RS3T 1
#endif
    for (int r4_ = 0; r4_ < RS3T; ++r4_) { asm volatile("" ::: "memory");
    {
        const int R = BWD ? 32 * hb + cc : 63 - 32 * hb - cc, colb = BWD ? 32 * hb : 32 * (1 - hb);
#pragma unroll
        for (int q = 0; q < 4; ++q) { const f32x4 a0 = *(const LAS f32x4*)(S1 + colb + 8 * q), a1 = *(const LAS f32x4*)(S1 + colb + 8 * q + 4), b0 = *(const LAS f32x4*)(S2 + colb + 8 * q), b1 = *(const LAS f32x4*)(S2 + colb + 8 * q + 4);
            f32x4 v0, v1;
#pragma unroll
            for (int e = 0; e < 4; ++e) { v0[e] = BWD ? t[8 * q + e] : t[31 - 8 * q - e]; v1[e] = BWD ? t[8 * q + 4 + e] : t[27 - 8 * q - e]; }
            *(LAS bf16x8*)(T1 + R * AD_LDT + (colb + 8 * q) * 2) = pack8(v0 * a0, v1 * a1); *(LAS bf16x8*)(T2 + R * AD_LDT + (colb + 8 * q) * 2) = pack8(v0 * b0, v1 * b1); }
    }
    __builtin_amdgcn_sched_barrier(0);
    if (hb == 0) {
#pragma unroll
        for (int q = 0; q < 4; ++q) *(LAS bf16x8*)(SA + cc * 80 + 16 * q) = pack8((f32x4){t[8 * q], t[8 * q + 1], t[8 * q + 2], t[8 * q + 3]}, (f32x4){t[8 * q + 4], t[8 * q + 5], t[8 * q + 6], t[8 * q + 7]});
    } else {
#pragma unroll
        for (int i = 0; i < 32; i += 2) { const unsigned pk = cvtpk(t[i], t[i + 1]); *(LAS bf16*)(SB + i * 80 + 2 * cc) = (bf16)(pk & 0xffffu); *(LAS bf16*)(SB + (i + 1) * 80 + 2 * cc) = (bf16)(pk >> 16); }
    }
    asm volatile("s_waitcnt lgkmcnt(0)" ::: "memory");
    __builtin_amdgcn_sched_barrier(0);
    bf16x8 tbf[2];
#pragma unroll
    for (int ti = 0; ti < 2; ++ti) tbf[ti] = ld_frag(SA + (16 * ti + r16) * 80 + 16 * g);
    f32x4 P[2][2];
#pragma unroll
    for (int ti = 0; ti < 2; ++ti)
#pragma unroll
        for (int tj = 0; tj < 2; ++tj) P[ti][tj] = MFMA16(la[ti], tbf[tj], ((f32x4){0.f, 0.f, 0.f, 0.f}));
    bf16x8 pbb[2];
#pragma unroll
    for (int tj = 0; tj < 2; ++tj) pbb[tj] = pack8(P[0][tj], P[1][tj]);
#pragma unroll
    for (int tip = 0; tip < 2; ++tip) {
        const u32x2 lo = *(const LAS u32x2*)(SB + (16 * tip + r16) * 80 + 8 * g), hi = *(const LAS u32x2*)(SB + (16 * tip + r16) * 80 + 32 + 8 * g);
        const v4u aw = (v4u){lo.x, lo.y, hi.x, hi.y}; const bf16x8 af = __builtin_bit_cast(bf16x8, aw);
#pragma unroll
        for (int tj = 0; tj < 2; ++tj) { const f32x4 X = MFMA16(af, pbb[tj], ((f32x4){0.f, 0.f, 0.f, 0.f})); const int b = 16 * tj + r16;
            const int Rn = BWD ? b : 63 - b, col0 = BWD ? 32 + 16 * tip + 4 * g : 28 - 16 * tip - 4 * g;
            const f32x4 a0 = *(const LAS f32x4*)(S1 + col0), b0 = *(const LAS f32x4*)(S2 + col0);
            f32x4 xv;
#pragma unroll
            for (int e = 0; e < 4; ++e) xv[e] = BWD ? -X[e] : -X[3 - e];
            u32x2 o1, o2; o1.x = cvtpk(xv[0] * a0[0], xv[1] * a0[1]); o1.y = cvtpk(xv[2] * a0[2], xv[3] * a0[3]); o2.x = cvtpk(xv[0] * b0[0], xv[1] * b0[1]); o2.y = cvtpk(xv[2] * b0[2], xv[3] * b0[3]);
            *(LAS u32x2*)(T1 + Rn * AD_LDT + col0 * 2) = o1; *(LAS u32x2*)(T2 + Rn * AD_LDT + col0 * 2) = o2; }
    }
    }
}

DI void acons_s2(Frame& F, LAS unsigned char* L, LAS unsigned char* B, const LAS float* GV, int item_f, int wv, int lane) {
    int lane_o = lane; asm volatile("" : "+v"(lane_o));
    const int r16 = lane_o & 15, g = lane_o >> 4, item_b = item_f + 32;
    f32x4 accG[4], accQ[4];
#pragma unroll
    for (int tn = 0; tn < 4; ++tn) { accG[tn] = (f32x4){0.f, 0.f, 0.f, 0.f}; accQ[tn] = (f32x4){0.f, 0.f, 0.f, 0.f}; }
    const LAS unsigned char* Ab = B + AB_KH + (16 * wv + r16) * AB_LD + g * 16;
    const LAS unsigned char* Kb = B + AB_KH + r16 * AB_LD + g * 16;
    const LAS unsigned char* Qb = B + AB_QH + r16 * AB_LD + g * 16;
    bf16x8 fr[2][9];
#define S2_LD(dst, ks_) do { dst[0] = ld_frag(Ab + (ks_) * 64); _Pragma("unroll") for (int tn_ = 0; tn_ < 4; ++tn_) { dst[1 + tn_] = ld_frag(Kb + tn_ * 16 * AB_LD + (ks_) * 64); dst[5 + tn_] = ld_frag(Qb + tn_ * 16 * AB_LD + (ks_) * 64); } } while (0)
    S2_LD(fr[0], 0);
#pragma unroll
    for (int ks = 0; ks < 4; ++ks) {
        if (ks + 1 < 4) S2_LD(fr[(ks + 1) & 1], ks + 1);
        __builtin_amdgcn_sched_barrier(0);
#pragma unroll
        for (int tn = 0; tn < 4; ++tn) { accG[tn] = MFMA16(fr[ks & 1][0], fr[ks & 1][1 + tn], accG[tn]); accQ[tn] = MFMA16(fr[ks & 1][0], fr[ks & 1][5 + tn], accQ[tn]); }
        __builtin_amdgcn_sched_barrier(0); }
#undef S2_LD
    LAS float* LF = (LAS float*)(L + AD_F);
    f32x4 gfi, gbi, bfi, bbi;
    { const LAS float* gp = GV + 16 * wv + 4 * g; gfi = *(const LAS f32x4*)gp; gbi = *(const LAS f32x4*)(gp + 64); bfi = *(const LAS f32x4*)(gp + 128); bbi = *(const LAS f32x4*)(gp + 192); }
#pragma unroll
    for (int tn = 0; tn < 4; ++tn) {
        const int j = 16 * tn + r16; const float gcfj = GV[j], gcbj = GV[64 + j];
#pragma unroll
        for (int reg = 0; reg < 4; ++reg) { const int i = 16 * wv + 4 * g + reg; const bool low = (j <= i);
            const float arg = low ? gfi[reg] - gcfj : gbi[reg] - gcbj, bt = low ? bfi[reg] : bbi[reg];
            const int off = low ? (63 - j) * AD_LDL + (63 - i) : (AD_B - AD_F) / 4 + j * AD_LDL + i;
            LF[off] = bt * accG[tn][reg] * __expf(fminf(arg, 0.f)); } }
#pragma unroll
    for (int tn = 0; tn < 4; ++tn) {
        const int i = 16 * tn + r16; const float gcfi = GV[i], gcbi = GV[64 + i]; float qf[4], qb[4];
#pragma unroll
        for (int reg = 0; reg < 4; ++reg) { const int j = 16 * wv + 4 * g + reg; const float v = accQ[tn][reg];
            const float ef = __expf(fminf(gcfi - gfi[reg], 0.f)), eb = __expf(fminf(gcbi - gbi[reg], 0.f));
            qf[reg] = v * ef * ((j <= i) ? 1.f : 0.f); qb[reg] = v * eb * ((j >= i) ? 1.f : 0.f); }
        const int idx = 32 * (wv >> 1) + 8 * g + 4 * (wv & 1);
        u32x2 vf, vb; vf.x = cvtpk(qf[0], qf[1]); vf.y = cvtpk(qf[2], qf[3]); vb.x = cvtpk(qb[0], qb[1]); vb.y = cvtpk(qb[2], qb[3]);
        *(u32x2*)(item_blk(F.wsb, F.dbo, item_f) + IO_QK + i * 64 + idx) = vf; *(u32x2*)(item_blk(F.wsb, F.dbo, item_b) + IO_QK + i * 64 + idx) = vb; }
}
DI void acons_kdect(Frame& F, LAS unsigned char* B, int item, int half, int lane) {
    int lane_o = lane; asm volatile("" : "+v"(lane_o));
    const int i16 = lane_o & 15, gg = lane_o >> 4, q4 = i16 >> 2, p4 = i16 & 3;
    bf16* const kt = shared_blk(F.wsb, item) + SO_KT;
#pragma unroll
    for (int s = 0; s < 2; ++s) {
#pragma unroll
        for (int d4 = 0; d4 < 4; ++d4) { const int dt = 4 * half + d4; const LAS unsigned char* ap = B + AB_KH + (32 * s + 4 * gg + q4) * AB_LD + (16 * dt + 4 * p4) * 2;
            const s16x4 lo = vtr(ap), hi = vtr(ap + 16 * AB_LD);
            const v4u o = __builtin_bit_cast(v4u, (bf16x8){lo[0], lo[1], lo[2], lo[3], hi[0], hi[1], hi[2], hi[3]});
            *(v4u*)(kt + (16 * dt + i16) * 64 + 32 * s + 8 * gg) = o; __builtin_amdgcn_sched_barrier(0); } }
}
DI void acons_s4(const int dir, Frame& F, LAS unsigned char* L, LAS unsigned char* B, LAS unsigned char* stg_all, int item_f, int wv, int lane) {
    int lane_o = lane; asm volatile("" : "+v"(lane_o));
    const int hw = wv & 1, r16 = lane_o & 15, g = lane_o >> 4, q4 = r16 >> 2, p4 = r16 & 3;
    const LAS unsigned char* T1 = L + (dir ? AD_B : AD_F); const LAS unsigned char* T2 = T1 + AD_T2;
    LAS unsigned char* stg = stg_all + wv * 4352;
    bf16* const blk = item_blk(F.wsb, F.dbo, item_f + 32 * dir);
    const int rrow = lane_o >> 3, rpc = lane_o & 7;
#define S4_LDV(dst, te_) do { dst[0] = tr_frag(B + AB_VV + ((8 * g + q4) * 136 + 16 * (te_) + 4 * p4) * 2, 4 * AB_LD); dst[1] = tr_frag(B + AB_VV + ((32 + 8 * g + q4) * 136 + 16 * (te_) + 4 * p4) * 2, 4 * AB_LD); } while (0)
#define S4_LDK(dst, td_) do { dst[0] = tr_frag(B + AB_KH + ((8 * g + q4) * 136 + 16 * (td_) + 4 * p4) * 2, 4 * AB_LD); dst[1] = tr_frag(B + AB_KH + ((32 + 8 * g + q4) * 136 + 16 * (td_) + 4 * p4) * 2, 4 * AB_LD); } while (0)
#define S4_OUT(gptr_) do { _Pragma("unroll") for (int p_ = 0; p_ < 4; ++p_) { const LAS unsigned char* sp_ = stg + (rrow + 8 * p_) * 136 + rpc * 16; const u32x2 lo_ = *(const LAS u32x2*)sp_, hi_ = *(const LAS u32x2*)(sp_ + 8); \
        *(v4u*)((gptr_) + (size_t)(rrow + 8 * p_) * ROWE + rpc * 8) = (v4u){lo_.x, lo_.y, hi_.x, hi_.y}; } } while (0)
    {
        bf16x8 a1[4][2];
#pragma unroll
        for (int ti = 0; ti < 4; ++ti)
#pragma unroll
            for (int ks = 0; ks < 2; ++ks) a1[ti][ks] = ld_frag(T1 + (16 * ti + r16) * AD_LDT + ks * 64 + g * 16);
        bf16x8 fx[2][2];
        S4_LDV(fx[0], 4 * hw);
#pragma unroll
        for (int t4 = 0; t4 < 4; ++t4) {
            if (t4 + 1 < 4) S4_LDV(fx[(t4 + 1) & 1], 4 * hw + t4 + 1);
            __builtin_amdgcn_sched_barrier(0);
            const bf16x8 v0 = fx[t4 & 1][0], v1 = fx[t4 & 1][1];
#pragma unroll
            for (int ti = 0; ti < 4; ++ti) { f32x4 acc = (f32x4){0.f, 0.f, 0.f, 0.f};
                if (!(dir == 1 && ti >= 2)) acc = MFMA16(a1[ti][0], v0, acc);
                if (!(dir == 0 && ti < 2)) acc = MFMA16(a1[ti][1], v1, acc);
                u32x2 o; o.x = cvtpk(acc[0], acc[1]); o.y = cvtpk(acc[2], acc[3]);
                *(LAS u32x2*)(stg + (16 * (t4 & 1) + r16) * 136 + (16 * ti + 4 * g) * 2) = o; }
            __builtin_amdgcn_sched_barrier(0);
            if (t4 & 1) { constexpr int ROWE = 64; S4_OUT(blk + IO_UT + (size_t)(64 * hw + 16 * (t4 - 1)) * 64); __builtin_amdgcn_sched_barrier(0); }
        }
    }
    {
        const int tiA = hw ? 1 : 0, tiB = hw ? 2 : 3;
        const bool A0 = true, A1 = (dir == 1), B0 = (dir == 0), B1 = true;
        bf16x8 a2A[2], a2B[2];
#pragma unroll
        for (int ks = 0; ks < 2; ++ks) { a2A[ks] = ld_frag(T2 + (16 * tiA + r16) * AD_LDT + ks * 64 + g * 16); a2B[ks] = ld_frag(T2 + (16 * tiB + r16) * AD_LDT + ks * 64 + g * 16); }
        bf16x8 fx[2][2];
        S4_LDK(fx[0], 0);
#pragma unroll
        for (int td = 0; td < 8; ++td) {
            if (td + 1 < 8) S4_LDK(fx[(td + 1) & 1], td + 1);
            __builtin_amdgcn_sched_barrier(0);
            f32x4 accA = (f32x4){0.f, 0.f, 0.f, 0.f}, accB = (f32x4){0.f, 0.f, 0.f, 0.f};
            const bf16x8 k0 = fx[td & 1][0], k1 = fx[td & 1][1];
            if (A0) accA = MFMA16(k0, a2A[0], accA); if (B0) accB = MFMA16(k0, a2B[0], accB);
            if (A1) accA = MFMA16(k1, a2A[1], accA); if (B1) accB = MFMA16(k1, a2B[1], accB);
            const int idl = 32 * ((td & 3) >> 1) + 8 * g + 4 * (td & 1);
            u32x2 o; o.x = cvtpk(-accA[0], -accA[1]); o.y = cvtpk(-accA[2], -accA[3]);
            *(LAS u32x2*)(stg + r16 * 136 + idl * 2) = o;
            o.x = cvtpk(-accB[0], -accB[1]); o.y = cvtpk(-accB[2], -accB[3]);
            *(LAS u32x2*)(stg + (16 + r16) * 136 + idl * 2) = o;
            __builtin_amdgcn_sched_barrier(0);
            if ((td & 3) == 3) {
                const int hf = td >> 2;
#pragma unroll
                for (int p_ = 0; p_ < 4; ++p_) { const int sr = rrow + 8 * p_; const LAS unsigned char* sp_ = stg + sr * 136 + rpc * 16; const u32x2 lo_ = *(const LAS u32x2*)sp_, hi_ = *(const LAS u32x2*)(sp_ + 8);
                    const int grow = 16 * (sr < 16 ? tiA : tiB) + (sr & 15);
                    *(v4u*)(blk + IO_WN + (size_t)grow * 128 + 64 * hf + rpc * 8) = (v4u){lo_.x, lo_.y, hi_.x, hi_.y}; }
                __builtin_amdgcn_sched_barrier(0); }
        }
    }
#undef S4_LDV
#undef S4_LDK
#undef S4_OUT
}
DI void aprod_s0(Frame& F, LAS float* GV, const LAS float* RAW, int item_f, int h, int lane) {
    const float ga[4] = {RAW[lane], RAW[64 + lane], RAW[128 + lane], RAW[192 + lane]};
    const float xf_ = ga[0] + F.dt_f[h], xb_ = ga[1] + F.dt_b[h];
    const float gf = -__expf(F.a_log_f[h]) * (xf_ > 15.f ? xf_ : __logf(1.0f + __expf(xf_)));
    const float gb = -__expf(F.a_log_b[h]) * (xb_ > 15.f ? xb_ : __logf(1.0f + __expf(xb_)));
    float pf = gf, pb = gb;
#pragma unroll
    for (int o = 1; o < 64; o <<= 1) { const float tf = __shfl_up(pf, o), tb = __shfl_up(pb, o); if (lane >= o) { pf += tf; pb += tb; } }
    const float totf = __shfl(pf, 63), totb = __shfl(pb, 63);
    const float gcf = pf, gcb = totb - pb + gb;
    const float btf_ = __builtin_amdgcn_rcpf(1.0f + __expf(-ga[2])), btb_ = __builtin_amdgcn_rcpf(1.0f + __expf(-ga[3])), egf_ = __expf(gcf), egb_ = __expf(gcb);
    GV[lane] = gcf; GV[64 + lane] = gcb; GV[128 + lane] = btf_; GV[192 + lane] = btb_;
    GV[256 + lane] = egf_; GV[320 + lane] = egb_; GV[384 + lane] = __expf(totf - gcf); GV[448 + lane] = __expf(totb - gcb); GV[512 + lane] = btf_ * egf_; GV[576 + lane] = btb_ * egb_;
    if (lane == 0) { F.CD[item_f] = __expf(totf); F.CD[item_f + 32] = __expf(totb); }
    { float* sf = (float*)(item_blk(F.wsb, F.dbo, item_f) + IO_SC); float* sb = (float*)(item_blk(F.wsb, F.dbo, item_f + 32) + IO_SC);
      sf[lane] = egf_; sf[64 + lane] = __expf(totf - gcf); sb[lane] = egb_; sb[64 + lane] = __expf(totb - gcb); }
}
DI void aprod_load(Frame& F, v4u (&x)[8], int b, int c, int h, int part, int p0, int c16) {
#pragma unroll
    for (int r = 0; r < 8; ++r) { const int t = c * 64 + p0 - 2 + r; v4u v = (v4u){0u, 0u, 0u, 0u};
        if (t >= 0 && t < SEQ) v = *(const v4u*)(F.PA + ((size_t)b * SEQ + t) * 3072 + part * 1024 + h * 128 + 8 * c16);
        x[r] = v; }
}
DI void aprod_conv(Frame& F, const v4u (&x)[8], float (&o)[4][8], int h, int part, int c16) {
#pragma unroll
    for (int j = 0; j < 4; ++j)
#pragma unroll
        for (int e = 0; e < 8; ++e) o[j][e] = 0.f;
#pragma unroll
    for (int k = 0; k < 5; ++k) { const float* wp = F.conv_w + k * 3072 + part * 1024 + h * 128 + 8 * c16; const f32x4 w0 = *(const f32x4*)wp, w1 = *(const f32x4*)(wp + 4);
#pragma unroll
        for (int j = 0; j < 4; ++j) { const v4u xr = x[j + k];
            o[j][0] += bflo(xr.x) * w0[0]; o[j][1] += bfhi(xr.x) * w0[1]; o[j][2] += bflo(xr.y) * w0[2]; o[j][3] += bfhi(xr.y) * w0[3];
            o[j][4] += bflo(xr.z) * w1[0]; o[j][5] += bfhi(xr.z) * w1[1]; o[j][6] += bflo(xr.w) * w1[2]; o[j][7] += bfhi(xr.w) * w1[3]; } }
#pragma unroll
    for (int j = 0; j < 4; ++j)
#pragma unroll
        for (int e = 0; e < 8; ++e) o[j][e] = silu_f(o[j][e]);
}
DI void aprod_store_rows(LAS unsigned char* img, const float (&o)[4][8], const float (&sc)[4], int p0, int c16) {
#pragma unroll
    for (int j = 0; j < 4; ++j) { v4u w; w.x = cvtpk(o[j][0] * sc[j], o[j][1] * sc[j]); w.y = cvtpk(o[j][2] * sc[j], o[j][3] * sc[j]); w.z = cvtpk(o[j][4] * sc[j], o[j][5] * sc[j]); w.w = cvtpk(o[j][6] * sc[j], o[j][7] * sc[j]);
        *(LAS v4u*)(img + (p0 + j) * AB_LD + c16 * 16) = w; }
}

#ifndef DLY1
#define DLY1 0
#endif
#ifndef DLY2
#define DLY2 0
#endif
#ifndef DLY3
#define DLY3 0
#endif
#define SPIN_TICKS(n_) do { if ((n_) > 0) { const unsigned long long t0_ = __builtin_amdgcn_s_memrealtime(); while (__builtin_amdgcn_s_memrealtime() - t0_ < (unsigned long long)(n_)) __builtin_amdgcn_s_sleep(1); } } while (0)
#ifndef RCK
#define RCK 1
#endif
#ifndef RC2
#define RC2 1
#endif
#ifndef RC3
#define RC3 1
#endif
#ifndef RC4
#define RC4 1
#endif
#ifndef RP1
#define RP1 1
#endif
#ifndef RP2
#define RP2 1
#endif
#ifndef RP3
#define RP3 1
#endif
DI void a_prep_phase(Frame& F) {
    const int lane = F.lane, wave = F.wave;
    LAS unsigned char* L = F.lds + RING_OFF;
    const int nit = F.ap_nit, IT0 = F.ap_it0, IST = F.ap_stride;
    if (wave < 4) {
#pragma unroll 1
        for (int k = -1; k < nit; ++k) {
            LAS unsigned char* Bc = L + (k & 1) * AB_BUF;
            const LAS float* GVc = (const LAS float*)(L + AG_0 + (k & 1) * AG_SZ);
            const int itc = IT0 + k * IST;
            const int item_c = (((itc >> 8) * 8 + (itc & 7)) * 2) * 32 + ((itc >> 3) & 31);
            const bool cons = (k >= 0);
            if (cons) SPIN_TICKS(DLY1);
            if (cons) for (int r_ = 0; r_ < RC2; ++r_) { asm volatile("" ::: "memory"); acons_s2(F, L, Bc, GVc, item_c, wave, lane); }
            LBAR();
            if (cons) SPIN_TICKS(DLY2);
            if (cons) for (int r_ = 0; r_ < RC3; ++r_) { if (wave < 2) s3_solve(wave == 1, L, Bc + AB_QH, GVc, lane); else for (int r2_ = 0; r2_ < RCK; ++r2_) { asm volatile("" ::: "memory"); acons_kdect(F, Bc, item_c, wave - 2, lane); } }
            LBAR();
            if (cons) SPIN_TICKS(DLY3);
            if (cons) for (int r_ = 0; r_ < RC4; ++r_) { asm volatile("" ::: "memory"); acons_s4(wave >> 1, F, L, Bc, Bc + AB_QH, item_c, wave, lane); }
            LBAR();
        }
    } else {
        const int pw = wave - 4;
        LAS float* RAW = (LAS float*)(L + AG_RAW);
        v4u xq[8], xk[8], xv[8];
        { const int c16 = lane & 15, p0 = 16 * pw + 4 * (lane >> 4);
          if (nit > 0) { const int it = IT0; aprod_load(F, xk, it >> 8, (it >> 3) & 31, it & 7, 1, p0, c16); }
          if (wave == 4 && nit > 0) {
              { const int it = IT0; const int b = it >> 8, c = (it >> 3) & 31, h = it & 7; const float* gr = F.GATES + ((size_t)b * SEQ + c * 64 + lane) * 32; RAW[lane] = gr[h]; RAW[64 + lane] = gr[8 + h]; RAW[128 + lane] = gr[16 + h]; RAW[192 + lane] = gr[24 + h];
                aprod_s0(F, (LAS float*)(L + AG_0), RAW, ((b * 8 + h) * 2) * 32 + c, h, lane); }
              if (nit > 1) { const int it = IT0 + IST; const int b = it >> 8, c = (it >> 3) & 31, h = it & 7; const float* gr = F.GATES + ((size_t)b * SEQ + c * 64 + lane) * 32; const float g0 = gr[h], g1 = gr[8 + h], g2 = gr[16 + h], g3 = gr[24 + h];
                RAW[lane] = g0; RAW[64 + lane] = g1; RAW[128 + lane] = g2; RAW[192 + lane] = g3; } } }
#pragma unroll 1
        for (int k = -1; k < nit; ++k) {
            LAS unsigned char* Bn = L + ((k + 1) & 1) * AB_BUF;
            LAS float* GVn = (LAS float*)(L + AG_0 + ((k + 1) & 1) * AG_SZ);
            const int itn = IT0 + (k + 1) * IST;
            const int bn = itn >> 8, cn = (itn >> 3) & 31, hn = itn & 7; const int item_n = ((bn * 8 + hn) * 2) * 32 + cn;
            const bool prod = (k + 1 < nit);
            int lo_ = lane; asm volatile("" : "+v"(lo_));
            const int gI = lo_ >> 4, c16 = lo_ & 15, p0 = 16 * pw + 4 * gI;
            if (prod) {
                aprod_load(F, xq, bn, cn, hn, 0, p0, c16);
                for (int r_ = 0; r_ < RP1; ++r_) { asm volatile("" ::: "memory");
                float o[4][8]; aprod_conv(F, xk, o, hn, 1, c16);
                float sc[4];
#pragma unroll
                for (int j = 0; j < 4; ++j) { float ss = 0.f;
#pragma unroll
                    for (int e = 0; e < 8; ++e) ss += o[j][e] * o[j][e];
                    sc[j] = 1.0f / sqrtf(row16_sum(ss) + EPS); }
                aprod_store_rows(Bn + AB_KH, o, sc, p0, c16); }
            }
            LBAR();
            if (prod) {
                aprod_load(F, xv, bn, cn, hn, 2, p0, c16);
                float o[4][8]; float sc[4];
                for (int r_ = 0; r_ < RP2; ++r_) { asm volatile("" ::: "memory");
                aprod_conv(F, xq, o, hn, 0, c16);
#pragma unroll
                for (int j = 0; j < 4; ++j) { float ss = 0.f;
#pragma unroll
                    for (int e = 0; e < 8; ++e) ss += o[j][e] * o[j][e];
                    sc[j] = (1.0f / sqrtf(row16_sum(ss) + EPS)) * 0.08838834764831845f; }
                aprod_store_rows(Bn + AB_QH, o, sc, p0, c16); }
#ifndef RPQ
#define RPQ 1
#endif
                for (int r_ = 0; r_ < RPQ; ++r_) { asm volatile("" ::: "memory");
                const int b1 = (c16 >> 1) & 1, qoff = 32 * (c16 >> 2) + 8 * (2 * (c16 & 1) + b1);
#pragma unroll
                for (int j = 0; j < 4; ++j) { const int pos = p0 + j; const float e_ = sc[j];
                    const unsigned r0x = cvtpk(o[j][0] * e_, o[j][1] * e_), r0y = cvtpk(o[j][2] * e_, o[j][3] * e_), r1x = cvtpk(o[j][4] * e_, o[j][5] * e_), r1y = cvtpk(o[j][6] * e_, o[j][7] * e_);
                    const unsigned sx = b1 ? r0x : r1x, sy = b1 ? r0y : r1y;
                    const unsigned gx = (unsigned)__builtin_amdgcn_update_dpp(0, (int)sx, 0x4E, 0xf, 0xf, true), gy = (unsigned)__builtin_amdgcn_update_dpp(0, (int)sy, 0x4E, 0xf, 0xf, true);
                    const v4u w = b1 ? (v4u){gx, gy, r1x, r1y} : (v4u){r0x, r0y, gx, gy};
                    *(v4u*)(shared_blk(F.wsb, item_n) + SO_QD + pos * 128 + qoff) = w; }
                }
            }
            LBAR();
            {
                float g4[4] = {0.f, 0.f, 0.f, 0.f}; const bool more = (k + 2 < nit), more3 = (k + 3 < nit);
                if (more) { const int it2 = itn + IST; const int b2 = it2 >> 8, c2 = (it2 >> 3) & 31, h2 = it2 & 7; aprod_load(F, xk, b2, c2, h2, 1, p0, c16);
                    if (wave == 4) { aprod_s0(F, (LAS float*)(L + AG_0 + (k & 1) * AG_SZ), RAW, ((b2 * 8 + h2) * 2) * 32 + c2, h2, lane);
                        if (more3) { const int it3 = it2 + IST; const int b3 = it3 >> 8, c3 = (it3 >> 3) & 31, h3 = it3 & 7; const float* gr = F.GATES + ((size_t)b3 * SEQ + c3 * 64 + lane) * 32; g4[0] = gr[h3]; g4[1] = gr[8 + h3]; g4[2] = gr[16 + h3]; g4[3] = gr[24 + h3]; } } }
                if (prod) for (int r_ = 0; r_ < RP3; ++r_) { asm volatile("" ::: "memory"); float o[4][8]; aprod_conv(F, xv, o, hn, 2, c16);
                    const float sc[4] = {1.f, 1.f, 1.f, 1.f};
                    aprod_store_rows(Bn + AB_VV, o, sc, p0, c16); }
                if (more3 && wave == 4) { RAW[lane] = g4[0]; RAW[64 + lane] = g4[1]; RAW[128 + lane] = g4[2]; RAW[192 + lane] = g4[3]; }
            }
            LBAR();
        }
    }
}

constexpr int B_KB = 0, B_VB = 55296;
DI void b_attn_unit(Frame& F, int b, int nb, int kvh, bf16* MO) {
    const int tid = F.tid, lane = F.lane, wave = F.wave;
    LAS unsigned char* L = F.lds + RING_OFF;
#pragma unroll
    for (int it = 0; it < 6; ++it) { const int q = tid + 512 * it, row = q >> 3, cc = q & 7; const int t = (nb - 1) * 128 + row; const bool valid = (t >= 0) && (t < SEQ);
        v4u kv = (v4u){0u, 0u, 0u, 0u}, vv = (v4u){0u, 0u, 0u, 0u};
        if (valid) { const bf16* rp = F.PB + ((size_t)b * SEQ + t) * 768 + 512 + kvh * 64 + 8 * cc; kv = *(const v4u*)rp; vv = *(const v4u*)(rp + 128); }
        float xk[8]; xk[0] = bflo(kv.x); xk[1] = bfhi(kv.x); xk[2] = bflo(kv.y); xk[3] = bfhi(kv.y); xk[4] = bflo(kv.z); xk[5] = bfhi(kv.z); xk[6] = bflo(kv.w); xk[7] = bfhi(kv.w);
        float ss = 0.f;
#pragma unroll
        for (int e = 0; e < 8; ++e) ss += xk[e] * xk[e];
        ss += __shfl_xor(ss, 1); ss += __shfl_xor(ss, 2); ss += __shfl_xor(ss, 4);
        const float rstd = 1.0f / sqrtf(ss * (1.0f / 64.0f) + EPS);
        const int tt = valid ? t : 0; float o[8];
#pragma unroll
        for (int e = 0; e < 8; ++e) { const float y = xk[e] * rstd * F.k_norm_b[8 * cc + e]; const float pr = __shfl_xor(y, 4);
            const f32x2v cs = *(const f32x2v*)(F.ROPE + ((size_t)tt * 32 + ((8 * cc + e) & 31)) * 2);
            o[e] = (cc < 4) ? (y * cs.x - pr * cs.y) : (y * cs.x + pr * cs.y); }
        v4u ok; ok.x = cvtpk(o[0], o[1]); ok.y = cvtpk(o[2], o[3]); ok.z = cvtpk(o[4], o[5]); ok.w = cvtpk(o[6], o[7]);
        if (!valid) ok = (v4u){0u, 0u, 0u, 0u};
        *(LAS v4u*)(L + B_KB + row * 144 + cc * 16) = ok; *(LAS v4u*)(L + B_VB + row * 144 + cc * 16) = vv; }
    if (tid < 128) *(LAS v4u*)(L + B_VB + (384 + (tid >> 3)) * 144 + (tid & 7) * 16) = (v4u){0u, 0u, 0u, 0u};
    __syncthreads();
    const int hq = kvh * 4 + (wave >> 1), r16 = lane & 15, g = lane >> 4, q4 = r16 >> 2, p4 = r16 & 3;
    const float sk = F.sink_b[hq] * LOG2E;
#pragma unroll 1
    for (int qt = 0; qt < 4; ++qt) {
        const int i0 = (wave & 1) * 64 + 16 * qt, iq = i0 + r16, pos = nb * 128 + iq; const size_t m = (size_t)b * SEQ + pos;
        bf16x8 qf[2];
        { const bf16* qp = F.PB + m * 768 + hq * 64 + 8 * g; const v4u a = *(const v4u*)qp, c2 = *(const v4u*)(qp + 32);
          float x0[8], x1[8]; x0[0] = bflo(a.x); x0[1] = bfhi(a.x); x0[2] = bflo(a.y); x0[3] = bfhi(a.y); x0[4] = bflo(a.z); x0[5] = bfhi(a.z); x0[6] = bflo(a.w); x0[7] = bfhi(a.w);
          x1[0] = bflo(c2.x); x1[1] = bfhi(c2.x); x1[2] = bflo(c2.y); x1[3] = bfhi(c2.y); x1[4] = bflo(c2.z); x1[5] = bfhi(c2.z); x1[6] = bflo(c2.w); x1[7] = bfhi(c2.w);
          float ss = 0.f;
#pragma unroll
          for (int e = 0; e < 8; ++e) ss += x0[e] * x0[e] + x1[e] * x1[e];
          ss += __shfl_xor(ss, 16); ss += __shfl_xor(ss, 32);
          const float rstd = (1.0f / sqrtf(ss * (1.0f / 64.0f) + EPS));
          float o0[8], o1[8];
#pragma unroll
          for (int e = 0; e < 8; ++e) { const float y0 = x0[e] * rstd * F.q_norm_b[8 * g + e], y1 = x1[e] * rstd * F.q_norm_b[32 + 8 * g + e];
              const f32x2v cs = *(const f32x2v*)(F.ROPE + ((size_t)pos * 32 + 8 * g + e) * 2);
              o0[e] = (y0 * cs.x - y1 * cs.y) * (0.125f * LOG2E); o1[e] = (y1 * cs.x + y0 * cs.y) * (0.125f * LOG2E); }
          v4u w0, w1; w0.x = cvtpk(o0[0], o0[1]); w0.y = cvtpk(o0[2], o0[3]); w0.z = cvtpk(o0[4], o0[5]); w0.w = cvtpk(o0[6], o0[7]);
          w1.x = cvtpk(o1[0], o1[1]); w1.y = cvtpk(o1[2], o1[3]); w1.z = cvtpk(o1[4], o1[5]); w1.w = cvtpk(o1[6], o1[7]);
          qf[0] = __builtin_bit_cast(bf16x8, w0); qf[1] = __builtin_bit_cast(bf16x8, w1); }
        f32x4 st[18];
#pragma unroll
        for (int c = 0; c < 17; ++c) { f32x4 acc = (f32x4){0.f, 0.f, 0.f, 0.f};
#pragma unroll
            for (int s = 0; s < 2; ++s) acc = MFMA16(ld_frag(L + B_KB + (i0 + 16 * c + r16) * 144 + s * 64 + g * 16), qf[s], acc);
            st[c] = acc; __builtin_amdgcn_sched_barrier(0); }
        st[17] = (f32x4){0.f, 0.f, 0.f, 0.f};
        float mx = sk;
#pragma unroll
        for (int c = 0; c < 17; ++c)
#pragma unroll
            for (int reg = 0; reg < 4; ++reg) { const int j = i0 + 16 * c + 4 * g + reg; const int kpos = (nb - 1) * 128 + j;
                const bool ok = (j >= iq) && (j <= iq + 256) && (kpos >= 0) && (kpos < SEQ);
                const float v = ok ? st[c][reg] : -INFINITY; st[c][reg] = v; mx = fmaxf(mx, v); }
        mx = fmaxf(mx, __shfl_xor(mx, 16)); mx = fmaxf(mx, __shfl_xor(mx, 32));
        float sum = 0.f;
#pragma unroll
        for (int c = 0; c < 17; ++c)
#pragma unroll
            for (int reg = 0; reg < 4; ++reg) { const float p = __builtin_amdgcn_exp2f(st[c][reg] - mx); st[c][reg] = p; sum += p; }
        sum += __shfl_xor(sum, 16); sum += __shfl_xor(sum, 32);
        const float inv = 1.0f / (sum + __builtin_amdgcn_exp2f(sk - mx));
        bf16x8 pb[9];
#pragma unroll
        for (int kp = 0; kp < 9; ++kp) pb[kp] = pack8(st[2 * kp], st[2 * kp + 1]);
#pragma unroll
        for (int td = 0; td < 4; ++td) { f32x4 acc = (f32x4){0.f, 0.f, 0.f, 0.f};
#pragma unroll
            for (int kp = 0; kp < 9; ++kp) acc = MFMA16(tr_frag(L + B_VB + ((i0 + 32 * kp + 4 * g + q4) * 72 + 16 * td + 4 * p4) * 2, 16 * 144), pb[kp], acc);
            const size_t mo = m * 2048 + 1024 + hq * 64 + 16 * td + 4 * g; const u32x2 z = *(const u32x2*)(F.MIX + mo); bf16* mp = MO + mo;
            u32x2 o; o.x = cvtpk(acc[0] * inv * bflo(z.x), acc[1] * inv * bfhi(z.x)); o.y = cvtpk(acc[2] * inv * bflo(z.y), acc[3] * inv * bfhi(z.y));
            *(u32x2*)mp = o; __builtin_amdgcn_sched_barrier(0); }
    }
    __syncthreads();
}

constexpr int C_KC = 0, C_VC = 69632;
DI void c_attn_unit(Frame& F, int b, int hc, int qblk, bf16* MO) {
    const int tid = F.tid, lane = F.lane, wave = F.wave;
    LAS unsigned char* L = F.lds + RING_OFF;
#pragma unroll
    for (int it = 0; it < 8; ++it) { const int q = tid + 512 * it, row = q >> 4, cc = q & 15;
        const bf16* rp = F.KVM + ((size_t)b * MEMLEN + row) * 1024 + hc * 128 + 8 * cc; const v4u kv = *(const v4u*)rp, vv = *(const v4u*)(rp + 512);
        float xk[8]; xk[0] = bflo(kv.x); xk[1] = bfhi(kv.x); xk[2] = bflo(kv.y); xk[3] = bfhi(kv.y); xk[4] = bflo(kv.z); xk[5] = bfhi(kv.z); xk[6] = bflo(kv.w); xk[7] = bfhi(kv.w);
        float ss = 0.f;
#pragma unroll
        for (int e = 0; e < 8; ++e) ss += xk[e] * xk[e];
        ss += __shfl_xor(ss, 1); ss += __shfl_xor(ss, 2); ss += __shfl_xor(ss, 4); ss += __shfl_xor(ss, 8);
        const float rstd = 1.0f / sqrtf(ss * (1.0f / 128.0f) + EPS);
        float o[8];
#pragma unroll
        for (int e = 0; e < 8; ++e) o[e] = xk[e] * rstd * F.k_norm_c[8 * cc + e];
        v4u ok; ok.x = cvtpk(o[0], o[1]); ok.y = cvtpk(o[2], o[3]); ok.z = cvtpk(o[4], o[5]); ok.w = cvtpk(o[6], o[7]);
        *(LAS v4u*)(L + C_KC + row * 272 + cc * 16) = ok; *(LAS v4u*)(L + C_VC + row * 272 + cc * 16) = vv; }
    __syncthreads();
    const int r16 = lane & 15, g = lane >> 4, q4 = r16 >> 2, p4 = r16 & 3;
#pragma unroll 1
    for (int qt = 0; qt < 2; ++qt) {
        const size_t m = (size_t)b * SEQ + qblk * 256 + wave * 32 + qt * 16 + r16;
        bf16x8 qf[4];
        { float xs[4][8]; float ss = 0.f;
#pragma unroll
          for (int s = 0; s < 4; ++s) { const v4u a = *(const v4u*)(F.PC + m * 512 + hc * 128 + 32 * s + 8 * g);
              xs[s][0] = bflo(a.x); xs[s][1] = bfhi(a.x); xs[s][2] = bflo(a.y); xs[s][3] = bfhi(a.y); xs[s][4] = bflo(a.z); xs[s][5] = bfhi(a.z); xs[s][6] = bflo(a.w); xs[s][7] = bfhi(a.w);
#pragma unroll
              for (int e = 0; e < 8; ++e) ss += xs[s][e] * xs[s][e]; }
          ss += __shfl_xor(ss, 16); ss += __shfl_xor(ss, 32);
          const float rstd = (1.0f / sqrtf(ss * (1.0f / 128.0f) + EPS)) * (0.08838834764831845f * LOG2E);
#pragma unroll
          for (int s = 0; s < 4; ++s) { float o[8];
#pragma unroll
              for (int e = 0; e < 8; ++e) o[e] = xs[s][e] * rstd * F.q_norm_c[32 * s + 8 * g + e];
              v4u w0; w0.x = cvtpk(o[0], o[1]); w0.y = cvtpk(o[2], o[3]); w0.z = cvtpk(o[4], o[5]); w0.w = cvtpk(o[6], o[7]); qf[s] = __builtin_bit_cast(bf16x8, w0); } }
        f32x4 st[16];
#pragma unroll
        for (int c = 0; c < 16; ++c) { f32x4 acc = (f32x4){0.f, 0.f, 0.f, 0.f};
#pragma unroll
            for (int s = 0; s < 4; ++s) acc = MFMA16(ld_frag(L + C_KC + (16 * c + r16) * 272 + s * 64 + g * 16), qf[s], acc);
            st[c] = acc; __builtin_amdgcn_sched_barrier(0); }
        float mx = -INFINITY;
#pragma unroll
        for (int c = 0; c < 16; ++c)
#pragma unroll
            for (int reg = 0; reg < 4; ++reg) mx = fmaxf(mx, st[c][reg]);
        mx = fmaxf(mx, __shfl_xor(mx, 16)); mx = fmaxf(mx, __shfl_xor(mx, 32));
        float sum = 0.f;
#pragma unroll
        for (int c = 0; c < 16; ++c)
#pragma unroll
            for (int reg = 0; reg < 4; ++reg) { const float p = __builtin_amdgcn_exp2f(st[c][reg] - mx); st[c][reg] = p; sum += p; }
        sum += __shfl_xor(sum, 16); sum += __shfl_xor(sum, 32);
        const float inv = 1.0f / sum;
        bf16x8 pb[8];
#pragma unroll
        for (int kp = 0; kp < 8; ++kp) pb[kp] = pack8(st[2 * kp], st[2 * kp + 1]);
#pragma unroll
        for (int td = 0; td < 8; ++td) { f32x4 acc = (f32x4){0.f, 0.f, 0.f, 0.f};
#pragma unroll
            for (int kp = 0; kp < 8; ++kp) acc = MFMA16(tr_frag(L + C_VC + ((32 * kp + 4 * g + q4) * 136 + 16 * td + 4 * p4) * 2, 16 * 272), pb[kp], acc);
            const size_t mo = m * 2048 + 1536 + hc * 128 + 16 * td + 4 * g; const u32x2 z = *(const u32x2*)(F.MIX + mo); bf16* mp = MO + mo;
            u32x2 o; o.x = cvtpk(acc[0] * inv * bflo(z.x), acc[1] * inv * bfhi(z.x)); o.y = cvtpk(acc[2] * inv * bflo(z.y), acc[3] * inv * bfhi(z.y));
            *(u32x2*)mp = o; __builtin_amdgcn_sched_barrier(0); }
    }
    __syncthreads();
}

constexpr int S_WN = 0, S_QD = 18432, S_KT = 36864, S_QK = 55296, S_SC = 64512, S_BUF = 65024;
constexpr int S_OST = 2 * S_BUF, S_OLD = 272;
static_assert(S_OST + 64 * S_OLD <= RING_BYTES, "scan LDS");
#ifdef XBARS
#define XBAR() do { LBAR(); LBAR(); LBAR(); LBAR(); } while (0)
#else
#define XBAR() do {} while (0)
#endif
DI void scan_unit(LAS unsigned char* lds_, int tid, unsigned char* wsb_, unsigned char* dbo_, const float* CD_, bf16* OF_, bf16* OB_, gu32* PROG_, int bh, int dir) {
    const int lane = tid & 63, wave = __builtin_amdgcn_readfirstlane(tid >> 6);
    LAS unsigned char* L = lds_ + RING_OFF;
    const int b = bh >> 3, h = bh & 7;
    const int item0 = (bh * 2 + dir) * 32;
    const int r16 = lane & 15, g = lane >> 4;
    const int lt = tid - 256;
    const int e0 = wave * 32 + r16;
    if (wave == 7) {
        __syncthreads();
#pragma unroll 1
        for (int s = 0; s < 32; ++s) {
            if (lane == 0) __hip_atomic_store(PROG_, (unsigned)(s + 1), RLX_AGENT);
            if (s > 0) { const int np = dir ? 32 - s : s - 1; bf16* ob = (dir ? OB_ : OF_) + ((size_t)b * SEQ + (size_t)np * 64) * 1024 + h * 128;
                int lo_ = lane; asm volatile("" : "+v"(lo_));
#pragma unroll
                for (int i = 0; i < 16; ++i) { const int q = lo_ + 64 * i, row = q >> 4, cc = q & 15; const v4u v = *(const LAS v4u*)(L + S_OST + row * S_OLD + cc * 16);
                    *(v4u*)(ob + (size_t)row * 1024 + cc * 8) = v; } }
            LBAR(); LBAR(); XBAR();
        }
    } else if (wave >= 4) {
        const int l3 = tid - 256;
#define SC_DOF(p_) ((p_) < 1024 ? (unsigned)(S_QD + ((p_) >> 4) * 288 + ((p_) & 15) * 16) : (p_) < 2048 ? (unsigned)(S_KT + (((p_) - 1024) >> 3) * 144 + ((p_) & 7) * 16) : (p_) < 3072 ? (unsigned)(S_WN + (((p_) - 2048) >> 4) * 288 + ((p_) & 15) * 16) \
        : (p_) < 3584 ? (unsigned)(S_QK + (((p_) - 3072) >> 3) * 144 + ((p_) & 7) * 16) : (unsigned)(S_SC + ((p_) - 3584) * 16))
        const bool last_ok = (l3 + 192 * 18) < 3616;
        v4u ldA[19], ldB[19];
#define SC_LOAD(ld, n_) do { const v4u* sb_ = (const v4u*)shared_blk(wsb_, item0 + (n_)); const v4u* db_ = (const v4u*)item_blk(wsb_, dbo_, item0 + (n_)) - 2048; \
        _Pragma("unroll") for (int i_ = 0; i_ < 18; ++i_) { const int p_ = l3 + 192 * i_; ld[i_] = (i_ < 10) ? sb_[p_] : (i_ > 10) ? db_[p_] : (p_ < 2048 ? sb_ : db_)[p_]; } \
        ld[18] = db_[last_ok ? l3 + 192 * 18 : 2048]; } while (0)
#define SC_WRITE(ld, bufo_) do { LAS unsigned char* B_ = L + (bufo_); int lo_ = l3; asm volatile("" : "+v"(lo_)); \
        _Pragma("unroll") for (int i_ = 0; i_ < 18; ++i_) { const int p_ = lo_ + 192 * i_; *(LAS v4u*)(B_ + SC_DOF(p_)) = ld[i_]; } \
        if (last_ok) { const int p_ = lo_ + 192 * 18; *(LAS v4u*)(B_ + SC_DOF(p_)) = ld[18]; } } while (0)
#define SC_CH(k_) (dir ? 31 - ((k_) < 31 ? (k_) : 31) : ((k_) < 31 ? (k_) : 31))
        SC_LOAD(ldA, SC_CH(0)); SC_WRITE(ldA, 0); SC_LOAD(ldB, SC_CH(1)); SC_LOAD(ldA, SC_CH(2));
        __syncthreads();
#pragma unroll 1
        for (int s = 0; s < 32; s += 2) {
            SC_WRITE(ldB, S_BUF); SC_LOAD(ldB, SC_CH(s + 3));
            LBAR(); LBAR(); XBAR();
            SC_WRITE(ldA, 0); SC_LOAD(ldA, SC_CH(s + 4));
            LBAR(); LBAR(); XBAR();
        }
        asm volatile("s_waitcnt vmcnt(0)" ::: "memory");
#undef SC_CH
#undef SC_DOF
    } else {
        f32x4 S[2][8];
#pragma unroll
        for (int c = 0; c < 2; ++c)
#pragma unroll
            for (int td = 0; td < 8; ++td) S[c][td] = (f32x4){0.f, 0.f, 0.f, 0.f};
        u32x2 un[2][4]; float cdn;
        { const int n0 = dir ? 31 : 0;
#pragma unroll
          for (int c = 0; c < 2; ++c) { const bf16* up = item_blk(wsb_, dbo_, item0 + n0) + IO_UT + (e0 + 16 * c) * 64 + 4 * g;
#pragma unroll
              for (int t = 0; t < 4; ++t) un[c][t] = *(const u32x2*)(up + 16 * t); }
          cdn = CD_[item0 + n0]; }
        __syncthreads();
#pragma unroll 1
        for (int s = 0; s < 32; ++s) {
            const LAS unsigned char* Bf = L + (s & 1) * S_BUF;
            const float cd = cdn;
            f32x4 vacc[2][4];
#pragma unroll
            for (int c = 0; c < 2; ++c)
#pragma unroll
                for (int t = 0; t < 4; ++t) { const u32x2 uu = un[c][t]; vacc[c][t] = (f32x4){bflo(uu.x), bfhi(uu.x), bflo(uu.y), bfhi(uu.y)}; }
            if (s + 1 < 32) { const int nn = dir ? 30 - s : s + 1;
#pragma unroll
                for (int c = 0; c < 2; ++c) { const bf16* up = item_blk(wsb_, dbo_, item0 + nn) + IO_UT + (e0 + 16 * c) * 64 + 4 * g;
#pragma unroll
                    for (int t = 0; t < 4; ++t) un[c][t] = *(const u32x2*)(up + 16 * t); }
                cdn = CD_[item0 + nn]; }
            bf16x8 Sb[2][4];
#pragma unroll
            for (int c = 0; c < 2; ++c)
#pragma unroll
                for (int ks = 0; ks < 4; ++ks) Sb[c][ks] = pack8(S[c][2 * ks], S[c][2 * ks + 1]);
            bf16x8 fa[4], fb[4];
#define SC_SB() __builtin_amdgcn_sched_barrier(0)
#define SC_LD4(dst, base_, row_, rstride_) do { dst[0] = ld_frag(Bf + (base_) + ((row_) + r16) * (rstride_) + g * 16); dst[1] = ld_frag(Bf + (base_) + ((row_) + r16) * (rstride_) + 64 + g * 16); \
        dst[2] = ld_frag(Bf + (base_) + ((row_) + r16) * (rstride_) + 128 + g * 16); dst[3] = ld_frag(Bf + (base_) + ((row_) + r16) * (rstride_) + 192 + g * 16); } while (0)
#define SC_MM4(acc_, src, t_) do { acc_[0][t_] = MFMA16(src[0], Sb[0][0], acc_[0][t_]); acc_[1][t_] = MFMA16(src[0], Sb[1][0], acc_[1][t_]); acc_[0][t_] = MFMA16(src[1], Sb[0][1], acc_[0][t_]); acc_[1][t_] = MFMA16(src[1], Sb[1][1], acc_[1][t_]); \
        acc_[0][t_] = MFMA16(src[2], Sb[0][2], acc_[0][t_]); acc_[1][t_] = MFMA16(src[2], Sb[1][2], acc_[1][t_]); acc_[0][t_] = MFMA16(src[3], Sb[0][3], acc_[0][t_]); acc_[1][t_] = MFMA16(src[3], Sb[1][3], acc_[1][t_]); } while (0)
#define SC_MMV(src, t_) SC_MM4(vacc, src, t_)
#define SC_MMO(src, t_) SC_MM4(oacc, src, t_)
#ifndef RSC1
#define RSC1 1
#endif
            f32x4 vsave[2][4];
            if (RSC1 > 1) { _Pragma("unroll") for (int c = 0; c < 2; ++c) _Pragma("unroll") for (int t = 0; t < 4; ++t) vsave[c][t] = vacc[c][t]; }
            for (int r5_ = 0; r5_ < RSC1; ++r5_) {
            if (RSC1 > 1) { _Pragma("unroll") for (int c = 0; c < 2; ++c) _Pragma("unroll") for (int t = 0; t < 4; ++t) vacc[c][t] = vsave[c][t]; asm volatile("" : "+v"(Sb[0][0]), "+v"(Sb[1][0]), "+v"(Sb[0][1]), "+v"(Sb[1][1]), "+v"(Sb[0][2]), "+v"(Sb[1][2]), "+v"(Sb[0][3]), "+v"(Sb[1][3]) :: "memory"); }
            SC_LD4(fa, S_WN, 0, 288); SC_SB();
            SC_LD4(fb, S_WN, 16, 288); SC_SB(); SC_MMV(fa, 0); SC_SB();
            SC_LD4(fa, S_WN, 32, 288); SC_SB(); SC_MMV(fb, 1); SC_SB();
            SC_LD4(fb, S_WN, 48, 288); SC_SB(); SC_MMV(fa, 2); SC_SB();
            SC_LD4(fa, S_QD, 0, 288); SC_SB(); SC_MMV(fb, 3); SC_SB(); }
            bf16x8 Vb[2][2], Vk[2][2];
#pragma unroll
            for (int kp = 0; kp < 2; ++kp) { const f32x4 k0 = *(const LAS f32x4*)(Bf + S_SC + 256 + (32 * kp + 4 * g) * 4), k1 = *(const LAS f32x4*)(Bf + S_SC + 256 + (32 * kp + 16 + 4 * g) * 4);
#pragma unroll
                for (int c = 0; c < 2; ++c) { Vb[c][kp] = pack8(vacc[c][2 * kp], vacc[c][2 * kp + 1]); const f32x4 s0 = vacc[c][2 * kp] * k0, s1 = vacc[c][2 * kp + 1] * k1; Vk[c][kp] = pack8(s0, s1); } }
            f32x4 oacc[2][4];
#pragma unroll
            for (int c = 0; c < 2; ++c)
#pragma unroll
                for (int t = 0; t < 4; ++t) oacc[c][t] = (f32x4){0.f, 0.f, 0.f, 0.f};
            SC_LD4(fb, S_QD, 16, 288); SC_SB(); SC_MMO(fa, 0); SC_SB();
            SC_LD4(fa, S_QD, 32, 288); SC_SB(); SC_MMO(fb, 1); SC_SB();
            SC_LD4(fb, S_QD, 48, 288); SC_SB(); SC_MMO(fa, 2); SC_SB();
#define SC_LDQK(dst, t0_) do { dst[0] = ld_frag(Bf + S_QK + (16 * (t0_) + r16) * 144 + g * 16); dst[1] = ld_frag(Bf + S_QK + (16 * (t0_) + r16) * 144 + 64 + g * 16); \
        dst[2] = ld_frag(Bf + S_QK + (16 * ((t0_) + 1) + r16) * 144 + g * 16); dst[3] = ld_frag(Bf + S_QK + (16 * ((t0_) + 1) + r16) * 144 + 64 + g * 16); } while (0)
#define SC_MMQK1(f0_, f1_, t_) do { oacc[0][t_] = MFMA16(f0_, Vb[0][0], oacc[0][t_]); oacc[1][t_] = MFMA16(f0_, Vb[1][0], oacc[1][t_]); oacc[0][t_] = MFMA16(f1_, Vb[0][1], oacc[0][t_]); oacc[1][t_] = MFMA16(f1_, Vb[1][1], oacc[1][t_]); } while (0)
#define SC_MMQK(src, t0_) do { SC_MMQK1(src[0], src[1], (t0_)); SC_MMQK1(src[2], src[3], (t0_) + 1); } while (0)
            SC_LDQK(fa, 0); SC_SB(); SC_MMO(fb, 3); SC_SB();
#pragma unroll
            for (int t = 0; t < 4; ++t) { const f32x4 eg4 = *(const LAS f32x4*)(Bf + S_SC + (16 * t + 4 * g) * 4); oacc[0][t] *= eg4; oacc[1][t] *= eg4; }
            SC_SB();
            SC_LDQK(fb, 2); SC_SB(); SC_MMQK(fa, 0); SC_SB();
#define SC_LDKT(dst, td0_) do { dst[0] = ld_frag(Bf + S_KT + (16 * (td0_) + r16) * 144 + g * 16); dst[1] = ld_frag(Bf + S_KT + (16 * (td0_) + r16) * 144 + 64 + g * 16); \
        dst[2] = ld_frag(Bf + S_KT + (16 * ((td0_) + 1) + r16) * 144 + g * 16); dst[3] = ld_frag(Bf + S_KT + (16 * ((td0_) + 1) + r16) * 144 + 64 + g * 16); } while (0)
#define SC_MMKT1(f0_, f1_, td_) do { f32x4 a0_ = S[0][td_] * cd, a1_ = S[1][td_] * cd; a0_ = MFMA16(f0_, Vk[0][0], a0_); a1_ = MFMA16(f0_, Vk[1][0], a1_); a0_ = MFMA16(f1_, Vk[0][1], a0_); a1_ = MFMA16(f1_, Vk[1][1], a1_); S[0][td_] = a0_; S[1][td_] = a1_; } while (0)
#define SC_MMKT(src, td0_) do { SC_MMKT1(src[0], src[1], (td0_)); SC_MMKT1(src[2], src[3], (td0_) + 1); } while (0)
            SC_LDKT(fa, 0); SC_SB(); SC_MMQK(fb, 2); SC_SB();
            LBAR();
#pragma unroll
            for (int c = 0; c < 2; ++c)
#pragma unroll
                for (int t = 0; t < 4; ++t) { const unsigned p01 = cvtpk(oacc[c][t][0], oacc[c][t][1]), p23 = cvtpk(oacc[c][t][2], oacc[c][t][3]); LAS unsigned char* op = L + S_OST + (16 * t + 4 * g) * S_OLD + (e0 + 16 * c) * 2;
                    *(LAS bf16*)(op) = (bf16)(p01 & 0xffffu); *(LAS bf16*)(op + S_OLD) = (bf16)(p01 >> 16); *(LAS bf16*)(op + 2 * S_OLD) = (bf16)(p23 & 0xffffu); *(LAS bf16*)(op + 3 * S_OLD) = (bf16)(p23 >> 16); }
            SC_SB();
            SC_LDKT(fb, 2); SC_SB(); SC_MMKT(fa, 0); SC_SB();
            SC_LDKT(fa, 4); SC_SB(); SC_MMKT(fb, 2); SC_SB();
            SC_LDKT(fb, 6); SC_SB(); SC_MMKT(fa, 4); SC_SB();
            SC_MMKT(fb, 6);
#undef SC_SB
#undef SC_LD4
#undef SC_MMV
#undef SC_MM4
#undef SC_MMO
#undef SC_LDQK
#undef SC_MMQK
#undef SC_MMQK1
#undef SC_MMKT1
#undef SC_LDKT
#undef SC_MMKT
            LBAR(); XBAR();
        }
    }
    { const int np = dir ? 0 : 31;
#pragma unroll
      for (int i = 0; i < 2; ++i) { const int q = tid + 512 * i, row = q >> 4, cc = q & 15; const v4u v = *(const LAS v4u*)(L + S_OST + row * S_OLD + cc * 16);
          *(v4u*)((dir ? OB_ : OF_) + ((size_t)b * SEQ + (size_t)np * 64 + row) * 1024 + h * 128 + cc * 8) = v; } }
    __syncthreads();
#undef SC_LOAD
#undef SC_WRITE
}

DI void combine_row(Frame& F, size_t m, bf16* MO) {
    const int lane = F.lane; const size_t off = m * 1024 + 16 * lane;
    const v4u f0 = *(const v4u*)(F.OF + off), f1 = *(const v4u*)(F.OF + off + 8), b0 = *(const v4u*)(F.OB + off), b1 = *(const v4u*)(F.OB + off + 8);
    const bf16* zp = F.MIX + m * 2048 + 16 * lane; const v4u z0 = *(const v4u*)zp, z1 = *(const v4u*)(zp + 8); bf16* mp = MO + m * 2048 + 16 * lane;
    float o[16];
    o[0] = bflo(f0.x) + bflo(b0.x); o[1] = bfhi(f0.x) + bfhi(b0.x); o[2] = bflo(f0.y) + bflo(b0.y); o[3] = bfhi(f0.y) + bfhi(b0.y);
    o[4] = bflo(f0.z) + bflo(b0.z); o[5] = bfhi(f0.z) + bfhi(b0.z); o[6] = bflo(f0.w) + bflo(b0.w); o[7] = bfhi(f0.w) + bfhi(b0.w);
    o[8] = bflo(f1.x) + bflo(b1.x); o[9] = bfhi(f1.x) + bfhi(b1.x); o[10] = bflo(f1.y) + bflo(b1.y); o[11] = bfhi(f1.y) + bfhi(b1.y);
    o[12] = bflo(f1.z) + bflo(b1.z); o[13] = bfhi(f1.z) + bfhi(b1.z); o[14] = bflo(f1.w) + bflo(b1.w); o[15] = bfhi(f1.w) + bfhi(b1.w);
    float ss = 0.f;
#pragma unroll
    for (int e = 0; e < 16; ++e) ss += o[e] * o[e];
    ss += __shfl_xor(ss, 1); ss += __shfl_xor(ss, 2); ss += __shfl_xor(ss, 4);
    const float rstd = 1.0f / sqrtf(ss * (1.0f / 128.0f) + EPS);
    float z[16];
    z[0] = bflo(z0.x); z[1] = bfhi(z0.x); z[2] = bflo(z0.y); z[3] = bfhi(z0.y); z[4] = bflo(z0.z); z[5] = bfhi(z0.z); z[6] = bflo(z0.w); z[7] = bfhi(z0.w);
    z[8] = bflo(z1.x); z[9] = bfhi(z1.x); z[10] = bflo(z1.y); z[11] = bfhi(z1.y); z[12] = bflo(z1.z); z[13] = bfhi(z1.z); z[14] = bflo(z1.w); z[15] = bfhi(z1.w);
    const int c0 = (16 * lane) & 127; float y[16];
#pragma unroll
    for (int e = 0; e < 16; ++e) y[e] = o[e] * rstd * F.o_norm_a[c0 + e] * z[e];
    v4u w0, w1; w0.x = cvtpk(y[0], y[1]); w0.y = cvtpk(y[2], y[3]); w0.z = cvtpk(y[4], y[5]); w0.w = cvtpk(y[6], y[7]);
    w1.x = cvtpk(y[8], y[9]); w1.y = cvtpk(y[10], y[11]); w1.z = cvtpk(y[12], y[13]); w1.w = cvtpk(y[14], y[15]);
    *(v4u*)mp = w0; *(v4u*)(mp + 8) = w1;
}

struct Args { const float* in[18]; float* out; unsigned char* ws; int ph_lo, ph_hi, li, pad; };
__global__ void __launch_bounds__(NWAVES * 64, 2) hybrid_fwd(Args args) {
    extern __shared__ __attribute__((aligned(16))) unsigned char lds[];
    Frame F;
    F.lds = (LAS unsigned char*)lds;
    F.MISC = (volatile LAS unsigned*)(F.lds + MISC_OFF);
    F.tid = threadIdx.x; F.lane = F.tid & 63; F.wave = __builtin_amdgcn_readfirstlane(F.tid >> 6);
    F.G = gridDim.x; { const int bx = blockIdx.x; F.vcu = (F.G % 8 == 0) ? (bx % 8) * (F.G / 8) + bx / 8 : bx; }
    unsigned char* ws = args.ws;
    F.ctl = (gu32*)(ws + WS_CTL); F.wsb = ws; F.dbo = (unsigned char*)args.out;
    F.x = args.in[0]; F.mem = args.in[1]; F.norm_w = args.in[2]; F.w_in = args.in[3]; F.conv_w = args.in[4]; F.a_log_f = args.in[5]; F.a_log_b = args.in[6];
    F.dt_f = args.in[7]; F.dt_b = args.in[8]; F.o_norm_a = args.in[9]; F.q_norm_b = args.in[10]; F.k_norm_b = args.in[11]; F.sink_b = args.in[12];
    F.mem_norm_w = args.in[13]; F.w_mem_kv = args.in[14]; F.q_norm_c = args.in[15]; F.k_norm_c = args.in[16]; F.w_out = args.in[17]; F.out = args.out;
    F.WinT = (bf16*)(ws + WS_WIN); F.WmemT = (bf16*)(ws + WS_WMEM); F.WoutT = (bf16*)(ws + WS_WOUT); F.XN = (bf16*)(ws + WS_XN); F.MEMN = (bf16*)(ws + WS_MEMN);
    F.PA = (bf16*)(ws + WS_PA); F.PB = (bf16*)(ws + WS_PB); F.PC = (bf16*)(ws + WS_PC); F.MIX = (bf16*)(ws + WS_MIX); F.KVM = (bf16*)(ws + WS_KVM);
    F.UT = (bf16*)(ws + WS_UT); F.WNEG = (bf16*)(ws + WS_WNEG); F.QDEC = (bf16*)(ws + WS_QDEC); F.KDECT = (bf16*)(ws + WS_KDECT); F.QKM = (bf16*)(ws + WS_QKM);
    F.OF = (bf16*)(ws + WS_OF); F.OB = (bf16*)(ws + WS_OB);
    F.GATES = (float*)(ws + WS_GATES); F.ROPE = (float*)(ws + WS_ROPE); F.CD = (float*)(ws + WS_CD);
    for (int u = F.tid; u < (LDS_BYTES - LDSCTL_OFF) / 4; u += NWAVES * 64) ((LAS unsigned*)(F.lds + LDSCTL_OFF))[u] = 0u;
    __syncthreads();
    XcdBarrier bar; bar.bar = (unsigned*)(F.ctl + CW_BAR); bar.x = 0; bar.st = nullptr;
    if (N_LAUNCHES != PER_PHASE) bar = xcd_barrier_post((unsigned*)(F.ctl + CW_BAR), F.MISC + 8);
#define GRID_BAR() do { if (N_LAUNCHES == PER_PHASE) { if (F.tid == 0) __hip_atomic_store(F.ctl + CW_TMO, 0xBADBA0u, RLX_AGENT); } else { xcd_barrier(bar); } } while (0)
    const int lo = args.ph_lo, hi = args.ph_hi;
#define IN(k) (lo <= (k) && (k) < hi)
#define BOTH(k) (IN(k) && IN((k) + 1))

#ifndef REP0
#define REP0 1
#endif
#ifndef REP1
#define REP1 1
#endif
#ifndef REP2A
#define REP2A 1
#endif
#ifndef REP2B
#define REP2B 1
#endif
#ifndef REP2C
#define REP2C 1
#endif
#ifndef REP3
#define REP3 1
#endif
#ifndef REP4
#define REP4 1
#endif
#ifndef REP5
#define REP5 1
#endif
#ifndef REPBAR
#define REPBAR 1
#endif
#ifndef DUMMY
#define DUMMY 0
#endif
    if (DUMMY > 0) {
        f32x4 da[4]; bf16x8 dx = (bf16x8){(short)F.lane, 1, 2, 3, 4, 5, 6, 7};
        for (int q = 0; q < 4; ++q) da[q] = (f32x4){0.f, 0.f, 0.f, 0.f};
        for (int it = 0; it < DUMMY; ++it) {
#pragma unroll
            for (int r = 0; r < 16; ++r) { da[0] = MFMA16(dx, dx, da[0]); da[1] = MFMA16(dx, dx, da[1]); da[2] = MFMA16(dx, dx, da[2]); da[3] = MFMA16(dx, dx, da[3]); } }
        asm volatile("" :: "v"(da[0]), "v"(da[1]), "v"(da[2]), "v"(da[3]));
    }
    bf16* const DRY = (bf16*)F.out;
    if (IN(0)) { for (int rep = 0; rep < REP0; ++rep) p0_prologue(F); if (BOTH(0)) for (int rep = 0; rep < REPBAR; ++rep) GRID_BAR(); }

    if (IN(1)) {
        pg8::Gemm g{F.XN, F.WinT, M + NBATCH * MEMLEN, 6656 + 1024, DMODEL}; pg8::InOrder S; S.init(F.G, (int)blockIdx.x, REP1, (unsigned*)F.ctl, F.MISC + 8);
        pg8::EpiIn E{F.PA, F.PB, F.PC, F.MIX, F.KVM, F.GATES};
        pg8::gemm_phase<pg8::EpiIn, pg8::InOrder, true, true>(F.lds + RING_OFF, g, S, E);
        if (S.late() && F.tid == 0) S.announce();
        if (BOTH(1) && N_LAUNCHES == PER_PHASE) GRID_BAR();
    }

    if (IN(2)) {
        if (IN(1) && N_LAUNCHES != PER_PHASE && F.G == 256 && REP1 == 1) { const int bx = (int)blockIdx.x; F.ap_stride = 1;
            if (bx >= 160) { F.ap_it0 = (bx - 160) * 10; F.ap_nit = 10; } else if (bx < 128) { F.ap_it0 = 960 + bx * 7; F.ap_nit = 7; } else { F.ap_it0 = 1856 + (bx - 128) * 6; F.ap_nit = 6; } }
        else { F.ap_it0 = F.vcu; F.ap_stride = F.G; F.ap_nit = (F.vcu < 2048) ? (2048 - F.vcu + F.G - 1) / F.G : 0; }
        if (IN(1) && N_LAUNCHES != PER_PHASE) {
            if (F.tid == 0) { unsigned* ctl_ = (unsigned*)F.ctl; const unsigned nx = F.MISC[9];
                XB_SPIN(xb_ld(&ctl_[pg8::InOrder::ADONE_G]) < nx, ctl_ + CW_BAR);
                __builtin_amdgcn_fence(__ATOMIC_ACQUIRE, "agent"); asm volatile("s_waitcnt vmcnt(0)" ::: "memory"); }
            __syncthreads();
        }
        for (int rep = 0; rep < REP2A; ++rep) a_prep_phase(F);
        if (BOTH(2)) GRID_BAR();
    }

    if (IN(3)) {
        for (int rep = 0; rep < REP3; ++rep) if ((F.vcu & 1) == 0) for (int it = F.vcu >> 1; it < 128; it += (F.G + 1) >> 1) scan_unit(F.lds, F.tid, F.wsb, F.dbo, F.CD, F.OF, F.OB, F.ctl + CW_PROG + it, it >> 1, it & 1);
        for (;;) {
            if (F.tid == 0) F.MISC[16] = __hip_atomic_fetch_add(F.ctl + CW_WQ, 1u, RLX_AGENT);
            __syncthreads();
            const unsigned id = F.MISC[16];
            __syncthreads();
            if (id >= 512u * REP2B) break;
            const int it = (int)(id & 255u);
            if ((id & 511u) < 256u) b_attn_unit(F, it >> 5, (it >> 1) & 15, it & 1, id < 512u ? F.MIX : DRY);
            else c_attn_unit(F, it >> 5, (it >> 3) & 3, it & 7, id < 512u ? F.MIX : DRY);
        }
#ifdef PARTNER_PREFETCH
        if ((F.vcu & 1) == 1 && (F.vcu >> 1) < 128 && F.wave == 0) {
            const int it = F.vcu >> 1, dir = it & 1, item0 = ((it >> 1) * 2 + dir) * 32; gu32* prog = F.ctl + CW_PROG + it; unsigned acc_ = 0u;
            int k = 0; const unsigned long long t0 = rt();
            while (k < 32) {
                const unsigned done = (unsigned)__builtin_amdgcn_readfirstlane((int)__hip_atomic_load(prog, RLX_AGENT));
                if ((int)done >= 32 || rt() - t0 > 30000ull) break;
                if (k < (int)done + 4) k = (int)done + 4;
                if (k > (int)done + 5 || k >= 32) { if (k >= 32 && (int)done >= 27) break; __builtin_amdgcn_s_sleep(8); continue; }
                const unsigned char* blk = (const unsigned char*)shared_blk(F.wsb, item0 + (dir ? 31 - k : k));
#pragma unroll
                for (int q = 0; q < 4; ++q) { const int ln = F.lane + 64 * q; acc_ ^= *(const volatile unsigned*)(blk + (size_t)ln * 128); }
                ++k;
            }
            if (acc_ == 0x2468ace1u) F.ctl[202] = acc_;
        }
#endif
        if (BOTH(3)) GRID_BAR();
    }

    if (IN(4)) {
        const int gw = F.vcu * NWAVES + F.wave, NGW = F.G * NWAVES;
        for (int rep = 0; rep < REP4; ++rep) for (int m = gw; m < M; m += NGW) combine_row(F, (size_t)m, rep == REP4 - 1 ? F.MIX : DRY);
        if (BOTH(4)) GRID_BAR();
    }

    if (IN(5)) {
        pg8::Gemm g{F.MIX, F.WoutT, M, DMODEL, DMODEL}; pg8::RepOrder S; S.init(M, DMODEL, F.G, (int)blockIdx.x, REP5);
        pg8::EpiOut E{F.x, F.out};
        pg8::gemm_phase<pg8::EpiOut, pg8::RepOrder, false, true>(F.lds + RING_OFF, g, S, E);
    }
#undef IN
#undef BOTH
}

extern "C" void kernel_launch(void* const* d_in, const int* in_sizes, int n_in, void* d_out, int out_size, void* d_ws, size_t ws_size, hipStream_t stream) {
    static int grid = 0;
    if (grid == 0) {
        if (n_in != 18 || in_sizes[0] != M * DMODEL || out_size != M * DMODEL || ws_size < WS_END) { fprintf(stderr, "kernel_launch: unexpected problem shape (n_in %d, in0 %d, out %d, ws %zu); nothing launched\n", n_in, n_in > 0 ? in_sizes[0] : -1, out_size, ws_size); grid = -1; return; }
        int dev = 0, cus = 0, per_cu = 0;
        if (hipGetDevice(&dev) != hipSuccess || hipDeviceGetAttribute(&cus, hipDeviceAttributeMultiprocessorCount, dev) != hipSuccess) { fprintf(stderr, "kernel_launch: device query failed\n"); grid = -1; return; }
        if (hipFuncSetAttribute((const void*)hybrid_fwd, hipFuncAttributeMaxDynamicSharedMemorySize, LDS_BYTES) != hipSuccess) { fprintf(stderr, "kernel_launch: hipFuncSetAttribute failed\n"); grid = -1; return; }
        if (hipOccupancyMaxActiveBlocksPerMultiprocessor(&per_cu, (const void*)hybrid_fwd, NWAVES * 64, LDS_BYTES) != hipSuccess || per_cu < 1)
            fprintf(stderr, "kernel_launch: note: occupancy query reports %d workgroups per CU\n", per_cu);
        (void)hipGetLastError();
        grid = cus;
    }
    if (grid < 0) return;
    if (hipMemsetAsync((char*)d_ws + WS_CTL, 0, CTL_ZERO_BYTES, stream) != hipSuccess) { fprintf(stderr, "kernel_launch: hipMemsetAsync failed\n"); return; }
    Args a{};
    for (int i = 0; i < 18; ++i) a.in[i] = (const float*)d_in[i];
    a.out = (float*)d_out; a.ws = (unsigned char*)d_ws;
    for (int li = 0; li < N_LAUNCHES; ++li) {
        a.ph_lo = (N_LAUNCHES == PER_PHASE) ? li : 0; a.ph_hi = (N_LAUNCHES == PER_PHASE) ? li + 1 : PER_PHASE; a.li = li;
        hipLaunchKernelGGL(hybrid_fwd, dim3(grid), dim3(NWAVES * 64), LDS_BYTES, stream, a);
        const hipError_t le = hipPeekAtLastError();
        if (le != hipSuccess) { fprintf(stderr, "kernel_launch: launch %d failed: %s\n", li, hipGetErrorName(le)); break; }
    }
}
```

```cpp
#include <hip/hip_runtime.h>
#include <cstdio>
#include <cstdint>
#define GAS __attribute__((address_space(1)))
#define LAS __attribute__((address_space(3)))
typedef unsigned short bf16;
typedef unsigned v4u __attribute__((ext_vector_type(4)));
typedef float f32x4 __attribute__((ext_vector_type(4)));
typedef short bf16x8 __attribute__((ext_vector_type(8)));
typedef GAS unsigned gu32;
typedef GAS unsigned long long gu64;
#define RLX_AGENT __ATOMIC_RELAXED, __HIP_MEMORY_SCOPE_AGENT
#define LDS_WAIT() asm volatile("s_waitcnt lgkmcnt(0)" ::: "memory")
#define VM_WAIT() asm volatile("s_waitcnt vmcnt(0)" ::: "memory")
__device__ __forceinline__ unsigned long long rt() { return __builtin_amdgcn_s_memrealtime(); }
__device__ __forceinline__ unsigned f2bf(float f) { unsigned u = __builtin_bit_cast(unsigned, f); return (u + 0x7fffu + ((u >> 16) & 1u)) >> 16; }
__device__ __forceinline__ unsigned pk2(float lo, float hi) { return f2bf(lo) | (f2bf(hi) << 16); }

#define XB_TMO      128
#define XB_XCNT(j)  (256  + 64 * (j))
#define XB_XSUB(j)  (1280 + 64 * (j))
#define XB_XGEN(j)  (2304 + 64 * (j))
#define XB_TOP      3328
#define XB_TOPGEN   3392
#define XCD_BAR_WORDS 3456
#define XB_SPIN_CAP (1u << 18)

__device__ __forceinline__ unsigned xb_ld(unsigned* p)              { return __hip_atomic_load(p, __ATOMIC_RELAXED, __HIP_MEMORY_SCOPE_AGENT); }
__device__ __forceinline__ unsigned xb_add(unsigned* p, unsigned v) { return __hip_atomic_fetch_add(p, v, __ATOMIC_RELAXED, __HIP_MEMORY_SCOPE_AGENT); }
__device__ __forceinline__ unsigned xb_xcc_id() { return (unsigned)__builtin_amdgcn_s_getreg((3 << 11) | 20) & 0xFu; }
#define XB_SPIN(cond, bar) do { unsigned _sp = 0; while (cond) { __builtin_amdgcn_s_sleep(1); \
    if ((++_sp & 255u) == 0u) { if (xb_ld(&(bar)[XB_TMO])) break; if (_sp > XB_SPIN_CAP) { atomicAdd(&(bar)[XB_TMO], 1u); break; } } } } while (0)

struct XcdBarrier {
    unsigned* bar; unsigned x;
    volatile LAS unsigned* st;
};

__device__ __forceinline__ XcdBarrier xcd_barrier_post(unsigned* bar, volatile LAS unsigned* st) {
    XcdBarrier b; b.bar = bar; b.x = xb_xcc_id(); b.st = st;
    if (threadIdx.x == 0) (void)xb_add(&bar[XB_XCNT(b.x)], 1u);
    return b;
}
__device__ __forceinline__ void xcd_barrier_complete(unsigned* bar, unsigned x, unsigned& nloc, unsigned& nx) {
    const unsigned G = gridDim.x * gridDim.y * gridDim.z;
    unsigned sum, cnt, mine, sp = 0u;
    for (;;) {
        sum = 0u; cnt = 0u; mine = 0u;
#pragma unroll
        for (unsigned j = 0; j < 16; ++j) { const unsigned c = xb_ld(&bar[XB_XCNT(j)]); sum += c; cnt += (c > 0u) ? 1u : 0u; mine = (j == x) ? c : mine; }
        if (sum == G) break;
        __builtin_amdgcn_s_sleep(1);
        if ((++sp & 255u) == 0u) { if (xb_ld(&bar[XB_TMO])) break; if (sp > XB_SPIN_CAP) { atomicAdd(&bar[XB_TMO], 1u); break; } }
    }
    nloc = mine > 0u ? mine : 1u; nx = cnt > 0u ? cnt : 1u;
}

__device__ __forceinline__ void xcd_barrier(const XcdBarrier& b) {
    asm volatile("s_waitcnt vmcnt(0)" ::: "memory");
    __syncthreads();
    if (threadIdx.x == 0) {
        unsigned* bar = b.bar;
        __builtin_amdgcn_s_waitcnt(0);
        unsigned nloc = b.st[0], nx = b.st[1];
        if (nloc == 0u) { xcd_barrier_complete(bar, b.x, nloc, nx); b.st[0] = nloc; b.st[1] = nx; }
        const unsigned old = xb_add(&bar[XB_XSUB(b.x)], 1u);
        const unsigned gen = old / nloc;
        if (old + 1u == (gen + 1u) * nloc) {
            __builtin_amdgcn_fence(__ATOMIC_RELEASE, "agent");
            asm volatile("s_waitcnt vmcnt(0)" ::: "memory");
            const unsigned og = xb_add(&bar[XB_TOP], 1u);
            const unsigned tg = og / nx;
            if (og + 1u == (tg + 1u) * nx) xb_add(&bar[XB_TOPGEN], 1u);
            else XB_SPIN(xb_ld(&bar[XB_TOPGEN]) == tg, bar);
            __builtin_amdgcn_fence(__ATOMIC_ACQUIRE, "agent");
            xb_add(&bar[XB_XGEN(b.x)], 1u);
            asm volatile("s_waitcnt vmcnt(0)" ::: "memory");
        } else {
            XB_SPIN(xb_ld(&bar[XB_XGEN(b.x)]) == gen, bar);
            __builtin_amdgcn_fence(__ATOMIC_ACQUIRE, "agent");
            asm volatile("s_waitcnt vmcnt(0)" ::: "memory");
        }
    }
    __syncthreads();
}
namespace pg8 {
#define PG8_LAS __attribute__((address_space(3)))
typedef unsigned short bf16_t;
typedef short bf16x8 __attribute__((ext_vector_type(8)));
typedef float f32x4 __attribute__((ext_vector_type(4)));
typedef unsigned u32x4 __attribute__((ext_vector_type(4)));
constexpr int BM = 256, BK = 64, HALF = 128, HTB = HALF * BK * 2  , STAGE_BYTES = 8 * HTB, NXCD = 8, WGM = 8;

__host__ __device__ __forceinline__ int lds_byte(int r, int c) { const int st = (r >> 4) * 2 + (c >> 5), rr = r & 15, cc = c & 31, ob = rr * 64 + cc * 2; return st * 1024 + (ob ^ (((ob >> 9) & 1) << 5)); }
__host__ __device__ __forceinline__ void stage_rc(int b, int& R, int& C) { const int st = b / 1024, sb = b % 1024, swz = sb ^ (((sb >> 9) & 1) << 5); R = (st >> 1) * 16 + swz / 64; C = (st & 1) * 32 + (swz % 64) / 2; }
__host__ __device__ __forceinline__ int perm32(int rho) { const int n = rho >> 4, i = rho & 15; return 8 * (i >> 2) + 4 * n + (i & 3); }

struct Unit { int pm, pn; };
struct Gemm { const bf16_t* A; const bf16_t* Bt; int M, N, K; };

struct StaticOrder {
    int nM, nN, nwg, G, c;
    __host__ __device__ void init(int M, int N, int G_, int c_) { nM = M / BM; nN = N / BM; nwg = nM * nN; G = G_; c = c_; }
    __host__ __device__ bool next(int i, Unit& u) const {
        const long L = (long)i * G + c; if (L >= nwg) return false;
        int wgid = (int)L; { const int q = nwg / NXCD, r = nwg % NXCD, xcd = wgid % NXCD, off = wgid / NXCD; wgid = (xcd < r ? xcd * (q + 1) : r * (q + 1) + (xcd - r) * q) + off; }
        const int nig = WGM * nN, gid = wgid / nig, fm = gid * WGM, gsz = (nM - fm) < WGM ? (nM - fm) : WGM;
        u.pm = fm + ((wgid % nig) % gsz); u.pn = (wgid % nig) / gsz; return true;
    }
    __device__ __forceinline__ void a_ready(const Unit&) const {}
    __device__ __forceinline__ void pre_epi(int) const {}
    __device__ __forceinline__ void done(const Unit&) const {}
};

typedef float f32x2 __attribute__((ext_vector_type(2)));
typedef __bf16 bf16x2_t __attribute__((ext_vector_type(2)));
__device__ __forceinline__ unsigned cvt_pk_bf16(float lo, float hi) { f32x2 v = {lo, hi}; bf16x2_t b = __builtin_convertvector(v, bf16x2_t); return __builtin_bit_cast(unsigned, b); }
__device__ __forceinline__ float silu_f(float v) { return v * __builtin_amdgcn_rcpf(1.0f + __expf(-v)); }

struct EpiIn {
    static constexpr bool PERM = true, AFTER_DRAIN = false;
    bf16_t *PA, *PB, *PC, *MIX, *KVM; float* GATES;
    __device__ __forceinline__ void init(f32x4 (&acc)[2][2][4][2], const Unit&, int, int, int, int) const {
#pragma unroll
        for (int a = 0; a < 2; ++a)
#pragma unroll
            for (int b = 0; b < 2; ++b)
#pragma unroll
                for (int m = 0; m < 4; ++m)
#pragma unroll
                    for (int n = 0; n < 2; ++n) acc[a][b][m][n] = (f32x4){0.f, 0.f, 0.f, 0.f};
    }
    __device__ __forceinline__ void operator()(const f32x4 (&acc)[2][2][4][2], const Unit& u, int wr, int wc, int fr, int fq) const {
        const int row0 = u.pm * BM + wr * 64 + fr, cl = wc * 32 + 8 * fq, pn = u.pn;
        if (u.pm < 64 && pn == 25) {
            if (wc == 0) {
#pragma unroll
                for (int ai = 0; ai < 2; ++ai)
#pragma unroll
                    for (int m = 0; m < 4; ++m) { float* g = GATES + (size_t)(row0 + ai * HALF + m * 16) * 32 + 8 * fq;
                        *(f32x4*)g = acc[ai][0][m][0]; *(f32x4*)(g + 4) = acc[ai][0][m][1]; }
            }
            return;
        }
        bf16_t* base; int ldc; bool act = false;
        if (u.pm >= 64) { base = KVM + (size_t)(row0 - 16384) * 1024 + (pn - 26) * 256; ldc = 1024; }
        else if (pn < 12) { base = PA + (size_t)row0 * 3072 + pn * 256; ldc = 3072; }
        else if (pn < 16) { base = MIX + (size_t)row0 * 2048 + (pn - 12) * 256; ldc = 2048; act = true; }
        else if (pn < 19) { base = PB + (size_t)row0 * 768 + (pn - 16) * 256; ldc = 768; }
        else if (pn < 21) { base = MIX + (size_t)row0 * 2048 + 1024 + (pn - 19) * 256; ldc = 2048; act = true; }
        else if (pn < 23) { base = PC + (size_t)row0 * 512 + (pn - 21) * 256; ldc = 512; }
        else { base = MIX + (size_t)row0 * 2048 + 1536 + (pn - 23) * 256; ldc = 2048; act = true; }
        base += cl;
#pragma unroll
        for (int ai = 0; ai < 2; ++ai)
#pragma unroll
            for (int m = 0; m < 4; ++m) { bf16_t* rowp = base + (size_t)(ai * HALF + m * 16) * ldc;
#pragma unroll
                for (int bj = 0; bj < 2; ++bj) { f32x4 v0 = acc[ai][bj][m][0], v1 = acc[ai][bj][m][1];
                    if (act) { v0 = (f32x4){silu_f(v0[0]), silu_f(v0[1]), silu_f(v0[2]), silu_f(v0[3])}; v1 = (f32x4){silu_f(v1[0]), silu_f(v1[1]), silu_f(v1[2]), silu_f(v1[3])}; }
                    u32x4 w; w.x = cvt_pk_bf16(v0[0], v0[1]); w.y = cvt_pk_bf16(v0[2], v0[3]); w.z = cvt_pk_bf16(v1[0], v1[1]); w.w = cvt_pk_bf16(v1[2], v1[3]);
                    *(u32x4*)(rowp + bj * HALF) = w; } }
    }
};
struct EpiOut {
    static constexpr bool PERM = false, AFTER_DRAIN = false;
    const float* X; float* O;
    __device__ __forceinline__ void init(f32x4 (&acc)[2][2][4][2], const Unit& u, int wr, int wc, int fr, int fq) const {
        const int row0 = u.pm * BM + wr * 64 + fr, col0 = u.pn * BM + wc * 32 + 4 * fq;
#pragma unroll
        for (int ai = 0; ai < 2; ++ai)
#pragma unroll
            for (int m = 0; m < 4; ++m) { const size_t off = (size_t)(row0 + ai * HALF + m * 16) * 2048 + col0;
#pragma unroll
                for (int bj = 0; bj < 2; ++bj)
#pragma unroll
                    for (int n = 0; n < 2; ++n) acc[ai][bj][m][n] = *(const f32x4*)(X + off + bj * HALF + n * 16); }
    }
    __device__ __forceinline__ void operator()(const f32x4 (&acc)[2][2][4][2], const Unit& u, int wr, int wc, int fr, int fq) const {
        const int row0 = u.pm * BM + wr * 64 + fr, col0 = u.pn * BM + wc * 32 + 4 * fq;
#pragma unroll
        for (int ai = 0; ai < 2; ++ai)
#pragma unroll
            for (int m = 0; m < 4; ++m) { const size_t off = (size_t)(row0 + ai * HALF + m * 16) * 2048 + col0;
#pragma unroll
                for (int bj = 0; bj < 2; ++bj)
#pragma unroll
                    for (int n = 0; n < 2; ++n) *(f32x4*)(O + off + bj * HALF + n * 16) = acc[ai][bj][m][n]; }
    }
};
struct InOrder {
    StaticOrder base; int G, c, rep, sig_ui; unsigned* ctl; volatile PG8_LAS unsigned* st;
    static constexpr int NL = 64 * 13, ADONE_G = 128, ADONE_X = 5120;
    __device__ __forceinline__ void init(int G_, int c_, int rep_, unsigned* ctl_, volatile PG8_LAS unsigned* st_) { G = G_; c = c_; rep = rep_; ctl = ctl_; st = st_; base.init(16384, 13 * 256, G_, 0);
        sig_ui = c_ < NL ? (NL - c_ + G_ - 1) / G_ : 0; }
    __device__ __forceinline__ bool late() const { const int tot = 2 * NL + 32; const int nu = c < tot ? (tot - c + G - 1) / G : 0; return nu <= sig_ui; }
    __device__ __forceinline__ bool next(int i, Unit& u) const {
        long L = (long)i * G + c; const long tot = 2 * NL + 32;
        if (L >= tot * rep) return false;
        L %= tot;
        if (L < 2 * NL) { const bool second = L >= NL; if (second) L -= NL; StaticOrder b2 = base; b2.c = (int)(L % G); b2.next((int)(L / G), u);
            u.pn = second ? u.pn + 12 : (u.pn == 12 ? 25 : u.pn); return true; }
        const int j = (int)(L - 2 * NL);
        u.pm = 64 + (j >> 2); u.pn = 26 + (j & 3); return true;
    }
    __device__ __forceinline__ void announce() const {
        const unsigned x = xb_xcc_id(), nloc = st[0];
        const unsigned old = xb_add(&ctl[ADONE_X + 64 * x], 1u);
        if (old + 1u == nloc) { __builtin_amdgcn_fence(__ATOMIC_RELEASE, "agent"); asm volatile("s_waitcnt vmcnt(0)" ::: "memory"); xb_add(&ctl[ADONE_G], 1u); }
    }
    __device__ __forceinline__ void a_ready(const Unit&) const {}
    __device__ __forceinline__ void pre_epi(int ui) const { if (ui == sig_ui && threadIdx.x == 0) announce(); }
    __device__ __forceinline__ void done(const Unit&) const {}
};
struct RepOrder {
    StaticOrder base; int G, c, rep;
    __host__ __device__ void init(int M_, int N_, int G_, int c_, int rep_ = 1) { G = G_; c = c_; rep = rep_; base.init(M_, N_, G_, 0); }
    __host__ __device__ bool next(int i, Unit& u) const {
        long L = (long)i * G + c; if (L >= (long)base.nwg * rep) return false;
        L %= base.nwg; StaticOrder b2 = base; b2.c = (int)(L % G); return b2.next((int)(L / G), u);
    }
    __device__ __forceinline__ void a_ready(const Unit&) const {}
    __device__ __forceinline__ void pre_epi(int) const {}
    __device__ __forceinline__ void done(const Unit&) const {}
};

template <class Epi, class Sched, bool ALIGN_EPI = false, bool SP2 = false>
__device__ __forceinline__ void gemm_phase(PG8_LAS unsigned char* lds, const Gemm g, const Sched& S, const Epi& E) {
    const int tid = threadIdx.x, wid = __builtin_amdgcn_readfirstlane(tid >> 6), lane = tid & 63, wr = wid >> 2, wc = wid & 3, fr = lane & 15, fq = lane >> 4;
    const int K = g.K, nt = K / BK;
    unsigned voffA[2], voffB[2];
#pragma unroll
    for (int i = 0; i < 2; ++i) { int R, C; stage_rc(tid * 16 + i * 8192, R, C); const int Rb = Epi::PERM ? ((R & ~31) + perm32(R & 31)) : R;
        voffA[i] = (unsigned)(R * K + C) * 2u; voffB[i] = (unsigned)(Rb * K + C) * 2u; }
    const size_t kstep = (size_t)(BK * 2);
    const size_t hstep = (size_t)HALF * K * 2;
    const size_t tstep = 2 * hstep;
    const unsigned ldsw = (unsigned)wid * 1024u;
    const int aoff = lds_byte(wr * 64 + fr, fq * 8), boff = lds_byte(wc * 32 + fr, fq * 8);
#define PG8_SA(b, h) (((b) * 2 + (h)) * HTB)
#define PG8_SB(b, h) ((4 + (b) * 2 + (h)) * HTB)
#define PG8_STAGE(bufoff, gbase, voff) do { _Pragma("unroll") for (int _i = 0; _i < 2; ++_i) \
        __builtin_amdgcn_global_load_lds((const unsigned*)((const char*)(gbase) + (voff)[_i]), (PG8_LAS unsigned*)(lds + (bufoff) + ldsw + _i * 8192), 16, 0, 0); } while (0)
#define PG8_LDA(dst, b, h) do { _Pragma("unroll") for (int m = 0; m < 4; ++m) _Pragma("unroll") for (int k = 0; k < 2; ++k) dst[m][k] = *(const PG8_LAS bf16x8*)(lds + PG8_SA(b, h) + aoff + m * 2048 + k * 1024); } while (0)
#define PG8_LDB(dst, b, h) do { _Pragma("unroll") for (int n = 0; n < 2; ++n) _Pragma("unroll") for (int k = 0; k < 2; ++k) dst[n][k] = *(const PG8_LAS bf16x8*)(lds + PG8_SB(b, h) + boff + n * 2048 + k * 1024); } while (0)
#define PG8_MMA(ai, bj, At, Bt) do { __builtin_amdgcn_s_setprio(1); _Pragma("unroll") for (int m = 0; m < 4; ++m) _Pragma("unroll") for (int n = 0; n < 2; ++n) _Pragma("unroll") for (int k = 0; k < 2; ++k) \
        acc[ai][bj][m][n] = __builtin_amdgcn_mfma_f32_16x16x32_bf16(Bt[n][k], At[m][k], acc[ai][bj][m][n], 0, 0, 0); __builtin_amdgcn_s_setprio(0); } while (0)
#define PG8_WAIT_V(n) asm volatile("s_waitcnt vmcnt(" #n ")" ::: "memory")
#define PG8_WAIT_L(n) asm volatile("s_waitcnt lgkmcnt(" #n ")" ::: "memory")
#define PG8_BAR __builtin_amdgcn_s_barrier()
#define PG8_SCHED __builtin_amdgcn_sched_barrier(0)
    Unit cur, nxt; int ui = 0;
    if (!S.next(0, cur)) return;
    f32x4 acc[2][2][4][2];
    E.init(acc, cur, wr, wc, fr, fq);
    bf16x8 At[4][2], B0[2][2], B1[2][2];
    const char* cA = (const char*)g.A + (size_t)cur.pm * tstep; const char* cB = (const char*)g.Bt + (size_t)cur.pn * tstep;
    S.a_ready(cur);
    if constexpr (SP2) {
        PG8_STAGE(PG8_SB(0, 0), cB, voffB); PG8_STAGE(PG8_SB(0, 1), cB + hstep, voffB); PG8_STAGE(PG8_SA(0, 0), cA, voffA); PG8_STAGE(PG8_SA(0, 1), cA + hstep, voffA);
        if (wr == 1) PG8_BAR;
        PG8_WAIT_V(2); PG8_BAR;
        PG8_STAGE(PG8_SB(1, 0), cB + kstep, voffB); PG8_STAGE(PG8_SA(1, 0), cA + kstep, voffA); PG8_STAGE(PG8_SB(1, 1), cB + hstep + kstep, voffB);
        PG8_WAIT_V(6); PG8_BAR;
    } else {
        PG8_STAGE(PG8_SB(0, 0), cB, voffB); PG8_STAGE(PG8_SA(0, 0), cA, voffA); PG8_STAGE(PG8_SB(0, 1), cB + hstep, voffB); PG8_STAGE(PG8_SA(0, 1), cA + hstep, voffA);
        if (wr == 1) PG8_BAR;
        PG8_WAIT_V(4); PG8_BAR;
        PG8_STAGE(PG8_SB(1, 0), cB + kstep, voffB); PG8_STAGE(PG8_SA(1, 0), cA + kstep, voffA); PG8_STAGE(PG8_SB(1, 1), cB + hstep + kstep, voffB);
        PG8_WAIT_V(6); PG8_BAR;
    }
    for (;;) {
        const bool has_next = S.next(ui + 1, nxt);
        const char* nA = has_next ? (const char*)g.A + (size_t)nxt.pm * tstep : cA; const char* nB = has_next ? (const char*)g.Bt + (size_t)nxt.pn * tstep : cB;
        for (int t = 0; t < nt; t += 2) {
            const bool last = (t == nt - 2);
            const char* a1 = cA + (size_t)(t + 1) * kstep;
            const char* a2 = last ? nA : cA + (size_t)(t + 2) * kstep; const char* b2 = last ? nB : cB + (size_t)(t + 2) * kstep;
            const char* a3 = a2 + kstep; const char* b3 = b2 + kstep;
            if (last && has_next) S.a_ready(nxt);
            if constexpr (SP2) {
            PG8_LDB(B0, 0, 0); PG8_LDB(B1, 0, 1); PG8_SCHED; PG8_LDA(At, 0, 0); PG8_STAGE(PG8_SA(1, 1), a1 + hstep, voffA);
            PG8_WAIT_V(8); PG8_WAIT_L(0); PG8_BAR; PG8_MMA(0, 0, At, B0); PG8_MMA(0, 1, At, B1); PG8_BAR; PG8_SCHED;
            PG8_LDA(At, 0, 1); PG8_STAGE(PG8_SB(0, 0), b2, voffB); PG8_STAGE(PG8_SB(0, 1), b2 + hstep, voffB); PG8_STAGE(PG8_SA(0, 0), a2, voffA);
            PG8_WAIT_V(8); PG8_WAIT_L(0); PG8_BAR; PG8_MMA(1, 0, At, B0); PG8_MMA(1, 1, At, B1); PG8_BAR; PG8_SCHED;
            PG8_LDB(B0, 1, 0); PG8_LDB(B1, 1, 1); PG8_SCHED; PG8_LDA(At, 1, 0); PG8_STAGE(PG8_SA(0, 1), a2 + hstep, voffA);
            PG8_WAIT_V(8); PG8_WAIT_L(0); PG8_BAR; PG8_MMA(0, 0, At, B0); PG8_MMA(0, 1, At, B1); PG8_BAR; PG8_SCHED;
            PG8_LDA(At, 1, 1); PG8_STAGE(PG8_SB(1, 0), b3, voffB); PG8_STAGE(PG8_SB(1, 1), b3 + hstep, voffB); PG8_STAGE(PG8_SA(1, 0), a3, voffA);
            PG8_WAIT_V(8); PG8_WAIT_L(0); PG8_BAR; PG8_MMA(1, 0, At, B0); PG8_MMA(1, 1, At, B1); PG8_BAR; PG8_SCHED;
            } else {
            PG8_LDB(B0, 0, 0); PG8_SCHED; PG8_LDA(At, 0, 0); PG8_STAGE(PG8_SA(1, 1), a1 + hstep, voffA);
            PG8_WAIT_L(8); PG8_BAR; PG8_WAIT_L(0); PG8_MMA(0, 0, At, B0); PG8_BAR; PG8_SCHED;
            PG8_LDB(B1, 0, 1); PG8_STAGE(PG8_SB(0, 0), b2, voffB);
            PG8_BAR; PG8_WAIT_L(0); PG8_MMA(0, 1, At, B1); PG8_BAR;
            PG8_LDA(At, 0, 1); PG8_STAGE(PG8_SA(0, 0), a2, voffA);
            PG8_BAR; PG8_WAIT_L(0); PG8_MMA(1, 0, At, B0); PG8_BAR; PG8_SCHED;
            PG8_STAGE(PG8_SB(0, 1), b2 + hstep, voffB);
            PG8_WAIT_V(6); PG8_BAR; PG8_MMA(1, 1, At, B1); PG8_BAR;
            PG8_LDB(B0, 1, 0); PG8_SCHED; PG8_LDA(At, 1, 0); PG8_STAGE(PG8_SA(0, 1), a2 + hstep, voffA);
            PG8_WAIT_L(8); PG8_BAR; PG8_WAIT_L(0); PG8_MMA(0, 0, At, B0); PG8_BAR; PG8_SCHED;
            PG8_LDB(B1, 1, 1); PG8_STAGE(PG8_SB(1, 0), b3, voffB);
            PG8_BAR; PG8_WAIT_L(0); PG8_MMA(0, 1, At, B1); PG8_BAR;
            PG8_LDA(At, 1, 1); PG8_STAGE(PG8_SA(1, 0), a3, voffA);
            PG8_BAR; PG8_WAIT_L(0); PG8_MMA(1, 0, At, B0); PG8_BAR; PG8_SCHED;
            PG8_STAGE(PG8_SB(1, 1), b3 + hstep, voffB);
            PG8_WAIT_V(6); PG8_BAR; PG8_MMA(1, 1, At, B1); PG8_BAR;
            }
        }
        S.pre_epi(ui);
        if constexpr (ALIGN_EPI) { if (wr == 0) PG8_BAR; }
        if constexpr (!Epi::AFTER_DRAIN) { E(acc, cur, wr, wc, fr, fq);
#ifdef REPEPI
            for (int re_ = 1; re_ < REPEPI; ++re_) { asm volatile("" ::: "memory"); E(acc, cur, wr, wc, fr, fq); }
#endif
            S.done(cur); }
        if (!has_next) break;
        cur = nxt; cA = nA; cB = nB; ++ui;
        E.init(acc, cur, wr, wc, fr, fq);
        if constexpr (ALIGN_EPI) { if (wr == 1) PG8_BAR; }
    }
    PG8_WAIT_V(0);
    if constexpr (!ALIGN_EPI) { if (wr == 0) PG8_BAR; }
    PG8_BAR;
    if constexpr (Epi::AFTER_DRAIN) { E.fused(acc, cur, wr, wc, fr, fq, lds, wid, lane); S.done(cur); }
#undef PG8_SA
#undef PG8_SB
#undef PG8_STAGE
#undef PG8_LDA
#undef PG8_LDB
#undef PG8_MMA
#undef PG8_WAIT_V
#undef PG8_WAIT_L
#undef PG8_BAR
#undef PG8_SCHED
}
}
constexpr int NWAVES = 8;
#ifndef MK_N_LAUNCHES
#define MK_N_LAUNCHES 1
#endif
constexpr int N_LAUNCHES = MK_N_LAUNCHES;
constexpr int PER_PHASE = 6;

constexpr int NBATCH = 8, SEQ = 2048, DMODEL = 2048, M = NBATCH * SEQ;
constexpr int MEMLEN = 256;
constexpr int NIN = 6432;
constexpr float EPS = 1e-6f;
constexpr float LOG2E = 1.4426950408889634f;

constexpr size_t MiB = 1u << 20;
constexpr size_t WS_CTL = 0, CTL_ZERO_BYTES = 24576;
constexpr size_t WS_WOUT = 1 * MiB;
constexpr size_t WS_WIN = 9 * MiB, WS_WMEM = 35 * MiB;
constexpr size_t WS_XN = 39 * MiB, WS_MEMN = 103 * MiB;
constexpr size_t WS_PA = 111 * MiB;
constexpr size_t WS_PB = 207 * MiB;
constexpr size_t WS_PC = 231 * MiB;
constexpr size_t WS_MIX = 247 * MiB;
constexpr size_t WS_GATES = 311 * MiB;
constexpr size_t WS_KVM = 313 * MiB;
constexpr size_t WS_ROPE = 317 * MiB;
constexpr size_t WS_CD = 317 * MiB + 512 * 1024;
constexpr size_t WS_UT = 318 * MiB, WS_WNEG = 382 * MiB, WS_QDEC = 446 * MiB;
constexpr size_t WS_KDECT = 9 * MiB, WS_QKM = 73 * MiB;
constexpr size_t WS_SB = 318 * MiB, WS_DA = 382 * MiB, WS_DB2 = 0  ; constexpr int SB_BYTES = 32768, DB_SPLIT = 3236, DB_BYTES = 41472;
constexpr int SO_QD = 0, SO_KT = 8192;
constexpr int IO_WN = 0, IO_QK = 8192, IO_SC = 12288, IO_UT = 12544;
static_assert(WS_DA + (size_t)DB_SPLIT * DB_BYTES <= 510 * MiB && WS_DB2 + (size_t)(4096 - DB_SPLIT) * DB_BYTES <= 128 * MiB && WS_SB + (size_t)2048 * SB_BYTES <= WS_DA, "scan operand blocks");
constexpr size_t WS_OF = 111 * MiB, WS_OB = 143 * MiB;
constexpr size_t WS_END = 510 * MiB;
constexpr int CW_TMO = 0, CW_CODE = 1, CW_WQ = 64, CW_ADONE = 128, CW_PROG = 256, CW_BAR = 1024;

constexpr int RING_OFF = 0, RING_BYTES = 149504;
constexpr int LDSCTL_OFF = RING_BYTES, MISC_OFF = LDSCTL_OFF + 320;
constexpr int LDS_BYTES = 150528;
static_assert(MISC_OFF + 128 <= LDS_BYTES, "LDS map");

#define DI __device__ __forceinline__
typedef short s16x4 __attribute__((ext_vector_type(4)));
typedef unsigned u32x2 __attribute__((ext_vector_type(2)));
typedef float f32x2v __attribute__((ext_vector_type(2)));
#define MFMA16(a, b, c) __builtin_amdgcn_mfma_f32_16x16x32_bf16((a), (b), (c), 0, 0, 0)
DI unsigned cvtpk(float lo, float hi) { return pg8::cvt_pk_bf16(lo, hi); }
DI float bflo(unsigned v) { return __uint_as_float(v << 16); }
DI float bfhi(unsigned v) { return __uint_as_float(v & 0xffff0000u); }
DI float wave_sum(float v) {
#pragma unroll
    for (int o = 1; o < 64; o <<= 1) v += __shfl_xor(v, o);
    return v;
}
DI float silu_f(float v) { return pg8::silu_f(v); }
DI float softplus_f(float x) { return x > 20.f ? x : log1pf(expf(x)); }
DI float sigmoid_f(float x) { return 1.0f / (1.0f + expf(-x)); }
DI int perm32k(int k) { return (k & ~31) | (((k >> 2) & 3) << 3) | (((k >> 4) & 1) << 2) | (k & 3); }
typedef short v4i16_t __attribute__((ext_vector_type(4)));
DI s16x4 vtr(const LAS unsigned char* p) { return __builtin_bit_cast(s16x4, __builtin_amdgcn_ds_read_tr16_b64_v4i16((LAS v4i16_t*)p)); }
DI bf16x8 tr_frag(const LAS unsigned char* lo, int hi_off) { const s16x4 a = vtr(lo), b = vtr(lo + hi_off); return (bf16x8){a[0], a[1], a[2], a[3], b[0], b[1], b[2], b[3]}; }
DI bf16x8 ld_frag(const LAS unsigned char* p) { return *(const LAS bf16x8*)p; }
DI bf16x8 pack8(const f32x4& a, const f32x4& b) { v4u w; w.x = cvtpk(a[0], a[1]); w.y = cvtpk(a[2], a[3]); w.z = cvtpk(b[0], b[1]); w.w = cvtpk(b[2], b[3]); return __builtin_bit_cast(bf16x8, w); }

struct Frame {
    LAS unsigned char* lds;
    volatile LAS unsigned* MISC;
    gu32* ctl;
    int tid, lane, wave;
    int vcu, G;
    int ap_it0, ap_stride, ap_nit;
    const float *x, *mem, *norm_w, *w_in, *conv_w, *a_log_f, *a_log_b, *dt_f, *dt_b, *o_norm_a, *q_norm_b, *k_norm_b, *sink_b, *mem_norm_w, *w_mem_kv, *q_norm_c, *k_norm_c, *w_out;
    float* out;
    bf16 *WinT, *WmemT, *WoutT, *XN, *MEMN, *PA, *PB, *PC, *MIX, *KVM, *UT, *WNEG, *QDEC, *KDECT, *QKM, *OF, *OB;
    float *GATES, *ROPE, *CD;
    unsigned char* wsb; unsigned char* dbo;
};
DI bf16* item_blk(unsigned char* wsb, unsigned char* dbo, int item) { return (bf16*)(item < DB_SPLIT ? wsb + WS_DA + (size_t)item * DB_BYTES : dbo + WS_DB2 + (size_t)(item - DB_SPLIT) * DB_BYTES); }
DI bf16* shared_blk(unsigned char* wsb, int item) { return (bf16*)(wsb + WS_SB + (size_t)(((item >> 6) << 5) | (item & 31)) * SB_BYTES); }

DI void p0_transpose_item(const float* W, int K, int N, bf16* WT, int k0, int n0, int drow0, LAS float* scr, int lane) {
#pragma unroll 8
    for (int i = 0; i < 32; ++i) { const int kk = 2 * i + (lane >> 5); scr[kk * 33 + (lane & 31)] = W[(size_t)(k0 + kk) * N + n0 + (lane & 31)]; }
    LDS_WAIT(); asm volatile("" ::: "memory");
    const int c = lane & 7;
#pragma unroll
    for (int j = 0; j < 4; ++j) { const int n = (lane >> 3) + 8 * j; const LAS float* s = scr + (8 * c) * 33 + n;
        v4u o; o.x = pk2(s[0 * 33], s[1 * 33]); o.y = pk2(s[2 * 33], s[3 * 33]); o.z = pk2(s[4 * 33], s[5 * 33]); o.w = pk2(s[6 * 33], s[7 * 33]);
        *(GAS v4u*)(WT + (size_t)(drow0 + n) * K + k0 + 8 * c) = o; }
    LDS_WAIT(); asm volatile("" ::: "memory");
}
DI void rms_row_to_bf16(const float* xrow, const float* w, bf16* orow, int lane) {
    const GAS f32x4* xr = (const GAS f32x4*)xrow + lane; const GAS f32x4* wr = (const GAS f32x4*)w + lane;
    f32x4 v[8]; float s = 0.f;
#pragma unroll
    for (int j = 0; j < 8; ++j) { v[j] = xr[64 * j]; s += (v[j].x * v[j].x + v[j].y * v[j].y) + (v[j].z * v[j].z + v[j].w * v[j].w); }
    const float rstd = 1.0f / sqrtf(wave_sum(s) * (1.0f / 2048.0f) + EPS);
    GAS unsigned long long* o8 = (GAS unsigned long long*)orow + lane;
#pragma unroll
    for (int j = 0; j < 8; ++j) { const f32x4 wv = wr[64 * j]; const f32x4 y = v[j] * rstd * wv;
        o8[64 * j] = (unsigned long long)cvtpk(y.x, y.y) | ((unsigned long long)cvtpk(y.z, y.w) << 32); }
}
DI void p0_wout_items(Frame& F, int first, int stride) {
    LAS float* scr = (LAS float*)(F.lds + RING_OFF + F.wave * 16384);
    for (int r = first; r < 32 * 64; r += stride) p0_transpose_item(F.w_out, 2048, 2048, F.WoutT, 64 * (r / 64), 32 * (r % 64), 32 * (r % 64), scr, F.lane);
}
DI void p0_prologue(Frame& F, const bool defer_wout) {
    LAS float* scr = (LAS float*)(F.lds + RING_OFF + F.wave * 16384);
    const int gw = F.vcu * NWAVES + F.wave, NGW = F.G * NWAVES;
    constexpr int I_IN = 32 * 201, I_MEM = 32 * 32, I_OUT = 32 * 64; const int NITEMS = I_IN + I_MEM + (defer_wout ? 0 : I_OUT);
    for (int it = gw; it < NITEMS; it += NGW) {
        int r = it;
        if (r < I_IN) { const int kb = r / 201, sb = r % 201, n0 = 32 * sb; const int drow = n0 < 4096 ? n0 : (n0 < 4128 ? 6400 + (n0 - 4096) : n0 - 32);
            p0_transpose_item(F.w_in, 2048, NIN, F.WinT, 64 * kb, n0, drow, scr, F.lane); continue; }
        r -= I_IN;
        if (r < I_MEM) { p0_transpose_item(F.w_mem_kv, 2048, 1024, F.WmemT, 64 * (r / 32), 32 * (r % 32), 32 * (r % 32), scr, F.lane); continue; }
        r -= I_MEM;
        p0_transpose_item(F.w_out, 2048, 2048, F.WoutT, 64 * (r / 64), 32 * (r % 64), 32 * (r % 64), scr, F.lane);
    }
    { GAS v4u* z = (GAS v4u*)(F.WinT + (size_t)NIN * 2048); const int gt = F.vcu * 512 + F.tid, NT = F.G * 512;
      for (int i = gt; i < 224 * 256; i += NT) z[i] = (v4u){0u, 0u, 0u, 0u}; }
    for (int m = gw; m < M; m += NGW) rms_row_to_bf16(F.x + (size_t)m * DMODEL, F.norm_w, F.XN + (size_t)m * DMODEL, F.lane);
    for (int m = gw; m < NBATCH * MEMLEN; m += NGW) rms_row_to_bf16(F.mem + (size_t)m * DMODEL, F.mem_norm_w, F.MEMN + (size_t)m * DMODEL, F.lane);
    { const int gt = F.vcu * 512 + F.tid, NT = F.G * 512;
      for (int i = gt; i < SEQ * 32; i += NT) { const int pos = i >> 5, fi = i & 31; const float inv = powf(10000.0f, -(float)(2 * fi) / 64.0f); const float ang = (float)pos * inv;
          F.ROPE[2 * i] = cosf(ang); F.ROPE[2 * i + 1] = sinf(ang); } }
}

constexpr int AB_QH = 0, AB_KH = 17408, AB_VV = 34816, AB_BUF = 52224, AB_LD = 272;
constexpr int AD_F = 104448, AD_B = 122880, AD_T2 = 9216, AD_LDL = 72, AD_LDT = 144;
constexpr int AG_0 = 141312, AG_SZ = 2560, AG_RAW = 146432;
constexpr int ASCR_F = 0, ASCR_B = 5120;
static_assert(AG_RAW == AG_0 + 2 * AG_SZ && AG_RAW + 1024 <= RING_BYTES && AD_F == 2 * AB_BUF && AD_B == AD_F + 64 * 72 * 4 && AG_0 == AD_B + 64 * 72 * 4, "A-prep LDS map");
#define LBAR() asm volatile("s_waitcnt lgkmcnt(0)\n\ts_barrier" ::: "memory")

#define DPP_ADD(s, ctrl) (s) += __builtin_bit_cast(float, __builtin_amdgcn_update_dpp(0, __builtin_bit_cast(int, (s)), (ctrl), 0xf, 0xf, true))
DI float row16_sum(float s) { DPP_ADD(s, 0xB1); DPP_ADD(s, 0x4E); DPP_ADD(s, 0x141); DPP_ADD(s, 0x140); return s; }

DI void s3_solve(const bool BWD, LAS unsigned char* L, LAS unsigned char* scr, const LAS float* GV, int lane) {
    int lane_o = lane; asm volatile("" : "+v"(lane_o));
    const int hb = lane_o >> 5, cc = lane_o & 31, r16 = lane_o & 15, g = lane_o >> 4;
    LAS unsigned char* D = L + (BWD ? AD_B : AD_F);
    const LAS float* LS = (const LAS float*)D;
    const LAS float* Lb = LS + hb * (32 * AD_LDL + 32);
    LAS unsigned char* SA = scr + (BWD ? ASCR_B : ASCR_F); LAS unsigned char* SB = SA + 2560;
    LAS unsigned char* T1 = D; LAS unsigned char* T2 = D + AD_T2;
    const LAS float* S1 = GV + (BWD ? 192 : 128); const LAS float* S2 = GV + (BWD ? 576 : 512);
    bf16x8 la[2];
#pragma unroll
    for (int ti = 0; ti < 2; ++ti) { const LAS float* lp = LS + (32 + 16 * ti + r16) * AD_LDL + 8 * g; const f32x4 x0 = *(const LAS f32x4*)lp, x1 = *(const LAS f32x4*)(lp + 4); la[ti] = pack8(x0, x1); }
#ifndef RS3L
#define RS3L 1
#endif
    float t[32];
    for (int r3_ = 0; r3_ < RS3L; ++r3_) { asm volatile("" ::: "memory"); int cc_o = cc; asm volatile("" : "+v"(cc_o));
    t[0] = (cc_o == 0) ? 1.f : 0.f;
    f32x4 rwA[8], rwB[8];
    rwB[0] = *(const LAS f32x4*)(Lb + AD_LDL);
#pragma unroll
    for (int i = 1; i < 32; ++i) {
        if (i + 1 < 32) {
#pragma unroll
            for (int q = 0; q < 8; ++q) if (4 * q < i + 1) { if ((i + 1) & 1) rwB[q] = *(const LAS f32x4*)(Lb + (i + 1) * AD_LDL + 4 * q); else rwA[q] = *(const LAS f32x4*)(Lb + (i + 1) * AD_LDL + 4 * q); } }
        __builtin_amdgcn_sched_barrier(0);
        float sa = (cc_o == i) ? 1.f : 0.f, sb = 0.f;
#pragma unroll
        for (int q = 0; q < 8; ++q)
#pragma unroll
            for (int e = 0; e < 4; ++e) if (4 * q + e < i) { const float lv = (i & 1) ? rwB[q][e] : rwA[q][e];
                if (e & 1) asm("v_fma_f32 %0, -%1, %2, %0" : "+v"(sb) : "v"(lv), "v"(t[4 * q + e])); else asm("v_fma_f32 %0, -%1, %2, %0" : "+v"(sa) : "v"(lv), "v"(t[4 * q + e])); }
        t[i] = sa + sb;
        __builtin_amdgcn_sched_barrier(0);
    }
    }
#ifndef RS3T
#define RS3T 1
#endif
    for (int r4_ = 0; r4_ < RS3T; ++r4_) { asm volatile("" ::: "memory");
    {
        const int R = BWD ? 32 * hb + cc : 63 - 32 * hb - cc, colb = BWD ? 32 * hb : 32 * (1 - hb);
#pragma unroll
        for (int q = 0; q < 4; ++q) { const f32x4 a0 = *(const LAS f32x4*)(S1 + colb + 8 * q), a1 = *(const LAS f32x4*)(S1 + colb + 8 * q + 4), b0 = *(const LAS f32x4*)(S2 + colb + 8 * q), b1 = *(const LAS f32x4*)(S2 + colb + 8 * q + 4);
            f32x4 v0, v1;
#pragma unroll
            for (int e = 0; e < 4; ++e) { v0[e] = BWD ? t[8 * q + e] : t[31 - 8 * q - e]; v1[e] = BWD ? t[8 * q + 4 + e] : t[27 - 8 * q - e]; }
            *(LAS bf16x8*)(T1 + R * AD_LDT + (colb + 8 * q) * 2) = pack8(v0 * a0, v1 * a1); *(LAS bf16x8*)(T2 + R * AD_LDT + (colb + 8 * q) * 2) = pack8(v0 * b0, v1 * b1); }
    }
    __builtin_amdgcn_sched_barrier(0);
    if (hb == 0) {
#pragma unroll
        for (int q = 0; q < 4; ++q) *(LAS bf16x8*)(SA + cc * 80 + 16 * q) = pack8((f32x4){t[8 * q], t[8 * q + 1], t[8 * q + 2], t[8 * q + 3]}, (f32x4){t[8 * q + 4], t[8 * q + 5], t[8 * q + 6], t[8 * q + 7]});
    } else {
#pragma unroll
        for (int i = 0; i < 32; i += 2) { const unsigned pk = cvtpk(t[i], t[i + 1]); *(LAS bf16*)(SB + i * 80 + 2 * cc) = (bf16)(pk & 0xffffu); *(LAS bf16*)(SB + (i + 1) * 80 + 2 * cc) = (bf16)(pk >> 16); }
    }
    asm volatile("s_waitcnt lgkmcnt(0)" ::: "memory");
    __builtin_amdgcn_sched_barrier(0);
    bf16x8 tbf[2];
#pragma unroll
    for (int ti = 0; ti < 2; ++ti) tbf[ti] = ld_frag(SA + (16 * ti + r16) * 80 + 16 * g);
    f32x4 P[2][2];
#pragma unroll
    for (int ti = 0; ti < 2; ++ti)
#pragma unroll
        for (int tj = 0; tj < 2; ++tj) P[ti][tj] = MFMA16(la[ti], tbf[tj], ((f32x4){0.f, 0.f, 0.f, 0.f}));
    bf16x8 pbb[2];
#pragma unroll
    for (int tj = 0; tj < 2; ++tj) pbb[tj] = pack8(P[0][tj], P[1][tj]);
#pragma unroll
    for (int tip = 0; tip < 2; ++tip) {
        const u32x2 lo = *(const LAS u32x2*)(SB + (16 * tip + r16) * 80 + 8 * g), hi = *(const LAS u32x2*)(SB + (16 * tip + r16) * 80 + 32 + 8 * g);
        const v4u aw = (v4u){lo.x, lo.y, hi.x, hi.y}; const bf16x8 af = __builtin_bit_cast(bf16x8, aw);
#pragma unroll
        for (int tj = 0; tj < 2; ++tj) { const f32x4 X = MFMA16(af, pbb[tj], ((f32x4){0.f, 0.f, 0.f, 0.f})); const int b = 16 * tj + r16;
            const int Rn = BWD ? b : 63 - b, col0 = BWD ? 32 + 16 * tip + 4 * g : 28 - 16 * tip - 4 * g;
            const f32x4 a0 = *(const LAS f32x4*)(S1 + col0), b0 = *(const LAS f32x4*)(S2 + col0);
            f32x4 xv;
#pragma unroll
            for (int e = 0; e < 4; ++e) xv[e] = BWD ? -X[e] : -X[3 - e];
            u32x2 o1, o2; o1.x = cvtpk(xv[0] * a0[0], xv[1] * a0[1]); o1.y = cvtpk(xv[2] * a0[2], xv[3] * a0[3]); o2.x = cvtpk(xv[0] * b0[0], xv[1] * b0[1]); o2.y = cvtpk(xv[2] * b0[2], xv[3] * b0[3]);
            *(LAS u32x2*)(T1 + Rn * AD_LDT + col0 * 2) = o1; *(LAS u32x2*)(T2 + Rn * AD_LDT + col0 * 2) = o2; }
    }
    }
}

DI void acons_s2(Frame& F, LAS unsigned char* L, LAS unsigned char* B, const LAS float* GV, int item_f, int wv, int lane) {
    int lane_o = lane; asm volatile("" : "+v"(lane_o));
    const int r16 = lane_o & 15, g = lane_o >> 4, item_b = item_f + 32;
    f32x4 accG[4], accQ[4];
#pragma unroll
    for (int tn = 0; tn < 4; ++tn) { accG[tn] = (f32x4){0.f, 0.f, 0.f, 0.f}; accQ[tn] = (f32x4){0.f, 0.f, 0.f, 0.f}; }
    const LAS unsigned char* Ab = B + AB_KH + (16 * wv + r16) * AB_LD + g * 16;
    const LAS unsigned char* Kb = B + AB_KH + r16 * AB_LD + g * 16;
    const LAS unsigned char* Qb = B + AB_QH + r16 * AB_LD + g * 16;
    bf16x8 fr[2][9];
#define S2_LD(dst, ks_) do { dst[0] = ld_frag(Ab + (ks_) * 64); _Pragma("unroll") for (int tn_ = 0; tn_ < 4; ++tn_) { dst[1 + tn_] = ld_frag(Kb + tn_ * 16 * AB_LD + (ks_) * 64); dst[5 + tn_] = ld_frag(Qb + tn_ * 16 * AB_LD + (ks_) * 64); } } while (0)
    S2_LD(fr[0], 0);
#pragma unroll
    for (int ks = 0; ks < 4; ++ks) {
        if (ks + 1 < 4) S2_LD(fr[(ks + 1) & 1], ks + 1);
        __builtin_amdgcn_sched_barrier(0);
#pragma unroll
        for (int tn = 0; tn < 4; ++tn) { accG[tn] = MFMA16(fr[ks & 1][0], fr[ks & 1][1 + tn], accG[tn]); accQ[tn] = MFMA16(fr[ks & 1][0], fr[ks & 1][5 + tn], accQ[tn]); }
        __builtin_amdgcn_sched_barrier(0); }
#undef S2_LD
    LAS float* LF = (LAS float*)(L + AD_F);
    f32x4 gfi, gbi, bfi, bbi;
    { const LAS float* gp = GV + 16 * wv + 4 * g; gfi = *(const LAS f32x4*)gp; gbi = *(const LAS f32x4*)(gp + 64); bfi = *(const LAS f32x4*)(gp + 128); bbi = *(const LAS f32x4*)(gp + 192); }
#pragma unroll
    for (int tn = 0; tn < 4; ++tn) {
        const int j = 16 * tn + r16; const float gcfj = GV[j], gcbj = GV[64 + j];
#pragma unroll
        for (int reg = 0; reg < 4; ++reg) { const int i = 16 * wv + 4 * g + reg; const bool low = (j <= i);
            const float arg = low ? gfi[reg] - gcfj : gbi[reg] - gcbj, bt = low ? bfi[reg] : bbi[reg];
            const int off = low ? (63 - j) * AD_LDL + (63 - i) : (AD_B - AD_F) / 4 + j * AD_LDL + i;
            LF[off] = bt * accG[tn][reg] * __expf(fminf(arg, 0.f)); } }
#pragma unroll
    for (int tn = 0; tn < 4; ++tn) {
        const int i = 16 * tn + r16; const float gcfi = GV[i], gcbi = GV[64 + i]; float qf[4], qb[4];
#pragma unroll
        for (int reg = 0; reg < 4; ++reg) { const int j = 16 * wv + 4 * g + reg; const float v = accQ[tn][reg];
            const float ef = __expf(fminf(gcfi - gfi[reg], 0.f)), eb = __expf(fminf(gcbi - gbi[reg], 0.f));
            qf[reg] = v * ef * ((j <= i) ? 1.f : 0.f); qb[reg] = v * eb * ((j >= i) ? 1.f : 0.f); }
        const int idx = 32 * (wv >> 1) + 8 * g + 4 * (wv & 1);
        u32x2 vf, vb; vf.x = cvtpk(qf[0], qf[1]); vf.y = cvtpk(qf[2], qf[3]); vb.x = cvtpk(qb[0], qb[1]); vb.y = cvtpk(qb[2], qb[3]);
        *(u32x2*)(item_blk(F.wsb, F.dbo, item_f) + IO_QK + i * 64 + idx) = vf; *(u32x2*)(item_blk(F.wsb, F.dbo, item_b) + IO_QK + i * 64 + idx) = vb; }
}
DI void acons_kdect(Frame& F, LAS unsigned char* B, int item, int half, int lane) {
    int lane_o = lane; asm volatile("" : "+v"(lane_o));
    const int i16 = lane_o & 15, gg = lane_o >> 4, q4 = i16 >> 2, p4 = i16 & 3;
    bf16* const kt = shared_blk(F.wsb, item) + SO_KT;
#pragma unroll
    for (int s = 0; s < 2; ++s) {
#pragma unroll
        for (int d4 = 0; d4 < 4; ++d4) { const int dt = 4 * half + d4; const LAS unsigned char* ap = B + AB_KH + (32 * s + 4 * gg + q4) * AB_LD + (16 * dt + 4 * p4) * 2;
            const s16x4 lo = vtr(ap), hi = vtr(ap + 16 * AB_LD);
            const v4u o = __builtin_bit_cast(v4u, (bf16x8){lo[0], lo[1], lo[2], lo[3], hi[0], hi[1], hi[2], hi[3]});
            *(v4u*)(kt + (16 * dt + i16) * 64 + 32 * s + 8 * gg) = o; __builtin_amdgcn_sched_barrier(0); } }
}
DI void acons_s4(const int dir, Frame& F, LAS unsigned char* L, LAS unsigned char* B, LAS unsigned char* stg_all, int item_f, int wv, int lane) {
    int lane_o = lane; asm volatile("" : "+v"(lane_o));
    const int hw = wv & 1, r16 = lane_o & 15, g = lane_o >> 4, q4 = r16 >> 2, p4 = r16 & 3;
    const LAS unsigned char* T1 = L + (dir ? AD_B : AD_F); const LAS unsigned char* T2 = T1 + AD_T2;
    LAS unsigned char* stg = stg_all + wv * 4352;
    bf16* const blk = item_blk(F.wsb, F.dbo, item_f + 32 * dir);
    const int rrow = lane_o >> 3, rpc = lane_o & 7;
#define S4_LDV(dst, te_) do { dst[0] = tr_frag(B + AB_VV + ((8 * g + q4) * 136 + 16 * (te_) + 4 * p4) * 2, 4 * AB_LD); dst[1] = tr_frag(B + AB_VV + ((32 + 8 * g + q4) * 136 + 16 * (te_) + 4 * p4) * 2, 4 * AB_LD); } while (0)
#define S4_LDK(dst, td_) do { dst[0] = tr_frag(B + AB_KH + ((8 * g + q4) * 136 + 16 * (td_) + 4 * p4) * 2, 4 * AB_LD); dst[1] = tr_frag(B + AB_KH + ((32 + 8 * g + q4) * 136 + 16 * (td_) + 4 * p4) * 2, 4 * AB_LD); } while (0)
#define S4_OUT(gptr_) do { _Pragma("unroll") for (int p_ = 0; p_ < 4; ++p_) { const LAS unsigned char* sp_ = stg + (rrow + 8 * p_) * 136 + rpc * 16; const u32x2 lo_ = *(const LAS u32x2*)sp_, hi_ = *(const LAS u32x2*)(sp_ + 8); \
        *(v4u*)((gptr_) + (size_t)(rrow + 8 * p_) * ROWE + rpc * 8) = (v4u){lo_.x, lo_.y, hi_.x, hi_.y}; } } while (0)
    {
        bf16x8 a1[4][2];
#pragma unroll
        for (int ti = 0; ti < 4; ++ti)
#pragma unroll
            for (int ks = 0; ks < 2; ++ks) a1[ti][ks] = ld_frag(T1 + (16 * ti + r16) * AD_LDT + ks * 64 + g * 16);
        bf16x8 fx[2][2];
        S4_LDV(fx[0], 4 * hw);
#pragma unroll
        for (int t4 = 0; t4 < 4; ++t4) {
            if (t4 + 1 < 4) S4_LDV(fx[(t4 + 1) & 1], 4 * hw + t4 + 1);
            __builtin_amdgcn_sched_barrier(0);
            const bf16x8 v0 = fx[t4 & 1][0], v1 = fx[t4 & 1][1];
#pragma unroll
            for (int ti = 0; ti < 4; ++ti) { f32x4 acc = (f32x4){0.f, 0.f, 0.f, 0.f};
                if (!(dir == 1 && ti >= 2)) acc = MFMA16(a1[ti][0], v0, acc);
                if (!(dir == 0 && ti < 2)) acc = MFMA16(a1[ti][1], v1, acc);
                u32x2 o; o.x = cvtpk(acc[0], acc[1]); o.y = cvtpk(acc[2], acc[3]);
                *(LAS u32x2*)(stg + (16 * (t4 & 1) + r16) * 136 + (16 * ti + 4 * g) * 2) = o; }
            __builtin_amdgcn_sched_barrier(0);
            if (t4 & 1) { constexpr int ROWE = 64; S4_OUT(blk + IO_UT + (size_t)(64 * hw + 16 * (t4 - 1)) * 64); __builtin_amdgcn_sched_barrier(0); }
        }
    }
    {
        const int tiA = hw ? 1 : 0, tiB = hw ? 2 : 3;
        const bool A0 = true, A1 = (dir == 1), B0 = (dir == 0), B1 = true;
        bf16x8 a2A[2], a2B[2];
#pragma unroll
        for (int ks = 0; ks < 2; ++ks) { a2A[ks] = ld_frag(T2 + (16 * tiA + r16) * AD_LDT + ks * 64 + g * 16); a2B[ks] = ld_frag(T2 + (16 * tiB + r16) * AD_LDT + ks * 64 + g * 16); }
        bf16x8 fx[2][2];
        S4_LDK(fx[0], 0);
#pragma unroll
        for (int td = 0; td < 8; ++td) {
            if (td + 1 < 8) S4_LDK(fx[(td + 1) & 1], td + 1);
            __builtin_amdgcn_sched_barrier(0);
            f32x4 accA = (f32x4){0.f, 0.f, 0.f, 0.f}, accB = (f32x4){0.f, 0.f, 0.f, 0.f};
            const bf16x8 k0 = fx[td & 1][0], k1 = fx[td & 1][1];
            if (A0) accA = MFMA16(k0, a2A[0], accA); if (B0) accB = MFMA16(k0, a2B[0], accB);
            if (A1) accA = MFMA16(k1, a2A[1], accA); if (B1) accB = MFMA16(k1, a2B[1], accB);
            const int idl = 32 * ((td & 3) >> 1) + 8 * g + 4 * (td & 1);
            u32x2 o; o.x = cvtpk(-accA[0], -accA[1]); o.y = cvtpk(-accA[2], -accA[3]);
            *(LAS u32x2*)(stg + r16 * 136 + idl * 2) = o;
            o.x = cvtpk(-accB[0], -accB[1]); o.y = cvtpk(-accB[2], -accB[3]);
            *(LAS u32x2*)(stg + (16 + r16) * 136 + idl * 2) = o;
            __builtin_amdgcn_sched_barrier(0);
            if ((td & 3) == 3) {
                const int hf = td >> 2;
#pragma unroll
                for (int p_ = 0; p_ < 4; ++p_) { const int sr = rrow + 8 * p_; const LAS unsigned char* sp_ = stg + sr * 136 + rpc * 16; const u32x2 lo_ = *(const LAS u32x2*)sp_, hi_ = *(const LAS u32x2*)(sp_ + 8);
                    const int grow = 16 * (sr < 16 ? tiA : tiB) + (sr & 15);
                    *(v4u*)(blk + IO_WN + (size_t)grow * 128 + 64 * hf + rpc * 8) = (v4u){lo_.x, lo_.y, hi_.x, hi_.y}; }
                __builtin_amdgcn_sched_barrier(0); }
        }
    }
#undef S4_LDV
#undef S4_LDK
#undef S4_OUT
}
DI void aprod_s0(Frame& F, LAS float* GV, const LAS float* RAW, int item_f, int h, int lane) {
    const float ga[4] = {RAW[lane], RAW[64 + lane], RAW[128 + lane], RAW[192 + lane]};
    const float xf_ = ga[0] + F.dt_f[h], xb_ = ga[1] + F.dt_b[h];
    const float gf = -__expf(F.a_log_f[h]) * (xf_ > 15.f ? xf_ : __logf(1.0f + __expf(xf_)));
    const float gb = -__expf(F.a_log_b[h]) * (xb_ > 15.f ? xb_ : __logf(1.0f + __expf(xb_)));
    float pf = gf, pb = gb;
#pragma unroll
    for (int o = 1; o < 64; o <<= 1) { const float tf = __shfl_up(pf, o), tb = __shfl_up(pb, o); if (lane >= o) { pf += tf; pb += tb; } }
    const float totf = __shfl(pf, 63), totb = __shfl(pb, 63);
    const float gcf = pf, gcb = totb - pb + gb;
    const float btf_ = __builtin_amdgcn_rcpf(1.0f + __expf(-ga[2])), btb_ = __builtin_amdgcn_rcpf(1.0f + __expf(-ga[3])), egf_ = __expf(gcf), egb_ = __expf(gcb);
    GV[lane] = gcf; GV[64 + lane] = gcb; GV[128 + lane] = btf_; GV[192 + lane] = btb_;
    GV[256 + lane] = egf_; GV[320 + lane] = egb_; GV[384 + lane] = __expf(totf - gcf); GV[448 + lane] = __expf(totb - gcb); GV[512 + lane] = btf_ * egf_; GV[576 + lane] = btb_ * egb_;
    if (lane == 0) { F.CD[item_f] = __expf(totf); F.CD[item_f + 32] = __expf(totb); }
    { float* sf = (float*)(item_blk(F.wsb, F.dbo, item_f) + IO_SC); float* sb = (float*)(item_blk(F.wsb, F.dbo, item_f + 32) + IO_SC);
      sf[lane] = egf_; sf[64 + lane] = __expf(totf - gcf); sb[lane] = egb_; sb[64 + lane] = __expf(totb - gcb); }
}
DI void aprod_load(Frame& F, v4u (&x)[8], int b, int c, int h, int part, int p0, int c16) {
#pragma unroll
    for (int r = 0; r < 8; ++r) { const int t = c * 64 + p0 - 2 + r; v4u v = (v4u){0u, 0u, 0u, 0u};
        if (t >= 0 && t < SEQ) v = *(const v4u*)(F.PA + ((size_t)b * SEQ + t) * 3072 + part * 1024 + h * 128 + 8 * c16);
        x[r] = v; }
}
DI void aprod_conv(Frame& F, const v4u (&x)[8], float (&o)[4][8], int h, int part, int c16) {
#pragma unroll
    for (int j = 0; j < 4; ++j)
#pragma unroll
        for (int e = 0; e < 8; ++e) o[j][e] = 0.f;
#pragma unroll
    for (int k = 0; k < 5; ++k) { const float* wp = F.conv_w + k * 3072 + part * 1024 + h * 128 + 8 * c16; const f32x4 w0 = *(const f32x4*)wp, w1 = *(const f32x4*)(wp + 4);
#pragma unroll
        for (int j = 0; j < 4; ++j) { const v4u xr = x[j + k];
            o[j][0] += bflo(xr.x) * w0[0]; o[j][1] += bfhi(xr.x) * w0[1]; o[j][2] += bflo(xr.y) * w0[2]; o[j][3] += bfhi(xr.y) * w0[3];
            o[j][4] += bflo(xr.z) * w1[0]; o[j][5] += bfhi(xr.z) * w1[1]; o[j][6] += bflo(xr.w) * w1[2]; o[j][7] += bfhi(xr.w) * w1[3]; } }
#pragma unroll
    for (int j = 0; j < 4; ++j)
#pragma unroll
        for (int e = 0; e < 8; ++e) o[j][e] = silu_f(o[j][e]);
}
DI void aprod_store_rows(LAS unsigned char* img, const float (&o)[4][8], const float (&sc)[4], int p0, int c16) {
#pragma unroll
    for (int j = 0; j < 4; ++j) { v4u w; w.x = cvtpk(o[j][0] * sc[j], o[j][1] * sc[j]); w.y = cvtpk(o[j][2] * sc[j], o[j][3] * sc[j]); w.z = cvtpk(o[j][4] * sc[j], o[j][5] * sc[j]); w.w = cvtpk(o[j][6] * sc[j], o[j][7] * sc[j]);
        *(LAS v4u*)(img + (p0 + j) * AB_LD + c16 * 16) = w; }
}

#ifndef DLY1
#define DLY1 0
#endif
#ifndef DLY2
#define DLY2 0
#endif
#ifndef DLY3
#define DLY3 0
#endif
#define SPIN_TICKS(n_) do { if ((n_) > 0) { const unsigned long long t0_ = __builtin_amdgcn_s_memrealtime(); while (__builtin_amdgcn_s_memrealtime() - t0_ < (unsigned long long)(n_)) __builtin_amdgcn_s_sleep(1); } } while (0)
#ifndef RCK
#define RCK 1
#endif
#ifndef RC2
#define RC2 1
#endif
#ifndef RC3
#define RC3 1
#endif
#ifndef RC4
#define RC4 1
#endif
#ifndef RP1
#define RP1 1
#endif
#ifndef RP2
#define RP2 1
#endif
#ifndef RP3
#define RP3 1
#endif
DI void a_prep_phase(Frame& F) {
    const int lane = F.lane, wave = F.wave;
    LAS unsigned char* L = F.lds + RING_OFF;
    const int nit = F.ap_nit, IT0 = F.ap_it0, IST = F.ap_stride;
    if (wave < 4) {
#pragma unroll 1
        for (int k = -1; k < nit; ++k) {
            LAS unsigned char* Bc = L + (k & 1) * AB_BUF;
            const LAS float* GVc = (const LAS float*)(L + AG_0 + (k & 1) * AG_SZ);
            const int itc = IT0 + k * IST;
            const int item_c = (((itc >> 8) * 8 + (itc & 7)) * 2) * 32 + ((itc >> 3) & 31);
            const bool cons = (k >= 0);
            if (cons) SPIN_TICKS(DLY1);
            if (cons) for (int r_ = 0; r_ < RC2; ++r_) { asm volatile("" ::: "memory"); acons_s2(F, L, Bc, GVc, item_c, wave, lane); }
            LBAR();
            if (cons) SPIN_TICKS(DLY2);
            if (cons) for (int r_ = 0; r_ < RC3; ++r_) { if (wave < 2) s3_solve(wave == 1, L, Bc + AB_QH, GVc, lane); else for (int r2_ = 0; r2_ < RCK; ++r2_) { asm volatile("" ::: "memory"); acons_kdect(F, Bc, item_c, wave - 2, lane); } }
            LBAR();
            if (cons) SPIN_TICKS(DLY3);
            if (cons) for (int r_ = 0; r_ < RC4; ++r_) { asm volatile("" ::: "memory"); acons_s4(wave >> 1, F, L, Bc, Bc + AB_QH, item_c, wave, lane); }
            LBAR();
        }
    } else {
        const int pw = wave - 4;
        LAS float* RAW = (LAS float*)(L + AG_RAW);
        v4u xq[8], xk[8], xv[8];
        { const int c16 = lane & 15, p0 = 16 * pw + 4 * (lane >> 4);
          if (nit > 0) { const int it = IT0; aprod_load(F, xk, it >> 8, (it >> 3) & 31, it & 7, 1, p0, c16); }
          if (wave == 4 && nit > 0) {
              { const int it = IT0; const int b = it >> 8, c = (it >> 3) & 31, h = it & 7; const float* gr = F.GATES + ((size_t)b * SEQ + c * 64 + lane) * 32; RAW[lane] = gr[h]; RAW[64 + lane] = gr[8 + h]; RAW[128 + lane] = gr[16 + h]; RAW[192 + lane] = gr[24 + h];
                aprod_s0(F, (LAS float*)(L + AG_0), RAW, ((b * 8 + h) * 2) * 32 + c, h, lane); }
              if (nit > 1) { const int it = IT0 + IST; const int b = it >> 8, c = (it >> 3) & 31, h = it & 7; const float* gr = F.GATES + ((size_t)b * SEQ + c * 64 + lane) * 32; const float g0 = gr[h], g1 = gr[8 + h], g2 = gr[16 + h], g3 = gr[24 + h];
                RAW[lane] = g0; RAW[64 + lane] = g1; RAW[128 + lane] = g2; RAW[192 + lane] = g3; } } }
#pragma unroll 1
        for (int k = -1; k < nit; ++k) {
            LAS unsigned char* Bn = L + ((k + 1) & 1) * AB_BUF;
            LAS float* GVn = (LAS float*)(L + AG_0 + ((k + 1) & 1) * AG_SZ);
            const int itn = IT0 + (k + 1) * IST;
            const int bn = itn >> 8, cn = (itn >> 3) & 31, hn = itn & 7; const int item_n = ((bn * 8 + hn) * 2) * 32 + cn;
            const bool prod = (k + 1 < nit);
            int lo_ = lane; asm volatile("" : "+v"(lo_));
            const int gI = lo_ >> 4, c16 = lo_ & 15, p0 = 16 * pw + 4 * gI;
            if (prod) {
                aprod_load(F, xq, bn, cn, hn, 0, p0, c16);
                for (int r_ = 0; r_ < RP1; ++r_) { asm volatile("" ::: "memory");
                float o[4][8]; aprod_conv(F, xk, o, hn, 1, c16);
                float sc[4];
#pragma unroll
                for (int j = 0; j < 4; ++j) { float ss = 0.f;
#pragma unroll
                    for (int e = 0; e < 8; ++e) ss += o[j][e] * o[j][e];
                    sc[j] = 1.0f / sqrtf(row16_sum(ss) + EPS); }
                aprod_store_rows(Bn + AB_KH, o, sc, p0, c16); }
            }
            LBAR();
            if (prod) {
                aprod_load(F, xv, bn, cn, hn, 2, p0, c16);
                float o[4][8]; float sc[4];
                for (int r_ = 0; r_ < RP2; ++r_) { asm volatile("" ::: "memory");
                aprod_conv(F, xq, o, hn, 0, c16);
#pragma unroll
                for (int j = 0; j < 4; ++j) { float ss = 0.f;
#pragma unroll
                    for (int e = 0; e < 8; ++e) ss += o[j][e] * o[j][e];
                    sc[j] = (1.0f / sqrtf(row16_sum(ss) + EPS)) * 0.08838834764831845f; }
                aprod_store_rows(Bn + AB_QH, o, sc, p0, c16); }
#ifndef RPQ
#define RPQ 1
#endif
                for (int r_ = 0; r_ < RPQ; ++r_) { asm volatile("" ::: "memory");
                const int b1 = (c16 >> 1) & 1, qoff = 32 * (c16 >> 2) + 8 * (2 * (c16 & 1) + b1);
#pragma unroll
                for (int j = 0; j < 4; ++j) { const int pos = p0 + j; const float e_ = sc[j];
                    const unsigned r0x = cvtpk(o[j][0] * e_, o[j][1] * e_), r0y = cvtpk(o[j][2] * e_, o[j][3] * e_), r1x = cvtpk(o[j][4] * e_, o[j][5] * e_), r1y = cvtpk(o[j][6] * e_, o[j][7] * e_);
                    const unsigned sx = b1 ? r0x : r1x, sy = b1 ? r0y : r1y;
                    const unsigned gx = (unsigned)__builtin_amdgcn_update_dpp(0, (int)sx, 0x4E, 0xf, 0xf, true), gy = (unsigned)__builtin_amdgcn_update_dpp(0, (int)sy, 0x4E, 0xf, 0xf, true);
                    const v4u w = b1 ? (v4u){gx, gy, r1x, r1y} : (v4u){r0x, r0y, gx, gy};
                    *(v4u*)(shared_blk(F.wsb, item_n) + SO_QD + pos * 128 + qoff) = w; }
                }
            }
            LBAR();
            {
                float g4[4] = {0.f, 0.f, 0.f, 0.f}; const bool more = (k + 2 < nit), more3 = (k + 3 < nit);
                if (more) { const int it2 = itn + IST; const int b2 = it2 >> 8, c2 = (it2 >> 3) & 31, h2 = it2 & 7; aprod_load(F, xk, b2, c2, h2, 1, p0, c16);
                    if (wave == 4) { aprod_s0(F, (LAS float*)(L + AG_0 + (k & 1) * AG_SZ), RAW, ((b2 * 8 + h2) * 2) * 32 + c2, h2, lane);
                        if (more3) { const int it3 = it2 + IST; const int b3 = it3 >> 8, c3 = (it3 >> 3) & 31, h3 = it3 & 7; const float* gr = F.GATES + ((size_t)b3 * SEQ + c3 * 64 + lane) * 32; g4[0] = gr[h3]; g4[1] = gr[8 + h3]; g4[2] = gr[16 + h3]; g4[3] = gr[24 + h3]; } } }
                if (prod) for (int r_ = 0; r_ < RP3; ++r_) { asm volatile("" ::: "memory"); float o[4][8]; aprod_conv(F, xv, o, hn, 2, c16);
                    const float sc[4] = {1.f, 1.f, 1.f, 1.f};
                    aprod_store_rows(Bn + AB_VV, o, sc, p0, c16); }
                if (more3 && wave == 4) { RAW[lane] = g4[0]; RAW[64 + lane] = g4[1]; RAW[128 + lane] = g4[2]; RAW[192 + lane] = g4[3]; }
            }
            LBAR();
        }
    }
}

constexpr int B_KB = 0, B_VB = 55296;
DI void b_attn_unit(Frame& F, int b, int nb, int kvh, bf16* MO) {
    const int tid = F.tid, lane = F.lane, wave = F.wave;
    LAS unsigned char* L = F.lds + RING_OFF;
#pragma unroll
    for (int it = 0; it < 6; ++it) { const int q = tid + 512 * it, row = q >> 3, cc = q & 7; const int t = (nb - 1) * 128 + row; const bool valid = (t >= 0) && (t < SEQ);
        v4u kv = (v4u){0u, 0u, 0u, 0u}, vv = (v4u){0u, 0u, 0u, 0u};
        if (valid) { const bf16* rp = F.PB + ((size_t)b * SEQ + t) * 768 + 512 + kvh * 64 + 8 * cc; kv = *(const v4u*)rp; vv = *(const v4u*)(rp + 128); }
        float xk[8]; xk[0] = bflo(kv.x); xk[1] = bfhi(kv.x); xk[2] = bflo(kv.y); xk[3] = bfhi(kv.y); xk[4] = bflo(kv.z); xk[5] = bfhi(kv.z); xk[6] = bflo(kv.w); xk[7] = bfhi(kv.w);
        float ss = 0.f;
#pragma unroll
        for (int e = 0; e < 8; ++e) ss += xk[e] * xk[e];
        ss += __shfl_xor(ss, 1); ss += __shfl_xor(ss, 2); ss += __shfl_xor(ss, 4);
        const float rstd = 1.0f / sqrtf(ss * (1.0f / 64.0f) + EPS);
        const int tt = valid ? t : 0; float o[8];
#pragma unroll
        for (int e = 0; e < 8; ++e) { const float y = xk[e] * rstd * F.k_norm_b[8 * cc + e]; const float pr = __shfl_xor(y, 4);
            const f32x2v cs = *(const f32x2v*)(F.ROPE + ((size_t)tt * 32 + ((8 * cc + e) & 31)) * 2);
            o[e] = (cc < 4) ? (y * cs.x - pr * cs.y) : (y * cs.x + pr * cs.y); }
        v4u ok; ok.x = cvtpk(o[0], o[1]); ok.y = cvtpk(o[2], o[3]); ok.z = cvtpk(o[4], o[5]); ok.w = cvtpk(o[6], o[7]);
        if (!valid) ok = (v4u){0u, 0u, 0u, 0u};
        *(LAS v4u*)(L + B_KB + row * 144 + cc * 16) = ok; *(LAS v4u*)(L + B_VB + row * 144 + cc * 16) = vv; }
    if (tid < 128) *(LAS v4u*)(L + B_VB + (384 + (tid >> 3)) * 144 + (tid & 7) * 16) = (v4u){0u, 0u, 0u, 0u};
    __syncthreads();
    const int hq = kvh * 4 + (wave >> 1), r16 = lane & 15, g = lane >> 4, q4 = r16 >> 2, p4 = r16 & 3;
    const float sk = F.sink_b[hq] * LOG2E;
#pragma unroll 1
    for (int qt = 0; qt < 4; ++qt) {
        const int i0 = (wave & 1) * 64 + 16 * qt, iq = i0 + r16, pos = nb * 128 + iq; const size_t m = (size_t)b * SEQ + pos;
        bf16x8 qf[2];
        { const bf16* qp = F.PB + m * 768 + hq * 64 + 8 * g; const v4u a = *(const v4u*)qp, c2 = *(const v4u*)(qp + 32);
          float x0[8], x1[8]; x0[0] = bflo(a.x); x0[1] = bfhi(a.x); x0[2] = bflo(a.y); x0[3] = bfhi(a.y); x0[4] = bflo(a.z); x0[5] = bfhi(a.z); x0[6] = bflo(a.w); x0[7] = bfhi(a.w);
          x1[0] = bflo(c2.x); x1[1] = bfhi(c2.x); x1[2] = bflo(c2.y); x1[3] = bfhi(c2.y); x1[4] = bflo(c2.z); x1[5] = bfhi(c2.z); x1[6] = bflo(c2.w); x1[7] = bfhi(c2.w);
          float ss = 0.f;
#pragma unroll
          for (int e = 0; e < 8; ++e) ss += x0[e] * x0[e] + x1[e] * x1[e];
          ss += __shfl_xor(ss, 16); ss += __shfl_xor(ss, 32);
          const float rstd = (1.0f / sqrtf(ss * (1.0f / 64.0f) + EPS));
          float o0[8], o1[8];
#pragma unroll
          for (int e = 0; e < 8; ++e) { const float y0 = x0[e] * rstd * F.q_norm_b[8 * g + e], y1 = x1[e] * rstd * F.q_norm_b[32 + 8 * g + e];
              const f32x2v cs = *(const f32x2v*)(F.ROPE + ((size_t)pos * 32 + 8 * g + e) * 2);
              o0[e] = (y0 * cs.x - y1 * cs.y) * (0.125f * LOG2E); o1[e] = (y1 * cs.x + y0 * cs.y) * (0.125f * LOG2E); }
          v4u w0, w1; w0.x = cvtpk(o0[0], o0[1]); w0.y = cvtpk(o0[2], o0[3]); w0.z = cvtpk(o0[4], o0[5]); w0.w = cvtpk(o0[6], o0[7]);
          w1.x = cvtpk(o1[0], o1[1]); w1.y = cvtpk(o1[2], o1[3]); w1.z = cvtpk(o1[4], o1[5]); w1.w = cvtpk(o1[6], o1[7]);
          qf[0] = __builtin_bit_cast(bf16x8, w0); qf[1] = __builtin_bit_cast(bf16x8, w1); }
        f32x4 st[18];
#pragma unroll
        for (int c = 0; c < 17; ++c) { f32x4 acc = (f32x4){0.f, 0.f, 0.f, 0.f};
#pragma unroll
            for (int s = 0; s < 2; ++s) acc = MFMA16(ld_frag(L + B_KB + (i0 + 16 * c + r16) * 144 + s * 64 + g * 16), qf[s], acc);
            st[c] = acc; __builtin_amdgcn_sched_barrier(0); }
        st[17] = (f32x4){0.f, 0.f, 0.f, 0.f};
        float mx = sk;
#pragma unroll
        for (int c = 0; c < 17; ++c)
#pragma unroll
            for (int reg = 0; reg < 4; ++reg) { const int j = i0 + 16 * c + 4 * g + reg; const int kpos = (nb - 1) * 128 + j;
                const bool ok = (j >= iq) && (j <= iq + 256) && (kpos >= 0) && (kpos < SEQ);
                const float v = ok ? st[c][reg] : -INFINITY; st[c][reg] = v; mx = fmaxf(mx, v); }
        mx = fmaxf(mx, __shfl_xor(mx, 16)); mx = fmaxf(mx, __shfl_xor(mx, 32));
        float sum = 0.f;
#pragma unroll
        for (int c = 0; c < 17; ++c)
#pragma unroll
            for (int reg = 0; reg < 4; ++reg) { const float p = __builtin_amdgcn_exp2f(st[c][reg] - mx); st[c][reg] = p; sum += p; }
        sum += __shfl_xor(sum, 16); sum += __shfl_xor(sum, 32);
        const float inv = 1.0f / (sum + __builtin_amdgcn_exp2f(sk - mx));
        bf16x8 pb[9];
#pragma unroll
        for (int kp = 0; kp < 9; ++kp) pb[kp] = pack8(st[2 * kp], st[2 * kp + 1]);
#pragma unroll
        for (int td = 0; td < 4; ++td) { f32x4 acc = (f32x4){0.f, 0.f, 0.f, 0.f};
#pragma unroll
            for (int kp = 0; kp < 9; ++kp) acc = MFMA16(tr_frag(L + B_VB + ((i0 + 32 * kp + 4 * g + q4) * 72 + 16 * td + 4 * p4) * 2, 16 * 144), pb[kp], acc);
            const size_t mo = m * 2048 + 1024 + hq * 64 + 16 * td + 4 * g; const u32x2 z = *(const u32x2*)(F.MIX + mo); bf16* mp = MO + mo;
            u32x2 o; o.x = cvtpk(acc[0] * inv * bflo(z.x), acc[1] * inv * bfhi(z.x)); o.y = cvtpk(acc[2] * inv * bflo(z.y), acc[3] * inv * bfhi(z.y));
            *(u32x2*)mp = o; __builtin_amdgcn_sched_barrier(0); }
    }
    __syncthreads();
}

constexpr int C_KC = 0, C_VC = 69632;
DI void c_attn_unit(Frame& F, int b, int hc, int qblk, bf16* MO) {
    const int tid = F.tid, lane = F.lane, wave = F.wave;
    LAS unsigned char* L = F.lds + RING_OFF;
#pragma unroll
    for (int it = 0; it < 8; ++it) { const int q = tid + 512 * it, row = q >> 4, cc = q & 15;
        const bf16* rp = F.KVM + ((size_t)b * MEMLEN + row) * 1024 + hc * 128 + 8 * cc; const v4u kv = *(const v4u*)rp, vv = *(const v4u*)(rp + 512);
        float xk[8]; xk[0] = bflo(kv.x); xk[1] = bfhi(kv.x); xk[2] = bflo(kv.y); xk[3] = bfhi(kv.y); xk[4] = bflo(kv.z); xk[5] = bfhi(kv.z); xk[6] = bflo(kv.w); xk[7] = bfhi(kv.w);
        float ss = 0.f;
#pragma unroll
        for (int e = 0; e < 8; ++e) ss += xk[e] * xk[e];
        ss += __shfl_xor(ss, 1); ss += __shfl_xor(ss, 2); ss += __shfl_xor(ss, 4); ss += __shfl_xor(ss, 8);
        const float rstd = 1.0f / sqrtf(ss * (1.0f / 128.0f) + EPS);
        float o[8];
#pragma unroll
        for (int e = 0; e < 8; ++e) o[e] = xk[e] * rstd * F.k_norm_c[8 * cc + e];
        v4u ok; ok.x = cvtpk(o[0], o[1]); ok.y = cvtpk(o[2], o[3]); ok.z = cvtpk(o[4], o[5]); ok.w = cvtpk(o[6], o[7]);
        *(LAS v4u*)(L + C_KC + row * 272 + cc * 16) = ok; *(LAS v4u*)(L + C_VC + row * 272 + cc * 16) = vv; }
    __syncthreads();
    const int r16 = lane & 15, g = lane >> 4, q4 = r16 >> 2, p4 = r16 & 3;
#pragma unroll 1
    for (int qt = 0; qt < 2; ++qt) {
        const size_t m = (size_t)b * SEQ + qblk * 256 + wave * 32 + qt * 16 + r16;
        bf16x8 qf[4];
        { float xs[4][8]; float ss = 0.f;
#pragma unroll
          for (int s = 0; s < 4; ++s) { const v4u a = *(const v4u*)(F.PC + m * 512 + hc * 128 + 32 * s + 8 * g);
              xs[s][0] = bflo(a.x); xs[s][1] = bfhi(a.x); xs[s][2] = bflo(a.y); xs[s][3] = bfhi(a.y); xs[s][4] = bflo(a.z); xs[s][5] = bfhi(a.z); xs[s][6] = bflo(a.w); xs[s][7] = bfhi(a.w);
#pragma unroll
              for (int e = 0; e < 8; ++e) ss += xs[s][e] * xs[s][e]; }
          ss += __shfl_xor(ss, 16); ss += __shfl_xor(ss, 32);
          const float rstd = (1.0f / sqrtf(ss * (1.0f / 128.0f) + EPS)) * (0.08838834764831845f * LOG2E);
#pragma unroll
          for (int s = 0; s < 4; ++s) { float o[8];
#pragma unroll
              for (int e = 0; e < 8; ++e) o[e] = xs[s][e] * rstd * F.q_norm_c[32 * s + 8 * g + e];
              v4u w0; w0.x = cvtpk(o[0], o[1]); w0.y = cvtpk(o[2], o[3]); w0.z = cvtpk(o[4], o[5]); w0.w = cvtpk(o[6], o[7]); qf[s] = __builtin_bit_cast(bf16x8, w0); } }
        f32x4 st[16];
#pragma unroll
        for (int c = 0; c < 16; ++c) { f32x4 acc = (f32x4){0.f, 0.f, 0.f, 0.f};
#pragma unroll
            for (int s = 0; s < 4; ++s) acc = MFMA16(ld_frag(L + C_KC + (16 * c + r16) * 272 + s * 64 + g * 16), qf[s], acc);
            st[c] = acc; __builtin_amdgcn_sched_barrier(0); }
        float mx = -INFINITY;
#pragma unroll
        for (int c = 0; c < 16; ++c)
#pragma unroll
            for (int reg = 0; reg < 4; ++reg) mx = fmaxf(mx, st[c][reg]);
        mx = fmaxf(mx, __shfl_xor(mx, 16)); mx = fmaxf(mx, __shfl_xor(mx, 32));
        float sum = 0.f;
#pragma unroll
        for (int c = 0; c < 16; ++c)
#pragma unroll
            for (int reg = 0; reg < 4; ++reg) { const float p = __builtin_amdgcn_exp2f(st[c][reg] - mx); st[c][reg] = p; sum += p; }
        sum += __shfl_xor(sum, 16); sum += __shfl_xor(sum, 32);
        const float inv = 1.0f / sum;
        bf16x8 pb[8];
#pragma unroll
        for (int kp = 0; kp < 8; ++kp) pb[kp] = pack8(st[2 * kp], st[2 * kp + 1]);
#pragma unroll
        for (int td = 0; td < 8; ++td) { f32x4 acc = (f32x4){0.f, 0.f, 0.f, 0.f};
#pragma unroll
            for (int kp = 0; kp < 8; ++kp) acc = MFMA16(tr_frag(L + C_VC + ((32 * kp + 4 * g + q4) * 136 + 16 * td + 4 * p4) * 2, 16 * 272), pb[kp], acc);
            const size_t mo = m * 2048 + 1536 + hc * 128 + 16 * td + 4 * g; const u32x2 z = *(const u32x2*)(F.MIX + mo); bf16* mp = MO + mo;
            u32x2 o; o.x = cvtpk(acc[0] * inv * bflo(z.x), acc[1] * inv * bfhi(z.x)); o.y = cvtpk(acc[2] * inv * bflo(z.y), acc[3] * inv * bfhi(z.y));
            *(u32x2*)mp = o; __builtin_amdgcn_sched_barrier(0); }
    }
    __syncthreads();
}

constexpr int S_WN = 0, S_QD = 18432, S_KT = 36864, S_QK = 55296, S_SC = 64512, S_BUF = 65024;
constexpr int S_OST = 2 * S_BUF, S_OLD = 272;
static_assert(S_OST + 64 * S_OLD <= RING_BYTES, "scan LDS");
#ifdef XBARS
#define XBAR() do { LBAR(); LBAR(); LBAR(); LBAR(); } while (0)
#else
#define XBAR() do {} while (0)
#endif
DI void scan_unit(LAS unsigned char* lds_, int tid, unsigned char* wsb_, unsigned char* dbo_, const float* CD_, bf16* OF_, bf16* OB_, gu32* PROG_, int bh, int dir) {
    const int lane = tid & 63, wave = __builtin_amdgcn_readfirstlane(tid >> 6);
    LAS unsigned char* L = lds_ + RING_OFF;
    const int b = bh >> 3, h = bh & 7;
    const int item0 = (bh * 2 + dir) * 32;
    const int r16 = lane & 15, g = lane >> 4;
    const int lt = tid - 256;
    const int e0 = wave * 32 + r16;
    if (wave == 7) {
        __syncthreads();
#pragma unroll 1
        for (int s = 0; s < 32; ++s) {
            if (lane == 0) __hip_atomic_store(PROG_, (unsigned)(s + 1), RLX_AGENT);
            if (s > 0) { const int np = dir ? 32 - s : s - 1; bf16* ob = (dir ? OB_ : OF_) + ((size_t)b * SEQ + (size_t)np * 64) * 1024 + h * 128;
                int lo_ = lane; asm volatile("" : "+v"(lo_));
#pragma unroll
                for (int i = 0; i < 16; ++i) { const int q = lo_ + 64 * i, row = q >> 4, cc = q & 15; const v4u v = *(const LAS v4u*)(L + S_OST + row * S_OLD + cc * 16);
                    *(v4u*)(ob + (size_t)row * 1024 + cc * 8) = v; } }
            LBAR(); LBAR(); XBAR();
        }
    } else if (wave >= 4) {
        const int l3 = tid - 256;
#define SC_DOF(p_) ((p_) < 1024 ? (unsigned)(S_QD + ((p_) >> 4) * 288 + ((p_) & 15) * 16) : (p_) < 2048 ? (unsigned)(S_KT + (((p_) - 1024) >> 3) * 144 + ((p_) & 7) * 16) : (p_) < 3072 ? (unsigned)(S_WN + (((p_) - 2048) >> 4) * 288 + ((p_) & 15) * 16) \
        : (p_) < 3584 ? (unsigned)(S_QK + (((p_) - 3072) >> 3) * 144 + ((p_) & 7) * 16) : (unsigned)(S_SC + ((p_) - 3584) * 16))
        const bool last_ok = (l3 + 192 * 18) < 3616;
        v4u ldA[19], ldB[19];
#define SC_LOAD(ld, n_) do { const v4u* sb_ = (const v4u*)shared_blk(wsb_, item0 + (n_)); const v4u* db_ = (const v4u*)item_blk(wsb_, dbo_, item0 + (n_)) - 2048; \
        _Pragma("unroll") for (int i_ = 0; i_ < 18; ++i_) { const int p_ = l3 + 192 * i_; ld[i_] = (i_ < 10) ? sb_[p_] : (i_ > 10) ? db_[p_] : (p_ < 2048 ? sb_ : db_)[p_]; } \
        ld[18] = db_[last_ok ? l3 + 192 * 18 : 2048]; } while (0)
#define SC_WRITE(ld, bufo_) do { LAS unsigned char* B_ = L + (bufo_); int lo_ = l3; asm volatile("" : "+v"(lo_)); \
        _Pragma("unroll") for (int i_ = 0; i_ < 18; ++i_) { const int p_ = lo_ + 192 * i_; *(LAS v4u*)(B_ + SC_DOF(p_)) = ld[i_]; } \
        if (last_ok) { const int p_ = lo_ + 192 * 18; *(LAS v4u*)(B_ + SC_DOF(p_)) = ld[18]; } } while (0)
#define SC_CH(k_) (dir ? 31 - ((k_) < 31 ? (k_) : 31) : ((k_) < 31 ? (k_) : 31))
        SC_LOAD(ldA, SC_CH(0)); SC_WRITE(ldA, 0); SC_LOAD(ldB, SC_CH(1)); SC_LOAD(ldA, SC_CH(2));
        __syncthreads();
#pragma unroll 1
        for (int s = 0; s < 32; s += 2) {
            SC_WRITE(ldB, S_BUF); SC_LOAD(ldB, SC_CH(s + 3));
            LBAR(); LBAR(); XBAR();
            SC_WRITE(ldA, 0); SC_LOAD(ldA, SC_CH(s + 4));
            LBAR(); LBAR(); XBAR();
        }
        asm volatile("s_waitcnt vmcnt(0)" ::: "memory");
#undef SC_CH
#undef SC_DOF
    } else {
        f32x4 S[2][8];
#pragma unroll
        for (int c = 0; c < 2; ++c)
#pragma unroll
            for (int td = 0; td < 8; ++td) S[c][td] = (f32x4){0.f, 0.f, 0.f, 0.f};
        u32x2 un[2][4]; float cdn;
        { const int n0 = dir ? 31 : 0;
#pragma unroll
          for (int c = 0; c < 2; ++c) { const bf16* up = item_blk(wsb_, dbo_, item0 + n0) + IO_UT + (e0 + 16 * c) * 64 + 4 * g;
#pragma unroll
              for (int t = 0; t < 4; ++t) un[c][t] = *(const u32x2*)(up + 16 * t); }
          cdn = CD_[item0 + n0]; }
        __syncthreads();
#pragma unroll 1
        for (int s = 0; s < 32; ++s) {
            const LAS unsigned char* Bf = L + (s & 1) * S_BUF;
            const float cd = cdn;
            f32x4 vacc[2][4];
#pragma unroll
            for (int c = 0; c < 2; ++c)
#pragma unroll
                for (int t = 0; t < 4; ++t) { const u32x2 uu = un[c][t]; vacc[c][t] = (f32x4){bflo(uu.x), bfhi(uu.x), bflo(uu.y), bfhi(uu.y)}; }
            if (s + 1 < 32) { const int nn = dir ? 30 - s : s + 1;
#pragma unroll
                for (int c = 0; c < 2; ++c) { const bf16* up = item_blk(wsb_, dbo_, item0 + nn) + IO_UT + (e0 + 16 * c) * 64 + 4 * g;
#pragma unroll
                    for (int t = 0; t < 4; ++t) un[c][t] = *(const u32x2*)(up + 16 * t); }
                cdn = CD_[item0 + nn]; }
            bf16x8 Sb[2][4];
#pragma unroll
            for (int c = 0; c < 2; ++c)
#pragma unroll
                for (int ks = 0; ks < 4; ++ks) Sb[c][ks] = pack8(S[c][2 * ks], S[c][2 * ks + 1]);
            bf16x8 fa[4], fb[4];
#define SC_SB() __builtin_amdgcn_sched_barrier(0)
#define SC_LD4(dst, base_, row_, rstride_) do { dst[0] = ld_frag(Bf + (base_) + ((row_) + r16) * (rstride_) + g * 16); dst[1] = ld_frag(Bf + (base_) + ((row_) + r16) * (rstride_) + 64 + g * 16); \
        dst[2] = ld_frag(Bf + (base_) + ((row_) + r16) * (rstride_) + 128 + g * 16); dst[3] = ld_frag(Bf + (base_) + ((row_) + r16) * (rstride_) + 192 + g * 16); } while (0)
#define SC_MM4(acc_, src, t_) do { acc_[0][t_] = MFMA16(src[0], Sb[0][0], acc_[0][t_]); acc_[1][t_] = MFMA16(src[0], Sb[1][0], acc_[1][t_]); acc_[0][t_] = MFMA16(src[1], Sb[0][1], acc_[0][t_]); acc_[1][t_] = MFMA16(src[1], Sb[1][1], acc_[1][t_]); \
        acc_[0][t_] = MFMA16(src[2], Sb[0][2], acc_[0][t_]); acc_[1][t_] = MFMA16(src[2], Sb[1][2], acc_[1][t_]); acc_[0][t_] = MFMA16(src[3], Sb[0][3], acc_[0][t_]); acc_[1][t_] = MFMA16(src[3], Sb[1][3], acc_[1][t_]); } while (0)
#define SC_MMV(src, t_) SC_MM4(vacc, src, t_)
#define SC_MMO(src, t_) SC_MM4(oacc, src, t_)
#ifndef RSC1
#define RSC1 1
#endif
            f32x4 vsave[2][4];
            if (RSC1 > 1) { _Pragma("unroll") for (int c = 0; c < 2; ++c) _Pragma("unroll") for (int t = 0; t < 4; ++t) vsave[c][t] = vacc[c][t]; }
            for (int r5_ = 0; r5_ < RSC1; ++r5_) {
            if (RSC1 > 1) { _Pragma("unroll") for (int c = 0; c < 2; ++c) _Pragma("unroll") for (int t = 0; t < 4; ++t) vacc[c][t] = vsave[c][t]; asm volatile("" : "+v"(Sb[0][0]), "+v"(Sb[1][0]), "+v"(Sb[0][1]), "+v"(Sb[1][1]), "+v"(Sb[0][2]), "+v"(Sb[1][2]), "+v"(Sb[0][3]), "+v"(Sb[1][3]) :: "memory"); }
            SC_LD4(fa, S_WN, 0, 288); SC_SB();
            SC_LD4(fb, S_WN, 16, 288); SC_SB(); SC_MMV(fa, 0); SC_SB();
            SC_LD4(fa, S_WN, 32, 288); SC_SB(); SC_MMV(fb, 1); SC_SB();
            SC_LD4(fb, S_WN, 48, 288); SC_SB(); SC_MMV(fa, 2); SC_SB();
            SC_LD4(fa, S_QD, 0, 288); SC_SB(); SC_MMV(fb, 3); SC_SB(); }
            bf16x8 Vb[2][2], Vk[2][2];
#pragma unroll
            for (int kp = 0; kp < 2; ++kp) { const f32x4 k0 = *(const LAS f32x4*)(Bf + S_SC + 256 + (32 * kp + 4 * g) * 4), k1 = *(const LAS f32x4*)(Bf + S_SC + 256 + (32 * kp + 16 + 4 * g) * 4);
#pragma unroll
                for (int c = 0; c < 2; ++c) { Vb[c][kp] = pack8(vacc[c][2 * kp], vacc[c][2 * kp + 1]); const f32x4 s0 = vacc[c][2 * kp] * k0, s1 = vacc[c][2 * kp + 1] * k1; Vk[c][kp] = pack8(s0, s1); } }
            f32x4 oacc[2][4];
#pragma unroll
            for (int c = 0; c < 2; ++c)
#pragma unroll
                for (int t = 0; t < 4; ++t) oacc[c][t] = (f32x4){0.f, 0.f, 0.f, 0.f};
            SC_LD4(fb, S_QD, 16, 288); SC_SB(); SC_MMO(fa, 0); SC_SB();
            SC_LD4(fa, S_QD, 32, 288); SC_SB(); SC_MMO(fb, 1); SC_SB();
            SC_LD4(fb, S_QD, 48, 288); SC_SB(); SC_MMO(fa, 2); SC_SB();
#define SC_LDQK(dst, t0_) do { dst[0] = ld_frag(Bf + S_QK + (16 * (t0_) + r16) * 144 + g * 16); dst[1] = ld_frag(Bf + S_QK + (16 * (t0_) + r16) * 144 + 64 + g * 16); \
        dst[2] = ld_frag(Bf + S_QK + (16 * ((t0_) + 1) + r16) * 144 + g * 16); dst[3] = ld_frag(Bf + S_QK + (16 * ((t0_) + 1) + r16) * 144 + 64 + g * 16); } while (0)
#define SC_MMQK1(f0_, f1_, t_) do { oacc[0][t_] = MFMA16(f0_, Vb[0][0], oacc[0][t_]); oacc[1][t_] = MFMA16(f0_, Vb[1][0], oacc[1][t_]); oacc[0][t_] = MFMA16(f1_, Vb[0][1], oacc[0][t_]); oacc[1][t_] = MFMA16(f1_, Vb[1][1], oacc[1][t_]); } while (0)
#define SC_MMQK(src, t0_) do { SC_MMQK1(src[0], src[1], (t0_)); SC_MMQK1(src[2], src[3], (t0_) + 1); } while (0)
            SC_LDQK(fa, 0); SC_SB(); SC_MMO(fb, 3); SC_SB();
#pragma unroll
            for (int t = 0; t < 4; ++t) { const f32x4 eg4 = *(const LAS f32x4*)(Bf + S_SC + (16 * t + 4 * g) * 4); oacc[0][t] *= eg4; oacc[1][t] *= eg4; }
            SC_SB();
            SC_LDQK(fb, 2); SC_SB(); SC_MMQK(fa, 0); SC_SB();
#define SC_LDKT(dst, td0_) do { dst[0] = ld_frag(Bf + S_KT + (16 * (td0_) + r16) * 144 + g * 16); dst[1] = ld_frag(Bf + S_KT + (16 * (td0_) + r16) * 144 + 64 + g * 16); \
        dst[2] = ld_frag(Bf + S_KT + (16 * ((td0_) + 1) + r16) * 144 + g * 16); dst[3] = ld_frag(Bf + S_KT + (16 * ((td0_) + 1) + r16) * 144 + 64 + g * 16); } while (0)
#define SC_MMKT1(f0_, f1_, td_) do { f32x4 a0_ = S[0][td_] * cd, a1_ = S[1][td_] * cd; a0_ = MFMA16(f0_, Vk[0][0], a0_); a1_ = MFMA16(f0_, Vk[1][0], a1_); a0_ = MFMA16(f1_, Vk[0][1], a0_); a1_ = MFMA16(f1_, Vk[1][1], a1_); S[0][td_] = a0_; S[1][td_] = a1_; } while (0)
#define SC_MMKT(src, td0_) do { SC_MMKT1(src[0], src[1], (td0_)); SC_MMKT1(src[2], src[3], (td0_) + 1); } while (0)
            SC_LDKT(fa, 0); SC_SB(); SC_MMQK(fb, 2); SC_SB();
            LBAR();
#pragma unroll
            for (int c = 0; c < 2; ++c)
#pragma unroll
                for (int t = 0; t < 4; ++t) { const unsigned p01 = cvtpk(oacc[c][t][0], oacc[c][t][1]), p23 = cvtpk(oacc[c][t][2], oacc[c][t][3]); LAS unsigned char* op = L + S_OST + (16 * t + 4 * g) * S_OLD + (e0 + 16 * c) * 2;
                    *(LAS bf16*)(op) = (bf16)(p01 & 0xffffu); *(LAS bf16*)(op + S_OLD) = (bf16)(p01 >> 16); *(LAS bf16*)(op + 2 * S_OLD) = (bf16)(p23 & 0xffffu); *(LAS bf16*)(op + 3 * S_OLD) = (bf16)(p23 >> 16); }
            SC_SB();
            SC_LDKT(fb, 2); SC_SB(); SC_MMKT(fa, 0); SC_SB();
            SC_LDKT(fa, 4); SC_SB(); SC_MMKT(fb, 2); SC_SB();
            SC_LDKT(fb, 6); SC_SB(); SC_MMKT(fa, 4); SC_SB();
            SC_MMKT(fb, 6);
#undef SC_SB
#undef SC_LD4
#undef SC_MMV
#undef SC_MM4
#undef SC_MMO
#undef SC_LDQK
#undef SC_MMQK
#undef SC_MMQK1
#undef SC_MMKT1
#undef SC_LDKT
#undef SC_MMKT
            LBAR(); XBAR();
        }
    }
    { const int np = dir ? 0 : 31;
#pragma unroll
      for (int i = 0; i < 2; ++i) { const int q = tid + 512 * i, row = q >> 4, cc = q & 15; const v4u v = *(const LAS v4u*)(L + S_OST + row * S_OLD + cc * 16);
          *(v4u*)((dir ? OB_ : OF_) + ((size_t)b * SEQ + (size_t)np * 64 + row) * 1024 + h * 128 + cc * 8) = v; } }
    __syncthreads();
#undef SC_LOAD
#undef SC_WRITE
}

DI void combine_row(Frame& F, size_t m, bf16* MO) {
    const int lane = F.lane; const size_t off = m * 1024 + 16 * lane;
    const v4u f0 = *(const v4u*)(F.OF + off), f1 = *(const v4u*)(F.OF + off + 8), b0 = *(const v4u*)(F.OB + off), b1 = *(const v4u*)(F.OB + off + 8);
    const bf16* zp = F.MIX + m * 2048 + 16 * lane; const v4u z0 = *(const v4u*)zp, z1 = *(const v4u*)(zp + 8); bf16* mp = MO + m * 2048 + 16 * lane;
    float o[16];
    o[0] = bflo(f0.x) + bflo(b0.x); o[1] = bfhi(f0.x) + bfhi(b0.x); o[2] = bflo(f0.y) + bflo(b0.y); o[3] = bfhi(f0.y) + bfhi(b0.y);
    o[4] = bflo(f0.z) + bflo(b0.z); o[5] = bfhi(f0.z) + bfhi(b0.z); o[6] = bflo(f0.w) + bflo(b0.w); o[7] = bfhi(f0.w) + bfhi(b0.w);
    o[8] = bflo(f1.x) + bflo(b1.x); o[9] = bfhi(f1.x) + bfhi(b1.x); o[10] = bflo(f1.y) + bflo(b1.y); o[11] = bfhi(f1.y) + bfhi(b1.y);
    o[12] = bflo(f1.z) + bflo(b1.z); o[13] = bfhi(f1.z) + bfhi(b1.z); o[14] = bflo(f1.w) + bflo(b1.w); o[15] = bfhi(f1.w) + bfhi(b1.w);
    float ss = 0.f;
#pragma unroll
    for (int e = 0; e < 16; ++e) ss += o[e] * o[e];
    ss += __shfl_xor(ss, 1); ss += __shfl_xor(ss, 2); ss += __shfl_xor(ss, 4);
    const float rstd = 1.0f / sqrtf(ss * (1.0f / 128.0f) + EPS);
    float z[16];
    z[0] = bflo(z0.x); z[1] = bfhi(z0.x); z[2] = bflo(z0.y); z[3] = bfhi(z0.y); z[4] = bflo(z0.z); z[5] = bfhi(z0.z); z[6] = bflo(z0.w); z[7] = bfhi(z0.w);
    z[8] = bflo(z1.x); z[9] = bfhi(z1.x); z[10] = bflo(z1.y); z[11] = bfhi(z1.y); z[12] = bflo(z1.z); z[13] = bfhi(z1.z); z[14] = bflo(z1.w); z[15] = bfhi(z1.w);
    const int c0 = (16 * lane) & 127; float y[16];
#pragma unroll
    for (int e = 0; e < 16; ++e) y[e] = o[e] * rstd * F.o_norm_a[c0 + e] * z[e];
    v4u w0, w1; w0.x = cvtpk(y[0], y[1]); w0.y = cvtpk(y[2], y[3]); w0.z = cvtpk(y[4], y[5]); w0.w = cvtpk(y[6], y[7]);
    w1.x = cvtpk(y[8], y[9]); w1.y = cvtpk(y[10], y[11]); w1.z = cvtpk(y[12], y[13]); w1.w = cvtpk(y[14], y[15]);
    *(v4u*)mp = w0; *(v4u*)(mp + 8) = w1;
}

struct Args { const float* in[18]; float* out; unsigned char* ws; int ph_lo, ph_hi, li, pad; };
__global__ void __launch_bounds__(NWAVES * 64, 2) hybrid_fwd(Args args) {
    extern __shared__ __attribute__((aligned(16))) unsigned char lds[];
    Frame F;
    F.lds = (LAS unsigned char*)lds;
    F.MISC = (volatile LAS unsigned*)(F.lds + MISC_OFF);
    F.tid = threadIdx.x; F.lane = F.tid & 63; F.wave = __builtin_amdgcn_readfirstlane(F.tid >> 6);
    F.G = gridDim.x; { const int bx = blockIdx.x; F.vcu = (F.G % 8 == 0) ? (bx % 8) * (F.G / 8) + bx / 8 : bx; }
    unsigned char* ws = args.ws;
    F.ctl = (gu32*)(ws + WS_CTL); F.wsb = ws; F.dbo = (unsigned char*)args.out;
    F.x = args.in[0]; F.mem = args.in[1]; F.norm_w = args.in[2]; F.w_in = args.in[3]; F.conv_w = args.in[4]; F.a_log_f = args.in[5]; F.a_log_b = args.in[6];
    F.dt_f = args.in[7]; F.dt_b = args.in[8]; F.o_norm_a = args.in[9]; F.q_norm_b = args.in[10]; F.k_norm_b = args.in[11]; F.sink_b = args.in[12];
    F.mem_norm_w = args.in[13]; F.w_mem_kv = args.in[14]; F.q_norm_c = args.in[15]; F.k_norm_c = args.in[16]; F.w_out = args.in[17]; F.out = args.out;
    F.WinT = (bf16*)(ws + WS_WIN); F.WmemT = (bf16*)(ws + WS_WMEM); F.WoutT = (bf16*)(ws + WS_WOUT); F.XN = (bf16*)(ws + WS_XN); F.MEMN = (bf16*)(ws + WS_MEMN);
    F.PA = (bf16*)(ws + WS_PA); F.PB = (bf16*)(ws + WS_PB); F.PC = (bf16*)(ws + WS_PC); F.MIX = (bf16*)(ws + WS_MIX); F.KVM = (bf16*)(ws + WS_KVM);
    F.UT = (bf16*)(ws + WS_UT); F.WNEG = (bf16*)(ws + WS_WNEG); F.QDEC = (bf16*)(ws + WS_QDEC); F.KDECT = (bf16*)(ws + WS_KDECT); F.QKM = (bf16*)(ws + WS_QKM);
    F.OF = (bf16*)(ws + WS_OF); F.OB = (bf16*)(ws + WS_OB);
    F.GATES = (float*)(ws + WS_GATES); F.ROPE = (float*)(ws + WS_ROPE); F.CD = (float*)(ws + WS_CD);
    for (int u = F.tid; u < (LDS_BYTES - LDSCTL_OFF) / 4; u += NWAVES * 64) ((LAS unsigned*)(F.lds + LDSCTL_OFF))[u] = 0u;
    __syncthreads();
    XcdBarrier bar; bar.bar = (unsigned*)(F.ctl + CW_BAR); bar.x = 0; bar.st = nullptr;
    if (N_LAUNCHES != PER_PHASE) bar = xcd_barrier_post((unsigned*)(F.ctl + CW_BAR), F.MISC + 8);
#define GRID_BAR() do { if (N_LAUNCHES == PER_PHASE) { if (F.tid == 0) __hip_atomic_store(F.ctl + CW_TMO, 0xBADBA0u, RLX_AGENT); } else { xcd_barrier(bar); } } while (0)
    const int lo = args.ph_lo, hi = args.ph_hi;
#define IN(k) (lo <= (k) && (k) < hi)
#define BOTH(k) (IN(k) && IN((k) + 1))

#ifndef REP0
#define REP0 1
#endif
#ifndef REP1
#define REP1 1
#endif
#ifndef REP2A
#define REP2A 1
#endif
#ifndef REP2B
#define REP2B 1
#endif
#ifndef REP2C
#define REP2C 1
#endif
#ifndef REP3
#define REP3 1
#endif
#ifndef REP4
#define REP4 1
#endif
#ifndef REP5
#define REP5 1
#endif
#ifndef REPBAR
#define REPBAR 1
#endif
#ifndef DUMMY
#define DUMMY 0
#endif
    if (DUMMY > 0) {
        f32x4 da[4]; bf16x8 dx = (bf16x8){(short)F.lane, 1, 2, 3, 4, 5, 6, 7};
        for (int q = 0; q < 4; ++q) da[q] = (f32x4){0.f, 0.f, 0.f, 0.f};
        for (int it = 0; it < DUMMY; ++it) {
#pragma unroll
            for (int r = 0; r < 16; ++r) { da[0] = MFMA16(dx, dx, da[0]); da[1] = MFMA16(dx, dx, da[1]); da[2] = MFMA16(dx, dx, da[2]); da[3] = MFMA16(dx, dx, da[3]); } }
        asm volatile("" :: "v"(da[0]), "v"(da[1]), "v"(da[2]), "v"(da[3]));
    }
    bf16* const DRY = (bf16*)F.out;
#ifndef DEFER_WOUT
#define DEFER_WOUT 1
#endif
    const bool defer_wout = DEFER_WOUT && lo == 0 && hi >= 6 && N_LAUNCHES != PER_PHASE && F.G == 256 && REP0 == 1 && REP1 == 1;
    if (IN(0)) { for (int rep = 0; rep < REP0; ++rep) p0_prologue(F, defer_wout); if (BOTH(0)) for (int rep = 0; rep < REPBAR; ++rep) GRID_BAR(); }

    if (IN(1)) {
        pg8::Gemm g{F.XN, F.WinT, M + NBATCH * MEMLEN, 6656 + 1024, DMODEL}; pg8::InOrder S; S.init(F.G, (int)blockIdx.x, REP1, (unsigned*)F.ctl, F.MISC + 8);
        pg8::EpiIn E{F.PA, F.PB, F.PC, F.MIX, F.KVM, F.GATES};
        pg8::gemm_phase<pg8::EpiIn, pg8::InOrder, true, true>(F.lds + RING_OFF, g, S, E);
        if (defer_wout && blockIdx.x >= 160) p0_wout_items(F, ((int)blockIdx.x - 160) * NWAVES + F.wave, 96 * NWAVES);
        if (S.late() && F.tid == 0) S.announce();
        if (BOTH(1) && N_LAUNCHES == PER_PHASE) GRID_BAR();
    }

    if (IN(2)) {
        if (IN(1) && N_LAUNCHES != PER_PHASE && F.G == 256 && REP1 == 1) { const int bx = (int)blockIdx.x; F.ap_stride = 1;
            if (bx >= 160) { F.ap_it0 = (bx - 160) * 10; F.ap_nit = 10; } else if (bx < 128) { F.ap_it0 = 960 + bx * 7; F.ap_nit = 7; } else { F.ap_it0 = 1856 + (bx - 128) * 6; F.ap_nit = 6; } }
        else { F.ap_it0 = F.vcu; F.ap_stride = F.G; F.ap_nit = (F.vcu < 2048) ? (2048 - F.vcu + F.G - 1) / F.G : 0; }
        if (IN(1) && N_LAUNCHES != PER_PHASE) {
            if (F.tid == 0) { unsigned* ctl_ = (unsigned*)F.ctl; const unsigned nx = F.MISC[9];
                XB_SPIN(xb_ld(&ctl_[pg8::InOrder::ADONE_G]) < nx, ctl_ + CW_BAR);
                __builtin_amdgcn_fence(__ATOMIC_ACQUIRE, "agent"); asm volatile("s_waitcnt vmcnt(0)" ::: "memory"); }
            __syncthreads();
        }
        for (int rep = 0; rep < REP2A; ++rep) a_prep_phase(F);
        if (BOTH(2)) GRID_BAR();
    }

    if (IN(3)) {
        for (int rep = 0; rep < REP3; ++rep) if ((F.vcu & 1) == 0) for (int it = F.vcu >> 1; it < 128; it += (F.G + 1) >> 1) scan_unit(F.lds, F.tid, F.wsb, F.dbo, F.CD, F.OF, F.OB, F.ctl + CW_PROG + it, it >> 1, it & 1);
        for (;;) {
            if (F.tid == 0) F.MISC[16] = __hip_atomic_fetch_add(F.ctl + CW_WQ, 1u, RLX_AGENT);
            __syncthreads();
            const unsigned id = F.MISC[16];
            __syncthreads();
            if (id >= 512u * REP2B) break;
            const int it = (int)(id & 255u);
            if ((id & 511u) < 256u) b_attn_unit(F, it >> 5, (it >> 1) & 15, it & 1, id < 512u ? F.MIX : DRY);
            else c_attn_unit(F, it >> 5, (it >> 3) & 3, it & 7, id < 512u ? F.MIX : DRY);
        }
#ifdef PARTNER_PREFETCH
        if ((F.vcu & 1) == 1 && (F.vcu >> 1) < 128 && F.wave == 0) {
            const int it = F.vcu >> 1, dir = it & 1, item0 = ((it >> 1) * 2 + dir) * 32; gu32* prog = F.ctl + CW_PROG + it; unsigned acc_ = 0u;
            int k = 0; const unsigned long long t0 = rt();
            while (k < 32) {
                const unsigned done = (unsigned)__builtin_amdgcn_readfirstlane((int)__hip_atomic_load(prog, RLX_AGENT));
                if ((int)done >= 32 || rt() - t0 > 30000ull) break;
                if (k < (int)done + 4) k = (int)done + 4;
                if (k > (int)done + 5 || k >= 32) { if (k >= 32 && (int)done >= 27) break; __builtin_amdgcn_s_sleep(8); continue; }
                const unsigned char* blk = (const unsigned char*)shared_blk(F.wsb, item0 + (dir ? 31 - k : k));
#pragma unroll
                for (int q = 0; q < 4; ++q) { const int ln = F.lane + 64 * q; acc_ ^= *(const volatile unsigned*)(blk + (size_t)ln * 128); }
                ++k;
            }
            if (acc_ == 0x2468ace1u) F.ctl[202] = acc_;
        }
#endif
        if (BOTH(3)) GRID_BAR();
    }

    if (IN(4)) {
        const int gw = F.vcu * NWAVES + F.wave, NGW = F.G * NWAVES;
        for (int rep = 0; rep < REP4; ++rep) for (int m = gw; m < M; m += NGW) combine_row(F, (size_t)m, rep == REP4 - 1 ? F.MIX : DRY);
        if (BOTH(4)) GRID_BAR();
    }

    if (IN(5)) {
        pg8::Gemm g{F.MIX, F.WoutT, M, DMODEL, DMODEL}; pg8::RepOrder S; S.init(M, DMODEL, F.G, (int)blockIdx.x, REP5);
        pg8::EpiOut E{F.x, F.out};
        pg8::gemm_phase<pg8::EpiOut, pg8::RepOrder, false, true>(F.lds + RING_OFF, g, S, E);
    }
#undef IN
#undef BOTH
}

extern "C" void kernel_launch(void* const* d_in, const int* in_sizes, int n_in, void* d_out, int out_size, void* d_ws, size_t ws_size, hipStream_t stream) {
    static int grid = 0;
    if (grid == 0) {
        if (n_in != 18 || in_sizes[0] != M * DMODEL || out_size != M * DMODEL || ws_size < WS_END) { fprintf(stderr, "kernel_launch: unexpected problem shape (n_in %d, in0 %d, out %d, ws %zu); nothing launched\n", n_in, n_in > 0 ? in_sizes[0] : -1, out_size, ws_size); grid = -1; return; }
        int dev = 0, cus = 0, per_cu = 0;
        if (hipGetDevice(&dev) != hipSuccess || hipDeviceGetAttribute(&cus, hipDeviceAttributeMultiprocessorCount, dev) != hipSuccess) { fprintf(stderr, "kernel_launch: device query failed\n"); grid = -1; return; }
        if (hipFuncSetAttribute((const void*)hybrid_fwd, hipFuncAttributeMaxDynamicSharedMemorySize, LDS_BYTES) != hipSuccess) { fprintf(stderr, "kernel_launch: hipFuncSetAttribute failed\n"); grid = -1; return; }
        if (hipOccupancyMaxActiveBlocksPerMultiprocessor(&per_cu, (const void*)hybrid_fwd, NWAVES * 64, LDS_BYTES) != hipSuccess || per_cu < 1)
            fprintf(stderr, "kernel_launch: note: occupancy query reports %d workgroups per CU\n", per_cu);
        (void)hipGetLastError();
        grid = cus;
    }
    if (grid < 0) return;
    if (hipMemsetAsync((char*)d_ws + WS_CTL, 0, CTL_ZERO_BYTES, stream) != hipSuccess) { fprintf(stderr, "kernel_launch: hipMemsetAsync failed\n"); return; }
    Args a{};
    for (int i = 0; i < 18; ++i) a.in[i] = (const float*)d_in[i];
    a.out = (float*)d_out; a.ws = (unsigned char*)d_ws;
    for (int li = 0; li < N_LAUNCHES; ++li) {
        a.ph_lo = (N_LAUNCHES == PER_PHASE) ? li : 0; a.ph_hi = (N_LAUNCHES == PER_PHASE) ? li + 1 : PER_PHASE; a.li = li;
        hipLaunchKernelGGL(hybrid_fwd, dim3(grid), dim3(NWAVES * 64), LDS_BYTES, stream, a);
        const hipError_t le = hipPeekAtLastError();
        if (le != hipSuccess) { fprintf(stderr, "kernel_launch: launch %d failed: %s\n", li, hipGetErrorName(le)); break; }
    }
}
```

```cpp
#include <hip/hip_runtime.h>
#include <cstdio>
#include <cstdint>
#define GAS __attribute__((address_space(1)))
#define LAS __attribute__((address_space(3)))
typedef unsigned short bf16;
typedef unsigned v4u __attribute__((ext_vector_type(4)));
typedef float f32x4 __attribute__((ext_vector_type(4)));
typedef short bf16x8 __attribute__((ext_vector_type(8)));
typedef GAS unsigned gu32;
typedef GAS unsigned long long gu64;
#define RLX_AGENT __ATOMIC_RELAXED, __HIP_MEMORY_SCOPE_AGENT
#define LDS_WAIT() asm volatile("s_waitcnt lgkmcnt(0)" ::: "memory")
#define VM_WAIT() asm volatile("s_waitcnt vmcnt(0)" ::: "memory")
__device__ __forceinline__ unsigned long long rt() { return __builtin_amdgcn_s_memrealtime(); }
__device__ __forceinline__ unsigned f2bf(float f) { unsigned u = __builtin_bit_cast(unsigned, f); return (u + 0x7fffu + ((u >> 16) & 1u)) >> 16; }
__device__ __forceinline__ unsigned pk2(float lo, float hi) { return f2bf(lo) | (f2bf(hi) << 16); }

#define XB_TMO      128
#define XB_XCNT(j)  (256  + 64 * (j))
#define XB_XSUB(j)  (1280 + 64 * (j))
#define XB_XGEN(j)  (2304 + 64 * (j))
#define XB_TOP      3328
#define XB_TOPGEN   3392
#define XCD_BAR_WORDS 3456
#define XB_SPIN_CAP (1u << 18)

__device__ __forceinline__ unsigned xb_ld(unsigned* p)              { return __hip_atomic_load(p, __ATOMIC_RELAXED, __HIP_MEMORY_SCOPE_AGENT); }
__device__ __forceinline__ unsigned xb_add(unsigned* p, unsigned v) { return __hip_atomic_fetch_add(p, v, __ATOMIC_RELAXED, __HIP_MEMORY_SCOPE_AGENT); }
__device__ __forceinline__ unsigned xb_xcc_id() { return (unsigned)__builtin_amdgcn_s_getreg((3 << 11) | 20) & 0xFu; }
#define XB_SPIN(cond, bar) do { unsigned _sp = 0; while (cond) { __builtin_amdgcn_s_sleep(1); \
    if ((++_sp & 255u) == 0u) { if (xb_ld(&(bar)[XB_TMO])) break; if (_sp > XB_SPIN_CAP) { atomicAdd(&(bar)[XB_TMO], 1u); break; } } } } while (0)

struct XcdBarrier {
    unsigned* bar; unsigned x;
    volatile LAS unsigned* st;
};

__device__ __forceinline__ XcdBarrier xcd_barrier_post(unsigned* bar, volatile LAS unsigned* st) {
    XcdBarrier b; b.bar = bar; b.x = xb_xcc_id(); b.st = st;
    if (threadIdx.x == 0) (void)xb_add(&bar[XB_XCNT(b.x)], 1u);
    return b;
}
__device__ __forceinline__ void xcd_barrier_complete(unsigned* bar, unsigned x, unsigned& nloc, unsigned& nx) {
    const unsigned G = gridDim.x * gridDim.y * gridDim.z;
    unsigned sum, cnt, mine, sp = 0u;
    for (;;) {
        sum = 0u; cnt = 0u; mine = 0u;
#pragma unroll
        for (unsigned j = 0; j < 16; ++j) { const unsigned c = xb_ld(&bar[XB_XCNT(j)]); sum += c; cnt += (c > 0u) ? 1u : 0u; mine = (j == x) ? c : mine; }
        if (sum == G) break;
        __builtin_amdgcn_s_sleep(1);
        if ((++sp & 255u) == 0u) { if (xb_ld(&bar[XB_TMO])) break; if (sp > XB_SPIN_CAP) { atomicAdd(&bar[XB_TMO], 1u); break; } }
    }
    nloc = mine > 0u ? mine : 1u; nx = cnt > 0u ? cnt : 1u;
}

__device__ __forceinline__ void xcd_barrier(const XcdBarrier& b) {
    asm volatile("s_waitcnt vmcnt(0)" ::: "memory");
    __syncthreads();
    if (threadIdx.x == 0) {
        unsigned* bar = b.bar;
        __builtin_amdgcn_s_waitcnt(0);
        unsigned nloc = b.st[0], nx = b.st[1];
        if (nloc == 0u) { xcd_barrier_complete(bar, b.x, nloc, nx); b.st[0] = nloc; b.st[1] = nx; }
        const unsigned old = xb_add(&bar[XB_XSUB(b.x)], 1u);
        const unsigned gen = old / nloc;
        if (old + 1u == (gen + 1u) * nloc) {
            __builtin_amdgcn_fence(__ATOMIC_RELEASE, "agent");
            asm volatile("s_waitcnt vmcnt(0)" ::: "memory");
            const unsigned og = xb_add(&bar[XB_TOP], 1u);
            const unsigned tg = og / nx;
            if (og + 1u == (tg + 1u) * nx) xb_add(&bar[XB_TOPGEN], 1u);
            else XB_SPIN(xb_ld(&bar[XB_TOPGEN]) == tg, bar);
            __builtin_amdgcn_fence(__ATOMIC_ACQUIRE, "agent");
            xb_add(&bar[XB_XGEN(b.x)], 1u);
            asm volatile("s_waitcnt vmcnt(0)" ::: "memory");
        } else {
            XB_SPIN(xb_ld(&bar[XB_XGEN(b.x)]) == gen, bar);
            __builtin_amdgcn_fence(__ATOMIC_ACQUIRE, "agent");
            asm volatile("s_waitcnt vmcnt(0)" ::: "memory");
        }
    }
    __syncthreads();
}
namespace pg8 {
#define PG8_LAS __attribute__((address_space(3)))
typedef unsigned short bf16_t;
typedef short bf16x8 __attribute__((ext_vector_type(8)));
typedef float f32x4 __attribute__((ext_vector_type(4)));
typedef unsigned u32x4 __attribute__((ext_vector_type(4)));
constexpr int BM = 256, BK = 64, HALF = 128, HTB = HALF * BK * 2  , STAGE_BYTES = 8 * HTB, NXCD = 8, WGM = 8;

__host__ __device__ __forceinline__ int lds_byte(int r, int c) { const int st = (r >> 4) * 2 + (c >> 5), rr = r & 15, cc = c & 31, ob = rr * 64 + cc * 2; return st * 1024 + (ob ^ (((ob >> 9) & 1) << 5)); }
__host__ __device__ __forceinline__ void stage_rc(int b, int& R, int& C) { const int st = b / 1024, sb = b % 1024, swz = sb ^ (((sb >> 9) & 1) << 5); R = (st >> 1) * 16 + swz / 64; C = (st & 1) * 32 + (swz % 64) / 2; }
__host__ __device__ __forceinline__ int perm32(int rho) { const int n = rho >> 4, i = rho & 15; return 8 * (i >> 2) + 4 * n + (i & 3); }

struct Unit { int pm, pn; };
struct Gemm { const bf16_t* A; const bf16_t* Bt; int M, N, K; };

struct StaticOrder {
    int nM, nN, nwg, G, c;
    __host__ __device__ void init(int M, int N, int G_, int c_) { nM = M / BM; nN = N / BM; nwg = nM * nN; G = G_; c = c_; }
    __host__ __device__ bool next(int i, Unit& u) const {
        const long L = (long)i * G + c; if (L >= nwg) return false;
        int wgid = (int)L; { const int q = nwg / NXCD, r = nwg % NXCD, xcd = wgid % NXCD, off = wgid / NXCD; wgid = (xcd < r ? xcd * (q + 1) : r * (q + 1) + (xcd - r) * q) + off; }
        const int nig = WGM * nN, gid = wgid / nig, fm = gid * WGM, gsz = (nM - fm) < WGM ? (nM - fm) : WGM;
        u.pm = fm + ((wgid % nig) % gsz); u.pn = (wgid % nig) / gsz; return true;
    }
    __device__ __forceinline__ void a_ready(const Unit&) const {}
    __device__ __forceinline__ void pre_epi(int) const {}
    __device__ __forceinline__ void done(const Unit&) const {}
};

typedef float f32x2 __attribute__((ext_vector_type(2)));
typedef __bf16 bf16x2_t __attribute__((ext_vector_type(2)));
__device__ __forceinline__ unsigned cvt_pk_bf16(float lo, float hi) { f32x2 v = {lo, hi}; bf16x2_t b = __builtin_convertvector(v, bf16x2_t); return __builtin_bit_cast(unsigned, b); }
__device__ __forceinline__ float silu_f(float v) { return v * __builtin_amdgcn_rcpf(1.0f + __expf(-v)); }

struct EpiIn {
    static constexpr bool PERM = true, AFTER_DRAIN = false;
    bf16_t *PA, *PB, *PC, *MIX, *KVM; float* GATES;
    __device__ __forceinline__ void init(f32x4 (&acc)[2][2][4][2], const Unit&, int, int, int, int) const {
#pragma unroll
        for (int a = 0; a < 2; ++a)
#pragma unroll
            for (int b = 0; b < 2; ++b)
#pragma unroll
                for (int m = 0; m < 4; ++m)
#pragma unroll
                    for (int n = 0; n < 2; ++n) acc[a][b][m][n] = (f32x4){0.f, 0.f, 0.f, 0.f};
    }
    __device__ __forceinline__ void operator()(const f32x4 (&acc)[2][2][4][2], const Unit& u, int wr, int wc, int fr, int fq) const {
        const int row0 = u.pm * BM + wr * 64 + fr, cl = wc * 32 + 8 * fq, pn = u.pn;
        if (u.pm < 64 && pn == 25) {
            if (wc == 0) {
#pragma unroll
                for (int ai = 0; ai < 2; ++ai)
#pragma unroll
                    for (int m = 0; m < 4; ++m) { float* g = GATES + (size_t)(row0 + ai * HALF + m * 16) * 32 + 8 * fq;
                        *(f32x4*)g = acc[ai][0][m][0]; *(f32x4*)(g + 4) = acc[ai][0][m][1]; }
            }
            return;
        }
        bf16_t* base; int ldc; bool act = false;
        if (u.pm >= 64) { base = KVM + (size_t)(row0 - 16384) * 1024 + (pn - 26) * 256; ldc = 1024; }
        else if (pn < 12) { base = PA + (size_t)row0 * 3072 + pn * 256; ldc = 3072; }
        else if (pn < 16) { base = MIX + (size_t)row0 * 2048 + (pn - 12) * 256; ldc = 2048; act = true; }
        else if (pn < 19) { base = PB + (size_t)row0 * 768 + (pn - 16) * 256; ldc = 768; }
        else if (pn < 21) { base = MIX + (size_t)row0 * 2048 + 1024 + (pn - 19) * 256; ldc = 2048; act = true; }
        else if (pn < 23) { base = PC + (size_t)row0 * 512 + (pn - 21) * 256; ldc = 512; }
        else { base = MIX + (size_t)row0 * 2048 + 1536 + (pn - 23) * 256; ldc = 2048; act = true; }
        base += cl;
#pragma unroll
        for (int ai = 0; ai < 2; ++ai)
#pragma unroll
            for (int m = 0; m < 4; ++m) { bf16_t* rowp = base + (size_t)(ai * HALF + m * 16) * ldc;
#pragma unroll
                for (int bj = 0; bj < 2; ++bj) { f32x4 v0 = acc[ai][bj][m][0], v1 = acc[ai][bj][m][1];
                    if (act) { v0 = (f32x4){silu_f(v0[0]), silu_f(v0[1]), silu_f(v0[2]), silu_f(v0[3])}; v1 = (f32x4){silu_f(v1[0]), silu_f(v1[1]), silu_f(v1[2]), silu_f(v1[3])}; }
                    u32x4 w; w.x = cvt_pk_bf16(v0[0], v0[1]); w.y = cvt_pk_bf16(v0[2], v0[3]); w.z = cvt_pk_bf16(v1[0], v1[1]); w.w = cvt_pk_bf16(v1[2], v1[3]);
#ifdef EPI_NT
                    if (EPI_NT == 1 ? act : (EPI_NT == 3 ? (pn >= 12) : true)) __builtin_nontemporal_store(w, (u32x4*)(rowp + bj * HALF)); else *(u32x4*)(rowp + bj * HALF) = w; } }
#else
                    *(u32x4*)(rowp + bj * HALF) = w; } }
#endif
    }
};
struct EpiOut {
    static constexpr bool PERM = false, AFTER_DRAIN = false;
    const float* X; float* O;
    __device__ __forceinline__ void init(f32x4 (&acc)[2][2][4][2], const Unit& u, int wr, int wc, int fr, int fq) const {
        const int row0 = u.pm * BM + wr * 64 + fr, col0 = u.pn * BM + wc * 32 + 4 * fq;
#pragma unroll
        for (int ai = 0; ai < 2; ++ai)
#pragma unroll
            for (int m = 0; m < 4; ++m) { const size_t off = (size_t)(row0 + ai * HALF + m * 16) * 2048 + col0;
#pragma unroll
                for (int bj = 0; bj < 2; ++bj)
#pragma unroll
                    for (int n = 0; n < 2; ++n) acc[ai][bj][m][n] = __builtin_nontemporal_load((const f32x4*)(X + off + bj * HALF + n * 16)); }
    }
    __device__ __forceinline__ void operator()(const f32x4 (&acc)[2][2][4][2], const Unit& u, int wr, int wc, int fr, int fq) const {
        const int row0 = u.pm * BM + wr * 64 + fr, col0 = u.pn * BM + wc * 32 + 4 * fq;
#pragma unroll
        for (int ai = 0; ai < 2; ++ai)
#pragma unroll
            for (int m = 0; m < 4; ++m) { const size_t off = (size_t)(row0 + ai * HALF + m * 16) * 2048 + col0;
#pragma unroll
                for (int bj = 0; bj < 2; ++bj)
#pragma unroll
#ifdef P5O_NT
                    for (int n = 0; n < 2; ++n) __builtin_nontemporal_store(acc[ai][bj][m][n], (f32x4*)(O + off + bj * HALF + n * 16)); }
#else
                    for (int n = 0; n < 2; ++n) *(f32x4*)(O + off + bj * HALF + n * 16) = acc[ai][bj][m][n]; }
#endif
    }
};
struct InOrder {
    StaticOrder base; int G, c, rep, sig_ui; unsigned* ctl; volatile PG8_LAS unsigned* st;
    static constexpr int NL = 64 * 13, ADONE_G = 128, ADONE_X = 5120;
    __device__ __forceinline__ void init(int G_, int c_, int rep_, unsigned* ctl_, volatile PG8_LAS unsigned* st_) { G = G_; c = c_; rep = rep_; ctl = ctl_; st = st_; base.init(16384, 13 * 256, G_, 0);
        sig_ui = c_ < NL ? (NL - c_ + G_ - 1) / G_ : 0; }
    __device__ __forceinline__ bool late() const { const int tot = 2 * NL + 32; const int nu = c < tot ? (tot - c + G - 1) / G : 0; return nu <= sig_ui; }
    __device__ __forceinline__ bool next(int i, Unit& u) const {
        long L = (long)i * G + c; const long tot = 2 * NL + 32;
        if (L >= tot * rep) return false;
        L %= tot;
        if (L < 2 * NL) { const bool second = L >= NL; if (second) L -= NL; StaticOrder b2 = base; b2.c = (int)(L % G); b2.next((int)(L / G), u);
            u.pn = second ? u.pn + 12 : (u.pn == 12 ? 25 : u.pn); return true; }
        const int j = (int)(L - 2 * NL);
        u.pm = 64 + (j >> 2); u.pn = 26 + (j & 3); return true;
    }
    __device__ __forceinline__ void announce() const {
        const unsigned x = xb_xcc_id(), nloc = st[0];
        const unsigned old = xb_add(&ctl[ADONE_X + 64 * x], 1u);
        if (old + 1u == nloc) { __builtin_amdgcn_fence(__ATOMIC_RELEASE, "agent"); asm volatile("s_waitcnt vmcnt(0)" ::: "memory"); xb_add(&ctl[ADONE_G], 1u); }
    }
    __device__ __forceinline__ void a_ready(const Unit&) const {}
    __device__ __forceinline__ void pre_epi(int ui) const { if (ui == sig_ui && threadIdx.x == 0) announce(); }
    __device__ __forceinline__ void done(const Unit&) const {}
};
struct RepOrder {
    StaticOrder base; int G, c, rep;
    __host__ __device__ void init(int M_, int N_, int G_, int c_, int rep_ = 1) { G = G_; c = c_; rep = rep_; base.init(M_, N_, G_, 0); }
    __host__ __device__ bool next(int i, Unit& u) const {
        long L = (long)i * G + c; if (L >= (long)base.nwg * rep) return false;
        L %= base.nwg; StaticOrder b2 = base; b2.c = (int)(L % G); return b2.next((int)(L / G), u);
    }
    __device__ __forceinline__ void a_ready(const Unit&) const {}
    __device__ __forceinline__ void pre_epi(int) const {}
    __device__ __forceinline__ void done(const Unit&) const {}
};

template <class Epi, class Sched, bool ALIGN_EPI = false, bool SP2 = false>
__device__ __forceinline__ void gemm_phase(PG8_LAS unsigned char* lds, const Gemm g, const Sched& S, const Epi& E) {
    const int tid = threadIdx.x, wid = __builtin_amdgcn_readfirstlane(tid >> 6), lane = tid & 63, wr = wid >> 2, wc = wid & 3, fr = lane & 15, fq = lane >> 4;
    const int K = g.K, nt = K / BK;
    unsigned voffA[2], voffB[2];
#pragma unroll
    for (int i = 0; i < 2; ++i) { int R, C; stage_rc(tid * 16 + i * 8192, R, C); const int Rb = Epi::PERM ? ((R & ~31) + perm32(R & 31)) : R;
        voffA[i] = (unsigned)(R * K + C) * 2u; voffB[i] = (unsigned)(Rb * K + C) * 2u; }
    const size_t kstep = (size_t)(BK * 2);
    const size_t hstep = (size_t)HALF * K * 2;
    const size_t tstep = 2 * hstep;
    const unsigned ldsw = (unsigned)wid * 1024u;
    const int aoff = lds_byte(wr * 64 + fr, fq * 8), boff = lds_byte(wc * 32 + fr, fq * 8);
#define PG8_SA(b, h) (((b) * 2 + (h)) * HTB)
#define PG8_SB(b, h) ((4 + (b) * 2 + (h)) * HTB)
#define PG8_STAGE(bufoff, gbase, voff) do { _Pragma("unroll") for (int _i = 0; _i < 2; ++_i) \
        __builtin_amdgcn_global_load_lds((const unsigned*)((const char*)(gbase) + (voff)[_i]), (PG8_LAS unsigned*)(lds + (bufoff) + ldsw + _i * 8192), 16, 0, 0); } while (0)
#define PG8_LDA(dst, b, h) do { _Pragma("unroll") for (int m = 0; m < 4; ++m) _Pragma("unroll") for (int k = 0; k < 2; ++k) dst[m][k] = *(const PG8_LAS bf16x8*)(lds + PG8_SA(b, h) + aoff + m * 2048 + k * 1024); } while (0)
#define PG8_LDB(dst, b, h) do { _Pragma("unroll") for (int n = 0; n < 2; ++n) _Pragma("unroll") for (int k = 0; k < 2; ++k) dst[n][k] = *(const PG8_LAS bf16x8*)(lds + PG8_SB(b, h) + boff + n * 2048 + k * 1024); } while (0)
#define PG8_MMA(ai, bj, At, Bt) do { __builtin_amdgcn_s_setprio(1); _Pragma("unroll") for (int m = 0; m < 4; ++m) _Pragma("unroll") for (int n = 0; n < 2; ++n) _Pragma("unroll") for (int k = 0; k < 2; ++k) \
        acc[ai][bj][m][n] = __builtin_amdgcn_mfma_f32_16x16x32_bf16(Bt[n][k], At[m][k], acc[ai][bj][m][n], 0, 0, 0); __builtin_amdgcn_s_setprio(0); } while (0)
#define PG8_WAIT_V(n) asm volatile("s_waitcnt vmcnt(" #n ")" ::: "memory")
#define PG8_WAIT_L(n) asm volatile("s_waitcnt lgkmcnt(" #n ")" ::: "memory")
#define PG8_BAR __builtin_amdgcn_s_barrier()
#define PG8_SCHED __builtin_amdgcn_sched_barrier(0)
    Unit cur, nxt; int ui = 0;
    if (!S.next(0, cur)) return;
    f32x4 acc[2][2][4][2];
    E.init(acc, cur, wr, wc, fr, fq);
    bf16x8 At[4][2], B0[2][2], B1[2][2];
    const char* cA = (const char*)g.A + (size_t)cur.pm * tstep; const char* cB = (const char*)g.Bt + (size_t)cur.pn * tstep;
    S.a_ready(cur);
    if constexpr (SP2) {
        PG8_STAGE(PG8_SB(0, 0), cB, voffB); PG8_STAGE(PG8_SB(0, 1), cB + hstep, voffB); PG8_STAGE(PG8_SA(0, 0), cA, voffA); PG8_STAGE(PG8_SA(0, 1), cA + hstep, voffA);
        if (wr == 1) PG8_BAR;
        PG8_WAIT_V(2); PG8_BAR;
        PG8_STAGE(PG8_SB(1, 0), cB + kstep, voffB); PG8_STAGE(PG8_SA(1, 0), cA + kstep, voffA); PG8_STAGE(PG8_SB(1, 1), cB + hstep + kstep, voffB);
        PG8_WAIT_V(6); PG8_BAR;
    } else {
        PG8_STAGE(PG8_SB(0, 0), cB, voffB); PG8_STAGE(PG8_SA(0, 0), cA, voffA); PG8_STAGE(PG8_SB(0, 1), cB + hstep, voffB); PG8_STAGE(PG8_SA(0, 1), cA + hstep, voffA);
        if (wr == 1) PG8_BAR;
        PG8_WAIT_V(4); PG8_BAR;
        PG8_STAGE(PG8_SB(1, 0), cB + kstep, voffB); PG8_STAGE(PG8_SA(1, 0), cA + kstep, voffA); PG8_STAGE(PG8_SB(1, 1), cB + hstep + kstep, voffB);
        PG8_WAIT_V(6); PG8_BAR;
    }
    for (;;) {
        const bool has_next = S.next(ui + 1, nxt);
        const char* nA = has_next ? (const char*)g.A + (size_t)nxt.pm * tstep : cA; const char* nB = has_next ? (const char*)g.Bt + (size_t)nxt.pn * tstep : cB;
        for (int t = 0; t < nt; t += 2) {
            const bool last = (t == nt - 2);
            const char* a1 = cA + (size_t)(t + 1) * kstep;
            const char* a2 = last ? nA : cA + (size_t)(t + 2) * kstep; const char* b2 = last ? nB : cB + (size_t)(t + 2) * kstep;
            const char* a3 = a2 + kstep; const char* b3 = b2 + kstep;
            if (last && has_next) S.a_ready(nxt);
            if constexpr (SP2) {
            PG8_LDB(B0, 0, 0); PG8_LDB(B1, 0, 1); PG8_SCHED; PG8_LDA(At, 0, 0); PG8_STAGE(PG8_SA(1, 1), a1 + hstep, voffA);
            PG8_WAIT_V(8); PG8_WAIT_L(0); PG8_BAR; PG8_MMA(0, 0, At, B0); PG8_MMA(0, 1, At, B1); PG8_BAR; PG8_SCHED;
            PG8_LDA(At, 0, 1); PG8_STAGE(PG8_SB(0, 0), b2, voffB); PG8_STAGE(PG8_SB(0, 1), b2 + hstep, voffB); PG8_STAGE(PG8_SA(0, 0), a2, voffA);
            PG8_WAIT_V(8); PG8_WAIT_L(0); PG8_BAR; PG8_MMA(1, 0, At, B0); PG8_MMA(1, 1, At, B1); PG8_BAR; PG8_SCHED;
            PG8_LDB(B0, 1, 0); PG8_LDB(B1, 1, 1); PG8_SCHED; PG8_LDA(At, 1, 0); PG8_STAGE(PG8_SA(0, 1), a2 + hstep, voffA);
            PG8_WAIT_V(8); PG8_WAIT_L(0); PG8_BAR; PG8_MMA(0, 0, At, B0); PG8_MMA(0, 1, At, B1); PG8_BAR; PG8_SCHED;
            PG8_LDA(At, 1, 1); PG8_STAGE(PG8_SB(1, 0), b3, voffB); PG8_STAGE(PG8_SB(1, 1), b3 + hstep, voffB); PG8_STAGE(PG8_SA(1, 0), a3, voffA);
            PG8_WAIT_V(8); PG8_WAIT_L(0); PG8_BAR; PG8_MMA(1, 0, At, B0); PG8_MMA(1, 1, At, B1); PG8_BAR; PG8_SCHED;
            } else {
            PG8_LDB(B0, 0, 0); PG8_SCHED; PG8_LDA(At, 0, 0); PG8_STAGE(PG8_SA(1, 1), a1 + hstep, voffA);
            PG8_WAIT_L(8); PG8_BAR; PG8_WAIT_L(0); PG8_MMA(0, 0, At, B0); PG8_BAR; PG8_SCHED;
            PG8_LDB(B1, 0, 1); PG8_STAGE(PG8_SB(0, 0), b2, voffB);
            PG8_BAR; PG8_WAIT_L(0); PG8_MMA(0, 1, At, B1); PG8_BAR;
            PG8_LDA(At, 0, 1); PG8_STAGE(PG8_SA(0, 0), a2, voffA);
            PG8_BAR; PG8_WAIT_L(0); PG8_MMA(1, 0, At, B0); PG8_BAR; PG8_SCHED;
            PG8_STAGE(PG8_SB(0, 1), b2 + hstep, voffB);
            PG8_WAIT_V(6); PG8_BAR; PG8_MMA(1, 1, At, B1); PG8_BAR;
            PG8_LDB(B0, 1, 0); PG8_SCHED; PG8_LDA(At, 1, 0); PG8_STAGE(PG8_SA(0, 1), a2 + hstep, voffA);
            PG8_WAIT_L(8); PG8_BAR; PG8_WAIT_L(0); PG8_MMA(0, 0, At, B0); PG8_BAR; PG8_SCHED;
            PG8_LDB(B1, 1, 1); PG8_STAGE(PG8_SB(1, 0), b3, voffB);
            PG8_BAR; PG8_WAIT_L(0); PG8_MMA(0, 1, At, B1); PG8_BAR;
            PG8_LDA(At, 1, 1); PG8_STAGE(PG8_SA(1, 0), a3, voffA);
            PG8_BAR; PG8_WAIT_L(0); PG8_MMA(1, 0, At, B0); PG8_BAR; PG8_SCHED;
            PG8_STAGE(PG8_SB(1, 1), b3 + hstep, voffB);
            PG8_WAIT_V(6); PG8_BAR; PG8_MMA(1, 1, At, B1); PG8_BAR;
            }
        }
        S.pre_epi(ui);
        if constexpr (ALIGN_EPI) { if (wr == 0) PG8_BAR; }
        if constexpr (!Epi::AFTER_DRAIN) { E(acc, cur, wr, wc, fr, fq);
#ifdef REPEPI
            for (int re_ = 1; re_ < REPEPI; ++re_) { asm volatile("" ::: "memory"); E(acc, cur, wr, wc, fr, fq); }
#endif
            S.done(cur); }
        if (!has_next) break;
        cur = nxt; cA = nA; cB = nB; ++ui;
        E.init(acc, cur, wr, wc, fr, fq);
        if constexpr (ALIGN_EPI) { if (wr == 1) PG8_BAR; }
    }
    PG8_WAIT_V(0);
    if constexpr (!ALIGN_EPI) { if (wr == 0) PG8_BAR; }
    PG8_BAR;
    if constexpr (Epi::AFTER_DRAIN) { E.fused(acc, cur, wr, wc, fr, fq, lds, wid, lane); S.done(cur); }
#undef PG8_SA
#undef PG8_SB
#undef PG8_STAGE
#undef PG8_LDA
#undef PG8_LDB
#undef PG8_MMA
#undef PG8_WAIT_V
#undef PG8_WAIT_L
#undef PG8_BAR
#undef PG8_SCHED
}
}
constexpr int NWAVES = 8;
#ifndef MK_N_LAUNCHES
#define MK_N_LAUNCHES 1
#endif
constexpr int N_LAUNCHES = MK_N_LAUNCHES;
constexpr int PER_PHASE = 6;

constexpr int NBATCH = 8, SEQ = 2048, DMODEL = 2048, M = NBATCH * SEQ;
constexpr int MEMLEN = 256;
constexpr int NIN = 6432;
constexpr float EPS = 1e-6f;
constexpr float LOG2E = 1.4426950408889634f;

constexpr size_t MiB = 1u << 20;
constexpr size_t WS_CTL = 0, CTL_ZERO_BYTES = 24576;
constexpr size_t WS_WOUT = 1 * MiB;
constexpr size_t WS_WIN = 9 * MiB, WS_WMEM = 35 * MiB;
constexpr size_t WS_XN = 39 * MiB, WS_MEMN = 103 * MiB;
constexpr size_t WS_PA = 111 * MiB;
constexpr size_t WS_PB = 207 * MiB;
constexpr size_t WS_PC = 231 * MiB;
constexpr size_t WS_MIX = 247 * MiB;
constexpr size_t WS_GATES = 311 * MiB;
constexpr size_t WS_KVM = 313 * MiB;
constexpr size_t WS_ROPE = 317 * MiB;
constexpr size_t WS_CD = 317 * MiB + 512 * 1024;
constexpr size_t WS_UT = 318 * MiB, WS_WNEG = 382 * MiB, WS_QDEC = 446 * MiB;
constexpr size_t WS_KDECT = 9 * MiB, WS_QKM = 73 * MiB;
constexpr size_t WS_SB = 318 * MiB, WS_DA = 382 * MiB, WS_DB2 = 0  ; constexpr int SB_BYTES = 32768, DB_SPLIT = 4002, DB_BYTES = 33536;
constexpr int SO_QD = 0, SO_KT = 8192;
constexpr int IO_WN = 0, IO_SC = 8192, IO_UT = 8576;
static_assert(WS_DA + (size_t)DB_SPLIT * DB_BYTES <= 510 * MiB && WS_DB2 + (size_t)(4096 - DB_SPLIT) * DB_BYTES <= 128 * MiB && WS_SB + (size_t)2048 * SB_BYTES <= WS_DA, "scan operand blocks");
constexpr size_t WS_OF = 111 * MiB, WS_OB = 143 * MiB;
constexpr size_t WS_END = 510 * MiB;
constexpr int CW_TMO = 0, CW_CODE = 1, CW_WQ = 64, CW_ADONE = 128, CW_PROG = 256, CW_BAR = 1024;

constexpr int RING_OFF = 0, RING_BYTES = 149504;
constexpr int LDSCTL_OFF = RING_BYTES, MISC_OFF = LDSCTL_OFF + 320;
constexpr int LDS_BYTES = 150528;
static_assert(MISC_OFF + 128 <= LDS_BYTES, "LDS map");

#define DI __device__ __forceinline__
typedef short s16x4 __attribute__((ext_vector_type(4)));
typedef unsigned u32x2 __attribute__((ext_vector_type(2)));
typedef float f32x2v __attribute__((ext_vector_type(2)));
#define MFMA16(a, b, c) __builtin_amdgcn_mfma_f32_16x16x32_bf16((a), (b), (c), 0, 0, 0)
DI unsigned cvtpk(float lo, float hi) { return pg8::cvt_pk_bf16(lo, hi); }
DI float bflo(unsigned v) { return __uint_as_float(v << 16); }
DI float bfhi(unsigned v) { return __uint_as_float(v & 0xffff0000u); }
DI float wave_sum(float v) {
#pragma unroll
    for (int o = 1; o < 64; o <<= 1) v += __shfl_xor(v, o);
    return v;
}
DI float silu_f(float v) { return pg8::silu_f(v); }
DI float softplus_f(float x) { return x > 20.f ? x : log1pf(expf(x)); }
DI float sigmoid_f(float x) { return 1.0f / (1.0f + expf(-x)); }
DI int perm32k(int k) { return (k & ~31) | (((k >> 2) & 3) << 3) | (((k >> 4) & 1) << 2) | (k & 3); }
typedef short v4i16_t __attribute__((ext_vector_type(4)));
DI s16x4 vtr(const LAS unsigned char* p) { return __builtin_bit_cast(s16x4, __builtin_amdgcn_ds_read_tr16_b64_v4i16((LAS v4i16_t*)p)); }
DI bf16x8 tr_frag(const LAS unsigned char* lo, int hi_off) { const s16x4 a = vtr(lo), b = vtr(lo + hi_off); return (bf16x8){a[0], a[1], a[2], a[3], b[0], b[1], b[2], b[3]}; }
DI bf16x8 ld_frag(const LAS unsigned char* p) { return *(const LAS bf16x8*)p; }
DI bf16x8 pack8(const f32x4& a, const f32x4& b) { v4u w; w.x = cvtpk(a[0], a[1]); w.y = cvtpk(a[2], a[3]); w.z = cvtpk(b[0], b[1]); w.w = cvtpk(b[2], b[3]); return __builtin_bit_cast(bf16x8, w); }

struct Frame {
    LAS unsigned char* lds;
    volatile LAS unsigned* MISC;
    gu32* ctl;
    int tid, lane, wave;
    int vcu, G;
    int ap_it0, ap_stride, ap_nit;
    const float *x, *mem, *norm_w, *w_in, *conv_w, *a_log_f, *a_log_b, *dt_f, *dt_b, *o_norm_a, *q_norm_b, *k_norm_b, *sink_b, *mem_norm_w, *w_mem_kv, *q_norm_c, *k_norm_c, *w_out;
    float* out;
    bf16 *WinT, *WmemT, *WoutT, *XN, *MEMN, *PA, *PB, *PC, *MIX, *KVM, *UT, *WNEG, *QDEC, *KDECT, *QKM, *OF, *OB;
    float *GATES, *ROPE, *CD;
    unsigned char* wsb; unsigned char* dbo;
};
DI bf16* item_blk(unsigned char* wsb, unsigned char* dbo, int item) { return (bf16*)(item < DB_SPLIT ? wsb + WS_DA + (size_t)item * DB_BYTES : dbo + WS_DB2 + (size_t)(item - DB_SPLIT) * DB_BYTES); }
DI bf16* shared_blk(unsigned char* wsb, int item) { return (bf16*)(wsb + WS_SB + (size_t)(((item >> 6) << 5) | (item & 31)) * SB_BYTES); }

DI void p0_transpose_item(const float* W, int K, int N, bf16* WT, int k0, int n0, int drow0, LAS float* scr, int lane) {
#ifdef TR_NARROW
#pragma unroll 8
    for (int i = 0; i < 32; ++i) { const int kk = 2 * i + (lane >> 5); scr[kk * 33 + (lane & 31)] = W[(size_t)(k0 + kk) * N + n0 + (lane & 31)]; }
#else
    { f32x4 t[8];
#pragma unroll
      for (int i = 0; i < 8; ++i) t[i] = *(const f32x4*)(W + (size_t)(k0 + 8 * i + (lane >> 3)) * N + n0 + 4 * (lane & 7));
#pragma unroll
      for (int i = 0; i < 8; ++i) { LAS float* d = scr + (8 * i + (lane >> 3)) * 33 + 4 * (lane & 7); d[0] = t[i][0]; d[1] = t[i][1]; d[2] = t[i][2]; d[3] = t[i][3]; } }
#endif
    LDS_WAIT(); asm volatile("" ::: "memory");
    const int c = lane & 7;
#pragma unroll
    for (int j = 0; j < 4; ++j) { const int n = (lane >> 3) + 8 * j; const LAS float* s = scr + (8 * c) * 33 + n;
        v4u o; o.x = pk2(s[0 * 33], s[1 * 33]); o.y = pk2(s[2 * 33], s[3 * 33]); o.z = pk2(s[4 * 33], s[5 * 33]); o.w = pk2(s[6 * 33], s[7 * 33]);
        *(GAS v4u*)(WT + (size_t)(drow0 + n) * K + k0 + 8 * c) = o; }
    LDS_WAIT(); asm volatile("" ::: "memory");
}
DI void rms_row_to_bf16(const float* xrow, const float* w, bf16* orow, int lane) {
    const GAS f32x4* xr = (const GAS f32x4*)xrow + lane; const GAS f32x4* wr = (const GAS f32x4*)w + lane;
    f32x4 v[8]; float s = 0.f;
#pragma unroll
    for (int j = 0; j < 8; ++j) v[j] = __builtin_nontemporal_load(xr + 64 * j);
#pragma unroll
    for (int j = 0; j < 8; ++j) s += (v[j].x * v[j].x + v[j].y * v[j].y) + (v[j].z * v[j].z + v[j].w * v[j].w);
    const float rstd = 1.0f / sqrtf(wave_sum(s) * (1.0f / 2048.0f) + EPS);
    GAS unsigned long long* o8 = (GAS unsigned long long*)orow + lane;
#pragma unroll
    for (int j = 0; j < 8; ++j) { const f32x4 wv = wr[64 * j]; const f32x4 y = v[j] * rstd * wv;
#ifdef XN_WT
        __hip_atomic_store((unsigned long long*)(o8 + 64 * j), (unsigned long long)cvtpk(y.x, y.y) | ((unsigned long long)cvtpk(y.z, y.w) << 32), __ATOMIC_RELAXED, __HIP_MEMORY_SCOPE_AGENT); }
#else
#ifdef XN_NTS
        __builtin_nontemporal_store((unsigned long long)cvtpk(y.x, y.y) | ((unsigned long long)cvtpk(y.z, y.w) << 32), o8 + 64 * j); }
#else
        o8[64 * j] = (unsigned long long)cvtpk(y.x, y.y) | ((unsigned long long)cvtpk(y.z, y.w) << 32); }
#endif
#endif
}
struct TrItem { const float* src; int N; bf16* dst; };
DI void tr_load(const TrItem& d, f32x4 (&t)[8], int lane) {
#pragma unroll
    for (int i = 0; i < 8; ++i) t[i] = __builtin_nontemporal_load((const f32x4*)(d.src + (size_t)(8 * i + (lane >> 3)) * d.N + 4 * (lane & 7)));
}
DI void tr_store(const TrItem& d, const f32x4 (&t)[8], LAS float* scr, int lane) {
#pragma unroll
    for (int i = 0; i < 8; ++i) { LAS float* q = scr + (8 * i + (lane >> 3)) * 33 + 4 * (lane & 7); q[0] = t[i][0]; q[1] = t[i][1]; q[2] = t[i][2]; q[3] = t[i][3]; }
    LDS_WAIT(); asm volatile("" ::: "memory");
    const int c = lane & 7;
#pragma unroll
    for (int j = 0; j < 4; ++j) { const int n = (lane >> 3) + 8 * j; const LAS float* s = scr + (8 * c) * 33 + n;
        v4u o; o.x = pk2(s[0 * 33], s[1 * 33]); o.y = pk2(s[2 * 33], s[3 * 33]); o.z = pk2(s[4 * 33], s[5 * 33]); o.w = pk2(s[6 * 33], s[7 * 33]);
        *(GAS v4u*)(d.dst + (size_t)n * 2048 + 8 * c) = o; }
    LDS_WAIT(); asm volatile("" ::: "memory");
}
DI void p0_wout_items(Frame& F, int first, int stride) {
    LAS float* scr = (LAS float*)(F.lds + RING_OFF + F.wave * 16384);
    for (int r = first; r < 32 * 64; r += stride) p0_transpose_item(F.w_out, 2048, 2048, F.WoutT, 64 * (r / 64), 32 * (r % 64), 32 * (r % 64), scr, F.lane);
}
DI void p0_prologue(Frame& F, const bool defer_wout, unsigned long long* tmark = nullptr) {
    LAS float* scr = (LAS float*)(F.lds + RING_OFF + F.wave * 16384);
    const int gw = F.vcu * NWAVES + F.wave, NGW = F.G * NWAVES;
    constexpr int I_IN = 32 * 201, I_MEM = 32 * 32, I_OUT = 32 * 64; const int NITEMS = I_IN + I_MEM + (defer_wout ? 0 : I_OUT);
    auto desc = [&](int it) -> TrItem { int r = it;
        if (r < I_IN) { const int kb = r / 201, sb = r % 201, n0 = 32 * sb; const int drow = n0 < 4096 ? n0 : (n0 < 4128 ? 6400 + (n0 - 4096) : n0 - 32);
            return TrItem{F.w_in + (size_t)(64 * kb) * NIN + n0, NIN, F.WinT + (size_t)drow * 2048 + 64 * kb}; }
        r -= I_IN;
        if (r < I_MEM) return TrItem{F.w_mem_kv + (size_t)(64 * (r / 32)) * 1024 + 32 * (r % 32), 1024, F.WmemT + (size_t)(32 * (r % 32)) * 2048 + 64 * (r / 32)};
        r -= I_MEM;
        return TrItem{F.w_out + (size_t)(64 * (r / 64)) * 2048 + 32 * (r % 64), 2048, F.WoutT + (size_t)(32 * (r % 64)) * 2048 + 64 * (r / 64)}; };
    { f32x4 ta[8], tb[8]; int it = gw;
      if (it < NITEMS) { TrItem da = desc(it); tr_load(da, ta, F.lane);
        for (;;) {
            const int i2 = it + NGW; TrItem db = da; if (i2 < NITEMS) { db = desc(i2); tr_load(db, tb, F.lane); }
            tr_store(da, ta, scr, F.lane);
            if (i2 >= NITEMS) break;
            const int i3 = i2 + NGW; if (i3 < NITEMS) { da = desc(i3); tr_load(da, ta, F.lane); }
            tr_store(db, tb, scr, F.lane);
            if (i3 >= NITEMS) break;
            it = i3; } } }
    if (tmark) *tmark = rt();
    { GAS v4u* z = (GAS v4u*)(F.WinT + (size_t)NIN * 2048); const int gt = F.vcu * 512 + F.tid, NT = F.G * 512;
      for (int i = gt; i < 224 * 256; i += NT) z[i] = (v4u){0u, 0u, 0u, 0u}; }
    for (int m = gw; m < M; m += NGW) rms_row_to_bf16(F.x + (size_t)m * DMODEL, F.norm_w, F.XN + (size_t)m * DMODEL, F.lane);
    for (int m = gw; m < NBATCH * MEMLEN; m += NGW) rms_row_to_bf16(F.mem + (size_t)m * DMODEL, F.mem_norm_w, F.MEMN + (size_t)m * DMODEL, F.lane);
    { const int gt = F.vcu * 512 + F.tid, NT = F.G * 512;
      for (int i = gt; i < SEQ * 32; i += NT) { const int pos = i >> 5, fi = i & 31; const float inv = powf(10000.0f, -(float)(2 * fi) / 64.0f); const float ang = (float)pos * inv;
          F.ROPE[2 * i] = cosf(ang); F.ROPE[2 * i + 1] = sinf(ang); } }
}

constexpr int AB_QH = 0, AB_KH = 17408, AB_VV = 34816, AB_BUF = 52224, AB_LD = 272;
constexpr int AD_F = 104448, AD_B = 122880, AD_T2 = 9216, AD_LDL = 72, AD_LDT = 144;
constexpr int AG_0 = 141312, AG_SZ = 2560, AG_RAW = 146432;
constexpr int ASCR_F = 0, ASCR_B = 5120;
static_assert(AG_RAW == AG_0 + 2 * AG_SZ && AG_RAW + 1024 <= RING_BYTES && AD_F == 2 * AB_BUF && AD_B == AD_F + 64 * 72 * 4 && AG_0 == AD_B + 64 * 72 * 4, "A-prep LDS map");
#define LBAR() asm volatile("s_waitcnt lgkmcnt(0)\n\ts_barrier" ::: "memory")

#define DPP_ADD(s, ctrl) (s) += __builtin_bit_cast(float, __builtin_amdgcn_update_dpp(0, __builtin_bit_cast(int, (s)), (ctrl), 0xf, 0xf, true))
DI float row16_sum(float s) { DPP_ADD(s, 0xB1); DPP_ADD(s, 0x4E); DPP_ADD(s, 0x141); DPP_ADD(s, 0x140); return s; }

DI void s3_solve(const bool BWD, LAS unsigned char* L, LAS unsigned char* scr, const LAS float* GV, int lane) {
    int lane_o = lane; asm volatile("" : "+v"(lane_o));
    const int hb = lane_o >> 5, cc = lane_o & 31, r16 = lane_o & 15, g = lane_o >> 4;
    LAS unsigned char* D = L + (BWD ? AD_B : AD_F);
    const LAS float* LS = (const LAS float*)D;
    const LAS float* Lb = LS + hb * (32 * AD_LDL + 32);
    LAS unsigned char* SA = scr + (BWD ? ASCR_B : ASCR_F); LAS unsigned char* SB = SA + 2560;
    LAS unsigned char* T1 = D; LAS unsigned char* T2 = D + AD_T2;
    const LAS float* S1 = GV + (BWD ? 192 : 128); const LAS float* S2 = GV + (BWD ? 576 : 512);
    bf16x8 la[2];
#pragma unroll
    for (int ti = 0; ti < 2; ++ti) { const LAS float* lp = LS + (32 + 16 * ti + r16) * AD_LDL + 8 * g; const f32x4 x0 = *(const LAS f32x4*)lp, x1 = *(const LAS f32x4*)(lp + 4); la[ti] = pack8(x0, x1); }
#ifndef RS3L
#define RS3L 1
#endif
    float t[32];
    for (int r3_ = 0; r3_ < RS3L; ++r3_) { asm volatile("" ::: "memory"); int cc_o = cc; asm volatile("" : "+v"(cc_o));
    t[0] = (cc_o == 0) ? 1.f : 0.f;
    f32x4 rwA[8], rwB[8];
    rwB[0] = *(const LAS f32x4*)(Lb + AD_LDL);
#pragma unroll
    for (int i = 1; i < 32; ++i) {
        if (i + 1 < 32) {
#pragma unroll
            for (int q = 0; q < 8; ++q) if (4 * q < i + 1) { if ((i + 1) & 1) rwB[q] = *(const LAS f32x4*)(Lb + (i + 1) * AD_LDL + 4 * q); else rwA[q] = *(const LAS f32x4*)(Lb + (i + 1) * AD_LDL + 4 * q); } }
        __builtin_amdgcn_sched_barrier(0);
        float sa = (cc_o == i) ? 1.f : 0.f, sb = 0.f;
#pragma unroll
        for (int q = 0; q < 8; ++q)
#pragma unroll
            for (int e = 0; e < 4; ++e) if (4 * q + e < i) { const float lv = (i & 1) ? rwB[q][e] : rwA[q][e];
                if (e & 1) asm("v_fma_f32 %0, -%1, %2, %0" : "+v"(sb) : "v"(lv), "v"(t[4 * q + e])); else asm("v_fma_f32 %0, -%1, %2, %0" : "+v"(sa) : "v"(lv), "v"(t[4 * q + e])); }
        t[i] = sa + sb;
        __builtin_amdgcn_sched_barrier(0);
    }
    }
#ifndef RS3T
#define RS3T 1
#endif
    for (int r4_ = 0; r4_ < RS3T; ++r4_) { asm volatile("" ::: "memory");
    {
        const int R = BWD ? 32 * hb + cc : 63 - 32 * hb - cc, colb = BWD ? 32 * hb : 32 * (1 - hb);
#pragma unroll
        for (int q = 0; q < 4; ++q) { const f32x4 a0 = *(const LAS f32x4*)(S1 + colb + 8 * q), a1 = *(const LAS f32x4*)(S1 + colb + 8 * q + 4), b0 = *(const LAS f32x4*)(S2 + colb + 8 * q), b1 = *(const LAS f32x4*)(S2 + colb + 8 * q + 4);
            f32x4 v0, v1;
#pragma unroll
            for (int e = 0; e < 4; ++e) { v0[e] = BWD ? t[8 * q + e] : t[31 - 8 * q - e]; v1[e] = BWD ? t[8 * q + 4 + e] : t[27 - 8 * q - e]; }
            *(LAS bf16x8*)(T1 + R * AD_LDT + (colb + 8 * q) * 2) = pack8(v0 * a0, v1 * a1); *(LAS bf16x8*)(T2 + R * AD_LDT + (colb + 8 * q) * 2) = pack8(v0 * b0, v1 * b1); }
    }
    __builtin_amdgcn_sched_barrier(0);
    if (hb == 0) {
#pragma unroll
        for (int q = 0; q < 4; ++q) *(LAS bf16x8*)(SA + cc * 80 + 16 * q) = pack8((f32x4){t[8 * q], t[8 * q + 1], t[8 * q + 2], t[8 * q + 3]}, (f32x4){t[8 * q + 4], t[8 * q + 5], t[8 * q + 6], t[8 * q + 7]});
    } else {
#pragma unroll
        for (int i = 0; i < 32; i += 2) { const unsigned pk = cvtpk(t[i], t[i + 1]); *(LAS bf16*)(SB + i * 80 + 2 * cc) = (bf16)(pk & 0xffffu); *(LAS bf16*)(SB + (i + 1) * 80 + 2 * cc) = (bf16)(pk >> 16); }
    }
    asm volatile("s_waitcnt lgkmcnt(0)" ::: "memory");
    __builtin_amdgcn_sched_barrier(0);
    bf16x8 tbf[2];
#pragma unroll
    for (int ti = 0; ti < 2; ++ti) tbf[ti] = ld_frag(SA + (16 * ti + r16) * 80 + 16 * g);
    f32x4 P[2][2];
#pragma unroll
    for (int ti = 0; ti < 2; ++ti)
#pragma unroll
        for (int tj = 0; tj < 2; ++tj) P[ti][tj] = MFMA16(la[ti], tbf[tj], ((f32x4){0.f, 0.f, 0.f, 0.f}));
    bf16x8 pbb[2];
#pragma unroll
    for (int tj = 0; tj < 2; ++tj) pbb[tj] = pack8(P[0][tj], P[1][tj]);
#pragma unroll
    for (int tip = 0; tip < 2; ++tip) {
        const u32x2 lo = *(const LAS u32x2*)(SB + (16 * tip + r16) * 80 + 8 * g), hi = *(const LAS u32x2*)(SB + (16 * tip + r16) * 80 + 32 + 8 * g);
        const v4u aw = (v4u){lo.x, lo.y, hi.x, hi.y}; const bf16x8 af = __builtin_bit_cast(bf16x8, aw);
#pragma unroll
        for (int tj = 0; tj < 2; ++tj) { const f32x4 X = MFMA16(af, pbb[tj], ((f32x4){0.f, 0.f, 0.f, 0.f})); const int b = 16 * tj + r16;
            const int Rn = BWD ? b : 63 - b, col0 = BWD ? 32 + 16 * tip + 4 * g : 28 - 16 * tip - 4 * g;
            const f32x4 a0 = *(const LAS f32x4*)(S1 + col0), b0 = *(const LAS f32x4*)(S2 + col0);
            f32x4 xv;
#pragma unroll
            for (int e = 0; e < 4; ++e) xv[e] = BWD ? -X[e] : -X[3 - e];
            u32x2 o1, o2; o1.x = cvtpk(xv[0] * a0[0], xv[1] * a0[1]); o1.y = cvtpk(xv[2] * a0[2], xv[3] * a0[3]); o2.x = cvtpk(xv[0] * b0[0], xv[1] * b0[1]); o2.y = cvtpk(xv[2] * b0[2], xv[3] * b0[3]);
            *(LAS u32x2*)(T1 + Rn * AD_LDT + col0 * 2) = o1; *(LAS u32x2*)(T2 + Rn * AD_LDT + col0 * 2) = o2; }
    }
    }
}

DI void acons_s2(Frame& F, LAS unsigned char* L, LAS unsigned char* B, const LAS float* GV, int item_f, int wv, int lane) {
    int lane_o = lane; asm volatile("" : "+v"(lane_o));
    const int r16 = lane_o & 15, g = lane_o >> 4; (void)item_f; (void)F;
    f32x4 accG[4];
#pragma unroll
    for (int tn = 0; tn < 4; ++tn) accG[tn] = (f32x4){0.f, 0.f, 0.f, 0.f};
    const LAS unsigned char* Ab = B + AB_KH + (16 * wv + r16) * AB_LD + g * 16;
    const LAS unsigned char* Kb = B + AB_KH + r16 * AB_LD + g * 16;
    bf16x8 fr[2][5];
#define S2_LD(dst, ks_) do { dst[0] = ld_frag(Ab + (ks_) * 64); _Pragma("unroll") for (int tn_ = 0; tn_ < 4; ++tn_) dst[1 + tn_] = ld_frag(Kb + tn_ * 16 * AB_LD + (ks_) * 64); } while (0)
    S2_LD(fr[0], 0);
#pragma unroll
    for (int ks = 0; ks < 4; ++ks) {
        if (ks + 1 < 4) S2_LD(fr[(ks + 1) & 1], ks + 1);
        __builtin_amdgcn_sched_barrier(0);
#pragma unroll
        for (int tn = 0; tn < 4; ++tn) accG[tn] = MFMA16(fr[ks & 1][0], fr[ks & 1][1 + tn], accG[tn]);
        __builtin_amdgcn_sched_barrier(0); }
#undef S2_LD
    LAS float* LF = (LAS float*)(L + AD_F);
    f32x4 gfi, gbi, bfi, bbi;
    { const LAS float* gp = GV + 16 * wv + 4 * g; gfi = *(const LAS f32x4*)gp; gbi = *(const LAS f32x4*)(gp + 64); bfi = *(const LAS f32x4*)(gp + 128); bbi = *(const LAS f32x4*)(gp + 192); }
#pragma unroll
    for (int tn = 0; tn < 4; ++tn) {
        const int j = 16 * tn + r16; const float gcfj = GV[j], gcbj = GV[64 + j];
#pragma unroll
        for (int reg = 0; reg < 4; ++reg) { const int i = 16 * wv + 4 * g + reg; const bool low = (j <= i);
            const float arg = low ? gfi[reg] - gcfj : gbi[reg] - gcbj, bt = low ? bfi[reg] : bbi[reg];
            const int off = low ? (63 - j) * AD_LDL + (63 - i) : (AD_B - AD_F) / 4 + j * AD_LDL + i;
            LF[off] = bt * accG[tn][reg] * __expf(fminf(arg, 0.f)); } }
}
DI void acons_kdect(Frame& F, LAS unsigned char* B, int item, int half, int lane) {
    int lane_o = lane; asm volatile("" : "+v"(lane_o));
    const int i16 = lane_o & 15, gg = lane_o >> 4, q4 = i16 >> 2, p4 = i16 & 3;
    bf16* const kt = shared_blk(F.wsb, item) + SO_KT;
#pragma unroll
    for (int s = 0; s < 2; ++s) {
#pragma unroll
        for (int d4 = 0; d4 < 4; ++d4) { const int dt = 4 * half + d4; const LAS unsigned char* ap = B + AB_KH + (32 * s + 4 * gg + q4) * AB_LD + (16 * dt + 4 * p4) * 2;
            const s16x4 lo = vtr(ap), hi = vtr(ap + 16 * AB_LD);
            const v4u o = __builtin_bit_cast(v4u, (bf16x8){lo[0], lo[1], lo[2], lo[3], hi[0], hi[1], hi[2], hi[3]});
            *(v4u*)(kt + (16 * dt + i16) * 64 + 32 * s + 8 * gg) = o; __builtin_amdgcn_sched_barrier(0); } }
}
DI void acons_s4(const int dir, Frame& F, LAS unsigned char* L, LAS unsigned char* B, LAS unsigned char* stg_all, int item_f, int wv, int lane) {
    int lane_o = lane; asm volatile("" : "+v"(lane_o));
    const int hw = wv & 1, r16 = lane_o & 15, g = lane_o >> 4, q4 = r16 >> 2, p4 = r16 & 3;
    const LAS unsigned char* T1 = L + (dir ? AD_B : AD_F); const LAS unsigned char* T2 = T1 + AD_T2;
    LAS unsigned char* stg = stg_all + wv * 4352;
    bf16* const blk = item_blk(F.wsb, F.dbo, item_f + 32 * dir);
    const int rrow = lane_o >> 3, rpc = lane_o & 7;
#define S4_LDV(dst, te_) do { dst[0] = tr_frag(B + AB_VV + ((8 * g + q4) * 136 + 16 * (te_) + 4 * p4) * 2, 4 * AB_LD); dst[1] = tr_frag(B + AB_VV + ((32 + 8 * g + q4) * 136 + 16 * (te_) + 4 * p4) * 2, 4 * AB_LD); } while (0)
#define S4_LDK(dst, td_) do { dst[0] = tr_frag(B + AB_KH + ((8 * g + q4) * 136 + 16 * (td_) + 4 * p4) * 2, 4 * AB_LD); dst[1] = tr_frag(B + AB_KH + ((32 + 8 * g + q4) * 136 + 16 * (td_) + 4 * p4) * 2, 4 * AB_LD); } while (0)
#define S4_OUT(gptr_) do { _Pragma("unroll") for (int p_ = 0; p_ < 4; ++p_) { const LAS unsigned char* sp_ = stg + (rrow + 8 * p_) * 136 + rpc * 16; const u32x2 lo_ = *(const LAS u32x2*)sp_, hi_ = *(const LAS u32x2*)(sp_ + 8); \
        *(v4u*)((gptr_) + (size_t)(rrow + 8 * p_) * ROWE + rpc * 8) = (v4u){lo_.x, lo_.y, hi_.x, hi_.y}; } } while (0)
    {
        bf16x8 a1[4][2];
#pragma unroll
        for (int ti = 0; ti < 4; ++ti)
#pragma unroll
            for (int ks = 0; ks < 2; ++ks) a1[ti][ks] = ld_frag(T1 + (16 * ti + r16) * AD_LDT + ks * 64 + g * 16);
        bf16x8 fx[2][2];
        S4_LDV(fx[0], 4 * hw);
#pragma unroll
        for (int t4 = 0; t4 < 4; ++t4) {
            if (t4 + 1 < 4) S4_LDV(fx[(t4 + 1) & 1], 4 * hw + t4 + 1);
            __builtin_amdgcn_sched_barrier(0);
            const bf16x8 v0 = fx[t4 & 1][0], v1 = fx[t4 & 1][1];
#pragma unroll
            for (int ti = 0; ti < 4; ++ti) { f32x4 acc = (f32x4){0.f, 0.f, 0.f, 0.f};
                if (!(dir == 1 && ti >= 2)) acc = MFMA16(a1[ti][0], v0, acc);
                if (!(dir == 0 && ti < 2)) acc = MFMA16(a1[ti][1], v1, acc);
                u32x2 o; o.x = cvtpk(acc[0], acc[1]); o.y = cvtpk(acc[2], acc[3]);
                *(LAS u32x2*)(stg + (16 * (t4 & 1) + r16) * 136 + (16 * g + 4 * ti) * 2) = o; }
            __builtin_amdgcn_sched_barrier(0);
            if (t4 & 1) { constexpr int ROWE = 64; S4_OUT(blk + IO_UT + (size_t)(64 * hw + 16 * (t4 - 1)) * 64); __builtin_amdgcn_sched_barrier(0); }
        }
    }
    {
        const int tiA = hw ? 1 : 0, tiB = hw ? 2 : 3;
        const bool A0 = true, A1 = (dir == 1), B0 = (dir == 0), B1 = true;
        bf16x8 a2A[2], a2B[2];
#pragma unroll
        for (int ks = 0; ks < 2; ++ks) { a2A[ks] = ld_frag(T2 + (16 * tiA + r16) * AD_LDT + ks * 64 + g * 16); a2B[ks] = ld_frag(T2 + (16 * tiB + r16) * AD_LDT + ks * 64 + g * 16); }
        bf16x8 fx[2][2];
        S4_LDK(fx[0], 0);
#pragma unroll
        for (int td = 0; td < 8; ++td) {
            if (td + 1 < 8) S4_LDK(fx[(td + 1) & 1], td + 1);
            __builtin_amdgcn_sched_barrier(0);
            f32x4 accA = (f32x4){0.f, 0.f, 0.f, 0.f}, accB = (f32x4){0.f, 0.f, 0.f, 0.f};
            const bf16x8 k0 = fx[td & 1][0], k1 = fx[td & 1][1];
            if (A0) accA = MFMA16(k0, a2A[0], accA); if (B0) accB = MFMA16(k0, a2B[0], accB);
            if (A1) accA = MFMA16(k1, a2A[1], accA); if (B1) accB = MFMA16(k1, a2B[1], accB);
            const int idl = 32 * ((td & 3) >> 1) + 8 * g + 4 * (td & 1);
            u32x2 o; o.x = cvtpk(-accA[0], -accA[1]); o.y = cvtpk(-accA[2], -accA[3]);
            *(LAS u32x2*)(stg + r16 * 136 + idl * 2) = o;
            o.x = cvtpk(-accB[0], -accB[1]); o.y = cvtpk(-accB[2], -accB[3]);
            *(LAS u32x2*)(stg + (16 + r16) * 136 + idl * 2) = o;
            __builtin_amdgcn_sched_barrier(0);
            if ((td & 3) == 3) {
                const int hf = td >> 2;
#pragma unroll
                for (int p_ = 0; p_ < 4; ++p_) { const int sr = rrow + 8 * p_; const LAS unsigned char* sp_ = stg + sr * 136 + rpc * 16; const u32x2 lo_ = *(const LAS u32x2*)sp_, hi_ = *(const LAS u32x2*)(sp_ + 8);
                    const int grow = 16 * (sr < 16 ? tiA : tiB) + (sr & 15);
                    *(v4u*)(blk + IO_WN + (size_t)grow * 128 + 64 * hf + rpc * 8) = (v4u){lo_.x, lo_.y, hi_.x, hi_.y}; }
                __builtin_amdgcn_sched_barrier(0); }
        }
    }
#undef S4_LDV
#undef S4_LDK
#undef S4_OUT
}
DI void aprod_s0(Frame& F, LAS float* GV, const LAS float* RAW, int item_f, int h, int lane) {
    const float ga[4] = {RAW[lane], RAW[64 + lane], RAW[128 + lane], RAW[192 + lane]};
    const float xf_ = ga[0] + F.dt_f[h], xb_ = ga[1] + F.dt_b[h];
    const float gf = -__expf(F.a_log_f[h]) * (xf_ > 15.f ? xf_ : __logf(1.0f + __expf(xf_)));
    const float gb = -__expf(F.a_log_b[h]) * (xb_ > 15.f ? xb_ : __logf(1.0f + __expf(xb_)));
    float pf = gf, pb = gb;
#pragma unroll
    for (int o = 1; o < 64; o <<= 1) { const float tf = __shfl_up(pf, o), tb = __shfl_up(pb, o); if (lane >= o) { pf += tf; pb += tb; } }
    const float totf = __shfl(pf, 63), totb = __shfl(pb, 63);
    const float gcf = pf, gcb = totb - pb + gb;
    const float btf_ = __builtin_amdgcn_rcpf(1.0f + __expf(-ga[2])), btb_ = __builtin_amdgcn_rcpf(1.0f + __expf(-ga[3])), egf_ = __expf(gcf), egb_ = __expf(gcb);
    GV[lane] = gcf; GV[64 + lane] = gcb; GV[128 + lane] = btf_; GV[192 + lane] = btb_;
    GV[256 + lane] = egf_; GV[320 + lane] = egb_; GV[384 + lane] = __expf(totf - gcf); GV[448 + lane] = __expf(totb - gcb); GV[512 + lane] = btf_ * egf_; GV[576 + lane] = btb_ * egb_;
    if (lane == 0) { F.CD[item_f] = __expf(totf); F.CD[item_f + 32] = __expf(totb); }
    { float* sf = (float*)(item_blk(F.wsb, F.dbo, item_f) + IO_SC); float* sb = (float*)(item_blk(F.wsb, F.dbo, item_f + 32) + IO_SC);
      sf[lane] = egf_; sf[64 + lane] = __expf(totf - gcf); sf[128 + lane] = gcf; sb[lane] = egb_; sb[64 + lane] = __expf(totb - gcb); sb[128 + lane] = gcb; }
}
DI void aprod_load(Frame& F, v4u (&x)[8], int b, int c, int h, int part, int p0, int c16) {
#pragma unroll
    for (int r = 0; r < 8; ++r) { const int t = c * 64 + p0 - 2 + r, tc = t < 0 ? 0 : (t >= SEQ ? SEQ - 1 : t);
        x[r] = *(const v4u*)(F.PA + ((size_t)b * SEQ + tc) * 3072 + part * 1024 + h * 128 + 8 * c16); }
}
DI void aprod_convw(Frame& F, f32x4 (&w)[10], int h, int part, int c16) {
#pragma unroll
    for (int k = 0; k < 5; ++k) { const float* wp = F.conv_w + k * 3072 + part * 1024 + h * 128 + 8 * c16; w[2 * k] = *(const f32x4*)wp; w[2 * k + 1] = *(const f32x4*)(wp + 4); }
}
DI void aprod_conv(const f32x4 (&w)[10], const v4u (&x)[8], float (&o)[4][8], int c, int p0) {
#pragma unroll
    for (int j = 0; j < 4; ++j)
#pragma unroll
        for (int e = 0; e < 8; ++e) o[j][e] = 0.f;
#pragma unroll
    for (int k = 0; k < 5; ++k) { const f32x4 w0 = w[2 * k], w1 = w[2 * k + 1];
#pragma unroll
        for (int j = 0; j < 4; ++j) { const int t = c * 64 + p0 - 2 + j + k; v4u xr = x[j + k]; if (t < 0 || t >= SEQ) xr = (v4u){0u, 0u, 0u, 0u};
            o[j][0] += bflo(xr.x) * w0[0]; o[j][1] += bfhi(xr.x) * w0[1]; o[j][2] += bflo(xr.y) * w0[2]; o[j][3] += bfhi(xr.y) * w0[3];
            o[j][4] += bflo(xr.z) * w1[0]; o[j][5] += bfhi(xr.z) * w1[1]; o[j][6] += bflo(xr.w) * w1[2]; o[j][7] += bfhi(xr.w) * w1[3]; } }
#pragma unroll
    for (int j = 0; j < 4; ++j)
#pragma unroll
        for (int e = 0; e < 8; ++e) o[j][e] = silu_f(o[j][e]);
}
DI void aprod_store_rows(LAS unsigned char* img, const float (&o)[4][8], const float (&sc)[4], int p0, int c16) {
#pragma unroll
    for (int j = 0; j < 4; ++j) { v4u w; w.x = cvtpk(o[j][0] * sc[j], o[j][1] * sc[j]); w.y = cvtpk(o[j][2] * sc[j], o[j][3] * sc[j]); w.z = cvtpk(o[j][4] * sc[j], o[j][5] * sc[j]); w.w = cvtpk(o[j][6] * sc[j], o[j][7] * sc[j]);
        *(LAS v4u*)(img + (p0 + j) * AB_LD + c16 * 16) = w; }
}

#ifndef DLY1
#define DLY1 0
#endif
#ifndef DLY2
#define DLY2 0
#endif
#ifndef DLY3
#define DLY3 0
#endif
#define SPIN_TICKS(n_) do { if ((n_) > 0) { const unsigned long long t0_ = __builtin_amdgcn_s_memrealtime(); while (__builtin_amdgcn_s_memrealtime() - t0_ < (unsigned long long)(n_)) __builtin_amdgcn_s_sleep(1); } } while (0)
#ifndef RCK
#define RCK 1
#endif
#ifndef RC2
#define RC2 1
#endif
#ifndef RC3
#define RC3 1
#endif
#ifndef RC4
#define RC4 1
#endif
#ifndef RP1
#define RP1 1
#endif
#ifndef RP2
#define RP2 1
#endif
#ifndef RP3
#define RP3 1
#endif
DI void a_prep_phase(Frame& F) {
    const int lane = F.lane, wave = F.wave;
    LAS unsigned char* L = F.lds + RING_OFF;
    const int nit = F.ap_nit, IT0 = F.ap_it0, IST = F.ap_stride;
#ifdef APC_PRIO
    if (wave < 4) __builtin_amdgcn_s_setprio(APC_PRIO);
#endif
#ifdef APP_PRIO
    if (wave >= 4) __builtin_amdgcn_s_setprio(APP_PRIO);
#endif
    if (wave < 4) {
#pragma unroll 1
        for (int k = -1; k < nit; ++k) {
            LAS unsigned char* Bc = L + (k & 1) * AB_BUF;
            const LAS float* GVc = (const LAS float*)(L + AG_0 + (k & 1) * AG_SZ);
            const int itc = IT0 + k * IST;
            const int item_c = (((itc >> 8) * 8 + (itc & 7)) * 2) * 32 + ((itc >> 3) & 31);
            const bool cons = (k >= 0);
            if (cons) SPIN_TICKS(DLY1);
            if (cons) for (int r_ = 0; r_ < RC2; ++r_) { asm volatile("" ::: "memory"); acons_s2(F, L, Bc, GVc, item_c, wave, lane); }
            LBAR();
            if (cons) SPIN_TICKS(DLY2);
            if (cons) for (int r_ = 0; r_ < RC3; ++r_) { if (wave < 2) s3_solve(wave == 1, L, Bc + AB_QH, GVc, lane); else for (int r2_ = 0; r2_ < RCK; ++r2_) { asm volatile("" ::: "memory"); acons_kdect(F, Bc, item_c, wave - 2, lane); } }
            LBAR();
            if (cons) SPIN_TICKS(DLY3);
            if (cons) for (int r_ = 0; r_ < RC4; ++r_) { asm volatile("" ::: "memory"); acons_s4(wave >> 1, F, L, Bc, Bc + AB_QH, item_c, wave, lane); }
            LBAR();
        }
    } else {
        const int pw = wave - 4;
        LAS float* RAW = (LAS float*)(L + AG_RAW);
        v4u xq[8], xk[8], xv[8];
        { const int c16 = lane & 15, p0 = 16 * pw + 4 * (lane >> 4);
          if (nit > 0) { const int it = IT0; aprod_load(F, xk, it >> 8, (it >> 3) & 31, it & 7, 1, p0, c16); }
          if (wave == 4 && nit > 0) {
              { const int it = IT0; const int b = it >> 8, c = (it >> 3) & 31, h = it & 7; const float* gr = F.GATES + ((size_t)b * SEQ + c * 64 + lane) * 32; RAW[lane] = gr[h]; RAW[64 + lane] = gr[8 + h]; RAW[128 + lane] = gr[16 + h]; RAW[192 + lane] = gr[24 + h];
                aprod_s0(F, (LAS float*)(L + AG_0), RAW, ((b * 8 + h) * 2) * 32 + c, h, lane); }
              if (nit > 1) { const int it = IT0 + IST; const int b = it >> 8, c = (it >> 3) & 31, h = it & 7; const float* gr = F.GATES + ((size_t)b * SEQ + c * 64 + lane) * 32; const float g0 = gr[h], g1 = gr[8 + h], g2 = gr[16 + h], g3 = gr[24 + h];
                RAW[lane] = g0; RAW[64 + lane] = g1; RAW[128 + lane] = g2; RAW[192 + lane] = g3; } } }
#pragma unroll 1
        for (int k = -1; k < nit; ++k) {
            LAS unsigned char* Bn = L + ((k + 1) & 1) * AB_BUF;
            LAS float* GVn = (LAS float*)(L + AG_0 + ((k + 1) & 1) * AG_SZ);
            const int itn = IT0 + (k + 1) * IST;
            const int bn = itn >> 8, cn = (itn >> 3) & 31, hn = itn & 7; const int item_n = ((bn * 8 + hn) * 2) * 32 + cn;
            const bool prod = (k + 1 < nit);
            int lo_ = lane; asm volatile("" : "+v"(lo_));
            const int gI = lo_ >> 4, c16 = lo_ & 15, p0 = 16 * pw + 4 * gI;
            const int itc_ = prod ? itn : IT0 + (nit > 0 ? nit - 1 : 0) * IST; const int bl_ = itc_ >> 8, cl_ = (itc_ >> 3) & 31, hl_ = itc_ & 7;
            f32x4 wt_[10];
            aprod_convw(F, wt_, hl_, 1, c16); __builtin_amdgcn_sched_barrier(0);
            aprod_load(F, xq, bl_, cl_, hl_, 0, p0, c16); __builtin_amdgcn_sched_barrier(0);
            if (prod) {
                for (int r_ = 0; r_ < RP1; ++r_) { asm volatile("" ::: "memory");
                float o[4][8]; aprod_conv(wt_, xk, o, cn, p0);
                float sc[4];
#pragma unroll
                for (int j = 0; j < 4; ++j) { float ss = 0.f;
#pragma unroll
                    for (int e = 0; e < 8; ++e) ss += o[j][e] * o[j][e];
                    sc[j] = 1.0f / sqrtf(row16_sum(ss) + EPS); }
                aprod_store_rows(Bn + AB_KH, o, sc, p0, c16); }
            }
            LBAR();
            aprod_convw(F, wt_, hl_, 0, c16); __builtin_amdgcn_sched_barrier(0);
            aprod_load(F, xv, bl_, cl_, hl_, 2, p0, c16); __builtin_amdgcn_sched_barrier(0);
            if (prod) {
                float o[4][8]; float sc[4];
                for (int r_ = 0; r_ < RP2; ++r_) { asm volatile("" ::: "memory");
                aprod_conv(wt_, xq, o, cn, p0);
#pragma unroll
                for (int j = 0; j < 4; ++j) { float ss = 0.f;
#pragma unroll
                    for (int e = 0; e < 8; ++e) ss += o[j][e] * o[j][e];
                    sc[j] = (1.0f / sqrtf(row16_sum(ss) + EPS)) * 0.08838834764831845f; }
                aprod_store_rows(Bn + AB_QH, o, sc, p0, c16); }
#ifndef RPQ
#define RPQ 1
#endif
                for (int r_ = 0; r_ < RPQ; ++r_) { asm volatile("" ::: "memory");
                const int b1 = (c16 >> 1) & 1, qoff = 32 * (c16 >> 2) + 8 * (2 * (c16 & 1) + b1);
#pragma unroll
                for (int j = 0; j < 4; ++j) { const int pos = p0 + j; const float e_ = sc[j];
                    const unsigned r0x = cvtpk(o[j][0] * e_, o[j][1] * e_), r0y = cvtpk(o[j][2] * e_, o[j][3] * e_), r1x = cvtpk(o[j][4] * e_, o[j][5] * e_), r1y = cvtpk(o[j][6] * e_, o[j][7] * e_);
                    const unsigned sx = b1 ? r0x : r1x, sy = b1 ? r0y : r1y;
                    const unsigned gx = (unsigned)__builtin_amdgcn_update_dpp(0, (int)sx, 0x4E, 0xf, 0xf, true), gy = (unsigned)__builtin_amdgcn_update_dpp(0, (int)sy, 0x4E, 0xf, 0xf, true);
                    const v4u w = b1 ? (v4u){gx, gy, r1x, r1y} : (v4u){r0x, r0y, gx, gy};
                    *(v4u*)(shared_blk(F.wsb, item_n) + SO_QD + pos * 128 + qoff) = w; }
                }
            }
            LBAR();
            {
                float g4[4] = {0.f, 0.f, 0.f, 0.f}; const bool more = (k + 2 < nit), more3 = (k + 3 < nit);
                aprod_convw(F, wt_, hl_, 2, c16); __builtin_amdgcn_sched_barrier(0);
                { const int it2c = more ? itn + IST : itc_; aprod_load(F, xk, it2c >> 8, (it2c >> 3) & 31, it2c & 7, 1, p0, c16); } __builtin_amdgcn_sched_barrier(0);
                if (more) { const int it2 = itn + IST; const int b2 = it2 >> 8, c2 = (it2 >> 3) & 31, h2 = it2 & 7;
                    if (wave == 4) { aprod_s0(F, (LAS float*)(L + AG_0 + (k & 1) * AG_SZ), RAW, ((b2 * 8 + h2) * 2) * 32 + c2, h2, lane);
                        if (more3) { const int it3 = it2 + IST; const int b3 = it3 >> 8, c3 = (it3 >> 3) & 31, h3 = it3 & 7; const float* gr = F.GATES + ((size_t)b3 * SEQ + c3 * 64 + lane) * 32; g4[0] = gr[h3]; g4[1] = gr[8 + h3]; g4[2] = gr[16 + h3]; g4[3] = gr[24 + h3]; } } }
                if (prod) for (int r_ = 0; r_ < RP3; ++r_) { asm volatile("" ::: "memory"); float o[4][8]; aprod_conv(wt_, xv, o, cn, p0);
                    const float sc[4] = {1.f, 1.f, 1.f, 1.f};
                    aprod_store_rows(Bn + AB_VV, o, sc, p0, c16); }
                if (more3 && wave == 4) { RAW[lane] = g4[0]; RAW[64 + lane] = g4[1]; RAW[128 + lane] = g4[2]; RAW[192 + lane] = g4[3]; }
            }
            LBAR();
        }
    }
#if defined(APC_PRIO) || defined(APP_PRIO)
    __builtin_amdgcn_s_setprio(0);
#endif
}

constexpr int B_KB = 0, B_VB = 55296;
DI void b_attn_unit(Frame& F, int b, int nb, int kvh, bf16* MO) {
    int tid = F.tid; asm volatile("" : "+v"(tid));
    const int lane = tid & 63, wave = F.wave;
    LAS unsigned char* L = F.lds + RING_OFF;
    v4u kv_[6], vv_[6];
#pragma unroll
    for (int it = 0; it < 6; ++it) { const int q = tid + 512 * it, row = q >> 3, cc = q & 7; const int t = (nb - 1) * 128 + row, tc = t < 0 ? 0 : (t >= SEQ ? SEQ - 1 : t);
        const bf16* rp = F.PB + ((size_t)b * SEQ + tc) * 768 + 512 + kvh * 64 + 8 * cc; kv_[it] = *(const v4u*)rp; vv_[it] = *(const v4u*)(rp + 128); }
    __builtin_amdgcn_sched_barrier(0);
#pragma unroll
    for (int it = 0; it < 6; ++it) { const int q = tid + 512 * it, row = q >> 3, cc = q & 7; const int t = (nb - 1) * 128 + row; const bool valid = (t >= 0) && (t < SEQ);
        v4u kv = kv_[it], vv = vv_[it];
        if (!valid) { kv = (v4u){0u, 0u, 0u, 0u}; vv = (v4u){0u, 0u, 0u, 0u}; }
        float xk[8]; xk[0] = bflo(kv.x); xk[1] = bfhi(kv.x); xk[2] = bflo(kv.y); xk[3] = bfhi(kv.y); xk[4] = bflo(kv.z); xk[5] = bfhi(kv.z); xk[6] = bflo(kv.w); xk[7] = bfhi(kv.w);
        float ss = 0.f;
#pragma unroll
        for (int e = 0; e < 8; ++e) ss += xk[e] * xk[e];
        ss += __shfl_xor(ss, 1); ss += __shfl_xor(ss, 2); ss += __shfl_xor(ss, 4);
        const float rstd = 1.0f / sqrtf(ss * (1.0f / 64.0f) + EPS);
        const int tt = valid ? t : 0; float o[8];
#pragma unroll
        for (int e = 0; e < 8; ++e) { const float y = xk[e] * rstd * F.k_norm_b[8 * cc + e]; const float pr = __shfl_xor(y, 4);
            const f32x2v cs = *(const f32x2v*)(F.ROPE + ((size_t)tt * 32 + ((8 * cc + e) & 31)) * 2);
            o[e] = (cc < 4) ? (y * cs.x - pr * cs.y) : (y * cs.x + pr * cs.y); }
        v4u ok; ok.x = cvtpk(o[0], o[1]); ok.y = cvtpk(o[2], o[3]); ok.z = cvtpk(o[4], o[5]); ok.w = cvtpk(o[6], o[7]);
        if (!valid) ok = (v4u){0u, 0u, 0u, 0u};
        *(LAS v4u*)(L + B_KB + row * 144 + cc * 16) = ok;
        { LAS unsigned char* vp = L + B_VB + row * 144 + (32 * (cc & 1) + 4 * (cc >> 1)) * 2; *(LAS u32x2*)vp = (u32x2){vv.x, vv.y}; *(LAS u32x2*)(vp + 32) = (u32x2){vv.z, vv.w}; } }
    if (tid < 128) *(LAS v4u*)(L + B_VB + (384 + (tid >> 3)) * 144 + (tid & 7) * 16) = (v4u){0u, 0u, 0u, 0u};
    __syncthreads();
    const int hq = kvh * 4 + (wave >> 1), r16 = lane & 15, g = lane >> 4, q4 = r16 >> 2, p4 = r16 & 3;
    const float sk = F.sink_b[hq] * LOG2E;
#define B_TILE(QT_, QA_, QC_) do { u32x2 ZZ_[4]; { const size_t mz_ = (size_t)b * SEQ + nb * 128 + (wave & 1) * 64 + 16 * (QT_) + r16; const bf16* zp_ = F.MIX + mz_ * 2048 + 1024 + hq * 64 + 16 * g; const v4u za_ = *(const v4u*)zp_, zb_ = *(const v4u*)(zp_ + 8); \
        ZZ_[0] = (u32x2){za_.x, za_.y}; ZZ_[1] = (u32x2){za_.z, za_.w}; ZZ_[2] = (u32x2){zb_.x, zb_.y}; ZZ_[3] = (u32x2){zb_.z, zb_.w}; } \
        const int i0 = (wave & 1) * 64 + 16 * (QT_), iq = i0 + r16, pos = nb * 128 + iq; const size_t m = (size_t)b * SEQ + pos; \
        bf16x8 qf[2]; \
        { const v4u a = QA_, c2 = QC_; \
          float x0[8], x1[8]; x0[0] = bflo(a.x); x0[1] = bfhi(a.x); x0[2] = bflo(a.y); x0[3] = bfhi(a.y); x0[4] = bflo(a.z); x0[5] = bfhi(a.z); x0[6] = bflo(a.w); x0[7] = bfhi(a.w); \
          x1[0] = bflo(c2.x); x1[1] = bfhi(c2.x); x1[2] = bflo(c2.y); x1[3] = bfhi(c2.y); x1[4] = bflo(c2.z); x1[5] = bfhi(c2.z); x1[6] = bflo(c2.w); x1[7] = bfhi(c2.w); \
          float ss = 0.f; \
        _Pragma("unroll") \
          for (int e = 0; e < 8; ++e) ss += x0[e] * x0[e] + x1[e] * x1[e]; \
          ss += __shfl_xor(ss, 16); ss += __shfl_xor(ss, 32); \
          const float rstd = (1.0f / sqrtf(ss * (1.0f / 64.0f) + EPS)); \
          float o0[8], o1[8]; \
        _Pragma("unroll") \
          for (int e = 0; e < 8; ++e) { const float y0 = x0[e] * rstd * F.q_norm_b[8 * g + e], y1 = x1[e] * rstd * F.q_norm_b[32 + 8 * g + e]; \
              const f32x2v cs = *(const f32x2v*)(F.ROPE + ((size_t)pos * 32 + 8 * g + e) * 2); \
              o0[e] = (y0 * cs.x - y1 * cs.y) * (0.125f * LOG2E); o1[e] = (y1 * cs.x + y0 * cs.y) * (0.125f * LOG2E); } \
          v4u w0, w1; w0.x = cvtpk(o0[0], o0[1]); w0.y = cvtpk(o0[2], o0[3]); w0.z = cvtpk(o0[4], o0[5]); w0.w = cvtpk(o0[6], o0[7]); \
          w1.x = cvtpk(o1[0], o1[1]); w1.y = cvtpk(o1[2], o1[3]); w1.z = cvtpk(o1[4], o1[5]); w1.w = cvtpk(o1[6], o1[7]); \
          qf[0] = __builtin_bit_cast(bf16x8, w0); qf[1] = __builtin_bit_cast(bf16x8, w1); } \
 \
        f32x4 st[18]; \
        _Pragma("unroll") \
        for (int c = 0; c < 17; ++c) { f32x4 acc = (f32x4){0.f, 0.f, 0.f, 0.f}; \
        _Pragma("unroll") \
            for (int s = 0; s < 2; ++s) acc = MFMA16(ld_frag(L + B_KB + (i0 + 16 * c + r16) * 144 + s * 64 + g * 16), qf[s], acc); \
            st[c] = acc; if ((c & 3) == 3) __builtin_amdgcn_sched_barrier(0); } \
        st[17] = (f32x4){0.f, 0.f, 0.f, 0.f}; \
        float mx = sk; \
        _Pragma("unroll") \
        for (int c = 0; c < 17; ++c) \
        _Pragma("unroll") \
            for (int reg = 0; reg < 4; ++reg) { const int j = i0 + 16 * c + 4 * g + reg; const int kpos = (nb - 1) * 128 + j; \
                const bool ok = (j >= iq) && (j <= iq + 256) && (kpos >= 0) && (kpos < SEQ); \
                const float v = ok ? st[c][reg] : -INFINITY; st[c][reg] = v; mx = fmaxf(mx, v); } \
        mx = fmaxf(mx, __shfl_xor(mx, 16)); mx = fmaxf(mx, __shfl_xor(mx, 32)); \
        float sum = 0.f; \
        _Pragma("unroll") \
        for (int c = 0; c < 17; ++c) \
        _Pragma("unroll") \
            for (int reg = 0; reg < 4; ++reg) { const float p = __builtin_amdgcn_exp2f(st[c][reg] - mx); st[c][reg] = p; sum += p; } \
        sum += __shfl_xor(sum, 16); sum += __shfl_xor(sum, 32); \
        const float inv = 1.0f / (sum + __builtin_amdgcn_exp2f(sk - mx)); \
        bf16x8 pb[9]; \
        _Pragma("unroll") \
        for (int kp = 0; kp < 9; ++kp) pb[kp] = pack8(st[2 * kp], st[2 * kp + 1]); \
 \
        _Pragma("unroll") \
        for (int td = 0; td < 4; td += 2) { f32x4 acc = (f32x4){0.f, 0.f, 0.f, 0.f}, acd = acc;     \
        _Pragma("unroll") \
            for (int kp = 0; kp < 9; ++kp) { const LAS unsigned char* vp_ = L + B_VB + ((i0 + 32 * kp + 4 * g + q4) * 72 + 16 * td + 4 * p4) * 2; acc = MFMA16(tr_frag(vp_, 16 * 144), pb[kp], acc); acd = MFMA16(tr_frag(vp_ + 32, 16 * 144), pb[kp], acd); } \
            { const u32x2 z = ZZ_[td], y = ZZ_[td + 1]; v4u o; \
            o.x = cvtpk(acc[0] * inv * bflo(z.x), acc[1] * inv * bfhi(z.x)); o.y = cvtpk(acc[2] * inv * bflo(z.y), acc[3] * inv * bfhi(z.y)); \
            o.z = cvtpk(acd[0] * inv * bflo(y.x), acd[1] * inv * bfhi(y.x)); o.w = cvtpk(acd[2] * inv * bflo(y.y), acd[3] * inv * bfhi(y.y)); \
            *(v4u*)(MO + m * 2048 + 1024 + hq * 64 + 16 * g + 4 * td) = o; } __builtin_amdgcn_sched_barrier(0); } \
    } while (0)
#define B_FETCH(QT_, QA_, QC_) do { const size_t m_ = (size_t)b * SEQ + nb * 128 + (wave & 1) * 64 + 16 * (QT_) + r16; const bf16* qp_ = F.PB + m_ * 768 + hq * 64 + 8 * g; QA_ = *(const v4u*)qp_; QC_ = *(const v4u*)(qp_ + 32); } while (0)
    v4u qaA, qcA, qaB, qcB;
    B_FETCH(0, qaA, qcA);
#pragma unroll 1
    for (int qt = 0; qt < 4; qt += 2) {
        B_FETCH(qt + 1, qaB, qcB);
        B_TILE(qt, qaA, qcA);
        if (qt + 2 < 4) B_FETCH(qt + 2, qaA, qcA);
        B_TILE(qt + 1, qaB, qcB);
    }
#undef B_TILE
#undef B_FETCH
    __syncthreads();
}

constexpr int C_KC = 0, C_VC = 69632;
DI void c_attn_unit(Frame& F, int b, int hc, int qblk, bf16* MO) {
    int tid = F.tid; asm volatile("" : "+v"(tid));
    const int lane = tid & 63, wave = F.wave;
    LAS unsigned char* L = F.lds + RING_OFF;
#pragma unroll
    for (int it = 0; it < 8; ++it) { const int q = tid + 512 * it, row = q >> 4, cc = q & 15;
        const bf16* rp = F.KVM + ((size_t)b * MEMLEN + row) * 1024 + hc * 128 + 8 * cc; const v4u kv = *(const v4u*)rp, vv = *(const v4u*)(rp + 512);
        float xk[8]; xk[0] = bflo(kv.x); xk[1] = bfhi(kv.x); xk[2] = bflo(kv.y); xk[3] = bfhi(kv.y); xk[4] = bflo(kv.z); xk[5] = bfhi(kv.z); xk[6] = bflo(kv.w); xk[7] = bfhi(kv.w);
        float ss = 0.f;
#pragma unroll
        for (int e = 0; e < 8; ++e) ss += xk[e] * xk[e];
        ss += __shfl_xor(ss, 1); ss += __shfl_xor(ss, 2); ss += __shfl_xor(ss, 4); ss += __shfl_xor(ss, 8);
        const float rstd = 1.0f / sqrtf(ss * (1.0f / 128.0f) + EPS);
        float o[8];
#pragma unroll
        for (int e = 0; e < 8; ++e) o[e] = xk[e] * rstd * F.k_norm_c[8 * cc + e];
        v4u ok; ok.x = cvtpk(o[0], o[1]); ok.y = cvtpk(o[2], o[3]); ok.z = cvtpk(o[4], o[5]); ok.w = cvtpk(o[6], o[7]);
        *(LAS v4u*)(L + C_KC + row * 272 + cc * 16) = ok;
        { LAS unsigned char* vp = L + C_VC + row * 272 + (32 * (cc & 3) + 4 * (cc >> 2)) * 2; *(LAS u32x2*)vp = (u32x2){vv.x, vv.y}; *(LAS u32x2*)(vp + 32) = (u32x2){vv.z, vv.w}; } }
    __syncthreads();
    const int r16 = lane & 15, g = lane >> 4, q4 = r16 >> 2, p4 = r16 & 3;
#define C_TILE(QT_, QA_) do { \
        const size_t m = (size_t)b * SEQ + qblk * 256 + wave * 32 + (QT_) * 16 + r16; \
        bf16x8 qf[4]; \
        u32x2 zz_[8]; \
        _Pragma("unroll") \
        for (int k_ = 0; k_ < 4; ++k_) { const v4u zv_ = *(const v4u*)(F.MIX + m * 2048 + 1536 + hc * 128 + 32 * g + 8 * k_); zz_[2 * k_] = (u32x2){zv_.x, zv_.y}; zz_[2 * k_ + 1] = (u32x2){zv_.z, zv_.w}; } \
        { float xs[4][8]; float ss = 0.f; \
        _Pragma("unroll") \
          for (int s = 0; s < 4; ++s) { const v4u a = QA_[s]; \
              xs[s][0] = bflo(a.x); xs[s][1] = bfhi(a.x); xs[s][2] = bflo(a.y); xs[s][3] = bfhi(a.y); xs[s][4] = bflo(a.z); xs[s][5] = bfhi(a.z); xs[s][6] = bflo(a.w); xs[s][7] = bfhi(a.w); \
        _Pragma("unroll") \
              for (int e = 0; e < 8; ++e) ss += xs[s][e] * xs[s][e]; } \
          ss += __shfl_xor(ss, 16); ss += __shfl_xor(ss, 32); \
          const float rstd = (1.0f / sqrtf(ss * (1.0f / 128.0f) + EPS)) * (0.08838834764831845f * LOG2E); \
        _Pragma("unroll") \
          for (int s = 0; s < 4; ++s) { float o[8]; \
        _Pragma("unroll") \
              for (int e = 0; e < 8; ++e) o[e] = xs[s][e] * rstd * F.q_norm_c[32 * s + 8 * g + e]; \
              v4u w0; w0.x = cvtpk(o[0], o[1]); w0.y = cvtpk(o[2], o[3]); w0.z = cvtpk(o[4], o[5]); w0.w = cvtpk(o[6], o[7]); qf[s] = __builtin_bit_cast(bf16x8, w0); } } \
        f32x4 st[16]; \
        _Pragma("unroll") \
        for (int c = 0; c < 16; ++c) { f32x4 acc = (f32x4){0.f, 0.f, 0.f, 0.f}; \
        _Pragma("unroll") \
            for (int s = 0; s < 4; ++s) acc = MFMA16(ld_frag(L + C_KC + (16 * c + r16) * 272 + s * 64 + g * 16), qf[s], acc); \
            st[c] = acc; if ((c & 3) == 3) __builtin_amdgcn_sched_barrier(0); } \
        float mx = -INFINITY; \
        _Pragma("unroll") \
        for (int c = 0; c < 16; ++c) \
        _Pragma("unroll") \
            for (int reg = 0; reg < 4; ++reg) mx = fmaxf(mx, st[c][reg]); \
        mx = fmaxf(mx, __shfl_xor(mx, 16)); mx = fmaxf(mx, __shfl_xor(mx, 32)); \
        float sum = 0.f; \
        _Pragma("unroll") \
        for (int c = 0; c < 16; ++c) \
        _Pragma("unroll") \
            for (int reg = 0; reg < 4; ++reg) { const float p = __builtin_amdgcn_exp2f(st[c][reg] - mx); st[c][reg] = p; sum += p; } \
        sum += __shfl_xor(sum, 16); sum += __shfl_xor(sum, 32); \
        const float inv = 1.0f / sum; \
        bf16x8 pb[8]; \
        _Pragma("unroll") \
        for (int kp = 0; kp < 8; ++kp) pb[kp] = pack8(st[2 * kp], st[2 * kp + 1]); \
        _Pragma("unroll") \
        for (int td = 0; td < 8; td += 2) { f32x4 acc = (f32x4){0.f, 0.f, 0.f, 0.f}, acd = acc;     \
        _Pragma("unroll") \
            for (int kp = 0; kp < 8; ++kp) { const LAS unsigned char* vp_ = L + C_VC + ((32 * kp + 4 * g + q4) * 136 + 16 * td + 4 * p4) * 2; acc = MFMA16(tr_frag(vp_, 16 * 272), pb[kp], acc); acd = MFMA16(tr_frag(vp_ + 32, 16 * 272), pb[kp], acd); } \
            { const u32x2 z = zz_[td], y = zz_[td + 1]; v4u o; \
            o.x = cvtpk(acc[0] * inv * bflo(z.x), acc[1] * inv * bfhi(z.x)); o.y = cvtpk(acc[2] * inv * bflo(z.y), acc[3] * inv * bfhi(z.y)); \
            o.z = cvtpk(acd[0] * inv * bflo(y.x), acd[1] * inv * bfhi(y.x)); o.w = cvtpk(acd[2] * inv * bflo(y.y), acd[3] * inv * bfhi(y.y)); \
            *(v4u*)(MO + m * 2048 + 1536 + hc * 128 + 32 * g + 4 * td) = o; } __builtin_amdgcn_sched_barrier(0); } \
    } while (0)
#define C_FETCH(QT_, QA_) do { const size_t m_ = (size_t)b * SEQ + qblk * 256 + wave * 32 + (QT_) * 16 + r16; _Pragma("unroll") for (int s_ = 0; s_ < 4; ++s_) QA_[s_] = *(const v4u*)(F.PC + m_ * 512 + hc * 128 + 32 * s_ + 8 * g); } while (0)
    v4u qa0[4], qa1[4];
    C_FETCH(0, qa0); C_FETCH(1, qa1);
    C_TILE(0, qa0);
    C_TILE(1, qa1);
#undef C_TILE
#undef C_FETCH
    __syncthreads();
}

constexpr int S_WN = 0, S_QD = 18432, S_KT = 36864, S_QK = 55296, S_SC = 64512, S_BUF = 65280;
constexpr int S_OST = 2 * S_BUF, S_OLD = 272;
static_assert(S_OST + 64 * S_OLD <= RING_BYTES, "scan LDS");
#ifdef XBARS
#define XBAR() do { LBAR(); LBAR(); LBAR(); LBAR(); } while (0)
#else
#define XBAR() do {} while (0)
#endif
DI unsigned sc_dof(const int i, const int l3, const unsigned bA, const unsigned bB) {
    if (i < 5) return S_QD + bA + i * 12 * 288;
    if (i == 5) return l3 < 64 ? S_QD + bA + 60 * 288 : S_KT + bB - 8 * 144;
    if (i < 10) return S_KT + bB + (24 * i - 128) * 144;
    if (i == 10) return l3 < 128 ? S_KT + bB + 112 * 144 : S_WN + bA - 8 * 288;
    if (i < 16) return S_WN + bA + (12 * i - 128) * 288;
    return S_SC + (unsigned)l3 * 16;
}
DI void sc_qk4(LAS unsigned char* Bq, const int wq, const int lane, const int dir) {
    int lq = lane; asm volatile("" : "+v"(lq)); const int r16 = lq & 15, g = lq >> 4, q4 = r16 >> 2, p4 = r16 & 3; const LAS float* gct = (const LAS float*)(Bq + S_SC) + 128;
    const int jn0 = 32 * (wq >> 1) + 16 * (g & 1) + 4 * (2 * (wq & 1) + (g >> 1)); const f32x4 gcj = *(const LAS f32x4*)(gct + jn0);
    bf16x8 kt[4], qa[4], qb[4];
#pragma unroll
    for (int ks = 0; ks < 4; ++ks) kt[ks] = tr_frag(Bq + S_KT + (32 * ks + 4 * g + q4) * 144 + (16 * wq + 4 * p4) * 2, 16 * 144);
#define SCQ_LDQ(dst, tn_) do { _Pragma("unroll") for (int ks_ = 0; ks_ < 4; ++ks_) dst[ks_] = ld_frag(Bq + S_QD + (16 * (tn_) + r16) * 288 + ks_ * 64 + g * 16); } while (0)
#define SCQ_OUT(a_, tn_) do { const int i_ = 16 * (tn_) + r16; const float gci_ = gci[tn_]; float q_[4]; \
        _Pragma("unroll") for (int rg_ = 0; rg_ < 4; ++rg_) { const int jn_ = jn0 + rg_; const bool ok_ = dir ? (jn_ >= i_) : (jn_ <= i_); q_[rg_] = ok_ ? a_[rg_] * __expf(fminf(gci_ - gcj[rg_], 0.f)) : 0.f; } \
        u32x2 o_; o_.x = cvtpk(q_[0], q_[1]); o_.y = cvtpk(q_[2], q_[3]); *(LAS u32x2*)(Bq + S_QK + i_ * 144 + (16 * wq + 4 * g) * 2) = o_; } while (0)
    SCQ_LDQ(qa, 0); SCQ_LDQ(qb, 1);
    float gci[4];
#pragma unroll
    for (int tn = 0; tn < 4; ++tn) gci[tn] = gct[16 * tn + r16];
    __builtin_amdgcn_sched_barrier(0);
    f32x4 a0 = (f32x4){0.f, 0.f, 0.f, 0.f}, a1 = a0;
#pragma unroll
    for (int ks = 0; ks < 4; ++ks) { a0 = MFMA16(kt[ks], qa[ks], a0); a1 = MFMA16(kt[ks], qb[ks], a1); }
    __builtin_amdgcn_sched_barrier(0);
    SCQ_LDQ(qa, 2); SCQ_LDQ(qb, 3);
    __builtin_amdgcn_sched_barrier(0);
    SCQ_OUT(a0, 0); SCQ_OUT(a1, 1);
    __builtin_amdgcn_sched_barrier(0);
    f32x4 a2 = (f32x4){0.f, 0.f, 0.f, 0.f}, a3 = a2;
#pragma unroll
    for (int ks = 0; ks < 4; ++ks) { a2 = MFMA16(kt[ks], qa[ks], a2); a3 = MFMA16(kt[ks], qb[ks], a3); }
    SCQ_OUT(a2, 2); SCQ_OUT(a3, 3);
#undef SCQ_LDQ
#undef SCQ_OUT
}
DI void scan_unit(LAS unsigned char* lds_, int tid, unsigned char* wsb_, unsigned char* dbo_, const float* CD_, bf16* OF_, bf16* OB_, gu32* PROG_, int bh, int dir) {
    const int lane = tid & 63, wave = __builtin_amdgcn_readfirstlane(tid >> 6);
    LAS unsigned char* L = lds_ + RING_OFF;
    const int b = bh >> 3, h = bh & 7;
    const int item0 = (bh * 2 + dir) * 32;
    const int lt = tid - 256;
#ifndef LOAD_PRIO
#define LOAD_PRIO 2
#endif
    if (wave >= 4) __builtin_amdgcn_s_setprio(LOAD_PRIO);
    if (wave == 7) {
        __syncthreads();
        sc_qk4(L, 3, lane, dir);
        __syncthreads();
#pragma unroll 1
        for (int s = 0; s < 32; ++s) {
            if (s > 0) { const int np = dir ? 32 - s : s - 1; bf16* ob = (dir ? OB_ : OF_) + ((size_t)b * SEQ + (size_t)np * 64) * 1024 + h * 128;
                int lo_ = lane; asm volatile("" : "+v"(lo_));
#pragma unroll
                for (int i = 0; i < 16; ++i) { const int q = lo_ + 64 * i, row = q >> 4, cc = q & 15; const v4u v = *(const LAS v4u*)(L + S_OST + row * S_OLD + cc * 16);
                    *(v4u*)(ob + (size_t)row * 1024 + cc * 8) = v; } }
            LBAR();
            sc_qk4(L + ((s + 1) & 1) * S_BUF, 3, lane, dir);
            LBAR(); XBAR();
        }
    } else if (wave >= 4) {
        const int l3 = tid - 256, wq = wave - 4;
        const bool last_ok = l3 < 48;
        v4u ldA[17], ldB[17];
#ifdef SCAN_NT
#define SC_LDG(p_) __builtin_nontemporal_load(p_)
#else
#define SC_LDG(p_) (*(p_))
#endif
#define SC_LOAD(ld, n_) do { const v4u* sb_ = (const v4u*)shared_blk(wsb_, item0 + (n_)); const v4u* db_ = (const v4u*)item_blk(wsb_, dbo_, item0 + (n_)) - 2048; int lg_ = l3; asm volatile("" : "+v"(lg_)); \
        _Pragma("unroll") for (int i_ = 0; i_ < 16; ++i_) { const int p_ = lg_ + 192 * i_; ld[i_] = SC_LDG(((i_ < 10) ? sb_ : (i_ > 10) ? db_ : (p_ < 2048 ? sb_ : db_)) + p_); } \
        ld[16] = SC_LDG(db_ + (last_ok ? lg_ + 192 * 16 : 2048)); } while (0)
#define SC_WRITE(ld, bufo_) do { LAS unsigned char* B_ = L + (bufo_); int lo_ = l3; asm volatile("" : "+v"(lo_)); const unsigned bA_ = (unsigned)((lo_ >> 4) * 288 + (lo_ & 15) * 16), bB_ = (unsigned)((lo_ >> 3) * 144 + (lo_ & 7) * 16); \
        _Pragma("unroll") for (int i_ = 0; i_ < 16; ++i_) *(LAS v4u*)(B_ + sc_dof(i_, lo_, bA_, bB_)) = ld[i_]; \
        if (last_ok) *(LAS v4u*)(B_ + sc_dof(16, lo_, bA_, bB_)) = ld[16]; } while (0)
#define SC_CH(k_) (dir ? 31 - ((k_) < 31 ? (k_) : 31) : ((k_) < 31 ? (k_) : 31))
        SC_LOAD(ldA, SC_CH(0)); SC_LOAD(ldB, SC_CH(1)); SC_WRITE(ldA, 0); SC_LOAD(ldA, SC_CH(2));
        __syncthreads();
        sc_qk4(L, wq, lane, dir);
        __syncthreads();
#pragma unroll 1
        for (int s = 0; s < 32; s += 2) {
            SC_WRITE(ldB, S_BUF); SC_LOAD(ldB, SC_CH(s + 3)); LBAR(); sc_qk4(L + S_BUF, wq, lane, dir); LBAR(); XBAR();
            SC_WRITE(ldA, 0); SC_LOAD(ldA, SC_CH(s + 4)); LBAR(); sc_qk4(L, wq, lane, dir); LBAR(); XBAR();
        }
        asm volatile("s_waitcnt vmcnt(0)" ::: "memory");
#undef SC_CH
    } else {
#ifdef SCAN_PRIO
        __builtin_amdgcn_s_setprio(SCAN_PRIO);
#endif
        int lc_ = lane; asm volatile("" : "+v"(lc_));
        const int r16 = lc_ & 15, g = lc_ >> 4, e0 = wave * 32 + r16;
        f32x4 S[2][8];
#pragma unroll
        for (int c = 0; c < 2; ++c)
#pragma unroll
            for (int td = 0; td < 8; ++td) S[c][td] = (f32x4){0.f, 0.f, 0.f, 0.f};
        u32x2 un[2][4]; float cdn;
        { const int n0 = dir ? 31 : 0;
#pragma unroll
          for (int c = 0; c < 2; ++c) { const bf16* up = item_blk(wsb_, dbo_, item0 + n0) + IO_UT + (e0 + 16 * c) * 64 + 16 * g;
              const v4u ua = *(const v4u*)up, ub = *(const v4u*)(up + 8); un[c][0] = (u32x2){ua.x, ua.y}; un[c][1] = (u32x2){ua.z, ua.w}; un[c][2] = (u32x2){ub.x, ub.y}; un[c][3] = (u32x2){ub.z, ub.w}; }
          cdn = CD_[item0 + n0]; }
        __syncthreads(); __syncthreads();
#pragma unroll 1
        for (int s = 0; s < 32; ++s) {
            const LAS unsigned char* Bf = L + (s & 1) * S_BUF;
            const float cd = cdn;
            f32x4 vacc[2][4];
#pragma unroll
            for (int c = 0; c < 2; ++c)
#pragma unroll
                for (int t = 0; t < 4; ++t) { const u32x2 uu = un[c][t]; vacc[c][t] = (f32x4){bflo(uu.x), bfhi(uu.x), bflo(uu.y), bfhi(uu.y)}; }
            if (s + 1 < 32) { const int nn = dir ? 30 - s : s + 1;
#pragma unroll
                for (int c = 0; c < 2; ++c) { const bf16* up = item_blk(wsb_, dbo_, item0 + nn) + IO_UT + (e0 + 16 * c) * 64 + 16 * g;
                    const v4u ua = *(const v4u*)up, ub = *(const v4u*)(up + 8); un[c][0] = (u32x2){ua.x, ua.y}; un[c][1] = (u32x2){ua.z, ua.w}; un[c][2] = (u32x2){ub.x, ub.y}; un[c][3] = (u32x2){ub.z, ub.w}; }
                cdn = CD_[item0 + nn]; }
            bf16x8 Sb[2][4];
#pragma unroll
            for (int c = 0; c < 2; ++c)
#pragma unroll
                for (int ks = 0; ks < 4; ++ks) Sb[c][ks] = pack8(S[c][2 * ks], S[c][2 * ks + 1]);
            bf16x8 fa[4], fb[4];
#define SC_SB() __builtin_amdgcn_sched_barrier(0)
#define SC_LD4(dst, base_, row_, rstride_) do { dst[0] = ld_frag(Bf + (base_) + ((row_) + r16) * (rstride_) + g * 16); dst[1] = ld_frag(Bf + (base_) + ((row_) + r16) * (rstride_) + 64 + g * 16); \
        dst[2] = ld_frag(Bf + (base_) + ((row_) + r16) * (rstride_) + 128 + g * 16); dst[3] = ld_frag(Bf + (base_) + ((row_) + r16) * (rstride_) + 192 + g * 16); } while (0)
#define SC_MM4(acc_, src, t_) do { acc_[0][t_] = MFMA16(src[0], Sb[0][0], acc_[0][t_]); acc_[1][t_] = MFMA16(src[0], Sb[1][0], acc_[1][t_]); acc_[0][t_] = MFMA16(src[1], Sb[0][1], acc_[0][t_]); acc_[1][t_] = MFMA16(src[1], Sb[1][1], acc_[1][t_]); \
        acc_[0][t_] = MFMA16(src[2], Sb[0][2], acc_[0][t_]); acc_[1][t_] = MFMA16(src[2], Sb[1][2], acc_[1][t_]); acc_[0][t_] = MFMA16(src[3], Sb[0][3], acc_[0][t_]); acc_[1][t_] = MFMA16(src[3], Sb[1][3], acc_[1][t_]); } while (0)
#define SC_MMV(src, t_) SC_MM4(vacc, src, t_)
#define SC_MMO(src, t_) SC_MM4(oacc, src, t_)
#ifndef RSC1
#define RSC1 1
#endif
            f32x4 vsave[2][4];
            if (RSC1 > 1) { _Pragma("unroll") for (int c = 0; c < 2; ++c) _Pragma("unroll") for (int t = 0; t < 4; ++t) vsave[c][t] = vacc[c][t]; }
            for (int r5_ = 0; r5_ < RSC1; ++r5_) {
            if (RSC1 > 1) { _Pragma("unroll") for (int c = 0; c < 2; ++c) _Pragma("unroll") for (int t = 0; t < 4; ++t) vacc[c][t] = vsave[c][t]; asm volatile("" : "+v"(Sb[0][0]), "+v"(Sb[1][0]), "+v"(Sb[0][1]), "+v"(Sb[1][1]), "+v"(Sb[0][2]), "+v"(Sb[1][2]), "+v"(Sb[0][3]), "+v"(Sb[1][3]) :: "memory"); }
            SC_LD4(fa, S_WN, 0, 288); SC_SB();
            SC_LD4(fb, S_WN, 16, 288); SC_SB(); SC_MMV(fa, 0); SC_SB();
            SC_LD4(fa, S_WN, 32, 288); SC_SB(); SC_MMV(fb, 1); SC_SB();
            SC_LD4(fb, S_WN, 48, 288); SC_SB(); SC_MMV(fa, 2); SC_SB();
            SC_LD4(fa, S_QD, 0, 288); SC_SB(); SC_MMV(fb, 3); SC_SB(); }
            bf16x8 Vb[2][2], Vk[2][2];
#pragma unroll
            for (int kp = 0; kp < 2; ++kp) { const f32x4 k0 = *(const LAS f32x4*)(Bf + S_SC + 256 + (32 * kp + 4 * g) * 4), k1 = *(const LAS f32x4*)(Bf + S_SC + 256 + (32 * kp + 16 + 4 * g) * 4);
#pragma unroll
                for (int c = 0; c < 2; ++c) { Vb[c][kp] = pack8(vacc[c][2 * kp], vacc[c][2 * kp + 1]); const f32x4 s0 = vacc[c][2 * kp] * k0, s1 = vacc[c][2 * kp + 1] * k1; Vk[c][kp] = pack8(s0, s1); } }
            f32x4 oacc[2][4];
#pragma unroll
            for (int c = 0; c < 2; ++c)
#pragma unroll
                for (int t = 0; t < 4; ++t) oacc[c][t] = (f32x4){0.f, 0.f, 0.f, 0.f};
            SC_LD4(fb, S_QD, 16, 288); SC_SB(); SC_MMO(fa, 0); SC_SB();
            SC_LD4(fa, S_QD, 32, 288); SC_SB(); SC_MMO(fb, 1); SC_SB();
            SC_LD4(fb, S_QD, 48, 288); SC_SB(); SC_MMO(fa, 2); SC_SB();
#define SC_LDQK(dst, t0_) do { dst[0] = ld_frag(Bf + S_QK + (16 * (t0_) + r16) * 144 + g * 16); dst[1] = ld_frag(Bf + S_QK + (16 * (t0_) + r16) * 144 + 64 + g * 16); \
        dst[2] = ld_frag(Bf + S_QK + (16 * ((t0_) + 1) + r16) * 144 + g * 16); dst[3] = ld_frag(Bf + S_QK + (16 * ((t0_) + 1) + r16) * 144 + 64 + g * 16); } while (0)
#define SC_MMQK1(f0_, f1_, t_) do { oacc[0][t_] = MFMA16(f0_, Vb[0][0], oacc[0][t_]); oacc[1][t_] = MFMA16(f0_, Vb[1][0], oacc[1][t_]); oacc[0][t_] = MFMA16(f1_, Vb[0][1], oacc[0][t_]); oacc[1][t_] = MFMA16(f1_, Vb[1][1], oacc[1][t_]); } while (0)
#define SC_MMQK(src, t0_) do { SC_MMQK1(src[0], src[1], (t0_)); SC_MMQK1(src[2], src[3], (t0_) + 1); } while (0)
            SC_LDQK(fa, 0); SC_SB(); SC_MMO(fb, 3); SC_SB();
#pragma unroll
            for (int t = 0; t < 4; ++t) { const f32x4 eg4 = *(const LAS f32x4*)(Bf + S_SC + (16 * t + 4 * g) * 4); oacc[0][t] *= eg4; oacc[1][t] *= eg4; }
            SC_SB();
            SC_LDQK(fb, 2); SC_SB(); SC_MMQK(fa, 0); SC_SB();
#define SC_LDKT(dst, td0_) do { dst[0] = ld_frag(Bf + S_KT + (16 * (td0_) + r16) * 144 + g * 16); dst[1] = ld_frag(Bf + S_KT + (16 * (td0_) + r16) * 144 + 64 + g * 16); \
        dst[2] = ld_frag(Bf + S_KT + (16 * ((td0_) + 1) + r16) * 144 + g * 16); dst[3] = ld_frag(Bf + S_KT + (16 * ((td0_) + 1) + r16) * 144 + 64 + g * 16); } while (0)
#define SC_MMKT1(f0_, f1_, td_) do { f32x4 a0_ = S[0][td_] * cd, a1_ = S[1][td_] * cd; a0_ = MFMA16(f0_, Vk[0][0], a0_); a1_ = MFMA16(f0_, Vk[1][0], a1_); a0_ = MFMA16(f1_, Vk[0][1], a0_); a1_ = MFMA16(f1_, Vk[1][1], a1_); S[0][td_] = a0_; S[1][td_] = a1_; } while (0)
#define SC_MMKT(src, td0_) do { SC_MMKT1(src[0], src[1], (td0_)); SC_MMKT1(src[2], src[3], (td0_) + 1); } while (0)
            SC_LDKT(fa, 0); SC_SB(); SC_MMQK(fb, 2); SC_SB();
            LBAR();
#pragma unroll
            for (int c = 0; c < 2; ++c)
#pragma unroll
                for (int t = 0; t < 4; ++t) { const unsigned p01 = cvtpk(oacc[c][t][0], oacc[c][t][1]), p23 = cvtpk(oacc[c][t][2], oacc[c][t][3]); LAS unsigned char* op = L + S_OST + (16 * t + 4 * g) * S_OLD + (e0 + 16 * c) * 2;
                    *(LAS bf16*)(op) = (bf16)(p01 & 0xffffu); *(LAS bf16*)(op + S_OLD) = (bf16)(p01 >> 16); *(LAS bf16*)(op + 2 * S_OLD) = (bf16)(p23 & 0xffffu); *(LAS bf16*)(op + 3 * S_OLD) = (bf16)(p23 >> 16); }
            SC_SB();
            SC_LDKT(fb, 2); SC_SB(); SC_MMKT(fa, 0); SC_SB();
            SC_LDKT(fa, 4); SC_SB(); SC_MMKT(fb, 2); SC_SB();
            SC_LDKT(fb, 6); SC_SB(); SC_MMKT(fa, 4); SC_SB();
            SC_MMKT(fb, 6);
#undef SC_SB
#undef SC_LD4
#undef SC_MMV
#undef SC_MM4
#undef SC_MMO
#undef SC_LDQK
#undef SC_MMQK
#undef SC_MMQK1
#undef SC_MMKT1
#undef SC_LDKT
#undef SC_MMKT
            LBAR(); XBAR();
        }
    }
    __builtin_amdgcn_s_setprio(0);
    { const int np = dir ? 0 : 31;
#pragma unroll
      for (int i = 0; i < 2; ++i) { const int q = tid + 512 * i, row = q >> 4, cc = q & 15; const v4u v = *(const LAS v4u*)(L + S_OST + row * S_OLD + cc * 16);
          *(v4u*)((dir ? OB_ : OF_) + ((size_t)b * SEQ + (size_t)np * 64 + row) * 1024 + h * 128 + cc * 8) = v; } }
    __syncthreads();
#undef SC_LOAD
#undef SC_WRITE
}

DI void combine_row(Frame& F, size_t m, bf16* MO) {
    const int lane = F.lane; const size_t off = m * 1024 + 16 * lane;
#ifdef P4_NT
    const v4u f0 = __builtin_nontemporal_load((const v4u*)(F.OF + off)), f1 = __builtin_nontemporal_load((const v4u*)(F.OF + off + 8)), b0 = __builtin_nontemporal_load((const v4u*)(F.OB + off)), b1 = __builtin_nontemporal_load((const v4u*)(F.OB + off + 8));
#else
    const v4u f0 = *(const v4u*)(F.OF + off), f1 = *(const v4u*)(F.OF + off + 8), b0 = *(const v4u*)(F.OB + off), b1 = *(const v4u*)(F.OB + off + 8);
#endif
    const bf16* zp = F.MIX + m * 2048 + 16 * lane; const v4u z0 = *(const v4u*)zp, z1 = *(const v4u*)(zp + 8); bf16* mp = MO + m * 2048 + 16 * lane;
    float o[16];
    o[0] = bflo(f0.x) + bflo(b0.x); o[1] = bfhi(f0.x) + bfhi(b0.x); o[2] = bflo(f0.y) + bflo(b0.y); o[3] = bfhi(f0.y) + bfhi(b0.y);
    o[4] = bflo(f0.z) + bflo(b0.z); o[5] = bfhi(f0.z) + bfhi(b0.z); o[6] = bflo(f0.w) + bflo(b0.w); o[7] = bfhi(f0.w) + bfhi(b0.w);
    o[8] = bflo(f1.x) + bflo(b1.x); o[9] = bfhi(f1.x) + bfhi(b1.x); o[10] = bflo(f1.y) + bflo(b1.y); o[11] = bfhi(f1.y) + bfhi(b1.y);
    o[12] = bflo(f1.z) + bflo(b1.z); o[13] = bfhi(f1.z) + bfhi(b1.z); o[14] = bflo(f1.w) + bflo(b1.w); o[15] = bfhi(f1.w) + bfhi(b1.w);
    float ss = 0.f;
#pragma unroll
    for (int e = 0; e < 16; ++e) ss += o[e] * o[e];
    ss += __shfl_xor(ss, 1); ss += __shfl_xor(ss, 2); ss += __shfl_xor(ss, 4);
    const float rstd = 1.0f / sqrtf(ss * (1.0f / 128.0f) + EPS);
    float z[16];
    z[0] = bflo(z0.x); z[1] = bfhi(z0.x); z[2] = bflo(z0.y); z[3] = bfhi(z0.y); z[4] = bflo(z0.z); z[5] = bfhi(z0.z); z[6] = bflo(z0.w); z[7] = bfhi(z0.w);
    z[8] = bflo(z1.x); z[9] = bfhi(z1.x); z[10] = bflo(z1.y); z[11] = bfhi(z1.y); z[12] = bflo(z1.z); z[13] = bfhi(z1.z); z[14] = bflo(z1.w); z[15] = bfhi(z1.w);
    const int c0 = (16 * lane) & 127; float y[16];
#pragma unroll
    for (int e = 0; e < 16; ++e) y[e] = o[e] * rstd * F.o_norm_a[c0 + e] * z[e];
    v4u w0, w1; w0.x = cvtpk(y[0], y[1]); w0.y = cvtpk(y[2], y[3]); w0.z = cvtpk(y[4], y[5]); w0.w = cvtpk(y[6], y[7]);
    w1.x = cvtpk(y[8], y[9]); w1.y = cvtpk(y[10], y[11]); w1.z = cvtpk(y[12], y[13]); w1.w = cvtpk(y[14], y[15]);
    *(v4u*)mp = w0; *(v4u*)(mp + 8) = w1;
}

struct Args { const float* in[18]; float* out; unsigned char* ws; int ph_lo, ph_hi, li, pad; };
__global__ void __launch_bounds__(NWAVES * 64, 2) hybrid_fwd(Args args) {
    extern __shared__ __attribute__((aligned(16))) unsigned char lds[];
    Frame F;
    F.lds = (LAS unsigned char*)lds;
    F.MISC = (volatile LAS unsigned*)(F.lds + MISC_OFF);
    F.tid = threadIdx.x; F.lane = F.tid & 63; F.wave = __builtin_amdgcn_readfirstlane(F.tid >> 6);
    F.G = gridDim.x; { const int bx = blockIdx.x; F.vcu = (F.G % 8 == 0) ? (bx % 8) * (F.G / 8) + bx / 8 : bx; }
    unsigned char* ws = args.ws;
    F.ctl = (gu32*)(ws + WS_CTL); F.wsb = ws; F.dbo = (unsigned char*)args.out;
    F.x = args.in[0]; F.mem = args.in[1]; F.norm_w = args.in[2]; F.w_in = args.in[3]; F.conv_w = args.in[4]; F.a_log_f = args.in[5]; F.a_log_b = args.in[6];
    F.dt_f = args.in[7]; F.dt_b = args.in[8]; F.o_norm_a = args.in[9]; F.q_norm_b = args.in[10]; F.k_norm_b = args.in[11]; F.sink_b = args.in[12];
    F.mem_norm_w = args.in[13]; F.w_mem_kv = args.in[14]; F.q_norm_c = args.in[15]; F.k_norm_c = args.in[16]; F.w_out = args.in[17]; F.out = args.out;
    F.WinT = (bf16*)(ws + WS_WIN); F.WmemT = (bf16*)(ws + WS_WMEM); F.WoutT = (bf16*)(ws + WS_WOUT); F.XN = (bf16*)(ws + WS_XN); F.MEMN = (bf16*)(ws + WS_MEMN);
    F.PA = (bf16*)(ws + WS_PA); F.PB = (bf16*)(ws + WS_PB); F.PC = (bf16*)(ws + WS_PC); F.MIX = (bf16*)(ws + WS_MIX); F.KVM = (bf16*)(ws + WS_KVM);
    F.UT = (bf16*)(ws + WS_UT); F.WNEG = (bf16*)(ws + WS_WNEG); F.QDEC = (bf16*)(ws + WS_QDEC); F.KDECT = (bf16*)(ws + WS_KDECT); F.QKM = (bf16*)(ws + WS_QKM);
    F.OF = (bf16*)(ws + WS_OF); F.OB = (bf16*)(ws + WS_OB);
    F.GATES = (float*)(ws + WS_GATES); F.ROPE = (float*)(ws + WS_ROPE); F.CD = (float*)(ws + WS_CD);
    for (int u = F.tid; u < (LDS_BYTES - LDSCTL_OFF) / 4; u += NWAVES * 64) ((LAS unsigned*)(F.lds + LDSCTL_OFF))[u] = 0u;
    __syncthreads();
    XcdBarrier bar; bar.bar = (unsigned*)(F.ctl + CW_BAR); bar.x = 0; bar.st = nullptr;
    if (N_LAUNCHES != PER_PHASE) bar = xcd_barrier_post((unsigned*)(F.ctl + CW_BAR), F.MISC + 8);
#define GRID_BAR() do { if (N_LAUNCHES == PER_PHASE) { if (F.tid == 0) __hip_atomic_store(F.ctl + CW_TMO, 0xBADBA0u, RLX_AGENT); } else { xcd_barrier(bar); } } while (0)
    const int lo = args.ph_lo, hi = args.ph_hi;
#define IN(k) (lo <= (k) && (k) < hi)
#define BOTH(k) (IN(k) && IN((k) + 1))

#ifndef REP0
#define REP0 1
#endif
#ifndef REP1
#define REP1 1
#endif
#ifndef REP2A
#define REP2A 1
#endif
#ifndef REP2B
#define REP2B 1
#endif
#ifndef REP2C
#define REP2C 1
#endif
#ifndef REP3
#define REP3 1
#endif
#ifndef REP4
#define REP4 1
#endif
#ifndef REP5
#define REP5 1
#endif
#ifndef REPBAR
#define REPBAR 1
#endif
#ifndef DUMMY
#define DUMMY 0
#endif
    if (DUMMY > 0) {
        f32x4 da[4]; bf16x8 dx = (bf16x8){(short)F.lane, 1, 2, 3, 4, 5, 6, 7};
        for (int q = 0; q < 4; ++q) da[q] = (f32x4){0.f, 0.f, 0.f, 0.f};
        for (int it = 0; it < DUMMY; ++it) {
#pragma unroll
            for (int r = 0; r < 16; ++r) { da[0] = MFMA16(dx, dx, da[0]); da[1] = MFMA16(dx, dx, da[1]); da[2] = MFMA16(dx, dx, da[2]); da[3] = MFMA16(dx, dx, da[3]); } }
        asm volatile("" :: "v"(da[0]), "v"(da[1]), "v"(da[2]), "v"(da[3]));
    }
    bf16* const DRY = (bf16*)F.out;
#ifdef TPH
#ifndef TPHCU
#define TPHCU 0
#endif
    unsigned long long tph_[8]; tph_[0] = rt(); unsigned long long tp4w_ = 0, tpa_ = 0;
#define TS(n_) do { tph_[n_] = rt(); } while (0)
#else
#define TS(n_) do {} while (0)
#endif
#ifndef DEFER_WOUT
#define DEFER_WOUT 1
#endif
    const bool defer_wout = DEFER_WOUT && lo == 0 && hi >= 6 && N_LAUNCHES != PER_PHASE && F.G == 256 && REP0 == 1 && REP1 == 1;
#if defined(TPH) && defined(TPHX)
    if (IN(0)) { unsigned long long tm_ = 0; p0_prologue(F, defer_wout, &tm_); tph_[0] = TPHX == 1 ? tph_[0] : tm_; tph_[1] = TPHX == 1 ? tm_ : rt(); if (BOTH(0)) GRID_BAR(); }
    if (false) {
#else
    if (IN(0)) { for (int rep = 0; rep < REP0; ++rep) p0_prologue(F, defer_wout);
#endif
        if (BOTH(0)) for (int rep = 0; rep < REPBAR; ++rep) GRID_BAR(); }
#if !(defined(TPH) && defined(TPHX))
    TS(1);
#endif

    if (IN(1)) {
        pg8::Gemm g{F.XN, F.WinT, M + NBATCH * MEMLEN, 6656 + 1024, DMODEL}; pg8::InOrder S; S.init(F.G, (int)blockIdx.x, REP1, (unsigned*)F.ctl, F.MISC + 8);
        pg8::EpiIn E{F.PA, F.PB, F.PC, F.MIX, F.KVM, F.GATES};
#ifndef P1_ALIGN
#define P1_ALIGN true
#endif
        pg8::gemm_phase<pg8::EpiIn, pg8::InOrder, P1_ALIGN, true>(F.lds + RING_OFF, g, S, E);
        if (defer_wout && blockIdx.x >= 160) p0_wout_items(F, ((int)blockIdx.x - 160) * NWAVES + F.wave, 96 * NWAVES);
        if (S.late() && F.tid == 0) S.announce();
        TS(2);
        if (BOTH(1) && N_LAUNCHES == PER_PHASE) GRID_BAR();
    }

    if (IN(2)) {
        if (IN(1) && N_LAUNCHES != PER_PHASE && F.G == 256 && REP1 == 1) { const int bx = (int)blockIdx.x; F.ap_stride = 1;
#ifndef SHARE_H
#define SHARE_H 10
#endif
            constexpr int nH = SHARE_H, TL = 2048 - 96 * nH, qL = TL / 160, rL = TL % 160;
            static_assert(TL >= 0, "P2 shares");
            if (bx >= 160) { F.ap_it0 = (bx - 160) * nH; F.ap_nit = nH; } else if (bx < rL) { F.ap_it0 = 96 * nH + bx * (qL + 1); F.ap_nit = qL + 1; } else { F.ap_it0 = 96 * nH + rL * (qL + 1) + (bx - rL) * qL; F.ap_nit = qL; } }
        else { F.ap_it0 = F.vcu; F.ap_stride = F.G; F.ap_nit = (F.vcu < 2048) ? (2048 - F.vcu + F.G - 1) / F.G : 0; }
        if (IN(1) && N_LAUNCHES != PER_PHASE) {
            if (F.tid == 0) { unsigned* ctl_ = (unsigned*)F.ctl; const unsigned nx = F.MISC[9];
                XB_SPIN(xb_ld(&ctl_[pg8::InOrder::ADONE_G]) < nx, ctl_ + CW_BAR);
                __builtin_amdgcn_fence(__ATOMIC_ACQUIRE, "agent"); asm volatile("s_waitcnt vmcnt(0)" ::: "memory"); }
            __syncthreads();
        }
#if defined(TPH) && defined(TPA)
        unsigned long long tacc_[3] = {0ull, 0ull, 0ull}; a_prep_phase(F, tacc_); tpa_ = tacc_[TPA];
#else
        for (int rep = 0; rep < REP2A; ++rep) a_prep_phase(F);
#endif
        TS(3);
        if (BOTH(2)) GRID_BAR();
        TS(4);
    }

    if (IN(3)) {
        for (int rep = 0; rep < REP3; ++rep) if ((F.vcu & 1) == 0) for (int it = F.vcu >> 1; it < 128; it += (F.G + 1) >> 1) scan_unit(F.lds, F.tid, F.wsb, F.dbo, F.CD, F.OF, F.OB, F.ctl + CW_PROG + it, it >> 1, it & 1);
#ifdef TPHS
        TS(5);
#endif
#ifdef BCDELAY
        if ((F.vcu & 1) == 1) { const unsigned long long t0_ = rt(); while (rt() - t0_ < (unsigned long long)(BCDELAY)) __builtin_amdgcn_s_sleep(8); }
#endif
        for (;;) {
            if (F.tid == 0) F.MISC[16] = __hip_atomic_fetch_add(F.ctl + CW_WQ, 1u, RLX_AGENT);
            __syncthreads();
            const unsigned id = F.MISC[16];
            __syncthreads();
            if (id >= 512u * REP2B) break;
            const int it = (int)(id & 255u);
            if ((id & 511u) < 256u) b_attn_unit(F, it >> 5, (it >> 1) & 15, it & 1, id < 512u ? F.MIX : DRY);
            else c_attn_unit(F, it >> 5, (it >> 3) & 3, it & 7, id < 512u ? F.MIX : DRY);
        }
#ifdef PARTNER_PREFETCH
        if ((F.vcu & 1) == 1 && (F.vcu >> 1) < 128 && F.wave == 0) {
            const int it = F.vcu >> 1, dir = it & 1, item0 = ((it >> 1) * 2 + dir) * 32; gu32* prog = F.ctl + CW_PROG + it; unsigned acc_ = 0u;
            int k = 0; const unsigned long long t0 = rt();
            while (k < 32) {
                const unsigned done = (unsigned)__builtin_amdgcn_readfirstlane((int)__hip_atomic_load(prog, RLX_AGENT));
                if ((int)done >= 32 || rt() - t0 > 30000ull) break;
                if (k < (int)done + 4) k = (int)done + 4;
                if (k > (int)done + 5 || k >= 32) { if (k >= 32 && (int)done >= 27) break; __builtin_amdgcn_s_sleep(8); continue; }
                const unsigned char* blk = (const unsigned char*)shared_blk(F.wsb, item0 + (dir ? 31 - k : k));
#pragma unroll
                for (int q = 0; q < 4; ++q) { const int ln = F.lane + 64 * q; acc_ ^= *(const volatile unsigned*)(blk + (size_t)ln * 128); }
                ++k;
            }
            if (acc_ == 0x2468ace1u) F.ctl[202] = acc_;
        }
#endif
#ifndef TPHS
        TS(5);
#endif
        if (BOTH(3)) GRID_BAR();
        TS(6);
    }

    if (IN(4)) {
        const int gw = F.vcu * NWAVES + F.wave, NGW = F.G * NWAVES;
        for (int rep = 0; rep < REP4; ++rep) for (int m = gw; m < M; m += NGW) combine_row(F, (size_t)m, rep == REP4 - 1 ? F.MIX : DRY);
#if defined(TPH) && defined(TPHP4)
        tp4w_ = rt();
#endif
        if (BOTH(4)) GRID_BAR();
    }

#if defined(TPH) && defined(TPHP4)
    tph_[6] = (TPHP4 == 2) ? rt() : tph_[6]; const unsigned long long tp4_ = rt();
#endif
    if (IN(5)) {
        pg8::Gemm g{F.MIX, F.WoutT, M, DMODEL, DMODEL}; pg8::RepOrder S; S.init(M, DMODEL, F.G, (int)blockIdx.x, REP5);
        pg8::EpiOut E{F.x, F.out};
#ifndef P5_ALIGN
#define P5_ALIGN false
#endif
        pg8::gemm_phase<pg8::EpiOut, pg8::RepOrder, P5_ALIGN, true>(F.lds + RING_OFF, g, S, E);
    }
#ifdef TPH
    tph_[7] = rt();
#if defined(TPHP4)
    if (TPHP4 == 1) tph_[7] = tp4_;
    if (TPHP4 == 3) tph_[7] = tp4w_;
#endif
#if defined(TPA)
    tph_[TPH] = 0; tph_[TPH + 1] = tpa_;
#endif
    if ((int)blockIdx.x == TPHCU) { const unsigned long long d_ = (TPH == 7) ? tph_[7] - tph_[0] : tph_[TPH + 1] - tph_[TPH], t0_ = rt(); while (rt() - t0_ < d_) __builtin_amdgcn_s_sleep(8); }
#endif
#undef IN
#undef BOTH
}

extern "C" void kernel_launch(void* const* d_in, const int* in_sizes, int n_in, void* d_out, int out_size, void* d_ws, size_t ws_size, hipStream_t stream) {
    static int grid = 0;
    if (grid == 0) {
        if (n_in != 18 || in_sizes[0] != M * DMODEL || out_size != M * DMODEL || ws_size < WS_END) { fprintf(stderr, "kernel_launch: unexpected problem shape (n_in %d, in0 %d, out %d, ws %zu); nothing launched\n", n_in, n_in > 0 ? in_sizes[0] : -1, out_size, ws_size); grid = -1; return; }
        int dev = 0, cus = 0, per_cu = 0;
        if (hipGetDevice(&dev) != hipSuccess || hipDeviceGetAttribute(&cus, hipDeviceAttributeMultiprocessorCount, dev) != hipSuccess) { fprintf(stderr, "kernel_launch: device query failed\n"); grid = -1; return; }
        if (hipFuncSetAttribute((const void*)hybrid_fwd, hipFuncAttributeMaxDynamicSharedMemorySize, LDS_BYTES) != hipSuccess) { fprintf(stderr, "kernel_launch: hipFuncSetAttribute failed\n"); grid = -1; return; }
        if (hipOccupancyMaxActiveBlocksPerMultiprocessor(&per_cu, (const void*)hybrid_fwd, NWAVES * 64, LDS_BYTES) != hipSuccess || per_cu < 1)
            fprintf(stderr, "kernel_launch: note: occupancy query reports %d workgroups per CU\n", per_cu);
        (void)hipGetLastError();
        grid = cus;
    }
    if (grid < 0) return;
    if (hipMemsetAsync((char*)d_ws + WS_CTL, 0, CTL_ZERO_BYTES, stream) != hipSuccess) { fprintf(stderr, "kernel_launch: hipMemsetAsync failed\n"); return; }
    Args a{};
    for (int i = 0; i < 18; ++i) a.in[i] = (const float*)d_in[i];
    a.out = (float*)d_out; a.ws = (unsigned char*)d_ws;
    for (int li = 0; li < N_LAUNCHES; ++li) {
        a.ph_lo = (N_LAUNCHES == PER_PHASE) ? li : 0; a.ph_hi = (N_LAUNCHES == PER_PHASE) ? li + 1 : PER_PHASE; a.li = li;
        hipLaunchKernelGGL(hybrid_fwd, dim3(grid), dim3(NWAVES * 64), LDS_BYTES, stream, a);
        const hipError_t le = hipPeekAtLastError();
        if (le != hipSuccess) { fprintf(stderr, "kernel_launch: launch %d failed: %s\n", li, hipGetErrorName(le)); break; }
    }
}
```
